# Optimizing an MI355X kernel written in HIP

```python
import math
import jax, jax.numpy as jnp
from jax import lax
import numpy as np


D_MODEL = 1024
BATCH = 32
SEQ = 2048
DEPTH = 1
DEC_BATCH = 2
DEC_SEQ = 8192
PAST_LEN = 128

GRID_W = 64
RW_HEAD = 64
RW_HEADS = D_MODEL // RW_HEAD
RW_WIDTH = RW_HEADS * RW_HEAD
W_RANK = 64
A_RANK = 64
G_RANK = 128
DECAY_SCALE = math.exp(-0.5)
GN_EPS = 64e-5
ATT_HEAD = 128
ATT_Q_HEADS = D_MODEL // ATT_HEAD
ATT_KV_HEADS = 2
ATT_GROUP = ATT_Q_HEADS // ATT_KV_HEADS
ATT_Q = ATT_Q_HEADS * ATT_HEAD
ATT_KV = ATT_KV_HEADS * ATT_HEAD
Q_BLOCK = 128
ROPE_THETA = 10000.0
RMS_EPS = 1e-6
N_BRANCH = 2
D_FF = 4 * D_MODEL
LN_EPS = 1e-5
ALPHA = (2 * DEPTH) ** 0.25
BETA = (8 * DEPTH) ** -0.25
RW_SPLIT = [RW_WIDTH, RW_WIDTH, RW_WIDTH, 2 * W_RANK, 2 * A_RANK, G_RANK]
RW_COLS = sum(RW_SPLIT)
IN_SPLIT = [RW_COLS, ATT_Q, ATT_KV, ATT_KV, N_BRANCH * D_MODEL]
IN_COLS = sum(IN_SPLIT)

kernel_name = 'hybrid_rwkv7_axial_gqa_encoder'


def _offsets(sizes):
    out, acc = [], 0
    for s in sizes[:-1]:
        acc += s
        out.append(acc)
    return out


def _layernorm(x, g, b, eps):
    xf = x.astype(jnp.float32)
    mu = jnp.mean(xf, axis=-1, keepdims=True)
    var = jnp.mean(jnp.square(xf - mu), axis=-1, keepdims=True)
    return ((xf - mu) * lax.rsqrt(var + eps) * g + b).astype(x.dtype)


def _rmsnorm(x, g):
    xf = x.astype(jnp.float32)
    return (xf * lax.rsqrt(jnp.mean(xf * xf, axis=-1, keepdims=True) + RMS_EPS) * g).astype(x.dtype)


def _wkv_scan(r, w, kh, ak, v, kt, reverse):
    T, B, H, N = r.shape
    def step(S, inp):
        r_t, w_t, kh_t, ak_t, v_t, kt_t = inp
        sk = jnp.einsum('bhvk,bhk->bhv', S, kh_t)
        S = S * w_t[:, :, None, :] - sk[..., None] * ak_t[:, :, None, :] + v_t[..., None] * kt_t[:, :, None, :]
        return S, jnp.einsum('bhvk,bhk->bhv', S, r_t)
    S0 = jnp.zeros((B, H, N, N), jnp.float32)
    _, o = lax.scan(step, S0, (r, w, kh, ak, v, kt), reverse=reverse)
    return o


def _rwkv7_branch(z, mu_prev, mu_next, w0, w_up, a0, a_up, g_up, k_k, k_a, r_k, gn_g, gn_b):
    B, T, _ = z.shape
    H, N, C = RW_HEADS, RW_HEAD, RW_WIDTH
    f32 = jnp.float32
    z_prev = jnp.pad(z[:, :-1], ((0, 0), (1, 0), (0, 0)))
    z_next = jnp.pad(z[:, 1:], ((0, 0), (0, 1), (0, 0)))
    z = z + mu_prev * (z_prev - z) + mu_next * (z_next - z)
    r, k, v, wd, ad, gd = jnp.split(z, _offsets(RW_SPLIT), axis=-1)
    w_log = w0 + jnp.einsum('btdr,drc->btdc', jnp.tanh(wd.reshape(B, T, 2, W_RANK)), w_up)
    decay = jnp.exp(-DECAY_SCALE * jax.nn.sigmoid(w_log.astype(f32)))
    a = jax.nn.sigmoid((a0 + jnp.einsum('btdr,drc->btdc', ad.reshape(B, T, 2, A_RANK), a_up)).astype(f32))
    g = jnp.einsum('btr,rc->btc', jax.nn.sigmoid(gd), g_up)
    kf = k.astype(f32)
    kappa = (kf * k_k).reshape(B, T, 1, H, N)
    kappa_hat = kappa / jnp.maximum(jnp.sqrt(jnp.sum(kappa * kappa, axis=-1, keepdims=True)), 1e-12)
    k_tilde = (kf[:, :, None, :] * (1.0 + (a - 1.0) * k_a)).reshape(B, T, 2, H, N)
    ak = a.reshape(B, T, 2, H, N) * kappa_hat
    decay = decay.reshape(B, T, 2, H, N)
    r_h = r.astype(f32).reshape(B, T, H, N)
    v_h = v.astype(f32).reshape(B, T, H, N)
    tm = lambda u: jnp.moveaxis(u, 1, 0)
    r_t, v_t, kh_t = tm(r_h), tm(v_h), tm(kappa_hat[:, :, 0])
    o_f = _wkv_scan(r_t, tm(decay[:, :, 0]), kh_t, tm(ak[:, :, 0]), v_t, tm(k_tilde[:, :, 0]), False)
    o_b = _wkv_scan(r_t, tm(decay[:, :, 1]), kh_t, tm(ak[:, :, 1]), v_t, tm(k_tilde[:, :, 1]), True)
    o = jnp.moveaxis(o_f + o_b, 0, 1)
    o = _layernorm(o, gn_g.reshape(H, N), gn_b.reshape(H, N), GN_EPS)
    bonus = jnp.sum(r_h * jnp.sum(k_tilde, axis=2) * r_k.reshape(H, N), axis=-1, keepdims=True) * v_h
    return ((o + bonus).reshape(B, T, C) * g).astype(z.dtype)


def _axial_rope(T):
    rows = T // GRID_W
    row = jnp.repeat(jnp.arange(rows, dtype=jnp.float32), GRID_W)
    col = jnp.tile(jnp.arange(GRID_W, dtype=jnp.float32), rows)
    half = ATT_HEAD // 2
    inv = ROPE_THETA ** (-jnp.arange(0, half, 2, dtype=jnp.float32) / half)
    ang = jnp.stack([row[:, None] * inv, col[:, None] * inv], axis=1)
    ang = jnp.broadcast_to(ang[:, :, None, :], (T, 2, 2, half // 2)).reshape(T, ATT_HEAD)
    return jnp.cos(ang), jnp.sin(ang)


def _apply_rope(x, cos, sin):
    xs = x.reshape(x.shape[:-1] + (2, 2, ATT_HEAD // 4))
    rot = jnp.stack([-xs[..., 1, :], xs[..., 0, :]], axis=-2).reshape(x.shape)
    return (x * cos[None, :, None, :] + rot * sin[None, :, None, :]).astype(x.dtype)


def _attention_branch(q, k, v, q_norm, k_norm):
    B, T, _ = q.shape
    q = _rmsnorm(q.reshape(B, T, ATT_Q_HEADS, ATT_HEAD), q_norm)
    k = _rmsnorm(k.reshape(B, T, ATT_KV_HEADS, ATT_HEAD), k_norm)
    v = v.reshape(B, T, ATT_KV_HEADS, ATT_HEAD)
    cos, sin = _axial_rope(T)
    q = _apply_rope(q, cos, sin)
    k = _apply_rope(k, cos, sin)
    qb = q.reshape(B, T // Q_BLOCK, Q_BLOCK, ATT_KV_HEADS, ATT_GROUP, ATT_HEAD)
    qb = jnp.moveaxis(qb, 1, 0)
    scale = ATT_HEAD ** -0.5
    def block(qi):
        s = jnp.einsum('bqhgd,bkhd->bhgqk', qi, k).astype(jnp.float32) * scale
        p = jax.nn.softmax(s, axis=-1).astype(v.dtype)
        return jnp.einsum('bhgqk,bkhd->bqhgd', p, v)
    o = lax.map(block, qb)
    return jnp.moveaxis(o, 0, 1).reshape(B, T, ATT_Q)


def _encoder_layer(x, w_in, rw_mu_prev, rw_mu_next, rw_w0, rw_w_up, rw_a0, rw_a_up, rw_g_up,
                   rw_k_k, rw_k_a, rw_r_k, rw_gn_g, rw_gn_b, q_norm, k_norm,
                   w_proj_rwkv, w_proj_attn, w_out, ln1_g, ln1_b, w_ff1, w_ff2, ln2_g, ln2_b):
    B, T, D = x.shape
    z = jnp.einsum('btd,dc->btc', x, w_in)
    z_rw, q, k, v, gate_logits = jnp.split(z, _offsets(IN_SPLIT), axis=-1)
    o_rw = _rwkv7_branch(z_rw, rw_mu_prev, rw_mu_next, rw_w0, rw_w_up, rw_a0, rw_a_up, rw_g_up,
                         rw_k_k, rw_k_a, rw_r_k, rw_gn_g, rw_gn_b)
    o_att = _attention_branch(q, k, v, q_norm, k_norm)
    gates = jax.nn.sigmoid(gate_logits.astype(jnp.float32)).astype(x.dtype).reshape(B, T, N_BRANCH, D)
    merged = (gates[:, :, 0] * jnp.einsum('btc,cd->btd', o_rw, w_proj_rwkv)
              + gates[:, :, 1] * jnp.einsum('btc,cd->btd', o_att, w_proj_attn))
    mix = jnp.einsum('btd,de->bte', merged, w_out)
    h = _layernorm(ALPHA * x + mix, ln1_g, ln1_b, LN_EPS)
    ff = jnp.einsum('btf,fd->btd', jnp.square(jax.nn.relu(jnp.einsum('btd,df->btf', h, w_ff1))), w_ff2)
    return _layernorm(ALPHA * h + ff, ln2_g, ln2_b, LN_EPS)


def _trunk(x, params):
    h = x
    for l in range(DEPTH):
        h = _encoder_layer(h, *[p[l] for p in params])
    return h


def setup_inputs(seed: int = 0) -> dict:
    key = jax.random.key(seed)
    ks = iter(jax.random.split(key, 40))
    f32 = jnp.float32
    def nrm(shape, scale):
        return jax.random.normal(next(ks), shape, f32) * scale
    def unif(shape, lo, hi):
        return jax.random.uniform(next(ks), shape, f32, lo, hi)
    L, C, D = DEPTH, RW_WIDTH, D_MODEL
    return {
        'x_prompt': nrm((BATCH, SEQ, D), 1.0),
        'x_sample': nrm((DEC_BATCH, DEC_SEQ, D), 1.0),
        'w_in': nrm((L, D, IN_COLS), D ** -0.5),
        'rw_mu_prev': unif((L, RW_COLS), 0.0, 0.5),
        'rw_mu_next': unif((L, RW_COLS), 0.0, 0.5),
        'rw_w0': nrm((L, 2, C), 0.5) - 1.0,
        'rw_w_up': nrm((L, 2, W_RANK, C), 0.5 * W_RANK ** -0.5),
        'rw_a0': nrm((L, 2, C), 0.5),
        'rw_a_up': nrm((L, 2, A_RANK, C), 0.5 * A_RANK ** -0.5),
        'rw_g_up': nrm((L, G_RANK, C), G_RANK ** -0.5),
        'rw_k_k': 0.85 + nrm((L, C), 0.1),
        'rw_k_a': 1.0 + nrm((L, C), 0.1),
        'rw_r_k': nrm((L, C), 0.1),
        'rw_gn_g': 1.0 + nrm((L, C), 0.1),
        'rw_gn_b': nrm((L, C), 0.01),
        'q_norm': 1.0 + nrm((L, ATT_HEAD), 0.1),
        'k_norm': 1.0 + nrm((L, ATT_HEAD), 0.1),
        'w_proj_rwkv': nrm((L, C, D), BETA * C ** -0.5),
        'w_proj_attn': nrm((L, ATT_Q, D), BETA * ATT_Q ** -0.5),
        'w_out': nrm((L, D, D), BETA * D ** -0.5),
        'ln1_g': 1.0 + nrm((L, D), 0.1),
        'ln1_b': nrm((L, D), 0.01),
        'w_ff1': nrm((L, D, D_FF), BETA * D ** -0.5),
        'w_ff2': nrm((L, D_FF, D), BETA * D_FF ** -0.5),
        'ln2_g': 1.0 + nrm((L, D), 0.1),
        'ln2_b': nrm((L, D), 0.01),
    }


def reference(x_prompt, x_sample, w_in, rw_mu_prev, rw_mu_next, rw_w0, rw_w_up, rw_a0, rw_a_up,
              rw_g_up, rw_k_k, rw_k_a, rw_r_k, rw_gn_g, rw_gn_b, q_norm, k_norm,
              w_proj_rwkv, w_proj_attn, w_out, ln1_g, ln1_b, w_ff1, w_ff2, ln2_g, ln2_b):
    params = (w_in, rw_mu_prev, rw_mu_next, rw_w0, rw_w_up, rw_a0, rw_a_up, rw_g_up,
              rw_k_k, rw_k_a, rw_r_k, rw_gn_g, rw_gn_b, q_norm, k_norm,
              w_proj_rwkv, w_proj_attn, w_out, ln1_g, ln1_b, w_ff1, w_ff2, ln2_g, ln2_b)
    y_prompt = _trunk(x_prompt, params)
    y_sample = _trunk(x_sample, params)
    return (y_prompt, y_sample)
```

```cpp
#include <hip/hip_runtime.h>
#include <hip/hip_bf16.h>
#include <hip/hip_cooperative_groups.h>
#include <cstdio>
#include <cstdint>
namespace cg = cooperative_groups;
namespace pg8 {
#define PG8_LAS __attribute__((address_space(3)))
typedef unsigned short bf16_t;
typedef short bf16x8 __attribute__((ext_vector_type(8)));
typedef float f32x4 __attribute__((ext_vector_type(4)));
typedef unsigned u32x4 __attribute__((ext_vector_type(4)));
constexpr int BM = 256, BK = 64, HALF = 128, HTB = HALF * BK * 2  , STAGE_BYTES = 8 * HTB, NXCD = 8, WGM = 8;

__host__ __device__ __forceinline__ int lds_byte(int r, int c) { const int st = (r >> 4) * 2 + (c >> 5), rr = r & 15, cc = c & 31, ob = rr * 64 + cc * 2; return st * 1024 + (ob ^ (((ob >> 9) & 1) << 5)); }
__host__ __device__ __forceinline__ void stage_rc(int b, int& R, int& C) { const int st = b / 1024, sb = b % 1024, swz = sb ^ (((sb >> 9) & 1) << 5); R = (st >> 1) * 16 + swz / 64; C = (st & 1) * 32 + (swz % 64) / 2; }
__host__ __device__ __forceinline__ int perm32(int rho) { const int n = rho >> 4, i = rho & 15; return 8 * (i >> 2) + 4 * n + (i & 3); }

struct Unit { int pm, pn; };
struct Gemm { const bf16_t* A; const bf16_t* Bt; int M, N, K; };

struct StaticOrder {
    int nM, nN, nwg, G, c;
    __host__ __device__ void init(int M, int N, int G_, int c_) { nM = M / BM; nN = N / BM; nwg = nM * nN; G = G_; c = c_; }
    __host__ __device__ bool next(int i, Unit& u) const {
        const long L = (long)i * G + c; if (L >= nwg) return false;
        int wgid = (int)L; { const int q = nwg / NXCD, r = nwg % NXCD, xcd = wgid % NXCD, off = wgid / NXCD; wgid = (xcd < r ? xcd * (q + 1) : r * (q + 1) + (xcd - r) * q) + off; }
        const int nig = WGM * nN, gid = wgid / nig, fm = gid * WGM, gsz = (nM - fm) < WGM ? (nM - fm) : WGM;
        u.pm = fm + ((wgid % nig) % gsz); u.pn = (wgid % nig) / gsz; return true;
    }
    __device__ __forceinline__ void a_ready(const Unit&) const {}
    __device__ __forceinline__ void done(const Unit&) const {}
};
__device__ __forceinline__ unsigned cvt_pk_bf16(float lo, float hi) { unsigned r; asm volatile("v_cvt_pk_bf16_f32 %0, %1, %2" : "=v"(r) : "v"(lo), "v"(hi)); return r; }
typedef float f32x2 __attribute__((ext_vector_type(2)));
template <class Epi, class Sched, bool ALIGN_EPI = false, bool SP2 = false>
__device__ __forceinline__ void gemm_phase(PG8_LAS unsigned char* lds, const Gemm g, const Sched& S, const Epi& E) {
    int tid_ = threadIdx.x; asm volatile("" : "+v"(tid_));
    const int tid = tid_, wid = __builtin_amdgcn_readfirstlane(tid >> 6), lane = tid & 63, wr = wid >> 2, wc = wid & 3, fr = lane & 15, fq = lane >> 4;
    const int K = g.K, nt = K / BK;
    unsigned voffA[2], voffB[2];
#pragma unroll
    for (int i = 0; i < 2; ++i) { int R, C; stage_rc(tid * 16 + i * 8192, R, C); const int Rb = Epi::PERM ? ((R & ~31) + perm32(R & 31)) : R;
        voffA[i] = (unsigned)(R * K + C) * 2u; voffB[i] = (unsigned)(Rb * K + C) * 2u; }
    const size_t kstep = (size_t)(BK * 2);
    const size_t hstep = (size_t)HALF * K * 2;
    const size_t tstep = 2 * hstep;
    const unsigned ldsw = (unsigned)wid * 1024u;
    const int aoff = lds_byte(wr * 64 + fr, fq * 8), boff = lds_byte(wc * 32 + fr, fq * 8);
#define PG8_SA(b, h) (((b) * 2 + (h)) * HTB)
#define PG8_SB(b, h) ((4 + (b) * 2 + (h)) * HTB)
#define PG8_STAGE(bufoff, gbase, voff) do { _Pragma("unroll") for (int _i = 0; _i < 2; ++_i) \
        __builtin_amdgcn_global_load_lds((const unsigned*)((const char*)(gbase) + (voff)[_i]), (PG8_LAS unsigned*)(lds + (bufoff) + ldsw + _i * 8192), 16, 0, 0); } while (0)
#define PG8_LDA(dst, b, h) do { _Pragma("unroll") for (int m = 0; m < 4; ++m) _Pragma("unroll") for (int k = 0; k < 2; ++k) dst[m][k] = *(const PG8_LAS bf16x8*)(lds + PG8_SA(b, h) + aoff + m * 2048 + k * 1024); } while (0)
#define PG8_LDB(dst, b, h) do { _Pragma("unroll") for (int n = 0; n < 2; ++n) _Pragma("unroll") for (int k = 0; k < 2; ++k) dst[n][k] = *(const PG8_LAS bf16x8*)(lds + PG8_SB(b, h) + boff + n * 2048 + k * 1024); } while (0)
#define PG8_MMA(ai, bj, At, Bt) do { __builtin_amdgcn_s_setprio(1); _Pragma("unroll") for (int m = 0; m < 4; ++m) _Pragma("unroll") for (int n = 0; n < 2; ++n) _Pragma("unroll") for (int k = 0; k < 2; ++k) \
        acc[ai][bj][m][n] = __builtin_amdgcn_mfma_f32_16x16x32_bf16(Bt[n][k], At[m][k], acc[ai][bj][m][n], 0, 0, 0); __builtin_amdgcn_s_setprio(0); } while (0)
#define PG8_WAIT_V(n) asm volatile("s_waitcnt vmcnt(" #n ")" ::: "memory")
#define PG8_WAIT_L(n) asm volatile("s_waitcnt lgkmcnt(" #n ")" ::: "memory")
#define PG8_BAR __builtin_amdgcn_s_barrier()
#define PG8_SCHED __builtin_amdgcn_sched_barrier(0)
    Unit cur, nxt; int ui = 0;
    if (!S.next(0, cur)) return;
    f32x4 acc[2][2][4][2];
#pragma unroll
    for (int a = 0; a < 2; ++a)
#pragma unroll
        for (int b = 0; b < 2; ++b)
#pragma unroll
            for (int m = 0; m < 4; ++m)
#pragma unroll
                for (int n = 0; n < 2; ++n) acc[a][b][m][n] = (f32x4){0.f, 0.f, 0.f, 0.f};
    bf16x8 At[4][2], B0[2][2], B1[2][2];
    const char* cA = (const char*)g.A + (size_t)cur.pm * tstep; const char* cB = (const char*)g.Bt + (size_t)cur.pn * tstep;
    S.a_ready(cur);
    if constexpr (SP2) {
        PG8_STAGE(PG8_SB(0, 0), cB, voffB); PG8_STAGE(PG8_SB(0, 1), cB + hstep, voffB); PG8_STAGE(PG8_SA(0, 0), cA, voffA); PG8_STAGE(PG8_SA(0, 1), cA + hstep, voffA);
        if (wr == 1) PG8_BAR;
        PG8_WAIT_V(2); PG8_BAR;
        PG8_STAGE(PG8_SB(1, 0), cB + kstep, voffB); PG8_STAGE(PG8_SA(1, 0), cA + kstep, voffA); PG8_STAGE(PG8_SB(1, 1), cB + hstep + kstep, voffB);
        PG8_WAIT_V(6); PG8_BAR;
    } else {
        PG8_STAGE(PG8_SB(0, 0), cB, voffB); PG8_STAGE(PG8_SA(0, 0), cA, voffA); PG8_STAGE(PG8_SB(0, 1), cB + hstep, voffB); PG8_STAGE(PG8_SA(0, 1), cA + hstep, voffA);
        if (wr == 1) PG8_BAR;
        PG8_WAIT_V(4); PG8_BAR;
        PG8_STAGE(PG8_SB(1, 0), cB + kstep, voffB); PG8_STAGE(PG8_SA(1, 0), cA + kstep, voffA); PG8_STAGE(PG8_SB(1, 1), cB + hstep + kstep, voffB);
        PG8_WAIT_V(6); PG8_BAR;
    }
    for (;;) {
        const bool has_next = S.next(ui + 1, nxt);
        const char* nA = has_next ? (const char*)g.A + (size_t)nxt.pm * tstep : cA; const char* nB = has_next ? (const char*)g.Bt + (size_t)nxt.pn * tstep : cB;
        for (int t = 0; t < nt; t += 2) {
            const bool last = (t == nt - 2);
            const char* a1 = cA + (size_t)(t + 1) * kstep;
            const char* a2 = last ? nA : cA + (size_t)(t + 2) * kstep; const char* b2 = last ? nB : cB + (size_t)(t + 2) * kstep;
            const char* a3 = a2 + kstep; const char* b3 = b2 + kstep;
            if (last && has_next) S.a_ready(nxt);
            if constexpr (SP2) {
            PG8_LDB(B0, 0, 0); PG8_LDB(B1, 0, 1); PG8_SCHED; PG8_LDA(At, 0, 0); PG8_STAGE(PG8_SA(1, 1), a1 + hstep, voffA);
            PG8_WAIT_V(8); PG8_WAIT_L(0); PG8_BAR; PG8_MMA(0, 0, At, B0); PG8_MMA(0, 1, At, B1); PG8_BAR; PG8_SCHED;
            PG8_LDA(At, 0, 1); PG8_STAGE(PG8_SB(0, 0), b2, voffB); PG8_STAGE(PG8_SB(0, 1), b2 + hstep, voffB); PG8_STAGE(PG8_SA(0, 0), a2, voffA);
            PG8_WAIT_V(8); PG8_WAIT_L(0); PG8_BAR; PG8_MMA(1, 0, At, B0); PG8_MMA(1, 1, At, B1); PG8_BAR; PG8_SCHED;
            PG8_LDB(B0, 1, 0); PG8_LDB(B1, 1, 1); PG8_SCHED; PG8_LDA(At, 1, 0); PG8_STAGE(PG8_SA(0, 1), a2 + hstep, voffA);
            PG8_WAIT_V(8); PG8_WAIT_L(0); PG8_BAR; PG8_MMA(0, 0, At, B0); PG8_MMA(0, 1, At, B1); PG8_BAR; PG8_SCHED;
            PG8_LDA(At, 1, 1); PG8_STAGE(PG8_SB(1, 0), b3, voffB); PG8_STAGE(PG8_SB(1, 1), b3 + hstep, voffB); PG8_STAGE(PG8_SA(1, 0), a3, voffA);
            PG8_WAIT_V(8); PG8_WAIT_L(0); PG8_BAR; PG8_MMA(1, 0, At, B0); PG8_MMA(1, 1, At, B1); PG8_BAR; PG8_SCHED;
            } else {
            PG8_LDB(B0, 0, 0); PG8_SCHED; PG8_LDA(At, 0, 0); PG8_STAGE(PG8_SA(1, 1), a1 + hstep, voffA);
            PG8_WAIT_L(8); PG8_BAR; PG8_WAIT_L(0); PG8_MMA(0, 0, At, B0); PG8_BAR; PG8_SCHED;
            PG8_LDB(B1, 0, 1); PG8_STAGE(PG8_SB(0, 0), b2, voffB);
            PG8_BAR; PG8_WAIT_L(0); PG8_MMA(0, 1, At, B1); PG8_BAR;
            PG8_LDA(At, 0, 1); PG8_STAGE(PG8_SA(0, 0), a2, voffA);
            PG8_BAR; PG8_WAIT_L(0); PG8_MMA(1, 0, At, B0); PG8_BAR; PG8_SCHED;
            PG8_STAGE(PG8_SB(0, 1), b2 + hstep, voffB);
            PG8_WAIT_V(6); PG8_BAR; PG8_MMA(1, 1, At, B1); PG8_BAR;
            PG8_LDB(B0, 1, 0); PG8_SCHED; PG8_LDA(At, 1, 0); PG8_STAGE(PG8_SA(0, 1), a2 + hstep, voffA);
            PG8_WAIT_L(8); PG8_BAR; PG8_WAIT_L(0); PG8_MMA(0, 0, At, B0); PG8_BAR; PG8_SCHED;
            PG8_LDB(B1, 1, 1); PG8_STAGE(PG8_SB(1, 0), b3, voffB);
            PG8_BAR; PG8_WAIT_L(0); PG8_MMA(0, 1, At, B1); PG8_BAR;
            PG8_LDA(At, 1, 1); PG8_STAGE(PG8_SA(1, 0), a3, voffA);
            PG8_BAR; PG8_WAIT_L(0); PG8_MMA(1, 0, At, B0); PG8_BAR; PG8_SCHED;
            PG8_STAGE(PG8_SB(1, 1), b3 + hstep, voffB);
            PG8_WAIT_V(6); PG8_BAR; PG8_MMA(1, 1, At, B1); PG8_BAR;
            }
        }
        if constexpr (ALIGN_EPI) { if (wr == 0) PG8_BAR; }
        if constexpr (!Epi::AFTER_DRAIN) { E(acc, cur, wr, wc, fr, fq); S.done(cur); }
        if (!has_next) break;
#pragma unroll
        for (int a = 0; a < 2; ++a)
#pragma unroll
            for (int b = 0; b < 2; ++b)
#pragma unroll
                for (int m = 0; m < 4; ++m)
#pragma unroll
                    for (int n = 0; n < 2; ++n) acc[a][b][m][n] = (f32x4){0.f, 0.f, 0.f, 0.f};
        cur = nxt; cA = nA; cB = nB; ++ui;
        if constexpr (ALIGN_EPI) { if (wr == 1) PG8_BAR; }
    }
    PG8_WAIT_V(0);
    if constexpr (!ALIGN_EPI) { if (wr == 0) PG8_BAR; }
    PG8_BAR;
    if constexpr (Epi::AFTER_DRAIN) { E.fused(acc, cur, wr, wc, fr, fq, lds, wid, lane); S.done(cur); }
#undef PG8_SA
#undef PG8_SB
#undef PG8_STAGE
#undef PG8_LDA
#undef PG8_LDB
#undef PG8_MMA
#undef PG8_WAIT_V
#undef PG8_WAIT_L
#undef PG8_BAR
#undef PG8_SCHED
}
}
namespace att {
using bf16 = __hip_bfloat16;
constexpr int   D = 128, NW = 8, QBLK = 32, KVBLK = 64;
constexpr float SCALE = 0.088388347648318440f;
constexpr float THR = 8.f;
constexpr int LDQ = 7168, LDK = 7168, LDO = 1024;
constexpr size_t SHM_V = KVBLK * D * 2, SHM_K = KVBLK * D * 2, SHM_ATTN = 2 * SHM_V + 2 * SHM_K + NW * 64 * 4;
using bf16x8 = __attribute__((ext_vector_type(8))) short;
using s16x4  = __attribute__((ext_vector_type(4))) short;
using f32x16 = __attribute__((ext_vector_type(16))) float;
using u32x4  = __attribute__((ext_vector_type(4))) unsigned;
#define KSWZ(row, colB) ((row) * 256 + ((colB) ^ (((row) & 7) << 4)))
#define SBAR() __builtin_amdgcn_sched_barrier(0)
__device__ __forceinline__ int crow(int r, int hi) { return (r & 3) + 8 * (r >> 2) + 4 * hi; }
__device__ __forceinline__ unsigned cvtpk(float lo, float hi) {
  unsigned r; asm volatile("v_cvt_pk_bf16_f32 %0, %1, %2" : "=v"(r) : "v"(lo), "v"(hi)); return r;
}
__device__ __forceinline__ bf16x8 ld8(const bf16* p) { return *reinterpret_cast<const bf16x8*>(p); }
__device__ __forceinline__ void partialSM(f32x16& p0, f32x16& p1, float& m_reg, float& mn, float& alpha) {
  constexpr float C = SCALE * 1.4426950408889634f;
  float pmax = p0[0]; for (int r = 1; r < 16; ++r) pmax = fmaxf(pmax, p0[r]); for (int r = 0; r < 16; ++r) pmax = fmaxf(pmax, p1[r]);
  { auto rr = __builtin_amdgcn_permlane32_swap(__float_as_uint(pmax), __float_as_uint(pmax), false, false);
    pmax = fmaxf(__uint_as_float(rr[0]), __uint_as_float(rr[1])); }
  if (__builtin_expect(__all(pmax - m_reg <= THR / SCALE), 1)) { mn = m_reg; alpha = 1.f; }
  else { mn = fmaxf(m_reg, pmax); alpha = __builtin_amdgcn_exp2f((m_reg - mn) * C); m_reg = mn; }
  float mnC = -mn * C;
  for (int r = 0; r < 16; ++r) p0[r] = fmaf(p0[r], C, mnC); for (int r = 0; r < 16; ++r) p1[r] = fmaf(p1[r], C, mnC);
  for (int r = 0; r < 16; ++r) p0[r] = __builtin_amdgcn_exp2f(p0[r]);
}
__device__ __forceinline__ void finishSM(f32x16& p0, f32x16& p1, float alpha, float& l_reg, bf16x8& pa0, bf16x8& pa1, bf16x8& pa2, bf16x8& pa3) {
  for (int r = 0; r < 16; ++r) p1[r] = __builtin_amdgcn_exp2f(p1[r]);
  float ps = 0; for (int r = 0; r < 16; ++r) ps += p0[r]; for (int r = 0; r < 16; ++r) ps += p1[r];
  { auto rr = __builtin_amdgcn_permlane32_swap(__float_as_uint(ps), __float_as_uint(ps), false, false);
    ps = __uint_as_float(rr[0]) + __uint_as_float(rr[1]); }
  l_reg = l_reg * alpha + ps;
#define PK4(P, BASE, OUT) do { unsigned a0 = cvtpk(P[BASE + 0], P[BASE + 1]), a1 = cvtpk(P[BASE + 2], P[BASE + 3]);   \
    unsigned b0 = cvtpk(P[BASE + 4], P[BASE + 5]), b1 = cvtpk(P[BASE + 6], P[BASE + 7]);                              \
    auto r0 = __builtin_amdgcn_permlane32_swap(a0, b0, false, false); auto r1 = __builtin_amdgcn_permlane32_swap(a1, b1, false, false); \
    u32x4 w = {r0[0], r1[0], r0[1], r1[1]}; OUT = *reinterpret_cast<bf16x8*>(&w); } while (0)
  PK4(p0, 0, pa0); PK4(p0, 8, pa1); PK4(p1, 0, pa2); PK4(p1, 8, pa3);
#undef PK4
}
__device__ __forceinline__ void qkt(f32x16& p0, f32x16& p1, const bf16* Ks, const bf16x8* qr, int r32, int hi) {
  p0 = f32x16{}; p1 = f32x16{};
  for (int d0 = 0; d0 < 8; ++d0) { int cb = (d0 * 16 + hi * 8) * 2;
    bf16x8 b0 = *reinterpret_cast<const bf16x8*>((const char*)Ks + KSWZ(r32, cb));
    bf16x8 b1 = *reinterpret_cast<const bf16x8*>((const char*)Ks + KSWZ(32 + r32, cb));
    p0 = __builtin_amdgcn_mfma_f32_32x32x16_bf16(b0, qr[d0], p0, 0, 0, 0);
    p1 = __builtin_amdgcn_mfma_f32_32x32x16_bf16(b1, qr[d0], p1, 0, 0, 0); }
}
__device__ __forceinline__ int v_st(int k, int c) { const int kk = (k & ~0xC) | ((k & 4) << 1) | ((k & 8) >> 1); return ((kk >> 3) * 4 + (c >> 5)) * 512 + ((kk & 7) * 32 + (c & 31)) * 2; }
__device__ __forceinline__ int v_rd_base(int lane) { return ((lane & 3) << 3) | (((lane >> 2) & 3) << 6) | (((lane >> 4) & 1) << 5) | (((lane >> 5) & 1) << 8); }
constexpr int v_rd_off(int d0, int ks, int half) { return d0 * 512 + ks * 4096 + half * 2048; }
template <int OFF> __device__ __forceinline__ s16x4 tr_read(int vb) {
  s16x4 r; asm volatile("ds_read_b64_tr_b16 %0, %1 offset:%2" : "=&v"(r) : "v"(vb), "i"(OFF) : "memory"); return r;
}
template <int D0> __device__ __forceinline__ void pv_one(f32x16& od, int vb, bf16x8 pa0, bf16x8 pa1, bf16x8 pa2, bf16x8 pa3) {
  const s16x4 l0 = tr_read<v_rd_off(D0, 0, 0)>(vb), h0 = tr_read<v_rd_off(D0, 0, 1)>(vb), l1 = tr_read<v_rd_off(D0, 1, 0)>(vb), h1 = tr_read<v_rd_off(D0, 1, 1)>(vb);
  const s16x4 l2 = tr_read<v_rd_off(D0, 2, 0)>(vb), h2 = tr_read<v_rd_off(D0, 2, 1)>(vb), l3 = tr_read<v_rd_off(D0, 3, 0)>(vb), h3 = tr_read<v_rd_off(D0, 3, 1)>(vb);
  asm volatile("s_waitcnt lgkmcnt(0)" ::: "memory"); SBAR();
#define PK(L, H) (bf16x8){L[0], L[1], L[2], L[3], H[0], H[1], H[2], H[3]}
  od = __builtin_amdgcn_mfma_f32_32x32x16_bf16(pa0, PK(l0, h0), od, 0, 0, 0);
  od = __builtin_amdgcn_mfma_f32_32x32x16_bf16(pa1, PK(l1, h1), od, 0, 0, 0);
  od = __builtin_amdgcn_mfma_f32_32x32x16_bf16(pa2, PK(l2, h2), od, 0, 0, 0);
  od = __builtin_amdgcn_mfma_f32_32x32x16_bf16(pa3, PK(l3, h3), od, 0, 0, 0);
#undef PK
}
__device__ __forceinline__ void pv_d0(f32x16* o, int vb, bf16x8 pa0, bf16x8 pa1, bf16x8 pa2, bf16x8 pa3) {
  pv_one<0>(o[0], vb, pa0, pa1, pa2, pa3); pv_one<1>(o[1], vb, pa0, pa1, pa2, pa3); pv_one<2>(o[2], vb, pa0, pa1, pa2, pa3); pv_one<3>(o[3], vb, pa0, pa1, pa2, pa3);
}
__device__ __forceinline__ void attn_dense_body(const bf16* __restrict__ Qb, const bf16* __restrict__ Kh, const bf16* __restrict__ Vh,
                                                bf16* __restrict__ Ob, int seq, char* lds) {
  int tid_ = threadIdx.x; asm volatile("" : "+v"(tid_));
  const int tid = tid_, wid = tid >> 6, lane = tid & 63, r32 = lane & 31, hi = lane >> 5;
  bf16* V_lds = (bf16*)lds; bf16* K_lds = (bf16*)(lds + 2 * SHM_V);
  float* ws = (float*)(lds + 2 * SHM_V + 2 * SHM_K) + wid * 64; float* li_l = ws; float* al_l = ws + 32;
  float m_reg = -1e30f, l_reg = 0; f32x16 o[4] = {}; bf16x8 qr[8];
  const bf16* Qw = Qb + (long)(wid * QBLK + r32) * LDQ + hi * 8;
#pragma unroll
  for (int d0 = 0; d0 < 8; ++d0) qr[d0] = ld8(Qw + d0 * 16);
  const int sr = tid >> 4, sc = (tid & 15) * 8, vst0 = v_st(sr, sc), vst1 = v_st(32 + sr, sc);
  const int vb0 = (int)(uintptr_t)V_lds + v_rd_base(lane);
  struct { bf16x8 vs0, vs1, ks0, ks1; } sr_[2];
#define SLOAD(i, k0) do { sr_[i].vs0 = ld8(&Vh[(long)((k0) + sr) * LDK + sc]); sr_[i].vs1 = ld8(&Vh[(long)((k0) + 32 + sr) * LDK + sc]); \
    sr_[i].ks0 = ld8(&Kh[(long)((k0) + sr) * LDK + sc]); sr_[i].ks1 = ld8(&Kh[(long)((k0) + 32 + sr) * LDK + sc]); } while (0)
#define SWRITE(b, i) do { *(bf16x8*)((char*)V_lds + (b) * SHM_V + vst0) = sr_[i].vs0;          \
    *(bf16x8*)((char*)V_lds + (b) * SHM_V + vst1) = sr_[i].vs1; int kc = sc * 2;               \
    *(bf16x8*)((char*)K_lds + (b) * SHM_K + KSWZ(sr, kc)) = sr_[i].ks0;                       \
    *(bf16x8*)((char*)K_lds + (b) * SHM_K + KSWZ(32 + sr, kc)) = sr_[i].ks1; } while (0)
#define SWAIT() do { asm volatile("s_waitcnt vmcnt(4)" ::: "memory"); } while (0)
#define RESC(a) do { if (__any((a) < 1.f)) { if (hi == 0) al_l[r32] = (a); asm volatile("s_waitcnt lgkmcnt(0)" ::: "memory"); \
    for (int d = 0; d < 4; ++d) for (int r = 0; r < 16; ++r) o[d][r] *= al_l[crow(r, hi)]; } } while (0)
  f32x16 pA0, pA1, pB0, pB1; float mnA, mnB, alA, alB; bf16x8 pa0, pa1, pa2, pa3; const int NT = seq / KVBLK;
  constexpr int SE = 0, SO = 1;
  SLOAD(SE, 0); asm volatile("s_waitcnt vmcnt(0)" ::: "memory"); SWRITE(0, SE); __syncthreads();
  qkt(pA0, pA1, K_lds, qr, r32, hi); partialSM(pA0, pA1, m_reg, mnA, alA);
  SLOAD(SO, KVBLK); if (2 < NT) SLOAD(SE, 2 * KVBLK);
  SWAIT(); SWRITE(1, SO); __syncthreads();
  for (int j = 1; j + 1 < NT; j += 2) {
    SBAR(); qkt(pB0, pB1, (bf16*)((char*)K_lds + SHM_K), qr, r32, hi);
    finishSM(pA0, pA1, alA, l_reg, pa0, pa1, pa2, pa3); SBAR();
    SLOAD(SO, (j + 2) * KVBLK); SBAR();
    pv_d0(o, vb0, pa0, pa1, pa2, pa3); partialSM(pB0, pB1, m_reg, mnB, alB);
    __syncthreads(); SWAIT(); SWRITE(0, SE);
    RESC(alB); __syncthreads();
    SBAR(); qkt(pA0, pA1, K_lds, qr, r32, hi);
    finishSM(pB0, pB1, alB, l_reg, pa0, pa1, pa2, pa3); SBAR();
    if (j + 3 < NT) SLOAD(SE, (j + 3) * KVBLK); SBAR();
    pv_d0(o, vb0 + (int)SHM_V, pa0, pa1, pa2, pa3); partialSM(pA0, pA1, m_reg, mnA, alA);
    __syncthreads(); SWAIT(); SWRITE(1, SO);
    RESC(alA); __syncthreads();
  }
  SBAR(); qkt(pB0, pB1, (bf16*)((char*)K_lds + SHM_K), qr, r32, hi);
  finishSM(pA0, pA1, alA, l_reg, pa0, pa1, pa2, pa3); SBAR();
  pv_d0(o, vb0, pa0, pa1, pa2, pa3); partialSM(pB0, pB1, m_reg, mnB, alB);
  __syncthreads(); RESC(alB);
  finishSM(pB0, pB1, alB, l_reg, pa0, pa1, pa2, pa3); SBAR();
  pv_d0(o, vb0 + (int)SHM_V, pa0, pa1, pa2, pa3);
  if (hi == 0) li_l[r32] = l_reg; asm volatile("s_waitcnt lgkmcnt(0)" ::: "memory");
  float rli[16];
#pragma unroll
  for (int r = 0; r < 16; ++r) rli[r] = __builtin_amdgcn_rcpf(li_l[crow(r, hi)]);
  bf16* Ow = Ob + (long)(wid * QBLK) * LDO;
#pragma unroll
  for (int r = 0; r < 16; ++r) { int orow = crow(r, hi);
    for (int d0 = 0; d0 < 4; ++d0) Ow[(long)orow * LDO + d0 * 32 + r32] = __float2bfloat16(o[d0][r] * rli[r]); }
  __syncthreads();
#undef SLOAD
#undef SWRITE
#undef SWAIT
#undef RESC
}
#undef KSWZ
#undef SBAR
}
#define LAS __attribute__((address_space(3)))
typedef unsigned short bf16_t;
typedef float f32x4 __attribute__((ext_vector_type(4)));
typedef unsigned u32x4 __attribute__((ext_vector_type(4)));
typedef unsigned u32x2 __attribute__((ext_vector_type(2)));

#ifndef EXP_RW
#define EXP_RW 1.0f
#endif
#ifndef EXP_ATT
#define EXP_ATT 1.0f
#endif
#ifndef EXP_NOSCAN
#define EXP_NOSCAN 0
#endif
#ifndef EXP_ZFILL
#define EXP_ZFILL 0
#endif
#ifndef EXP_STATIC
#define EXP_STATIC 0
#endif
#ifndef EXP_TWICE
#define EXP_TWICE 0
#endif
#ifndef EXP_MIX
#define EXP_MIX 1.0f
#endif
#ifndef EN_SCAN
#define EN_SCAN 1
#endif
#ifndef EN_ATT
#define EN_ATT 1
#endif
#ifndef EN_PREP
#define EN_PREP 1
#endif
#ifndef EN_GEMM
#define EN_GEMM 1
#endif
constexpr int NWAVES = 8, NTHREADS = 512;
constexpr int D = 1024, FF = 4096, NIN = 7040, NINP = 7168, RWC = 3456;
constexpr int MC = 16384, NCHUNK = 5, MTOT = 81920;
constexpr float ALPHA = 1.189207115002721f;
constexpr float LN_EPS = 1e-5f, GN_EPS = 64e-5f, RMS_EPS = 1e-6f;
constexpr float DECAY_SCALE = 0.6065306597126334f;

constexpr size_t MiB = 1u << 20;
constexpr size_t WS_CTL = 0;
constexpr size_t WS_WIN = 1 * MiB, WS_WPR = 15 * MiB, WS_WPA = 17 * MiB, WS_WOUT = 19 * MiB, WS_WF1 = 21 * MiB, WS_WF2 = 29 * MiB;
constexpr size_t WS_WUP = 37 * MiB, WS_AUP = 37 * MiB + 512 * 1024, WS_GUP = 38 * MiB;
constexpr size_t WS_XB = 40 * MiB, WS_OF = 40 * MiB;
constexpr size_t WS_Z = 72 * MiB;
constexpr size_t WS_OPR = 296 * MiB, WS_OPKH = 360 * MiB, WS_VS = 424 * MiB;
constexpr size_t WS_KS = 488 * MiB, WS_OB = 488 * MiB, WS_HB = 488 * MiB;
constexpr size_t WS_TW = 520 * MiB, WS_AD = 524 * MiB, WS_SG = 528 * MiB;
constexpr size_t WS_OPW = 532 * MiB, WS_OPAK = 660 * MiB, WS_OPKT = 788 * MiB;
constexpr size_t WS_G = 916 * MiB, WS_OATT = 948 * MiB, WS_END = 980 * MiB;
constexpr size_t WS_ORW = 532 * MiB, WS_M32 = 564 * MiB, WS_MB = 628 * MiB, WS_FFH = 660 * MiB;
constexpr int ZLD = 7168, ZQ = 3456, ZK = 4480, ZV = 4736, ZG = 4992;

constexpr int LDS_BYTES = 131072 + 1024;
constexpr int LDS_MISC = 131072;

#define INP(k) (A.in[(k) + z])
struct Args {
    const float* in[26];
    float* out; unsigned char* ws;
    int ph_lo, ph_hi;
};

__device__ __forceinline__ float bf2f(unsigned v) { return __uint_as_float(v << 16); }
__device__ __forceinline__ float bflo(unsigned w) { return __uint_as_float(w << 16); }
__device__ __forceinline__ float bfhi(unsigned w) { return __uint_as_float(w & 0xffff0000u); }
typedef float f32x2c_t __attribute__((ext_vector_type(2))); typedef __bf16 bf16x2c_t __attribute__((ext_vector_type(2)));
__device__ __forceinline__ unsigned pk2(float lo, float hi) { f32x2c_t v = {lo, hi}; bf16x2c_t b = __builtin_convertvector(v, bf16x2c_t); return __builtin_bit_cast(unsigned, b); }
__device__ __forceinline__ float sigmoidf_(float x) { return 1.0f / (1.0f + __expf(-x)); }
__device__ __forceinline__ float wave_sum(float v) {
#pragma unroll
    for (int o = 1; o < 64; o <<= 1) v += __shfl_xor(v, o);
    return v;
}

__device__ __forceinline__ void p0_transpose_item(const float* W, int K, int N, bf16_t* WT, LAS float* scr, int item, int lane) {
    const int nblk = N / 32, kb = item / nblk, nb = item % nblk, k0 = 64 * kb, n0 = 32 * nb;
#pragma unroll 8
    for (int i = 0; i < 32; ++i) { const int kk = 2 * i + (lane >> 5); scr[kk * 33 + (lane & 31)] = W[(size_t)(k0 + kk) * N + n0 + (lane & 31)]; }
    asm volatile("s_waitcnt lgkmcnt(0)" ::: "memory");
    const int c = lane & 7;
#pragma unroll
    for (int j = 0; j < 4; ++j) { const int n = (lane >> 3) + 8 * j; const LAS float* s = scr + (8 * c) * 33 + n;
        u32x4 o; o.x = pk2(s[0 * 33], s[1 * 33]); o.y = pk2(s[2 * 33], s[3 * 33]); o.z = pk2(s[4 * 33], s[5 * 33]); o.w = pk2(s[6 * 33], s[7 * 33]);
        *(u32x4*)(WT + (size_t)(n0 + n) * K + k0 + 8 * c) = o; }
    asm volatile("s_waitcnt lgkmcnt(0)" ::: "memory");
}

__device__ __forceinline__ void cvt_x_chunk(const float* x, bf16_t* xb, int gtid, int gthreads) {
    const size_t n8 = (size_t)MC * D / 8;
    for (size_t i = gtid; i < n8; i += gthreads) {
        const f32x4 a = *(const f32x4*)(x + i * 8), b = *(const f32x4*)(x + i * 8 + 4);
        u32x4 o; o.x = pk2(a.x, a.y); o.y = pk2(a.z, a.w); o.z = pk2(b.x, b.y); o.w = pk2(b.z, b.w);
        *(u32x4*)(xb + i * 8) = o;
    }
}

__device__ __forceinline__ void ln_rows(float* base, const float* g, const float* b, bf16_t* hb, int gw, int ngw, int lane) {
    for (int m = gw; m < MC; m += ngw) {
        f32x4* xr = (f32x4*)(base + (size_t)m * D) + lane;
        f32x4 v[4]; float s = 0.f;
#pragma unroll
        for (int j = 0; j < 4; ++j) { v[j] = xr[64 * j]; s += (v[j].x + v[j].y) + (v[j].z + v[j].w); }
        const float mean = wave_sum(s) * (1.f / D); float s2 = 0.f;
#pragma unroll
        for (int j = 0; j < 4; ++j) { v[j] = v[j] - mean; s2 += (v[j].x * v[j].x + v[j].y * v[j].y) + (v[j].z * v[j].z + v[j].w * v[j].w); }
        const float rstd = 1.f / sqrtf(wave_sum(s2) * (1.f / D) + LN_EPS);
#pragma unroll
        for (int j = 0; j < 4; ++j) {
            const f32x4 gg = *((const f32x4*)g + 64 * j + lane), bb = *((const f32x4*)b + 64 * j + lane);
            const f32x4 y = v[j] * rstd * gg + bb;
            xr[64 * j] = y;
            if (hb) { u32x2 w; w.x = pk2(y.x, y.y); w.y = pk2(y.z, y.w); *(u32x2*)(hb + (size_t)m * D + 256 * j + 4 * lane) = w; }
        }
    }
}

template <class F> struct Epi4 {
    static constexpr bool PERM = false, AFTER_DRAIN = false; F f;
    __device__ __forceinline__ void operator()(const pg8::f32x4 (&acc)[2][2][4][2], const pg8::Unit& u, int wr, int wc, int fr, int fq) const {
        const int row0 = u.pm * 256 + wr * 64 + fr, col0 = u.pn * 256 + wc * 32 + 4 * fq;
#pragma unroll
        for (int ai = 0; ai < 2; ++ai)
#pragma unroll
            for (int m = 0; m < 4; ++m)
#pragma unroll
                for (int bj = 0; bj < 2; ++bj)
#pragma unroll
                    for (int n = 0; n < 2; ++n) { f(row0 + ai * 128 + m * 16, col0 + bj * 128 + n * 16, acc[ai][bj][m][n]); asm volatile("" ::: "memory"); }
    }
};
template <class F> struct Epi8 {
    static constexpr bool PERM = true, AFTER_DRAIN = false; F f;
    __device__ __forceinline__ void operator()(const pg8::f32x4 (&acc)[2][2][4][2], const pg8::Unit& u, int wr, int wc, int fr, int fq) const {
        const int row0 = u.pm * 256 + wr * 64 + fr, col0 = u.pn * 256 + wc * 32 + 8 * fq;
#pragma unroll
        for (int ai = 0; ai < 2; ++ai)
#pragma unroll
            for (int m = 0; m < 4; ++m)
#pragma unroll
                for (int bj = 0; bj < 2; ++bj) { f(row0 + ai * 128 + m * 16, col0 + bj * 128, acc[ai][bj][m][0], acc[ai][bj][m][1]); asm volatile("" ::: "memory"); }
    }
};
__device__ __forceinline__ u32x4 pack8(f32x4 a, f32x4 b) { u32x4 w; w.x = pk2(a.x, a.y); w.y = pk2(a.z, a.w); w.z = pk2(b.x, b.y); w.w = pk2(b.z, b.w); return w; }

struct FZ { bf16_t* z;
    __device__ __forceinline__ void operator()(int row, int col, f32x4 a, f32x4 b) const { *(u32x4*)(z + (size_t)row * ZLD + col) = pack8(a, b); } };
struct FW { const float* w0; float* opw;
    __device__ __forceinline__ void operator()(int row, int col, float a) const {
        opw[(size_t)row * D + col] = __expf(-DECAY_SCALE * sigmoidf_(a + w0[col])); } };
struct FA { const float *a0, *k_a; const bf16_t* ks; const float* kh; float *opak, *opkt;
    __device__ __forceinline__ void operator()(int row, int col, float acc) const {
        const size_t o = (size_t)row * D + col; const float a = sigmoidf_(acc + a0[col]); const float k = bf2f((unsigned)ks[o]);
        opak[o] = a * kh[o]; opkt[o] = k * (1.0f + (a - 1.0f) * k_a[col]); } };
struct FG { bf16_t* g;
    __device__ __forceinline__ void operator()(int row, int col, float a) const { g[(size_t)row * D + col] = (bf16_t)(pk2(a, a) & 0xffffu); } };
typedef short bf16x8v __attribute__((ext_vector_type(8)));
typedef float f32x16v __attribute__((ext_vector_type(16)));
template <int K, class F> __device__ __forceinline__ void wave_gemm_tile(const bf16_t* A, int aoff, const bf16_t* Bt, int m0, int n0, int lane, const F& f) {
    const int l32 = lane & 31, hi = lane >> 5;
    bf16x8v a[K / 16];
#pragma unroll
    for (int ks = 0; ks < K / 16; ++ks) a[ks] = *(const bf16x8v*)(A + (size_t)(m0 + l32) * 128 + aoff + ks * 16 + 8 * hi);
#pragma unroll 1
    for (int nb = 0; nb < 4; ++nb) {
        f32x16v acc = {};
        const bf16_t* bp = Bt + (size_t)(n0 + nb * 32 + l32) * K + 8 * hi;
#pragma unroll
        for (int ks = 0; ks < K / 16; ++ks) { const bf16x8v b = *(const bf16x8v*)(bp + ks * 16); acc = __builtin_amdgcn_mfma_f32_32x32x16_bf16(a[ks], b, acc, 0, 0, 0); }
#pragma unroll
        for (int r = 0; r < 16; ++r) f(m0 + (r & 3) + 8 * (r >> 2) + 4 * hi, n0 + nb * 32 + l32, acc[r]);
    }
}
struct FP1 { const bf16_t* gates; float* m32;
    __device__ __forceinline__ void operator()(int row, int col, f32x4 a) const {
        const u32x2 gw = *(const u32x2*)(gates + (size_t)row * ZLD + ZG + col); f32x4 y;
        y.x = sigmoidf_(bflo(gw.x)) * a.x; y.y = sigmoidf_(bfhi(gw.x)) * a.y; y.z = sigmoidf_(bflo(gw.y)) * a.z; y.w = sigmoidf_(bfhi(gw.y)) * a.w; y = y * EXP_RW;
        *(f32x4*)(m32 + (size_t)row * D + col) = y;
    } };
struct FP2 { const bf16_t* gates; const float* m32; bf16_t* mb;
    __device__ __forceinline__ void operator()(int row, int col, f32x4 a) const {
        const u32x2 gw = *(const u32x2*)(gates + (size_t)row * ZLD + ZG + 1024 + col); const f32x4 p = *(const f32x4*)(m32 + (size_t)row * D + col); f32x4 y; a = a * EXP_ATT;
        y.x = p.x + sigmoidf_(bflo(gw.x)) * a.x; y.y = p.y + sigmoidf_(bfhi(gw.x)) * a.y; y.z = p.z + sigmoidf_(bflo(gw.y)) * a.z; y.w = p.w + sigmoidf_(bfhi(gw.y)) * a.w;
        u32x2 w; w.x = pk2(y.x, y.y); w.y = pk2(y.z, y.w); *(u32x2*)(mb + (size_t)row * D + col) = w;
    } };
struct FOut { const float* x; float* out;
    __device__ __forceinline__ void operator()(int row, int col, f32x4 a) const {
        const size_t o = (size_t)row * D + col; *(f32x4*)(out + o) = *(const f32x4*)(x + o) * ALPHA + a * EXP_MIX; } };
struct FF1 { bf16_t* ffh;
    __device__ __forceinline__ void operator()(int row, int col, f32x4 a, f32x4 b) const {
#pragma unroll
        for (int i = 0; i < 4; ++i) { const float u = fmaxf(a[i], 0.f), v = fmaxf(b[i], 0.f); a[i] = u * u; b[i] = v * v; }
        *(u32x4*)(ffh + (size_t)row * FF + col) = pack8(a, b); } };
struct FF2 { float* out;
    __device__ __forceinline__ void operator()(int row, int col, f32x4 a) const {
        const size_t o = (size_t)row * D + col; *(f32x4*)(out + o) = *(const f32x4*)(out + o) * ALPHA + a; } };

template <class E> __device__ __forceinline__ void run_gemm(LAS unsigned char* lds, const bf16_t* A, const bf16_t* Bt, int M, int N, int K, const E& e) {

    int G_ = (int)gridDim.x, c_ = (int)blockIdx.x; asm volatile("" : "+s"(G_), "+s"(c_));
    pg8::Gemm g{A, Bt, M, N, K}; pg8::StaticOrder S; S.init(M, N, G_, c_);
    if (EN_GEMM) pg8::gemm_phase<E, pg8::StaticOrder, true, true>(lds, g, S, e);
}

__device__ __forceinline__ void prep_rows(const float* mu_p, const float* mu_n, const float* k_k, const float* qn, const float* kn, unsigned char* ws, int T, int gw, int ngw, int lane) {
    bf16_t* Z = (bf16_t*)(ws + WS_Z);
    float* OPR = (float*)(ws + WS_OPR); float* OPKH = (float*)(ws + WS_OPKH); float* VS = (float*)(ws + WS_VS);
    bf16_t* KS = (bf16_t*)(ws + WS_KS); bf16_t* TW = (bf16_t*)(ws + WS_TW); bf16_t* AD = (bf16_t*)(ws + WS_AD); bf16_t* SG = (bf16_t*)(ws + WS_SG);
    for (int row = gw; row < MC; row += ngw) {
        const int t = row & (T - 1); const bool hp = t > 0, hn = t < T - 1;
        const bf16_t* zc = Z + (size_t)row * ZLD;
#pragma unroll 1
        for (int pass = 0; pass < 7; ++pass) {
            const int c = pass * 512 + lane * 8;
            if (c < RWC) {
                const u32x4 wc_ = *(const u32x4*)(zc + c);
                u32x4 wp = {0u, 0u, 0u, 0u}, wn = {0u, 0u, 0u, 0u};
                if (hp) wp = *(const u32x4*)(zc - ZLD + c);
                if (hn) wn = *(const u32x4*)(zc + ZLD + c);
                const f32x4 mp0 = *(const f32x4*)(mu_p + c), mp1 = *(const f32x4*)(mu_p + c + 4), mn0 = *(const f32x4*)(mu_n + c), mn1 = *(const f32x4*)(mu_n + c + 4);
                float z[8];
#pragma unroll
                for (int i = 0; i < 4; ++i) {
                    const float c0 = bflo(wc_[i]), c1 = bfhi(wc_[i]), p0 = bflo(wp[i]), p1 = bfhi(wp[i]), n0 = bflo(wn[i]), n1 = bfhi(wn[i]);
                    const float mpa = (2 * i < 4) ? mp0[2 * i] : mp1[2 * i - 4], mpb = (2 * i + 1 < 4) ? mp0[2 * i + 1] : mp1[2 * i - 3];
                    const float mna = (2 * i < 4) ? mn0[2 * i] : mn1[2 * i - 4], mnb = (2 * i + 1 < 4) ? mn0[2 * i + 1] : mn1[2 * i - 3];
                    z[2 * i] = c0 + mpa * (p0 - c0) + mna * (n0 - c0);
                    z[2 * i + 1] = c1 + mpb * (p1 - c1) + mnb * (n1 - c1);
                }
                if (pass < 2) {
                    float* o = OPR + (size_t)row * D + c;
                    *(f32x4*)o = (f32x4){z[0], z[1], z[2], z[3]}; *(f32x4*)(o + 4) = (f32x4){z[4], z[5], z[6], z[7]};
                } else if (pass < 4) {
                    const int cc = c - 1024;
                    u32x4 w; w.x = pk2(z[0], z[1]); w.y = pk2(z[2], z[3]); w.z = pk2(z[4], z[5]); w.w = pk2(z[6], z[7]);
                    *(u32x4*)(KS + (size_t)row * D + cc) = w;
                    const f32x4 kk0 = *(const f32x4*)(k_k + cc), kk1 = *(const f32x4*)(k_k + cc + 4);
                    float kp[8]; float ss = 0.f;
#pragma unroll
                    for (int i = 0; i < 8; ++i) { kp[i] = z[i] * (i < 4 ? kk0[i] : kk1[i - 4]); ss += kp[i] * kp[i]; }
                    ss += __shfl_xor(ss, 1); ss += __shfl_xor(ss, 2); ss += __shfl_xor(ss, 4);
                    const float inv = 1.0f / fmaxf(sqrtf(ss), 1e-12f);
                    float* o = OPKH + (size_t)row * D + cc;
                    *(f32x4*)o = (f32x4){kp[0] * inv, kp[1] * inv, kp[2] * inv, kp[3] * inv}; *(f32x4*)(o + 4) = (f32x4){kp[4] * inv, kp[5] * inv, kp[6] * inv, kp[7] * inv};
                } else if (pass < 6) {
                    float* o = VS + (size_t)row * D + (c - 2048);
                    *(f32x4*)o = (f32x4){z[0], z[1], z[2], z[3]}; *(f32x4*)(o + 4) = (f32x4){z[4], z[5], z[6], z[7]};
                } else {
                    const int sect = lane >> 4, cc = (lane & 15) * 8;
                    float y[8];
#pragma unroll
                    for (int i = 0; i < 8; ++i) {
                        if (sect == 0) { const float e = __expf(2.0f * z[i]); y[i] = 1.0f - 2.0f / (e + 1.0f); }
                        else if (sect == 1) y[i] = z[i];
                        else y[i] = sigmoidf_(z[i]);
                    }
                    u32x4 w; w.x = pk2(y[0], y[1]); w.y = pk2(y[2], y[3]); w.z = pk2(y[4], y[5]); w.w = pk2(y[6], y[7]);
                    bf16_t* dst = (sect == 0 ? TW : (sect == 1 ? AD : SG)) + (size_t)row * 128 + cc;
                    *(u32x4*)dst = w;
                }
            }
        }
        bf16_t* qrow = Z + (size_t)row * ZLD + ZQ;
#pragma unroll 1
        for (int p = 0; p < 3; ++p) {
            const int head = p * 4 + (lane >> 4), sub = lane & 15, d0 = sub * 8;
            const bool act = head < 10;
            bf16_t* px = qrow + head * 128 + d0;
            u32x4 w = {0u, 0u, 0u, 0u}; if (act) w = *(const u32x4*)px;
            float x[8]; float ss = 0.f;
#pragma unroll
            for (int i = 0; i < 4; ++i) { x[2 * i] = bflo(w[i]); x[2 * i + 1] = bfhi(w[i]); ss += x[2 * i] * x[2 * i] + x[2 * i + 1] * x[2 * i + 1]; }
            ss += __shfl_xor(ss, 1); ss += __shfl_xor(ss, 2); ss += __shfl_xor(ss, 4); ss += __shfl_xor(ss, 8);
            const float rinv = rsqrtf(ss * (1.0f / 128.0f) + RMS_EPS);
            const float* gn = (head < 8) ? qn : kn;
            const f32x4 g0 = *(const f32x4*)(gn + d0), g1 = *(const f32x4*)(gn + d0 + 4);
            const int axis = sub >> 3, hf = (sub >> 2) & 1;
            const float pos = (float)(axis ? (t & 63) : (t >> 6));
            float y[8];
#pragma unroll
            for (int i = 0; i < 8; ++i) {
                const float xn = x[i] * rinv * (i < 4 ? g0[i] : g1[i - 4]);
                const float xp = __shfl_xor(xn, 4);
                const int fi = (sub & 3) * 8 + i;
                const float ang = pos * exp2f(-0.41524101186092f * (float)fi);
                y[i] = xn * __cosf(ang) + (hf ? xp : -xp) * __sinf(ang);
            }
            if (act) { u32x4 o; o.x = pk2(y[0], y[1]); o.y = pk2(y[2], y[3]); o.z = pk2(y[4], y[5]); o.w = pk2(y[6], y[7]); *(u32x4*)px = o; }
        }
    }
}

__device__ __forceinline__ void post_rows(const float* r_k, const float* gn_g, const float* gn_b, unsigned char* ws, int gw, int ngw, int lane) {
    const bf16_t* OF = (const bf16_t*)(ws + WS_OF); const bf16_t* OB = (const bf16_t*)(ws + WS_OB);
    const float* OPR = (const float*)(ws + WS_OPR); const float* VS = (const float*)(ws + WS_VS);
    const float* KTF = (const float*)(ws + WS_OPKT); const float* KTB = KTF + (size_t)MC * D;
    const bf16_t* G = (const bf16_t*)(ws + WS_G); bf16_t* ORW = (bf16_t*)(ws + WS_ORW);
    for (int row = gw; row < MC; row += ngw) {
        const size_t ro = (size_t)row * D;
#pragma unroll 4
        for (int h = 0; h < 16; ++h) {
            const int c = h * 64 + lane; const size_t o = ro + c;
            const float ov = EXP_NOSCAN ? 0.f : bf2f((unsigned)OF[o]) + bf2f((unsigned)OB[o]);
            const float mean = wave_sum(ov) * (1.0f / 64.0f); const float dv = ov - mean;
            const float var = wave_sum(dv * dv) * (1.0f / 64.0f);
            float y = dv * rsqrtf(var + GN_EPS) * gn_g[c] + gn_b[c];
            const float bs = wave_sum(OPR[o] * (KTF[o] + KTB[o]) * r_k[c]);
            y = (y + bs * VS[o]) * bf2f((unsigned)G[o]);
            if (EXP_TWICE) { const bf16_t* A0 = (const bf16_t*)(ws + WS_OATT); const bf16_t* A1 = (const bf16_t*)(ws + WS_END); if (EXP_TWICE == 2 ? (A1[o] != OF[o]) : (A0[o] != OF[o] || A1[o] != OB[o])) y = __builtin_nanf(""); }
            ORW[o] = (bf16_t)(pk2(y, y) & 0xffffu);
        }
    }
}

#define DPPQ(q) "quad_perm:[" #q "," #q "," #q "," #q "] row_mask:0xf bank_mask:0xf"
#define FMAC_DPP(acc, x, s, q) asm("v_fmac_f32_dpp %0, %1, %2 " DPPQ(q) : "+v"(acc) : "v"(x), "v"(s))
#define MUL_DPP(dst, x, s, q) asm("v_mul_f32_dpp %0, %1, %2 " DPPQ(q) : "=v"(dst) : "v"(x), "v"(s))
#define LBAR() asm volatile("s_waitcnt lgkmcnt(0)\n\ts_barrier" ::: "memory")

struct ScanCtx {
    const float* pa[5]; const float* pv; bf16_t* po; long r0, dstep; int T;
    LAS float* part; LAS float* opart; int wid, lane;
};
typedef float f32x2s __attribute__((ext_vector_type(2)));
__device__ __forceinline__ void scan_load(const ScanCtx& C, int t1, float (&X)[4][10], float (&V)[4]) {
    if (t1 >= C.T) return;
#pragma unroll
    for (int s = 0; s < 4; ++s) {
        const long ro = (C.r0 + C.dstep * (long)(t1 + s)) * D;
#pragma unroll
        for (int a = 0; a < 5; ++a) { const f32x2s v = *(const f32x2s*)(C.pa[a] + ro); X[s][2 * a] = v.x; X[s][2 * a + 1] = v.y; }
        V[s] = C.pv[ro];
    }
}
#define STEP_Q(i, q, j) do { float tmp_; MUL_DPP(tmp_, X[s][6 + j], vv, q); FMAC_DPP(tmp_, X[s][4 + j], nsk, q); FMAC_DPP(tmp_, X[s][2 + j], S[i], q); S[i] = tmp_; } while (0)
__device__ __forceinline__ void scan_block(const ScanCtx& C, int sbase, float (&S)[8], const float (&X)[4][10], const float (&V)[4]) {
#pragma unroll
    for (int s = 0; s < 4; ++s) {
        float p0 = 0.f, p1 = 0.f;
        FMAC_DPP(p0, X[s][0], S[0], 0); FMAC_DPP(p1, X[s][1], S[1], 0); FMAC_DPP(p0, X[s][0], S[2], 1); FMAC_DPP(p1, X[s][1], S[3], 1);
        FMAC_DPP(p0, X[s][0], S[4], 2); FMAC_DPP(p1, X[s][1], S[5], 2); FMAC_DPP(p0, X[s][0], S[6], 3); FMAC_DPP(p1, X[s][1], S[7], 3);
        LAS float* pp = C.part + (s & 1) * 512;
        pp[C.wid * 64 + C.lane] = p0 + p1;
        LBAR();
        float sk = 0.f;
#pragma unroll
        for (int w = 0; w < 8; ++w) sk += pp[w * 64 + C.lane];
        const float nsk = -sk, vv = V[s];
        STEP_Q(0, 0, 0); STEP_Q(1, 0, 1); STEP_Q(2, 1, 0); STEP_Q(3, 1, 1);
        STEP_Q(4, 2, 0); STEP_Q(5, 2, 1); STEP_Q(6, 3, 0); STEP_Q(7, 3, 1);
        float o0 = 0.f, o1 = 0.f;
        FMAC_DPP(o0, X[s][8], S[0], 0); FMAC_DPP(o1, X[s][9], S[1], 0); FMAC_DPP(o0, X[s][8], S[2], 1); FMAC_DPP(o1, X[s][9], S[3], 1);
        FMAC_DPP(o0, X[s][8], S[4], 2); FMAC_DPP(o1, X[s][9], S[5], 2); FMAC_DPP(o0, X[s][8], S[6], 3); FMAC_DPP(o1, X[s][9], S[7], 3);
        C.opart[(sbase + s) * 512 + C.wid * 64 + C.lane] = o0 + o1;
    }
}
__device__ __forceinline__ void scan_chain(unsigned char* ws, LAS unsigned char* lds, int s, int h, int d, int T, int rep) {
    int tid_ = threadIdx.x; asm volatile("" : "+v"(tid_));
    const int tid = tid_, lane = tid & 63, wid = __builtin_amdgcn_readfirstlane(tid >> 6);
    ScanCtx C; C.T = T; C.wid = wid; C.lane = lane;
    const int col = h * 64; const size_t dofs = (size_t)d * MC * D;
    const int ko = col + wid * 8 + 2 * (lane & 3);
    C.pa[0] = (const float*)(ws + WS_OPKH) + ko; C.pa[1] = (const float*)(ws + WS_OPW) + dofs + ko; C.pa[2] = (const float*)(ws + WS_OPAK) + dofs + ko;
    C.pa[3] = (const float*)(ws + WS_OPKT) + dofs + ko; C.pa[4] = (const float*)(ws + WS_OPR) + ko;
    C.pv = (const float*)(ws + WS_VS) + col + lane;
    C.po = (bf16_t*)(ws + (rep ? (d ? (EXP_TWICE == 2 ? WS_OB : WS_END) : (EXP_TWICE == 2 ? WS_END : WS_OATT)) : (d ? WS_OB : WS_OF))) + col + lane;
    C.r0 = d ? (long)s * T + T - 1 : (long)s * T; C.dstep = d ? -1 : 1;
    C.part = (LAS float*)lds; C.opart = (LAS float*)(lds + 4096);
    float S[8];
#pragma unroll
    for (int i = 0; i < 8; ++i) S[i] = 0.f;
    float XA[4][10], XB[4][10], VA[4], VB[4];
    scan_load(C, 0, XA, VA);
    for (int t0 = 0; t0 < T; t0 += 8) {
        scan_load(C, t0 + 4, XB, VB);
        scan_block(C, 0, S, XA, VA);
        scan_load(C, t0 + 8, XA, VA);
        scan_block(C, 4, S, XB, VB);
        LBAR();
        { float o = 0.f;
#pragma unroll
          for (int w = 0; w < 8; ++w) o += C.opart[wid * 512 + w * 64 + lane];
          C.po[(C.r0 + C.dstep * (long)(t0 + wid)) * D] = (bf16_t)(pk2(o, o) & 0xffffu); }
    }
    LBAR();
}

#define RLX_AGENT __ATOMIC_RELAXED, __HIP_MEMORY_SCOPE_AGENT
#define XB_TMO      128
#define XB_XCNT(j)  (256  + 64 * (j))
#define XB_XSUB(j)  (1280 + 64 * (j))
#define XB_XGEN(j)  (2304 + 64 * (j))
#define XB_TOP      3328
#define XB_TOPGEN   3392
#define XCD_BAR_WORDS 3456
#define XB_SPIN_CAP (1u << 28)

__device__ __forceinline__ unsigned xb_ld(unsigned* p)              { return __hip_atomic_load(p, __ATOMIC_RELAXED, __HIP_MEMORY_SCOPE_AGENT); }
__device__ __forceinline__ unsigned xb_add(unsigned* p, unsigned v) { return __hip_atomic_fetch_add(p, v, __ATOMIC_RELAXED, __HIP_MEMORY_SCOPE_AGENT); }
__device__ __forceinline__ unsigned xb_xcc_id() { return (unsigned)__builtin_amdgcn_s_getreg((3 << 11) | 20) & 0xFu; }
#define XB_SPIN(cond, bar) do { unsigned _sp = 0; while (cond) { __builtin_amdgcn_s_sleep(1); \
    if ((++_sp & 255u) == 0u) { if (xb_ld(&(bar)[XB_TMO])) break; if (_sp > XB_SPIN_CAP) { atomicAdd(&(bar)[XB_TMO], 1u); break; } } } } while (0)

struct XcdBarrier {
    unsigned* bar; unsigned x;
    volatile LAS unsigned* st;
};

__device__ __forceinline__ XcdBarrier xcd_barrier_post(unsigned* bar, volatile LAS unsigned* st) {
    XcdBarrier b; b.bar = bar; b.x = xb_xcc_id(); b.st = st;
    if (threadIdx.x == 0) (void)xb_add(&bar[XB_XCNT(b.x)], 1u);
    return b;
}
__device__ __forceinline__ void xcd_barrier_complete(unsigned* bar, unsigned x, unsigned& nloc, unsigned& nx) {
    const unsigned G = gridDim.x * gridDim.y * gridDim.z;
    unsigned sum, cnt, mine, sp = 0u;
    for (;;) {
        sum = 0u; cnt = 0u; mine = 0u;
#pragma unroll
        for (unsigned j = 0; j < 16; ++j) { const unsigned c = xb_ld(&bar[XB_XCNT(j)]); sum += c; cnt += (c > 0u) ? 1u : 0u; mine = (j == x) ? c : mine; }
        if (sum == G) break;
        __builtin_amdgcn_s_sleep(1);
        if ((++sp & 255u) == 0u) { if (xb_ld(&bar[XB_TMO])) break; if (sp > XB_SPIN_CAP) { atomicAdd(&bar[XB_TMO], 1u); break; } }
    }
    nloc = mine > 0u ? mine : 1u; nx = cnt > 0u ? cnt : 1u;
}

__device__ __forceinline__ void xcd_barrier(const XcdBarrier& b) {
    asm volatile("s_waitcnt vmcnt(0)" ::: "memory");
    __syncthreads();
    if (threadIdx.x == 0) {
        unsigned* bar = b.bar;
        __builtin_amdgcn_s_waitcnt(0);
        unsigned nloc = b.st[0], nx = b.st[1];
        if (nloc == 0u) { xcd_barrier_complete(bar, b.x, nloc, nx); b.st[0] = nloc; b.st[1] = nx; }
        const unsigned old = xb_add(&bar[XB_XSUB(b.x)], 1u);
        const unsigned gen = old / nloc;
        if (old + 1u == (gen + 1u) * nloc) {
            __builtin_amdgcn_fence(__ATOMIC_RELEASE, "agent");
            asm volatile("s_waitcnt vmcnt(0)" ::: "memory");
            const unsigned og = xb_add(&bar[XB_TOP], 1u);
            const unsigned tg = og / nx;
            if (og + 1u == (tg + 1u) * nx) xb_add(&bar[XB_TOPGEN], 1u);
            else XB_SPIN(xb_ld(&bar[XB_TOPGEN]) == tg, bar);
            __builtin_amdgcn_fence(__ATOMIC_ACQUIRE, "agent");
            asm volatile("buffer_inv sc0 sc1" ::: "memory");
            xb_add(&bar[XB_XGEN(b.x)], 1u);
            asm volatile("s_waitcnt vmcnt(0)" ::: "memory");
        } else {
            XB_SPIN(xb_ld(&bar[XB_XGEN(b.x)]) == gen, bar);
            __builtin_amdgcn_fence(__ATOMIC_ACQUIRE, "agent");
            asm volatile("buffer_inv sc0 sc1" ::: "memory");
            asm volatile("s_waitcnt vmcnt(0)" ::: "memory");
        }
    }
    __syncthreads();
}
__global__ void __launch_bounds__(NTHREADS, 2) mega_fwd(Args A) {
    extern __shared__ __attribute__((aligned(16))) unsigned char lds_raw[];
    LAS unsigned char* lds = (LAS unsigned char*)lds_raw;
    cg::grid_group grid = cg::this_grid();
#define TIDV int tid_ = threadIdx.x; asm volatile("" : "+v"(tid_)); const int tid = tid_, lane = tid & 63, wave = __builtin_amdgcn_readfirstlane(tid >> 6); \
    const int G = gridDim.x, gw = blockIdx.x * NWAVES + wave, ngw = G * NWAVES, gtid = blockIdx.x * NTHREADS + tid, gthreads = G * NTHREADS; \
    (void)lane; (void)gw; (void)ngw; (void)gtid; (void)gthreads;

    if (A.ph_hi < 0) grid.sync();
    if (EXP_ZFILL) { for (int i = threadIdx.x; i < LDS_BYTES / 4; i += NTHREADS) ((LAS unsigned*)lds)[i] = 0u; __syncthreads(); }
    { volatile LAS unsigned* misc = (volatile LAS unsigned*)(lds + LDS_MISC);
      if (threadIdx.x < 32) misc[threadIdx.x] = 0u;
      __syncthreads(); }
    XcdBarrier bar = xcd_barrier_post((unsigned*)(A.ws + WS_CTL) + 4096, (volatile LAS unsigned*)(lds + LDS_MISC) + 8);
    for (int ph = A.ph_lo; ph < A.ph_hi; ++ph) {
        if (ph > A.ph_lo) xcd_barrier(bar);
        int z = 0; asm volatile("" : "+s"(z));
        unsigned char* ws = A.ws + z;
        if (ph == 0) {
            TIDV
            LAS float* scr = (LAS float*)(lds + wave * 16384);
            constexpr int I_IN = 16 * (NIN / 32), I_SQ = 16 * 32, I_F1 = 16 * 128, I_F2 = 64 * 32, I_G = 2 * 32, I_U = 32;
            constexpr int NITEMS = I_IN + 3 * I_SQ + I_F1 + I_F2 + I_G + 4 * I_U;
            for (int it = gw; it < NITEMS; it += ngw) {
                int r = it;
                if (r < I_IN) { p0_transpose_item(INP(2), D, NIN, (bf16_t*)(ws + WS_WIN), scr, r, lane); continue; } r -= I_IN;
                if (r < I_SQ) { p0_transpose_item(INP(17), D, D, (bf16_t*)(ws + WS_WPR), scr, r, lane); continue; } r -= I_SQ;
                if (r < I_SQ) { p0_transpose_item(INP(18), D, D, (bf16_t*)(ws + WS_WPA), scr, r, lane); continue; } r -= I_SQ;
                if (r < I_SQ) { p0_transpose_item(INP(19), D, D, (bf16_t*)(ws + WS_WOUT), scr, r, lane); continue; } r -= I_SQ;
                if (r < I_F1) { p0_transpose_item(INP(22), D, FF, (bf16_t*)(ws + WS_WF1), scr, r, lane); continue; } r -= I_F1;
                if (r < I_F2) { p0_transpose_item(INP(23), FF, D, (bf16_t*)(ws + WS_WF2), scr, r, lane); continue; } r -= I_F2;
                if (r < I_G) { p0_transpose_item(INP(9), 128, D, (bf16_t*)(ws + WS_GUP), scr, r, lane); continue; } r -= I_G;
                { const int which = r / I_U, it2 = r % I_U, dd = which & 1;
                  p0_transpose_item((which < 2 ? INP(6) : INP(8)) + (size_t)dd * 64 * 1024, 64, D, (bf16_t*)(ws + (which < 2 ? WS_WUP : WS_AUP)) + (size_t)dd * 1024 * 64, scr, it2, lane); }
            }
            cvt_x_chunk(INP(0), (bf16_t*)(ws + WS_XB), gtid, gthreads);
            if (EXP_ZFILL) { u32x4* zo = (u32x4*)A.out; const size_t no = (size_t)MTOT * D / 4; const u32x4 z0 = {0u, 0u, 0u, 0u};
                for (size_t i = gtid; i < no; i += gthreads) zo[i] = z0; }
            if (EXP_ZFILL) { u32x4* zp = (u32x4*)(ws + WS_Z); const size_t n16 = (WS_END - WS_Z) / 16; const u32x4 zz = {0u, 0u, 0u, 0u};
                for (size_t i = gtid; i < n16; i += gthreads) zp[i] = zz; }
            continue;
        }
        const int c = (ph - 1) / 11, sub = (ph - 1) % 11;
        const int T = (c < 4) ? 2048 : 8192;
        const float* xin = (c < 4) ? INP(0) + (size_t)c * MC * D : INP(1);
        float* outc = A.out + (size_t)c * MC * D;
        if (sub == 0) {
            Epi8<FZ> e{{(bf16_t*)(ws + WS_Z)}};
            run_gemm(lds, (const bf16_t*)(ws + WS_XB), (const bf16_t*)(ws + WS_WIN), MC, NINP, D, e);
        } else if (sub == 1) {
            TIDV
            if (EN_PREP) prep_rows(INP(3), INP(4), INP(10), INP(15), INP(16), ws, T, gw, ngw, lane);
        } else if (sub == 2) {
            TIDV
            constexpr int TW_ = (MC / 32) * 8;
            for (int it = gw; it < 5 * TW_; it += ngw) {
                const int which = it / TW_, r = it % TW_, m0 = (r >> 3) * 32, n0 = (r & 7) * 128;
                if (which < 2) { FW f{INP(5) + which * 1024, (float*)(ws + WS_OPW) + (size_t)which * MC * D};
                    wave_gemm_tile<64>((const bf16_t*)(ws + WS_TW), which * 64, (const bf16_t*)(ws + WS_WUP) + (size_t)which * 1024 * 64, m0, n0, lane, f); }
                else if (which < 4) { const int dd = which - 2;
                    FA f{INP(7) + dd * 1024, INP(11), (const bf16_t*)(ws + WS_KS), (const float*)(ws + WS_OPKH), (float*)(ws + WS_OPAK) + (size_t)dd * MC * D, (float*)(ws + WS_OPKT) + (size_t)dd * MC * D};
                    wave_gemm_tile<64>((const bf16_t*)(ws + WS_AD), dd * 64, (const bf16_t*)(ws + WS_AUP) + (size_t)dd * 1024 * 64, m0, n0, lane, f); }
                else { FG f{(bf16_t*)(ws + WS_G)};
                    wave_gemm_tile<128>((const bf16_t*)(ws + WS_SG), 0, (const bf16_t*)(ws + WS_GUP), m0, n0, lane, f); }
            }
        } else if (sub == 3) {
            const int nseq = MC / T, nchain = nseq * 32, nqb = T / 256, natt = nseq * 8 * nqb;
            LAS unsigned* qslot = (LAS unsigned*)(lds + LDS_MISC); const int tid = threadIdx.x;
            for (int stage = 0; stage < 2; ++stage) {
                if (stage == 1) xcd_barrier(bar);
                const int nitem = stage ? natt : nchain;
                for (;;) {
                    __syncthreads();
                    if (tid == 0) qslot[0] = atomicAdd((unsigned*)(ws + WS_CTL) + 64 * c + 16 * stage, 1u);
                    __syncthreads();
                    const int item = (int)qslot[0];
                    if (item >= nitem) break;
                    if (stage == 0) scan_chain(ws, lds, item >> 5, (item >> 1) & 15, item & 1, T, 0);
                    else {
                        const int u = item, qb = u % nqb, hq = (u / nqb) & 7, s = u / (nqb * 8);
                        const att::bf16* qkv = (const att::bf16*)(ws + WS_Z) + (size_t)s * T * ZLD;
                        att::attn_dense_body(qkv + (size_t)qb * 256 * ZLD + ZQ + hq * 128, qkv + ZK + (hq >> 2) * 128, qkv + ZV + (hq >> 2) * 128,
                                             (att::bf16*)(ws + WS_OATT) + ((size_t)s * T + (size_t)qb * 256) * D + hq * 128, T, (char*)lds_raw);
                    }
                }
            }
        } else if (sub == 4) {
            TIDV
            if (EN_PREP) post_rows(INP(12), INP(13), INP(14), ws, gw, ngw, lane);
        } else if (sub == 5) {
            { Epi4<FP1> e{{(const bf16_t*)(ws + WS_Z), (float*)(ws + WS_M32)}};
              run_gemm(lds, (const bf16_t*)(ws + WS_ORW), (const bf16_t*)(ws + WS_WPR), MC, D, D, e); }
            { Epi4<FP2> e{{(const bf16_t*)(ws + WS_Z), (const float*)(ws + WS_M32), (bf16_t*)(ws + WS_MB)}};
              run_gemm(lds, (const bf16_t*)(ws + WS_OATT), (const bf16_t*)(ws + WS_WPA), MC, D, D, e); }
        } else if (sub == 6) {
            Epi4<FOut> e{{xin, outc}};
            run_gemm(lds, (const bf16_t*)(ws + WS_MB), (const bf16_t*)(ws + WS_WOUT), MC, D, D, e);
        } else if (sub == 7) {
            TIDV
            ln_rows(outc, INP(20), INP(21), (bf16_t*)(ws + WS_HB), gw, ngw, lane);
        } else if (sub == 8) {
            Epi8<FF1> e{{(bf16_t*)(ws + WS_FFH)}};
            run_gemm(lds, (const bf16_t*)(ws + WS_HB), (const bf16_t*)(ws + WS_WF1), MC, FF, D, e);
        } else if (sub == 9) {
            Epi4<FF2> e{{outc}};
            run_gemm(lds, (const bf16_t*)(ws + WS_FFH), (const bf16_t*)(ws + WS_WF2), MC, D, FF, e);
        } else {
            TIDV
            ln_rows(outc, INP(24), INP(25), nullptr, gw, ngw, lane);
            if (c + 1 < NCHUNK) cvt_x_chunk((c + 1 < 4) ? INP(0) + (size_t)(c + 1) * MC * D : INP(1), (bf16_t*)(ws + WS_XB), gtid, gthreads);
        }
    }
}

constexpr int NPHASE = 1 + 11 * NCHUNK;
extern "C" void kernel_launch(void* const* d_in, const int* in_sizes, int n_in, void* d_out, int out_size, void* d_ws, size_t ws_size, hipStream_t stream) {
    static int grid = 0;
    if (grid == 0) {
        if (n_in != 26 || out_size != MTOT * D || ws_size < WS_END) { fprintf(stderr, "kernel_launch: unexpected shapes n_in %d out %d ws %zu\n", n_in, out_size, ws_size); grid = -1; return; }
        int dev = 0, cus = 0, per_cu = 0;
        hipGetDevice(&dev); hipDeviceGetAttribute(&cus, hipDeviceAttributeMultiprocessorCount, dev);
        if (hipFuncSetAttribute((const void*)mega_fwd, hipFuncAttributeMaxDynamicSharedMemorySize, LDS_BYTES) != hipSuccess) { fprintf(stderr, "kernel_launch: LDS attribute failed\n"); grid = -1; return; }
        if (hipOccupancyMaxActiveBlocksPerMultiprocessor(&per_cu, (const void*)mega_fwd, NTHREADS, LDS_BYTES) != hipSuccess || per_cu < 1) per_cu = 1;
        (void)hipGetLastError();
        grid = cus * (per_cu > 1 ? 1 : per_cu);
    }
    if (grid < 0) return;
    hipMemsetAsync((char*)d_ws + WS_CTL, 0, 64 * 1024, stream);
    Args a{};
    for (int i = 0; i < 26; ++i) a.in[i] = (const float*)d_in[i];
    a.out = (float*)d_out; a.ws = (unsigned char*)d_ws; a.ph_lo = 0; a.ph_hi = NPHASE;
    void* args[] = {&a};
    hipError_t e = hipLaunchCooperativeKernel((const void*)mega_fwd, dim3(grid), dim3(NTHREADS), args, LDS_BYTES, stream);
    if (e != hipSuccess) fprintf(stderr, "cooperative launch failed: %s (grid %d)\n", hipGetErrorString(e), grid);
}
```

```cpp
#include <hip/hip_runtime.h>
#include <hip/hip_bf16.h>
#include <hip/hip_cooperative_groups.h>
#include <cstdio>
#include <cstdint>
namespace cg = cooperative_groups;
namespace pg8 {
#define PG8_LAS __attribute__((address_space(3)))
typedef unsigned short bf16_t;
typedef short bf16x8 __attribute__((ext_vector_type(8)));
typedef float f32x4 __attribute__((ext_vector_type(4)));
typedef unsigned u32x4 __attribute__((ext_vector_type(4)));
constexpr int BM = 256, BK = 64, HALF = 128, HTB = HALF * BK * 2  , STAGE_BYTES = 8 * HTB, NXCD = 8, WGM = 8;

__host__ __device__ __forceinline__ int lds_byte(int r, int c) { const int st = (r >> 4) * 2 + (c >> 5), rr = r & 15, cc = c & 31, ob = rr * 64 + cc * 2; return st * 1024 + (ob ^ (((ob >> 9) & 1) << 5)); }
__host__ __device__ __forceinline__ void stage_rc(int b, int& R, int& C) { const int st = b / 1024, sb = b % 1024, swz = sb ^ (((sb >> 9) & 1) << 5); R = (st >> 1) * 16 + swz / 64; C = (st & 1) * 32 + (swz % 64) / 2; }
__host__ __device__ __forceinline__ int perm32(int rho) { const int n = rho >> 4, i = rho & 15; return 8 * (i >> 2) + 4 * n + (i & 3); }

struct Unit { int pm, pn; };
struct Gemm { const bf16_t* A; const bf16_t* Bt; int M, N, K; };

struct StaticOrder {
    int nM, nN, nwg, G, c;
    __host__ __device__ void init(int M, int N, int G_, int c_) { nM = M / BM; nN = N / BM; nwg = nM * nN; G = G_; c = c_; }
    __host__ __device__ bool next(int i, Unit& u) const {
        const long L = (long)i * G + c; if (L >= nwg) return false;
        int wgid = (int)L; { const int q = nwg / NXCD, r = nwg % NXCD, xcd = wgid % NXCD, off = wgid / NXCD; wgid = (xcd < r ? xcd * (q + 1) : r * (q + 1) + (xcd - r) * q) + off; }
        const int nig = WGM * nN, gid = wgid / nig, fm = gid * WGM, gsz = (nM - fm) < WGM ? (nM - fm) : WGM;
        u.pm = fm + ((wgid % nig) % gsz); u.pn = (wgid % nig) / gsz; return true;
    }
    __device__ __forceinline__ void a_ready(const Unit&) const {}
    __device__ __forceinline__ void done(const Unit&) const {}
};
__device__ __forceinline__ unsigned cvt_pk_bf16(float lo, float hi) { unsigned r; asm volatile("v_cvt_pk_bf16_f32 %0, %1, %2" : "=v"(r) : "v"(lo), "v"(hi)); return r; }
typedef float f32x2 __attribute__((ext_vector_type(2)));
template <class Epi, class Sched, bool ALIGN_EPI = false, bool SP2 = false>
__device__ __forceinline__ void gemm_phase(PG8_LAS unsigned char* lds, const Gemm g, const Sched& S, const Epi& E) {
    int tid_ = threadIdx.x; asm volatile("" : "+v"(tid_));
    const int tid = tid_, wid = __builtin_amdgcn_readfirstlane(tid >> 6), lane = tid & 63, wr = wid >> 2, wc = wid & 3, fr = lane & 15, fq = lane >> 4;
    const int K = g.K, nt = K / BK;
    unsigned voffA[2], voffB[2];
#pragma unroll
    for (int i = 0; i < 2; ++i) { int R, C; stage_rc(tid * 16 + i * 8192, R, C); const int Rb = Epi::PERM ? ((R & ~31) + perm32(R & 31)) : R;
        voffA[i] = (unsigned)(R * K + C) * 2u; voffB[i] = (unsigned)(Rb * K + C) * 2u; }
    const size_t kstep = (size_t)(BK * 2);
    const size_t hstep = (size_t)HALF * K * 2;
    const size_t tstep = 2 * hstep;
    const unsigned ldsw = (unsigned)wid * 1024u;
    const int aoff = lds_byte(wr * 64 + fr, fq * 8), boff = lds_byte(wc * 32 + fr, fq * 8);
#define PG8_SA(b, h) (((b) * 2 + (h)) * HTB)
#define PG8_SB(b, h) ((4 + (b) * 2 + (h)) * HTB)
#define PG8_STAGE(bufoff, gbase, voff) do { _Pragma("unroll") for (int _i = 0; _i < 2; ++_i) \
        __builtin_amdgcn_global_load_lds((const unsigned*)((const char*)(gbase) + (voff)[_i]), (PG8_LAS unsigned*)(lds + (bufoff) + ldsw + _i * 8192), 16, 0, 0); } while (0)
#define PG8_LDA(dst, b, h) do { _Pragma("unroll") for (int m = 0; m < 4; ++m) _Pragma("unroll") for (int k = 0; k < 2; ++k) dst[m][k] = *(const PG8_LAS bf16x8*)(lds + PG8_SA(b, h) + aoff + m * 2048 + k * 1024); } while (0)
#define PG8_LDB(dst, b, h) do { _Pragma("unroll") for (int n = 0; n < 2; ++n) _Pragma("unroll") for (int k = 0; k < 2; ++k) dst[n][k] = *(const PG8_LAS bf16x8*)(lds + PG8_SB(b, h) + boff + n * 2048 + k * 1024); } while (0)
#define PG8_MMA(ai, bj, At, Bt) do { __builtin_amdgcn_s_setprio(1); _Pragma("unroll") for (int m = 0; m < 4; ++m) _Pragma("unroll") for (int n = 0; n < 2; ++n) _Pragma("unroll") for (int k = 0; k < 2; ++k) \
        acc[ai][bj][m][n] = __builtin_amdgcn_mfma_f32_16x16x32_bf16(Bt[n][k], At[m][k], acc[ai][bj][m][n], 0, 0, 0); __builtin_amdgcn_s_setprio(0); } while (0)
#define PG8_WAIT_V(n) asm volatile("s_waitcnt vmcnt(" #n ")" ::: "memory")
#define PG8_WAIT_L(n) asm volatile("s_waitcnt lgkmcnt(" #n ")" ::: "memory")
#define PG8_BAR __builtin_amdgcn_s_barrier()
#define PG8_SCHED __builtin_amdgcn_sched_barrier(0)
    Unit cur, nxt; int ui = 0;
    if (!S.next(0, cur)) return;
    f32x4 acc[2][2][4][2];
#pragma unroll
    for (int a = 0; a < 2; ++a)
#pragma unroll
        for (int b = 0; b < 2; ++b)
#pragma unroll
            for (int m = 0; m < 4; ++m)
#pragma unroll
                for (int n = 0; n < 2; ++n) acc[a][b][m][n] = (f32x4){0.f, 0.f, 0.f, 0.f};
    bf16x8 At[4][2], B0[2][2], B1[2][2];
    const char* cA = (const char*)g.A + (size_t)cur.pm * tstep; const char* cB = (const char*)g.Bt + (size_t)cur.pn * tstep;
    S.a_ready(cur);
    if constexpr (SP2) {
        PG8_STAGE(PG8_SB(0, 0), cB, voffB); PG8_STAGE(PG8_SB(0, 1), cB + hstep, voffB); PG8_STAGE(PG8_SA(0, 0), cA, voffA); PG8_STAGE(PG8_SA(0, 1), cA + hstep, voffA);
        if (wr == 1) PG8_BAR;
        PG8_WAIT_V(2); PG8_BAR;
        PG8_STAGE(PG8_SB(1, 0), cB + kstep, voffB); PG8_STAGE(PG8_SA(1, 0), cA + kstep, voffA); PG8_STAGE(PG8_SB(1, 1), cB + hstep + kstep, voffB);
        PG8_WAIT_V(6); PG8_BAR;
    } else {
        PG8_STAGE(PG8_SB(0, 0), cB, voffB); PG8_STAGE(PG8_SA(0, 0), cA, voffA); PG8_STAGE(PG8_SB(0, 1), cB + hstep, voffB); PG8_STAGE(PG8_SA(0, 1), cA + hstep, voffA);
        if (wr == 1) PG8_BAR;
        PG8_WAIT_V(4); PG8_BAR;
        PG8_STAGE(PG8_SB(1, 0), cB + kstep, voffB); PG8_STAGE(PG8_SA(1, 0), cA + kstep, voffA); PG8_STAGE(PG8_SB(1, 1), cB + hstep + kstep, voffB);
        PG8_WAIT_V(6); PG8_BAR;
    }
    for (;;) {
        const bool has_next = S.next(ui + 1, nxt);
        const char* nA = has_next ? (const char*)g.A + (size_t)nxt.pm * tstep : cA; const char* nB = has_next ? (const char*)g.Bt + (size_t)nxt.pn * tstep : cB;
        for (int t = 0; t < nt; t += 2) {
            const bool last = (t == nt - 2);
            const char* a1 = cA + (size_t)(t + 1) * kstep;
            const char* a2 = last ? nA : cA + (size_t)(t + 2) * kstep; const char* b2 = last ? nB : cB + (size_t)(t + 2) * kstep;
            const char* a3 = a2 + kstep; const char* b3 = b2 + kstep;
            if (last && has_next) S.a_ready(nxt);
            if constexpr (SP2) {
            PG8_LDB(B0, 0, 0); PG8_LDB(B1, 0, 1); PG8_SCHED; PG8_LDA(At, 0, 0); PG8_STAGE(PG8_SA(1, 1), a1 + hstep, voffA);
            PG8_WAIT_V(8); PG8_WAIT_L(0); PG8_BAR; PG8_MMA(0, 0, At, B0); PG8_MMA(0, 1, At, B1); PG8_BAR; PG8_SCHED;
            PG8_LDA(At, 0, 1); PG8_STAGE(PG8_SB(0, 0), b2, voffB); PG8_STAGE(PG8_SB(0, 1), b2 + hstep, voffB); PG8_STAGE(PG8_SA(0, 0), a2, voffA);
            PG8_WAIT_V(8); PG8_WAIT_L(0); PG8_BAR; PG8_MMA(1, 0, At, B0); PG8_MMA(1, 1, At, B1); PG8_BAR; PG8_SCHED;
            PG8_LDB(B0, 1, 0); PG8_LDB(B1, 1, 1); PG8_SCHED; PG8_LDA(At, 1, 0); PG8_STAGE(PG8_SA(0, 1), a2 + hstep, voffA);
            PG8_WAIT_V(8); PG8_WAIT_L(0); PG8_BAR; PG8_MMA(0, 0, At, B0); PG8_MMA(0, 1, At, B1); PG8_BAR; PG8_SCHED;
            PG8_LDA(At, 1, 1); PG8_STAGE(PG8_SB(1, 0), b3, voffB); PG8_STAGE(PG8_SB(1, 1), b3 + hstep, voffB); PG8_STAGE(PG8_SA(1, 0), a3, voffA);
            PG8_WAIT_V(8); PG8_WAIT_L(0); PG8_BAR; PG8_MMA(1, 0, At, B0); PG8_MMA(1, 1, At, B1); PG8_BAR; PG8_SCHED;
            } else {
            PG8_LDB(B0, 0, 0); PG8_SCHED; PG8_LDA(At, 0, 0); PG8_STAGE(PG8_SA(1, 1), a1 + hstep, voffA);
            PG8_WAIT_L(8); PG8_BAR; PG8_WAIT_L(0); PG8_MMA(0, 0, At, B0); PG8_BAR; PG8_SCHED;
            PG8_LDB(B1, 0, 1); PG8_STAGE(PG8_SB(0, 0), b2, voffB);
            PG8_BAR; PG8_WAIT_L(0); PG8_MMA(0, 1, At, B1); PG8_BAR;
            PG8_LDA(At, 0, 1); PG8_STAGE(PG8_SA(0, 0), a2, voffA);
            PG8_BAR; PG8_WAIT_L(0); PG8_MMA(1, 0, At, B0); PG8_BAR; PG8_SCHED;
            PG8_STAGE(PG8_SB(0, 1), b2 + hstep, voffB);
            PG8_WAIT_V(6); PG8_BAR; PG8_MMA(1, 1, At, B1); PG8_BAR;
            PG8_LDB(B0, 1, 0); PG8_SCHED; PG8_LDA(At, 1, 0); PG8_STAGE(PG8_SA(0, 1), a2 + hstep, voffA);
            PG8_WAIT_L(8); PG8_BAR; PG8_WAIT_L(0); PG8_MMA(0, 0, At, B0); PG8_BAR; PG8_SCHED;
            PG8_LDB(B1, 1, 1); PG8_STAGE(PG8_SB(1, 0), b3, voffB);
            PG8_BAR; PG8_WAIT_L(0); PG8_MMA(0, 1, At, B1); PG8_BAR;
            PG8_LDA(At, 1, 1); PG8_STAGE(PG8_SA(1, 0), a3, voffA);
            PG8_BAR; PG8_WAIT_L(0); PG8_MMA(1, 0, At, B0); PG8_BAR; PG8_SCHED;
            PG8_STAGE(PG8_SB(1, 1), b3 + hstep, voffB);
            PG8_WAIT_V(6); PG8_BAR; PG8_MMA(1, 1, At, B1); PG8_BAR;
            }
        }
        if constexpr (ALIGN_EPI) { if (wr == 0) PG8_BAR; }
        if constexpr (!Epi::AFTER_DRAIN) { E(acc, cur, wr, wc, fr, fq); S.done(cur); }
        if (!has_next) break;
#pragma unroll
        for (int a = 0; a < 2; ++a)
#pragma unroll
            for (int b = 0; b < 2; ++b)
#pragma unroll
                for (int m = 0; m < 4; ++m)
#pragma unroll
                    for (int n = 0; n < 2; ++n) acc[a][b][m][n] = (f32x4){0.f, 0.f, 0.f, 0.f};
        cur = nxt; cA = nA; cB = nB; ++ui;
        if constexpr (ALIGN_EPI) { if (wr == 1) PG8_BAR; }
    }
    PG8_WAIT_V(0);
    if constexpr (!ALIGN_EPI) { if (wr == 0) PG8_BAR; }
    PG8_BAR;
    if constexpr (Epi::AFTER_DRAIN) { E.fused(acc, cur, wr, wc, fr, fq, lds, wid, lane); S.done(cur); }
#undef PG8_SA
#undef PG8_SB
#undef PG8_STAGE
#undef PG8_LDA
#undef PG8_LDB
#undef PG8_MMA
#undef PG8_WAIT_V
#undef PG8_WAIT_L
#undef PG8_BAR
#undef PG8_SCHED
}
}
namespace att {
using bf16 = __hip_bfloat16;
constexpr int   D = 128, NW = 8, QBLK = 32, KVBLK = 64;
constexpr float SCALE = 0.088388347648318440f;
constexpr float THR = 8.f;
constexpr int LDQ = 7168, LDK = 7168, LDO = 1024;
constexpr size_t SHM_V = KVBLK * D * 2, SHM_K = KVBLK * D * 2, SHM_ATTN = 2 * SHM_V + 2 * SHM_K + NW * 64 * 4;
using bf16x8 = __attribute__((ext_vector_type(8))) short;
using s16x4  = __attribute__((ext_vector_type(4))) short;
using f32x16 = __attribute__((ext_vector_type(16))) float;
using u32x4  = __attribute__((ext_vector_type(4))) unsigned;
#define KSWZ(row, colB) ((row) * 256 + ((colB) ^ (((row) & 7) << 4)))
#define SBAR() __builtin_amdgcn_sched_barrier(0)
__device__ __forceinline__ int crow(int r, int hi) { return (r & 3) + 8 * (r >> 2) + 4 * hi; }
__device__ __forceinline__ unsigned cvtpk(float lo, float hi) {
  unsigned r; asm volatile("v_cvt_pk_bf16_f32 %0, %1, %2" : "=v"(r) : "v"(lo), "v"(hi)); return r;
}
__device__ __forceinline__ bf16x8 ld8(const bf16* p) { return *reinterpret_cast<const bf16x8*>(p); }
__device__ __forceinline__ void partialSM(f32x16& p0, f32x16& p1, float& m_reg, float& mn, float& alpha) {
  constexpr float C = SCALE * 1.4426950408889634f;
  float pmax = p0[0]; for (int r = 1; r < 16; ++r) pmax = fmaxf(pmax, p0[r]); for (int r = 0; r < 16; ++r) pmax = fmaxf(pmax, p1[r]);
  { auto rr = __builtin_amdgcn_permlane32_swap(__float_as_uint(pmax), __float_as_uint(pmax), false, false);
    pmax = fmaxf(__uint_as_float(rr[0]), __uint_as_float(rr[1])); }
  if (__builtin_expect(__all(pmax - m_reg <= THR / SCALE), 1)) { mn = m_reg; alpha = 1.f; }
  else { mn = fmaxf(m_reg, pmax); alpha = __builtin_amdgcn_exp2f((m_reg - mn) * C); m_reg = mn; }
  float mnC = -mn * C;
  for (int r = 0; r < 16; ++r) p0[r] = fmaf(p0[r], C, mnC); for (int r = 0; r < 16; ++r) p1[r] = fmaf(p1[r], C, mnC);
  for (int r = 0; r < 16; ++r) p0[r] = __builtin_amdgcn_exp2f(p0[r]);
}
__device__ __forceinline__ void finishSM(f32x16& p0, f32x16& p1, float alpha, float& l_reg, bf16x8& pa0, bf16x8& pa1, bf16x8& pa2, bf16x8& pa3) {
  for (int r = 0; r < 16; ++r) p1[r] = __builtin_amdgcn_exp2f(p1[r]);
  float ps = 0; for (int r = 0; r < 16; ++r) ps += p0[r]; for (int r = 0; r < 16; ++r) ps += p1[r];
  { auto rr = __builtin_amdgcn_permlane32_swap(__float_as_uint(ps), __float_as_uint(ps), false, false);
    ps = __uint_as_float(rr[0]) + __uint_as_float(rr[1]); }
  l_reg = l_reg * alpha + ps;
#define PK4(P, BASE, OUT) do { unsigned a0 = cvtpk(P[BASE + 0], P[BASE + 1]), a1 = cvtpk(P[BASE + 2], P[BASE + 3]);   \
    unsigned b0 = cvtpk(P[BASE + 4], P[BASE + 5]), b1 = cvtpk(P[BASE + 6], P[BASE + 7]);                              \
    auto r0 = __builtin_amdgcn_permlane32_swap(a0, b0, false, false); auto r1 = __builtin_amdgcn_permlane32_swap(a1, b1, false, false); \
    u32x4 w = {r0[0], r1[0], r0[1], r1[1]}; OUT = *reinterpret_cast<bf16x8*>(&w); } while (0)
  PK4(p0, 0, pa0); PK4(p0, 8, pa1); PK4(p1, 0, pa2); PK4(p1, 8, pa3);
#undef PK4
}
__device__ __forceinline__ void qkt(f32x16& p0, f32x16& p1, const bf16* Ks, const bf16x8* qr, int r32, int hi) {
  p0 = f32x16{}; p1 = f32x16{};
  for (int d0 = 0; d0 < 8; ++d0) { int cb = (d0 * 16 + hi * 8) * 2;
    bf16x8 b0 = *reinterpret_cast<const bf16x8*>((const char*)Ks + KSWZ(r32, cb));
    bf16x8 b1 = *reinterpret_cast<const bf16x8*>((const char*)Ks + KSWZ(32 + r32, cb));
    p0 = __builtin_amdgcn_mfma_f32_32x32x16_bf16(b0, qr[d0], p0, 0, 0, 0);
    p1 = __builtin_amdgcn_mfma_f32_32x32x16_bf16(b1, qr[d0], p1, 0, 0, 0); }
}
__device__ __forceinline__ int v_st(int k, int c) { const int kk = (k & ~0xC) | ((k & 4) << 1) | ((k & 8) >> 1); return ((kk >> 3) * 4 + (c >> 5)) * 512 + ((kk & 7) * 32 + (c & 31)) * 2; }
__device__ __forceinline__ int v_rd_base(int lane) { return ((lane & 3) << 3) | (((lane >> 2) & 3) << 6) | (((lane >> 4) & 1) << 5) | (((lane >> 5) & 1) << 8); }
constexpr int v_rd_off(int d0, int ks, int half) { return d0 * 512 + ks * 4096 + half * 2048; }
template <int OFF> __device__ __forceinline__ s16x4 tr_read(int vb) {
  s16x4 r; asm volatile("ds_read_b64_tr_b16 %0, %1 offset:%2" : "=&v"(r) : "v"(vb), "i"(OFF) : "memory"); return r;
}
template <int D0> __device__ __forceinline__ void pv_one(f32x16& od, int vb, bf16x8 pa0, bf16x8 pa1, bf16x8 pa2, bf16x8 pa3) {
  const s16x4 l0 = tr_read<v_rd_off(D0, 0, 0)>(vb), h0 = tr_read<v_rd_off(D0, 0, 1)>(vb), l1 = tr_read<v_rd_off(D0, 1, 0)>(vb), h1 = tr_read<v_rd_off(D0, 1, 1)>(vb);
  const s16x4 l2 = tr_read<v_rd_off(D0, 2, 0)>(vb), h2 = tr_read<v_rd_off(D0, 2, 1)>(vb), l3 = tr_read<v_rd_off(D0, 3, 0)>(vb), h3 = tr_read<v_rd_off(D0, 3, 1)>(vb);
  asm volatile("s_waitcnt lgkmcnt(0)" ::: "memory"); SBAR();
#define PK(L, H) (bf16x8){L[0], L[1], L[2], L[3], H[0], H[1], H[2], H[3]}
  od = __builtin_amdgcn_mfma_f32_32x32x16_bf16(pa0, PK(l0, h0), od, 0, 0, 0);
  od = __builtin_amdgcn_mfma_f32_32x32x16_bf16(pa1, PK(l1, h1), od, 0, 0, 0);
  od = __builtin_amdgcn_mfma_f32_32x32x16_bf16(pa2, PK(l2, h2), od, 0, 0, 0);
  od = __builtin_amdgcn_mfma_f32_32x32x16_bf16(pa3, PK(l3, h3), od, 0, 0, 0);
#undef PK
}
__device__ __forceinline__ void pv_d0(f32x16* o, int vb, bf16x8 pa0, bf16x8 pa1, bf16x8 pa2, bf16x8 pa3) {
  pv_one<0>(o[0], vb, pa0, pa1, pa2, pa3); pv_one<1>(o[1], vb, pa0, pa1, pa2, pa3); pv_one<2>(o[2], vb, pa0, pa1, pa2, pa3); pv_one<3>(o[3], vb, pa0, pa1, pa2, pa3);
}
__device__ __forceinline__ void attn_dense_body(const bf16* __restrict__ Qb, const bf16* __restrict__ Kh, const bf16* __restrict__ Vh,
                                                bf16* __restrict__ Ob, int seq, char* lds) {
  int tid_ = threadIdx.x; asm volatile("" : "+v"(tid_));
  const int tid = tid_, wid = tid >> 6, lane = tid & 63, r32 = lane & 31, hi = lane >> 5;
  bf16* V_lds = (bf16*)lds; bf16* K_lds = (bf16*)(lds + 2 * SHM_V);
  float* ws = (float*)(lds + 2 * SHM_V + 2 * SHM_K) + wid * 64; float* li_l = ws; float* al_l = ws + 32;
  float m_reg = -1e30f, l_reg = 0; f32x16 o[4] = {}; bf16x8 qr[8];
  const bf16* Qw = Qb + (long)(wid * QBLK + r32) * LDQ + hi * 8;
#pragma unroll
  for (int d0 = 0; d0 < 8; ++d0) qr[d0] = ld8(Qw + d0 * 16);
  const int sr = tid >> 4, sc = (tid & 15) * 8, vst0 = v_st(sr, sc), vst1 = v_st(32 + sr, sc);
  const int vb0 = (int)(uintptr_t)V_lds + v_rd_base(lane);
  struct { bf16x8 vs0, vs1, ks0, ks1; } sr_[2];
#define SLOAD(i, k0) do { sr_[i].vs0 = ld8(&Vh[(long)((k0) + sr) * LDK + sc]); sr_[i].vs1 = ld8(&Vh[(long)((k0) + 32 + sr) * LDK + sc]); \
    sr_[i].ks0 = ld8(&Kh[(long)((k0) + sr) * LDK + sc]); sr_[i].ks1 = ld8(&Kh[(long)((k0) + 32 + sr) * LDK + sc]); } while (0)
#define SWRITE(b, i) do { *(bf16x8*)((char*)V_lds + (b) * SHM_V + vst0) = sr_[i].vs0;          \
    *(bf16x8*)((char*)V_lds + (b) * SHM_V + vst1) = sr_[i].vs1; int kc = sc * 2;               \
    *(bf16x8*)((char*)K_lds + (b) * SHM_K + KSWZ(sr, kc)) = sr_[i].ks0;                       \
    *(bf16x8*)((char*)K_lds + (b) * SHM_K + KSWZ(32 + sr, kc)) = sr_[i].ks1; } while (0)
#define SWAIT() do { asm volatile("s_waitcnt vmcnt(4)" ::: "memory"); } while (0)
#define RESC(a) do { if (__any((a) < 1.f)) { if (hi == 0) al_l[r32] = (a); asm volatile("s_waitcnt lgkmcnt(0)" ::: "memory"); \
    for (int d = 0; d < 4; ++d) for (int r = 0; r < 16; ++r) o[d][r] *= al_l[crow(r, hi)]; } } while (0)
  f32x16 pA0, pA1, pB0, pB1; float mnA, mnB, alA, alB; bf16x8 pa0, pa1, pa2, pa3; const int NT = seq / KVBLK;
  constexpr int SE = 0, SO = 1;
  SLOAD(SE, 0); asm volatile("s_waitcnt vmcnt(0)" ::: "memory"); SWRITE(0, SE); __syncthreads();
  qkt(pA0, pA1, K_lds, qr, r32, hi); partialSM(pA0, pA1, m_reg, mnA, alA);
  SLOAD(SO, KVBLK); if (2 < NT) SLOAD(SE, 2 * KVBLK);
  SWAIT(); SWRITE(1, SO); __syncthreads();
  for (int j = 1; j + 1 < NT; j += 2) {
    SBAR(); qkt(pB0, pB1, (bf16*)((char*)K_lds + SHM_K), qr, r32, hi);
    finishSM(pA0, pA1, alA, l_reg, pa0, pa1, pa2, pa3); SBAR();
    SLOAD(SO, (j + 2) * KVBLK); SBAR();
    pv_d0(o, vb0, pa0, pa1, pa2, pa3); partialSM(pB0, pB1, m_reg, mnB, alB);
    __syncthreads(); SWAIT(); SWRITE(0, SE);
    RESC(alB); __syncthreads();
    SBAR(); qkt(pA0, pA1, K_lds, qr, r32, hi);
    finishSM(pB0, pB1, alB, l_reg, pa0, pa1, pa2, pa3); SBAR();
    if (j + 3 < NT) SLOAD(SE, (j + 3) * KVBLK); SBAR();
    pv_d0(o, vb0 + (int)SHM_V, pa0, pa1, pa2, pa3); partialSM(pA0, pA1, m_reg, mnA, alA);
    __syncthreads(); SWAIT(); SWRITE(1, SO);
    RESC(alA); __syncthreads();
  }
  SBAR(); qkt(pB0, pB1, (bf16*)((char*)K_lds + SHM_K), qr, r32, hi);
  finishSM(pA0, pA1, alA, l_reg, pa0, pa1, pa2, pa3); SBAR();
  pv_d0(o, vb0, pa0, pa1, pa2, pa3); partialSM(pB0, pB1, m_reg, mnB, alB);
  __syncthreads(); RESC(alB);
  finishSM(pB0, pB1, alB, l_reg, pa0, pa1, pa2, pa3); SBAR();
  pv_d0(o, vb0 + (int)SHM_V, pa0, pa1, pa2, pa3);
  if (hi == 0) li_l[r32] = l_reg; asm volatile("s_waitcnt lgkmcnt(0)" ::: "memory");
  float rli[16];
#pragma unroll
  for (int r = 0; r < 16; ++r) rli[r] = __builtin_amdgcn_rcpf(li_l[crow(r, hi)]);
  bf16* Ow = Ob + (long)(wid * QBLK) * LDO;
#pragma unroll
  for (int r = 0; r < 16; ++r) { int orow = crow(r, hi);
    for (int d0 = 0; d0 < 4; ++d0) Ow[(long)orow * LDO + d0 * 32 + r32] = __float2bfloat16(o[d0][r] * rli[r]); }
  __syncthreads();
#undef SLOAD
#undef SWRITE
#undef SWAIT
#undef RESC
}
#undef KSWZ
#undef SBAR
}
#define LAS __attribute__((address_space(3)))
typedef unsigned short bf16_t;
typedef float f32x4 __attribute__((ext_vector_type(4)));
typedef unsigned u32x4 __attribute__((ext_vector_type(4)));
typedef unsigned u32x2 __attribute__((ext_vector_type(2)));

#ifndef EXP_RW
#define EXP_RW 1.0f
#endif
#ifndef EXP_ATT
#define EXP_ATT 1.0f
#endif
#ifndef EXP_NOSCAN
#define EXP_NOSCAN 0
#endif
#ifndef EXP_ZFILL
#define EXP_ZFILL 0
#endif
#ifndef EXP_STATIC
#define EXP_STATIC 0
#endif
#ifndef EXP_TWICE
#define EXP_TWICE 0
#endif
#ifndef PROBE_REP3
#define PROBE_REP3 1
#endif
#ifndef PROBE_MASK
#define PROBE_MASK 0
#endif
#ifndef PREP_UNROLL
#define PREP_UNROLL 7
#endif
#ifndef EXP_MIX
#define EXP_MIX 1.0f
#endif
#ifndef EN_SCAN
#define EN_SCAN 1
#endif
#ifndef EN_ATT
#define EN_ATT 1
#endif
#ifndef EN_PREP
#define EN_PREP 1
#endif
#ifndef EN_GEMM
#define EN_GEMM 1
#endif
constexpr int NWAVES = 8, NTHREADS = 512;
constexpr int D = 1024, FF = 4096, NIN = 7040, NINP = 7168, RWC = 3456;
constexpr int MC = 16384, NCHUNK = 5, MTOT = 81920;
constexpr float ALPHA = 1.189207115002721f;
constexpr float LN_EPS = 1e-5f, GN_EPS = 64e-5f, RMS_EPS = 1e-6f;
constexpr float DECAY_SCALE = 0.6065306597126334f;

constexpr size_t MiB = 1u << 20;
constexpr size_t WS_CTL = 0;
constexpr size_t WS_WIN = 1 * MiB, WS_WPR = 15 * MiB, WS_WPA = 17 * MiB, WS_WOUT = 19 * MiB, WS_WF1 = 21 * MiB, WS_WF2 = 29 * MiB;
constexpr size_t WS_WUP = 37 * MiB, WS_AUP = 37 * MiB + 512 * 1024, WS_GUP = 38 * MiB;
constexpr size_t WS_XB = 40 * MiB, WS_OF = 40 * MiB;
constexpr size_t WS_Z = 72 * MiB;
constexpr size_t WS_OPR = 296 * MiB, WS_OPKH = 360 * MiB, WS_VS = 424 * MiB;
constexpr size_t WS_KS = 488 * MiB, WS_OB = 488 * MiB, WS_HB = 488 * MiB;
constexpr size_t WS_TW = 520 * MiB, WS_AD = 524 * MiB, WS_SG = 528 * MiB;
constexpr size_t WS_OPW = 532 * MiB, WS_OPAK = 660 * MiB, WS_OPKT = 788 * MiB;
constexpr size_t WS_G = 916 * MiB, WS_OATT = 948 * MiB, WS_END = 980 * MiB;
constexpr size_t WS_ORW = 532 * MiB, WS_M32 = 564 * MiB, WS_MB = 628 * MiB, WS_FFH = 660 * MiB;
constexpr int ZLD = 7168, ZQ = 3456, ZK = 4480, ZV = 4736, ZG = 4992;

constexpr int LDS_BYTES = 131072 + 1024;
constexpr int LDS_MISC = 131072;

#define INP(k) (A.in[(k) + z])
struct Args {
    const float* in[26];
    float* out; unsigned char* ws;
    int ph_lo, ph_hi;
};

__device__ __forceinline__ float bf2f(unsigned v) { return __uint_as_float(v << 16); }
__device__ __forceinline__ float bflo(unsigned w) { return __uint_as_float(w << 16); }
__device__ __forceinline__ float bfhi(unsigned w) { return __uint_as_float(w & 0xffff0000u); }
typedef float f32x2c_t __attribute__((ext_vector_type(2))); typedef __bf16 bf16x2c_t __attribute__((ext_vector_type(2)));
__device__ __forceinline__ unsigned pk2(float lo, float hi) { f32x2c_t v = {lo, hi}; bf16x2c_t b = __builtin_convertvector(v, bf16x2c_t); return __builtin_bit_cast(unsigned, b); }
__device__ __forceinline__ float sigmoidf_(float x) { return 1.0f / (1.0f + __expf(-x)); }
__device__ __forceinline__ float wave_sum(float v) {
#pragma unroll
    for (int o = 1; o < 64; o <<= 1) v += __shfl_xor(v, o);
    return v;
}

__device__ __forceinline__ void p0_transpose_item(const float* W, int K, int N, bf16_t* WT, LAS float* scr, int item, int lane) {
    const int nblk = N / 32, kb = item / nblk, nb = item % nblk, k0 = 64 * kb, n0 = 32 * nb;
#pragma unroll 8
    for (int i = 0; i < 32; ++i) { const int kk = 2 * i + (lane >> 5); scr[kk * 33 + (lane & 31)] = W[(size_t)(k0 + kk) * N + n0 + (lane & 31)]; }
    asm volatile("s_waitcnt lgkmcnt(0)" ::: "memory");
    const int c = lane & 7;
#pragma unroll
    for (int j = 0; j < 4; ++j) { const int n = (lane >> 3) + 8 * j; const LAS float* s = scr + (8 * c) * 33 + n;
        u32x4 o; o.x = pk2(s[0 * 33], s[1 * 33]); o.y = pk2(s[2 * 33], s[3 * 33]); o.z = pk2(s[4 * 33], s[5 * 33]); o.w = pk2(s[6 * 33], s[7 * 33]);
        *(u32x4*)(WT + (size_t)(n0 + n) * K + k0 + 8 * c) = o; }
    asm volatile("s_waitcnt lgkmcnt(0)" ::: "memory");
}

__device__ __forceinline__ void cvt_x_chunk(const float* x, bf16_t* xb, int gtid, int gthreads) {
    const size_t n8 = (size_t)MC * D / 8;
    for (size_t i = gtid; i < n8; i += gthreads) {
        const f32x4 a = *(const f32x4*)(x + i * 8), b = *(const f32x4*)(x + i * 8 + 4);
        u32x4 o; o.x = pk2(a.x, a.y); o.y = pk2(a.z, a.w); o.z = pk2(b.x, b.y); o.w = pk2(b.z, b.w);
        *(u32x4*)(xb + i * 8) = o;
    }
}

__device__ __forceinline__ void ln_rows(float* base, const float* g, const float* b, bf16_t* hb, int gw, int ngw, int lane) {
    f32x4 gg[4], bb[4];
#pragma unroll
    for (int j = 0; j < 4; ++j) { gg[j] = *((const f32x4*)g + 64 * j + lane); bb[j] = *((const f32x4*)b + 64 * j + lane); }
    for (int m0 = gw; m0 < MC; m0 += 2 * ngw) {
        const int m1 = m0 + ngw; const bool has1 = m1 < MC;
        f32x4* xr0 = (f32x4*)(base + (size_t)m0 * D) + lane; f32x4* xr1 = (f32x4*)(base + (size_t)(has1 ? m1 : m0) * D) + lane;
        f32x4 v0[4], v1[4]; float s0 = 0.f, s1 = 0.f;
#pragma unroll
        for (int j = 0; j < 4; ++j) { v0[j] = xr0[64 * j]; v1[j] = xr1[64 * j]; }
#pragma unroll
        for (int j = 0; j < 4; ++j) { s0 += (v0[j].x + v0[j].y) + (v0[j].z + v0[j].w); s1 += (v1[j].x + v1[j].y) + (v1[j].z + v1[j].w); }
        const float mean0 = wave_sum(s0) * (1.f / D), mean1 = wave_sum(s1) * (1.f / D); float q0 = 0.f, q1 = 0.f;
#pragma unroll
        for (int j = 0; j < 4; ++j) { v0[j] = v0[j] - mean0; v1[j] = v1[j] - mean1;
            q0 += (v0[j].x * v0[j].x + v0[j].y * v0[j].y) + (v0[j].z * v0[j].z + v0[j].w * v0[j].w); q1 += (v1[j].x * v1[j].x + v1[j].y * v1[j].y) + (v1[j].z * v1[j].z + v1[j].w * v1[j].w); }
        const float rstd0 = 1.f / sqrtf(wave_sum(q0) * (1.f / D) + LN_EPS), rstd1 = 1.f / sqrtf(wave_sum(q1) * (1.f / D) + LN_EPS);
#pragma unroll
        for (int j = 0; j < 4; ++j) {
            const f32x4 y0 = v0[j] * rstd0 * gg[j] + bb[j]; xr0[64 * j] = y0;
            if (hb) { u32x2 w; w.x = pk2(y0.x, y0.y); w.y = pk2(y0.z, y0.w); *(u32x2*)(hb + (size_t)m0 * D + 256 * j + 4 * lane) = w; }
            if (has1) { const f32x4 y1 = v1[j] * rstd1 * gg[j] + bb[j]; xr1[64 * j] = y1;
                if (hb) { u32x2 w; w.x = pk2(y1.x, y1.y); w.y = pk2(y1.z, y1.w); *(u32x2*)(hb + (size_t)m1 * D + 256 * j + 4 * lane) = w; } }
        }
    }
}

template <class F> struct Epi4 {
    static constexpr bool PERM = false, AFTER_DRAIN = false; F f;
    __device__ __forceinline__ void operator()(const pg8::f32x4 (&acc)[2][2][4][2], const pg8::Unit& u, int wr, int wc, int fr, int fq) const {
        const int row0 = u.pm * 256 + wr * 64 + fr, col0 = u.pn * 256 + wc * 32 + 4 * fq;
#pragma unroll
        for (int ai = 0; ai < 2; ++ai)
#pragma unroll
            for (int m = 0; m < 4; ++m)
#pragma unroll
                for (int bj = 0; bj < 2; ++bj)
#pragma unroll
                    for (int n = 0; n < 2; ++n) { f(row0 + ai * 128 + m * 16, col0 + bj * 128 + n * 16, acc[ai][bj][m][n]); asm volatile("" ::: "memory"); }
    }
};
template <class F> struct Epi8 {
    static constexpr bool PERM = true, AFTER_DRAIN = false; F f;
    __device__ __forceinline__ void operator()(const pg8::f32x4 (&acc)[2][2][4][2], const pg8::Unit& u, int wr, int wc, int fr, int fq) const {
        const int row0 = u.pm * 256 + wr * 64 + fr, col0 = u.pn * 256 + wc * 32 + 8 * fq;
#pragma unroll
        for (int ai = 0; ai < 2; ++ai)
#pragma unroll
            for (int m = 0; m < 4; ++m)
#pragma unroll
                for (int bj = 0; bj < 2; ++bj) { f(row0 + ai * 128 + m * 16, col0 + bj * 128, acc[ai][bj][m][0], acc[ai][bj][m][1]); asm volatile("" ::: "memory"); }
    }
};
__device__ __forceinline__ u32x4 pack8(f32x4 a, f32x4 b) { u32x4 w; w.x = pk2(a.x, a.y); w.y = pk2(a.z, a.w); w.z = pk2(b.x, b.y); w.w = pk2(b.z, b.w); return w; }

struct FZ { bf16_t* z;
    __device__ __forceinline__ void operator()(int row, int col, f32x4 a, f32x4 b) const { *(u32x4*)(z + (size_t)row * ZLD + col) = pack8(a, b); } };
struct FW { const float* w0; float* opw;
    __device__ __forceinline__ void operator()(int row, int col, f32x4 a) const {
        const f32x4 x = a + *(const f32x4*)(w0 + col); f32x4 y;
#pragma unroll
        for (int i = 0; i < 4; ++i) y[i] = __expf(-DECAY_SCALE * sigmoidf_(x[i]));
        *(f32x4*)(opw + (size_t)row * D + col) = y; } };
struct FA { const float *a0, *k_a; const bf16_t* ks; const float* kh; float *opak, *opkt;
    __device__ __forceinline__ void operator()(int row, int col, f32x4 acc) const {
        const size_t o = (size_t)row * D + col;
        const f32x4 x = acc + *(const f32x4*)(a0 + col), ka = *(const f32x4*)(k_a + col), khv = *(const f32x4*)(kh + o);
        const u32x2 kw = *(const u32x2*)(ks + o);
        f32x4 k; k.x = bflo(kw.x); k.y = bfhi(kw.x); k.z = bflo(kw.y); k.w = bfhi(kw.y);
        f32x4 ak, kt;
#pragma unroll
        for (int i = 0; i < 4; ++i) { const float a = sigmoidf_(x[i]); ak[i] = a * khv[i]; kt[i] = k[i] * (1.0f + (a - 1.0f) * ka[i]); }
        *(f32x4*)(opak + o) = ak; *(f32x4*)(opkt + o) = kt; } };
struct FG { bf16_t* g;
    __device__ __forceinline__ void operator()(int row, int col, f32x4 a) const {
        u32x2 w; w.x = pk2(a.x, a.y); w.y = pk2(a.z, a.w); *(u32x2*)(g + (size_t)row * D + col) = w; } };
typedef short bf16x8v __attribute__((ext_vector_type(8)));
template <int K, class F> __device__ __forceinline__ void wave_gemm_tile(const bf16_t* A, int aoff, const bf16_t* Bt, int m0, int n0, int lane, const F& f) {
    const int fr = lane & 15, fq = lane >> 4; constexpr int KS = K / 32;
    bf16x8v a[2][KS];
#pragma unroll
    for (int mt = 0; mt < 2; ++mt)
#pragma unroll
        for (int ks = 0; ks < KS; ++ks) a[mt][ks] = *(const bf16x8v*)(A + (size_t)(m0 + mt * 16 + fr) * 128 + aoff + ks * 32 + 8 * fq);
#pragma unroll 2
    for (int nt = 0; nt < 8; ++nt) {
        const bf16_t* bp = Bt + (size_t)(n0 + nt * 16 + fr) * K + 8 * fq;
        f32x4 acc0 = {0.f, 0.f, 0.f, 0.f}, acc1 = {0.f, 0.f, 0.f, 0.f};
#pragma unroll
        for (int ks = 0; ks < KS; ++ks) { const bf16x8v b = *(const bf16x8v*)(bp + ks * 32);
            acc0 = __builtin_amdgcn_mfma_f32_16x16x32_bf16(b, a[0][ks], acc0, 0, 0, 0); acc1 = __builtin_amdgcn_mfma_f32_16x16x32_bf16(b, a[1][ks], acc1, 0, 0, 0); }
        f(m0 + fr, n0 + nt * 16 + 4 * fq, acc0); f(m0 + 16 + fr, n0 + nt * 16 + 4 * fq, acc1);
    }
}
struct FP1 { const bf16_t* gates; float* m32;
    __device__ __forceinline__ void operator()(int row, int col, f32x4 a) const {
        const u32x2 gw = *(const u32x2*)(gates + (size_t)row * ZLD + ZG + col); f32x4 y;
        y.x = sigmoidf_(bflo(gw.x)) * a.x; y.y = sigmoidf_(bfhi(gw.x)) * a.y; y.z = sigmoidf_(bflo(gw.y)) * a.z; y.w = sigmoidf_(bfhi(gw.y)) * a.w; y = y * EXP_RW;
        *(f32x4*)(m32 + (size_t)row * D + col) = y;
    } };
struct FP2 { const bf16_t* gates; const float* m32; bf16_t* mb;
    __device__ __forceinline__ void operator()(int row, int col, f32x4 a) const {
        const u32x2 gw = *(const u32x2*)(gates + (size_t)row * ZLD + ZG + 1024 + col); const f32x4 p = *(const f32x4*)(m32 + (size_t)row * D + col); f32x4 y; a = a * EXP_ATT;
        y.x = p.x + sigmoidf_(bflo(gw.x)) * a.x; y.y = p.y + sigmoidf_(bfhi(gw.x)) * a.y; y.z = p.z + sigmoidf_(bflo(gw.y)) * a.z; y.w = p.w + sigmoidf_(bfhi(gw.y)) * a.w;
        u32x2 w; w.x = pk2(y.x, y.y); w.y = pk2(y.z, y.w); *(u32x2*)(mb + (size_t)row * D + col) = w;
    } };
struct FOut { const float* x; float* out;
    __device__ __forceinline__ void operator()(int row, int col, f32x4 a) const {
        const size_t o = (size_t)row * D + col; *(f32x4*)(out + o) = *(const f32x4*)(x + o) * ALPHA + a * EXP_MIX; } };
struct FF1 { bf16_t* ffh;
    __device__ __forceinline__ void operator()(int row, int col, f32x4 a, f32x4 b) const {
#pragma unroll
        for (int i = 0; i < 4; ++i) { const float u = fmaxf(a[i], 0.f), v = fmaxf(b[i], 0.f); a[i] = u * u; b[i] = v * v; }
        *(u32x4*)(ffh + (size_t)row * FF + col) = pack8(a, b); } };
struct FF2 { float* out;
    __device__ __forceinline__ void operator()(int row, int col, f32x4 a) const {
        const size_t o = (size_t)row * D + col; *(f32x4*)(out + o) = *(const f32x4*)(out + o) * ALPHA + a; } };

template <class E> __device__ __forceinline__ void run_gemm(LAS unsigned char* lds, const bf16_t* A, const bf16_t* Bt, int M, int N, int K, const E& e) {

    int G_ = (int)gridDim.x, c_ = (int)blockIdx.x; asm volatile("" : "+s"(G_), "+s"(c_));
    pg8::Gemm g{A, Bt, M, N, K}; pg8::StaticOrder S; S.init(M, N, G_, c_);
    if (EN_GEMM) pg8::gemm_phase<E, pg8::StaticOrder, true, true>(lds, g, S, e);
}

__device__ __forceinline__ void prep_rows(const float* mu_p, const float* mu_n, const float* k_k, const float* qn, const float* kn, unsigned char* ws, int T, int gw, int ngw, int lane, bool do_att) {
    bf16_t* Z = (bf16_t*)(ws + WS_Z);
    float* OPR = (float*)(ws + WS_OPR); float* OPKH = (float*)(ws + WS_OPKH); float* VS = (float*)(ws + WS_VS);
    bf16_t* KS = (bf16_t*)(ws + WS_KS); bf16_t* TW = (bf16_t*)(ws + WS_TW); bf16_t* AD = (bf16_t*)(ws + WS_AD); bf16_t* SG = (bf16_t*)(ws + WS_SG);
    for (int row = gw; row < MC; row += ngw) {
        const int t = row & (T - 1); const bool hp = t > 0, hn = t < T - 1;
        const bf16_t* zc = Z + (size_t)row * ZLD;
#pragma unroll PREP_UNROLL
        for (int pass = 0; pass < 7; ++pass) {
            const int c = pass * 512 + lane * 8;
            if (c < RWC) {
                const u32x4 wc_ = *(const u32x4*)(zc + c);
                u32x4 wp = {0u, 0u, 0u, 0u}, wn = {0u, 0u, 0u, 0u};
                if (hp) wp = *(const u32x4*)(zc - ZLD + c);
                if (hn) wn = *(const u32x4*)(zc + ZLD + c);
                const f32x4 mp0 = *(const f32x4*)(mu_p + c), mp1 = *(const f32x4*)(mu_p + c + 4), mn0 = *(const f32x4*)(mu_n + c), mn1 = *(const f32x4*)(mu_n + c + 4);
                float z[8];
#pragma unroll
                for (int i = 0; i < 4; ++i) {
                    const float c0 = bflo(wc_[i]), c1 = bfhi(wc_[i]), p0 = bflo(wp[i]), p1 = bfhi(wp[i]), n0 = bflo(wn[i]), n1 = bfhi(wn[i]);
                    const float mpa = (2 * i < 4) ? mp0[2 * i] : mp1[2 * i - 4], mpb = (2 * i + 1 < 4) ? mp0[2 * i + 1] : mp1[2 * i - 3];
                    const float mna = (2 * i < 4) ? mn0[2 * i] : mn1[2 * i - 4], mnb = (2 * i + 1 < 4) ? mn0[2 * i + 1] : mn1[2 * i - 3];
                    z[2 * i] = c0 + mpa * (p0 - c0) + mna * (n0 - c0);
                    z[2 * i + 1] = c1 + mpb * (p1 - c1) + mnb * (n1 - c1);
                }
                if (pass < 2) {
                    float* o = OPR + (size_t)row * D + c;
                    *(f32x4*)o = (f32x4){z[0], z[1], z[2], z[3]}; *(f32x4*)(o + 4) = (f32x4){z[4], z[5], z[6], z[7]};
                } else if (pass < 4) {
                    const int cc = c - 1024;
                    u32x4 w; w.x = pk2(z[0], z[1]); w.y = pk2(z[2], z[3]); w.z = pk2(z[4], z[5]); w.w = pk2(z[6], z[7]);
                    *(u32x4*)(KS + (size_t)row * D + cc) = w;
                    const f32x4 kk0 = *(const f32x4*)(k_k + cc), kk1 = *(const f32x4*)(k_k + cc + 4);
                    float kp[8]; float ss = 0.f;
#pragma unroll
                    for (int i = 0; i < 8; ++i) { kp[i] = z[i] * (i < 4 ? kk0[i] : kk1[i - 4]); ss += kp[i] * kp[i]; }
                    ss += __shfl_xor(ss, 1); ss += __shfl_xor(ss, 2); ss += __shfl_xor(ss, 4);
                    const float inv = 1.0f / fmaxf(sqrtf(ss), 1e-12f);
                    float* o = OPKH + (size_t)row * D + cc;
                    *(f32x4*)o = (f32x4){kp[0] * inv, kp[1] * inv, kp[2] * inv, kp[3] * inv}; *(f32x4*)(o + 4) = (f32x4){kp[4] * inv, kp[5] * inv, kp[6] * inv, kp[7] * inv};
                } else if (pass < 6) {
                    float* o = VS + (size_t)row * D + (c - 2048);
                    *(f32x4*)o = (f32x4){z[0], z[1], z[2], z[3]}; *(f32x4*)(o + 4) = (f32x4){z[4], z[5], z[6], z[7]};
                } else {
                    const int sect = lane >> 4, cc = (lane & 15) * 8;
                    float y[8];
#pragma unroll
                    for (int i = 0; i < 8; ++i) {
                        if (sect == 0) { const float e = __expf(2.0f * z[i]); y[i] = 1.0f - 2.0f / (e + 1.0f); }
                        else if (sect == 1) y[i] = z[i];
                        else y[i] = sigmoidf_(z[i]);
                    }
                    u32x4 w; w.x = pk2(y[0], y[1]); w.y = pk2(y[2], y[3]); w.z = pk2(y[4], y[5]); w.w = pk2(y[6], y[7]);
                    bf16_t* dst = (sect == 0 ? TW : (sect == 1 ? AD : SG)) + (size_t)row * 128 + cc;
                    *(u32x4*)dst = w;
                }
            }
        }
        bf16_t* qrow = Z + (size_t)row * ZLD + ZQ;
#pragma unroll 1
        for (int p = do_att ? 0 : 3; p < 3; ++p) {
            const int head = p * 4 + (lane >> 4), sub = lane & 15, d0 = sub * 8;
            const bool act = head < 10;
            bf16_t* px = qrow + head * 128 + d0;
            u32x4 w = {0u, 0u, 0u, 0u}; if (act) w = *(const u32x4*)px;
            float x[8]; float ss = 0.f;
#pragma unroll
            for (int i = 0; i < 4; ++i) { x[2 * i] = bflo(w[i]); x[2 * i + 1] = bfhi(w[i]); ss += x[2 * i] * x[2 * i] + x[2 * i + 1] * x[2 * i + 1]; }
            ss += __shfl_xor(ss, 1); ss += __shfl_xor(ss, 2); ss += __shfl_xor(ss, 4); ss += __shfl_xor(ss, 8);
            const float rinv = rsqrtf(ss * (1.0f / 128.0f) + RMS_EPS);
            const float* gn = (head < 8) ? qn : kn;
            const f32x4 g0 = *(const f32x4*)(gn + d0), g1 = *(const f32x4*)(gn + d0 + 4);
            const int axis = sub >> 3, hf = (sub >> 2) & 1;
            const float pos = (float)(axis ? (t & 63) : (t >> 6));
            float y[8];
#pragma unroll
            for (int i = 0; i < 8; ++i) {
                const float xn = x[i] * rinv * (i < 4 ? g0[i] : g1[i - 4]);
                const float xp = __shfl_xor(xn, 4);
                const int fi = (sub & 3) * 8 + i;
                const float ang = pos * exp2f(-0.41524101186092f * (float)fi);
                y[i] = xn * __cosf(ang) + (hf ? xp : -xp) * __sinf(ang);
            }
            if (act) { u32x4 o; o.x = pk2(y[0], y[1]); o.y = pk2(y[2], y[3]); o.z = pk2(y[4], y[5]); o.w = pk2(y[6], y[7]); *(u32x4*)px = o; }
        }
    }
}

__device__ __forceinline__ float rowsum16(float x) {
    x += __int_as_float(__builtin_amdgcn_update_dpp(0, __float_as_int(x), 0x128, 0xf, 0xf, true));
    x += __int_as_float(__builtin_amdgcn_update_dpp(0, __float_as_int(x), 0x124, 0xf, 0xf, true));
    x += __int_as_float(__builtin_amdgcn_update_dpp(0, __float_as_int(x), 0x122, 0xf, 0xf, true));
    x += __int_as_float(__builtin_amdgcn_update_dpp(0, __float_as_int(x), 0x121, 0xf, 0xf, true));
    return x;
}
__device__ __forceinline__ void post_rows(const float* r_k, const float* gn_g, const float* gn_b, unsigned char* ws, int gw, int ngw, int lane) {
    const bf16_t* OF = (const bf16_t*)(ws + WS_OF); const bf16_t* OB = (const bf16_t*)(ws + WS_OB);
    const float* OPR = (const float*)(ws + WS_OPR); const float* VS = (const float*)(ws + WS_VS);
    const float* KTF = (const float*)(ws + WS_OPKT); const float* KTB = KTF + (size_t)MC * D;
    const bf16_t* G = (const bf16_t*)(ws + WS_G); bf16_t* ORW = (bf16_t*)(ws + WS_ORW);
    const int hg = lane >> 4, sub = lane & 15;
    for (int row = gw; row < MC; row += ngw) {
        const size_t ro = (size_t)row * D;
#pragma unroll 2
        for (int pass = 0; pass < 4; ++pass) {
            const int c = (4 * pass + hg) * 64 + sub * 4; const size_t o = ro + c;
            const u32x2 wf = *(const u32x2*)(OF + o), wb = *(const u32x2*)(OB + o), wg = *(const u32x2*)(G + o);
            const f32x4 r4 = *(const f32x4*)(OPR + o), ktf = *(const f32x4*)(KTF + o), ktb = *(const f32x4*)(KTB + o), v4 = *(const f32x4*)(VS + o);
            const f32x4 rk = *(const f32x4*)(r_k + c), gg = *(const f32x4*)(gn_g + c), gb = *(const f32x4*)(gn_b + c);
            f32x4 ov; ov.x = bflo(wf.x) + bflo(wb.x); ov.y = bfhi(wf.x) + bfhi(wb.x); ov.z = bflo(wf.y) + bflo(wb.y); ov.w = bfhi(wf.y) + bfhi(wb.y);
            const float mean = rowsum16((ov.x + ov.y) + (ov.z + ov.w)) * (1.0f / 64.0f);
            const f32x4 dv = ov - mean;
            const float var = rowsum16((dv.x * dv.x + dv.y * dv.y) + (dv.z * dv.z + dv.w * dv.w)) * (1.0f / 64.0f);
            const f32x4 bt = r4 * (ktf + ktb) * rk;
            const float bs = rowsum16((bt.x + bt.y) + (bt.z + bt.w));
            const float rstd = rsqrtf(var + GN_EPS);
            f32x4 g4; g4.x = bflo(wg.x); g4.y = bfhi(wg.x); g4.z = bflo(wg.y); g4.w = bfhi(wg.y);
            const f32x4 y = (dv * rstd * gg + gb + v4 * bs) * g4;
            u32x2 w; w.x = pk2(y.x, y.y); w.y = pk2(y.z, y.w); *(u32x2*)(ORW + o) = w;
        }
    }
}

#define DPPQ(q) "quad_perm:[" #q "," #q "," #q "," #q "] row_mask:0xf bank_mask:0xf"
#define FMAC_DPP(acc, x, s, q) asm("v_fmac_f32_dpp %0, %1, %2 " DPPQ(q) : "+v"(acc) : "v"(x), "v"(s))
#define MUL_DPP(dst, x, s, q) asm("v_mul_f32_dpp %0, %1, %2 " DPPQ(q) : "=v"(dst) : "v"(x), "v"(s))
#define LBAR() asm volatile("s_waitcnt lgkmcnt(0)\n\ts_barrier" ::: "memory")

struct ScanCtx {
    const char* pb[5]; const char* pvb; unsigned voff, voffv; bf16_t* po; long r0, dstep; int T;
    LAS float* part; LAS float* opart; int wid, lane;
};
typedef float f32x2s __attribute__((ext_vector_type(2)));
__device__ __forceinline__ void scan_load1(const ScanCtx& C, int t, float (&X)[10], float& V) {
    const long ro = (C.r0 + C.dstep * (long)t) * (long)(D * 4);
#pragma unroll
    for (int a = 0; a < 5; ++a) { const f32x2s v = *(const f32x2s*)(C.pb[a] + ro + C.voff); X[2 * a] = v.x; X[2 * a + 1] = v.y; }
    V = *(const float*)(C.pvb + ro + C.voffv);
}
#define STEP_Q(i, q, j) do { float tmp_; MUL_DPP(tmp_, X[6 + j], vv, q); FMAC_DPP(tmp_, X[4 + j], nsk, q); FMAC_DPP(tmp_, X[2 + j], S[i], q); S[i] = tmp_; } while (0)
__device__ __forceinline__ void scan_step(const ScanCtx& C, int s, float (&S)[8], const float (&X)[10], float vv) {
    float p0 = 0.f, p1 = 0.f;
    FMAC_DPP(p0, X[0], S[0], 0); FMAC_DPP(p1, X[1], S[1], 0); FMAC_DPP(p0, X[0], S[2], 1); FMAC_DPP(p1, X[1], S[3], 1);
    FMAC_DPP(p0, X[0], S[4], 2); FMAC_DPP(p1, X[1], S[5], 2); FMAC_DPP(p0, X[0], S[6], 3); FMAC_DPP(p1, X[1], S[7], 3);
    LAS float* pp = C.part + (s & 1) * 512;
    pp[C.wid * 64 + C.lane] = p0 + p1;
    LBAR();
    const unsigned paddr = (unsigned)(unsigned long)(pp + C.lane);
    f32x2s r0, r1, r2, r3;
    asm volatile("ds_read2st64_b32 %0, %4 offset1:1\n\tds_read2st64_b32 %1, %4 offset0:2 offset1:3\n\tds_read2st64_b32 %2, %4 offset0:4 offset1:5\n\tds_read2st64_b32 %3, %4 offset0:6 offset1:7\n\ts_waitcnt lgkmcnt(0)"
                 : "=&v"(r0), "=&v"(r1), "=&v"(r2), "=&v"(r3) : "v"(paddr) : "memory");
    const float nsk = -(((r0.x + r0.y) + (r1.x + r1.y)) + ((r2.x + r2.y) + (r3.x + r3.y)));
    STEP_Q(0, 0, 0); STEP_Q(1, 0, 1); STEP_Q(2, 1, 0); STEP_Q(3, 1, 1);
    STEP_Q(4, 2, 0); STEP_Q(5, 2, 1); STEP_Q(6, 3, 0); STEP_Q(7, 3, 1);
    float o0 = 0.f, o1 = 0.f;
    FMAC_DPP(o0, X[8], S[0], 0); FMAC_DPP(o1, X[9], S[1], 0); FMAC_DPP(o0, X[8], S[2], 1); FMAC_DPP(o1, X[9], S[3], 1);
    FMAC_DPP(o0, X[8], S[4], 2); FMAC_DPP(o1, X[9], S[5], 2); FMAC_DPP(o0, X[8], S[6], 3); FMAC_DPP(o1, X[9], S[7], 3);
    C.opart[s * 512 + C.wid * 64 + C.lane] = o0 + o1;
}
__device__ __forceinline__ void scan_chain(unsigned char* ws, LAS unsigned char* lds, int s, int h, int d, int T, int rep) {
    int tid_ = threadIdx.x; asm volatile("" : "+v"(tid_));
    const int tid = tid_, lane = tid & 63, wid = __builtin_amdgcn_readfirstlane(tid >> 6);
    ScanCtx C; C.T = T; C.wid = wid; C.lane = lane;
    const int col = h * 64; const size_t dofs = (size_t)d * MC * D;
    const size_t ub = (size_t)(col + wid * 8) * 4;
    C.pb[0] = (const char*)(ws + WS_OPKH) + ub; C.pb[1] = (const char*)(ws + WS_OPW) + dofs * 4 + ub; C.pb[2] = (const char*)(ws + WS_OPAK) + dofs * 4 + ub;
    C.pb[3] = (const char*)(ws + WS_OPKT) + dofs * 4 + ub; C.pb[4] = (const char*)(ws + WS_OPR) + ub;
    C.pvb = (const char*)(ws + WS_VS) + (size_t)col * 4; C.voff = (unsigned)(lane & 3) * 8u; C.voffv = (unsigned)lane * 4u;
    C.po = (bf16_t*)(ws + (d ? WS_OB : WS_OF)) + col + lane; (void)rep;
    C.r0 = d ? (long)s * T + T - 1 : (long)s * T; C.dstep = d ? -1 : 1;
    C.part = (LAS float*)lds; C.opart = (LAS float*)(lds + 4096);
    float S[8];
#pragma unroll
    for (int i = 0; i < 8; ++i) S[i] = 0.f;
    float X[8][10], V[8];
#pragma unroll
    for (int i = 0; i < 8; ++i) scan_load1(C, i, X[i], V[i]);
    for (int t0 = 0; t0 < T; t0 += 8) {
        const bool more = t0 + 8 < T;
#pragma unroll
        for (int i = 0; i < 8; ++i) {
            scan_step(C, i, S, X[i], V[i]);
            if (more) scan_load1(C, t0 + 8 + i, X[i], V[i]);
        }
        LBAR();
        { float o = 0.f;
#pragma unroll
          for (int w = 0; w < 8; ++w) o += C.opart[wid * 512 + w * 64 + lane];
          C.po[(C.r0 + C.dstep * (long)(t0 + wid)) * D] = (bf16_t)(pk2(o, o) & 0xffffu); }
    }
    LBAR();
}

#define RLX_AGENT __ATOMIC_RELAXED, __HIP_MEMORY_SCOPE_AGENT
#define XB_TMO      128
#define XB_XCNT(j)  (256  + 64 * (j))
#define XB_XSUB(j)  (1280 + 64 * (j))
#define XB_XGEN(j)  (2304 + 64 * (j))
#define XB_TOP      3328
#define XB_TOPGEN   3392
#define XCD_BAR_WORDS 3456
#define XB_SPIN_CAP (1u << 28)

__device__ __forceinline__ unsigned xb_ld(unsigned* p)              { return __hip_atomic_load(p, __ATOMIC_RELAXED, __HIP_MEMORY_SCOPE_AGENT); }
__device__ __forceinline__ unsigned xb_add(unsigned* p, unsigned v) { return __hip_atomic_fetch_add(p, v, __ATOMIC_RELAXED, __HIP_MEMORY_SCOPE_AGENT); }
__device__ __forceinline__ unsigned xb_xcc_id() { return (unsigned)__builtin_amdgcn_s_getreg((3 << 11) | 20) & 0xFu; }
#define XB_SPIN(cond, bar) do { unsigned _sp = 0; while (cond) { __builtin_amdgcn_s_sleep(1); \
    if ((++_sp & 255u) == 0u) { if (xb_ld(&(bar)[XB_TMO])) break; if (_sp > XB_SPIN_CAP) { atomicAdd(&(bar)[XB_TMO], 1u); break; } } } } while (0)

struct XcdBarrier {
    unsigned* bar; unsigned x;
    volatile LAS unsigned* st;
};

__device__ __forceinline__ XcdBarrier xcd_barrier_post(unsigned* bar, volatile LAS unsigned* st) {
    XcdBarrier b; b.bar = bar; b.x = xb_xcc_id(); b.st = st;
    if (threadIdx.x == 0) (void)xb_add(&bar[XB_XCNT(b.x)], 1u);
    return b;
}
__device__ __forceinline__ void xcd_barrier_complete(unsigned* bar, unsigned x, unsigned& nloc, unsigned& nx) {
    const unsigned G = gridDim.x * gridDim.y * gridDim.z;
    unsigned sum, cnt, mine, sp = 0u;
    for (;;) {
        sum = 0u; cnt = 0u; mine = 0u;
#pragma unroll
        for (unsigned j = 0; j < 16; ++j) { const unsigned c = xb_ld(&bar[XB_XCNT(j)]); sum += c; cnt += (c > 0u) ? 1u : 0u; mine = (j == x) ? c : mine; }
        if (sum == G) break;
        __builtin_amdgcn_s_sleep(1);
        if ((++sp & 255u) == 0u) { if (xb_ld(&bar[XB_TMO])) break; if (sp > XB_SPIN_CAP) { atomicAdd(&bar[XB_TMO], 1u); break; } }
    }
    nloc = mine > 0u ? mine : 1u; nx = cnt > 0u ? cnt : 1u;
}

__device__ __forceinline__ void xcd_barrier(const XcdBarrier& b) {
    asm volatile("s_waitcnt vmcnt(0)" ::: "memory");
    __syncthreads();
    if (threadIdx.x == 0) {
        unsigned* bar = b.bar;
        __builtin_amdgcn_s_waitcnt(0);
        unsigned nloc = b.st[0], nx = b.st[1];
        if (nloc == 0u) { xcd_barrier_complete(bar, b.x, nloc, nx); b.st[0] = nloc; b.st[1] = nx; }
        const unsigned old = xb_add(&bar[XB_XSUB(b.x)], 1u);
        const unsigned gen = old / nloc;
        if (old + 1u == (gen + 1u) * nloc) {
            __builtin_amdgcn_fence(__ATOMIC_RELEASE, "agent");
            asm volatile("s_waitcnt vmcnt(0)" ::: "memory");
            const unsigned og = xb_add(&bar[XB_TOP], 1u);
            const unsigned tg = og / nx;
            if (og + 1u == (tg + 1u) * nx) xb_add(&bar[XB_TOPGEN], 1u);
            else XB_SPIN(xb_ld(&bar[XB_TOPGEN]) == tg, bar);
            __builtin_amdgcn_fence(__ATOMIC_ACQUIRE, "agent");
            xb_add(&bar[XB_XGEN(b.x)], 1u);
            asm volatile("s_waitcnt vmcnt(0)" ::: "memory");
        } else {
            XB_SPIN(xb_ld(&bar[XB_XGEN(b.x)]) == gen, bar);
            __builtin_amdgcn_fence(__ATOMIC_ACQUIRE, "agent");
            asm volatile("s_waitcnt vmcnt(0)" ::: "memory");
        }
    }
    __syncthreads();
}
__global__ void __launch_bounds__(NTHREADS, 2) mega_fwd(Args A) {
    extern __shared__ __attribute__((aligned(16))) unsigned char lds_raw[];
    LAS unsigned char* lds = (LAS unsigned char*)lds_raw;
    cg::grid_group grid = cg::this_grid();
#define TIDV int tid_ = threadIdx.x; asm volatile("" : "+v"(tid_)); const int tid = tid_, lane = tid & 63, wave = __builtin_amdgcn_readfirstlane(tid >> 6); \
    const int G = gridDim.x, gw = blockIdx.x * NWAVES + wave, ngw = G * NWAVES, gtid = blockIdx.x * NTHREADS + tid, gthreads = G * NTHREADS; \
    (void)lane; (void)gw; (void)ngw; (void)gtid; (void)gthreads;

    if (A.ph_hi < 0) grid.sync();
    if (EXP_ZFILL) { for (int i = threadIdx.x; i < LDS_BYTES / 4; i += NTHREADS) ((LAS unsigned*)lds)[i] = 0u; __syncthreads(); }
    { volatile LAS unsigned* misc = (volatile LAS unsigned*)(lds + LDS_MISC);
      if (threadIdx.x < 32) misc[threadIdx.x] = 0u;
      __syncthreads(); }
    XcdBarrier bar = xcd_barrier_post((unsigned*)(A.ws + WS_CTL) + 4096, (volatile LAS unsigned*)(lds + LDS_MISC) + 8);
    for (int ph = A.ph_lo; ph < A.ph_hi; ++ph) {
        if (ph > A.ph_lo) xcd_barrier(bar);
        int z = 0; asm volatile("" : "+s"(z));
        unsigned char* ws = A.ws + z;
        if (ph == 0) {
            TIDV
            LAS float* scr = (LAS float*)(lds + wave * 16384);
            constexpr int I_IN = 16 * (NIN / 32), I_SQ = 16 * 32, I_F1 = 16 * 128, I_F2 = 64 * 32, I_G = 2 * 32, I_U = 32;
            constexpr int NITEMS = I_IN + 3 * I_SQ + I_F1 + I_F2 + I_G + 4 * I_U;
            for (int it = gw; it < NITEMS; it += ngw) {
                int r = it;
                if (r < I_IN) { p0_transpose_item(INP(2), D, NIN, (bf16_t*)(ws + WS_WIN), scr, r, lane); continue; } r -= I_IN;
                if (r < I_SQ) { p0_transpose_item(INP(17), D, D, (bf16_t*)(ws + WS_WPR), scr, r, lane); continue; } r -= I_SQ;
                if (r < I_SQ) { p0_transpose_item(INP(18), D, D, (bf16_t*)(ws + WS_WPA), scr, r, lane); continue; } r -= I_SQ;
                if (r < I_SQ) { p0_transpose_item(INP(19), D, D, (bf16_t*)(ws + WS_WOUT), scr, r, lane); continue; } r -= I_SQ;
                if (r < I_F1) { p0_transpose_item(INP(22), D, FF, (bf16_t*)(ws + WS_WF1), scr, r, lane); continue; } r -= I_F1;
                if (r < I_F2) { p0_transpose_item(INP(23), FF, D, (bf16_t*)(ws + WS_WF2), scr, r, lane); continue; } r -= I_F2;
                if (r < I_G) { p0_transpose_item(INP(9), 128, D, (bf16_t*)(ws + WS_GUP), scr, r, lane); continue; } r -= I_G;
                { const int which = r / I_U, it2 = r % I_U, dd = which & 1;
                  p0_transpose_item((which < 2 ? INP(6) : INP(8)) + (size_t)dd * 64 * 1024, 64, D, (bf16_t*)(ws + (which < 2 ? WS_WUP : WS_AUP)) + (size_t)dd * 1024 * 64, scr, it2, lane); }
            }
            cvt_x_chunk(INP(0), (bf16_t*)(ws + WS_XB), gtid, gthreads);
            if (EXP_ZFILL) { u32x4* zo = (u32x4*)A.out; const size_t no = (size_t)MTOT * D / 4; const u32x4 z0 = {0u, 0u, 0u, 0u};
                for (size_t i = gtid; i < no; i += gthreads) zo[i] = z0; }
            if (EXP_ZFILL) { u32x4* zp = (u32x4*)(ws + WS_Z); const size_t n16 = (WS_END - WS_Z) / 16; const u32x4 zz = {0u, 0u, 0u, 0u};
                for (size_t i = gtid; i < n16; i += gthreads) zp[i] = zz; }
            continue;
        }
        const int c = (ph - 1) / 11, sub = (ph - 1) % 11;
        const int T = (c < 4) ? 2048 : 8192;
        const float* xin = (c < 4) ? INP(0) + (size_t)c * MC * D : INP(1);
        float* outc = A.out + (size_t)c * MC * D;
        for (int rp_ = 0; rp_ < (((PROBE_MASK >> sub) & 1) ? 2 : 1); ++rp_)
        if (sub == 0) {
            Epi8<FZ> e{{(bf16_t*)(ws + WS_Z)}};
            run_gemm(lds, (const bf16_t*)(ws + WS_XB), (const bf16_t*)(ws + WS_WIN), MC, NINP, D, e);
        } else if (sub == 1) {
            TIDV
            if (EN_PREP) prep_rows(INP(3), INP(4), INP(10), INP(15), INP(16), ws, T, gw, ngw, lane, rp_ == 0);
        } else if (sub == 2) {
            TIDV
            constexpr int TW_ = (MC / 32) * 8;
            for (int it = gw; it < 5 * TW_; it += ngw) {
                const int which = it / TW_, r = it % TW_, m0 = (r >> 3) * 32, n0 = (r & 7) * 128;
                if (which < 2) { FW f{INP(5) + which * 1024, (float*)(ws + WS_OPW) + (size_t)which * MC * D};
                    wave_gemm_tile<64>((const bf16_t*)(ws + WS_TW), which * 64, (const bf16_t*)(ws + WS_WUP) + (size_t)which * 1024 * 64, m0, n0, lane, f); }
                else if (which < 4) { const int dd = which - 2;
                    FA f{INP(7) + dd * 1024, INP(11), (const bf16_t*)(ws + WS_KS), (const float*)(ws + WS_OPKH), (float*)(ws + WS_OPAK) + (size_t)dd * MC * D, (float*)(ws + WS_OPKT) + (size_t)dd * MC * D};
                    wave_gemm_tile<64>((const bf16_t*)(ws + WS_AD), dd * 64, (const bf16_t*)(ws + WS_AUP) + (size_t)dd * 1024 * 64, m0, n0, lane, f); }
                else { FG f{(bf16_t*)(ws + WS_G)};
                    wave_gemm_tile<128>((const bf16_t*)(ws + WS_SG), 0, (const bf16_t*)(ws + WS_GUP), m0, n0, lane, f); }
            }
        } else if (sub == 3) {
            const int nseq = MC / T, nchain = nseq * 32, nqb = T / 256, natt = nseq * 8 * nqb;
            LAS unsigned* qslot = (LAS unsigned*)(lds + LDS_MISC); const int tid = threadIdx.x;
            for (int pass_ = 0; pass_ < PROBE_REP3; ++pass_)
            for (;;) {
                __syncthreads();
                if (tid == 0) qslot[0] = atomicAdd((unsigned*)(ws + WS_CTL) + 64 * c + 16 * pass_, 1u);
                __syncthreads();
                const int item = __builtin_amdgcn_readfirstlane((int)qslot[0]);
                if (item >= nchain + natt) break;
                if (item < nchain) scan_chain(ws, lds, item >> 5, (item >> 1) & 15, item & 1, T, 0);
                else {
                    const int u = item - nchain, qb = u % nqb, hq = (u / nqb) & 7, s = u / (nqb * 8);
                    const att::bf16* qkv = (const att::bf16*)(ws + WS_Z) + (size_t)s * T * ZLD;
                    att::attn_dense_body(qkv + (size_t)qb * 256 * ZLD + ZQ + hq * 128, qkv + ZK + (hq >> 2) * 128, qkv + ZV + (hq >> 2) * 128,
                                         (att::bf16*)(ws + WS_OATT) + ((size_t)s * T + (size_t)qb * 256) * D + hq * 128, T, (char*)lds_raw);
                }
            }
        } else if (sub == 4) {
            TIDV
            if (EN_PREP) post_rows(INP(12), INP(13), INP(14), ws, gw, ngw, lane);
        } else if (sub == 5) {
            { Epi4<FP1> e{{(const bf16_t*)(ws + WS_Z), (float*)(ws + WS_M32)}};
              run_gemm(lds, (const bf16_t*)(ws + WS_ORW), (const bf16_t*)(ws + WS_WPR), MC, D, D, e); }
            { Epi4<FP2> e{{(const bf16_t*)(ws + WS_Z), (const float*)(ws + WS_M32), (bf16_t*)(ws + WS_MB)}};
              run_gemm(lds, (const bf16_t*)(ws + WS_OATT), (const bf16_t*)(ws + WS_WPA), MC, D, D, e); }
        } else if (sub == 6) {
            Epi4<FOut> e{{xin, outc}};
            run_gemm(lds, (const bf16_t*)(ws + WS_MB), (const bf16_t*)(ws + WS_WOUT), MC, D, D, e);
        } else if (sub == 7) {
            TIDV
            ln_rows(outc, INP(20), INP(21), (bf16_t*)(ws + WS_HB), gw, ngw, lane);
        } else if (sub == 8) {
            Epi8<FF1> e{{(bf16_t*)(ws + WS_FFH)}};
            run_gemm(lds, (const bf16_t*)(ws + WS_HB), (const bf16_t*)(ws + WS_WF1), MC, FF, D, e);
        } else if (sub == 9) {
            Epi4<FF2> e{{outc}};
            run_gemm(lds, (const bf16_t*)(ws + WS_FFH), (const bf16_t*)(ws + WS_WF2), MC, D, FF, e);
        } else {
            TIDV
            ln_rows(outc, INP(24), INP(25), nullptr, gw, ngw, lane);
            if (c + 1 < NCHUNK) cvt_x_chunk((c + 1 < 4) ? INP(0) + (size_t)(c + 1) * MC * D : INP(1), (bf16_t*)(ws + WS_XB), gtid, gthreads);
        }
    }
}

constexpr int NPHASE = 1 + 11 * NCHUNK;
extern "C" void kernel_launch(void* const* d_in, const int* in_sizes, int n_in, void* d_out, int out_size, void* d_ws, size_t ws_size, hipStream_t stream) {
    static int grid = 0;
    if (grid == 0) {
        if (n_in != 26 || out_size != MTOT * D || ws_size < WS_END) { fprintf(stderr, "kernel_launch: unexpected shapes n_in %d out %d ws %zu\n", n_in, out_size, ws_size); grid = -1; return; }
        int dev = 0, cus = 0, per_cu = 0;
        hipGetDevice(&dev); hipDeviceGetAttribute(&cus, hipDeviceAttributeMultiprocessorCount, dev);
        if (hipFuncSetAttribute((const void*)mega_fwd, hipFuncAttributeMaxDynamicSharedMemorySize, LDS_BYTES) != hipSuccess) { fprintf(stderr, "kernel_launch: LDS attribute failed\n"); grid = -1; return; }
        if (hipOccupancyMaxActiveBlocksPerMultiprocessor(&per_cu, (const void*)mega_fwd, NTHREADS, LDS_BYTES) != hipSuccess || per_cu < 1) per_cu = 1;
        (void)hipGetLastError();
        grid = cus * (per_cu > 1 ? 1 : per_cu);
    }
    if (grid < 0) return;
    hipMemsetAsync((char*)d_ws + WS_CTL, 0, 64 * 1024, stream);
    Args a{};
    for (int i = 0; i < 26; ++i) a.in[i] = (const float*)d_in[i];
    a.out = (float*)d_out; a.ws = (unsigned char*)d_ws; a.ph_lo = 0; a.ph_hi = NPHASE;
    void* args[] = {&a};
    hipError_t e = hipLaunchCooperativeKernel((const void*)mega_fwd, dim3(grid), dim3(NTHREADS), args, LDS_BYTES, stream);
    if (e != hipSuccess) fprintf(stderr, "cooperative launch failed: %s (grid %d)\n", hipGetErrorString(e), grid);
}
```

```cpp
#include <hip/hip_runtime.h>
#include <hip/hip_bf16.h>
#include <hip/hip_cooperative_groups.h>
#include <cstdio>
#include <cstdint>
namespace cg = cooperative_groups;
namespace pg8 {
#define PG8_LAS __attribute__((address_space(3)))
typedef unsigned short bf16_t;
typedef short bf16x8 __attribute__((ext_vector_type(8)));
typedef float f32x4 __attribute__((ext_vector_type(4)));
typedef unsigned u32x4 __attribute__((ext_vector_type(4)));
constexpr int BM = 256, BK = 64, HALF = 128, HTB = HALF * BK * 2  , STAGE_BYTES = 8 * HTB, NXCD = 8, WGM = 8;

__host__ __device__ __forceinline__ int lds_byte(int r, int c) { const int st = (r >> 4) * 2 + (c >> 5), rr = r & 15, cc = c & 31, ob = rr * 64 + cc * 2; return st * 1024 + (ob ^ (((ob >> 9) & 1) << 5)); }
__host__ __device__ __forceinline__ void stage_rc(int b, int& R, int& C) { const int st = b / 1024, sb = b % 1024, swz = sb ^ (((sb >> 9) & 1) << 5); R = (st >> 1) * 16 + swz / 64; C = (st & 1) * 32 + (swz % 64) / 2; }
__host__ __device__ __forceinline__ int perm32(int rho) { const int n = rho >> 4, i = rho & 15; return 8 * (i >> 2) + 4 * n + (i & 3); }

struct Unit { int pm, pn; };
struct Gemm { const bf16_t* A; const bf16_t* Bt; int M, N, K; };

struct StaticOrder {
    int nM, nN, nwg, G, c;
    __host__ __device__ void init(int M, int N, int G_, int c_) { nM = M / BM; nN = N / BM; nwg = nM * nN; G = G_; c = c_; }
    __host__ __device__ bool next(int i, Unit& u) const {
        const long L = (long)i * G + c; if (L >= nwg) return false;
        int wgid = (int)L; { const int q = nwg / NXCD, r = nwg % NXCD, xcd = wgid % NXCD, off = wgid / NXCD; wgid = (xcd < r ? xcd * (q + 1) : r * (q + 1) + (xcd - r) * q) + off; }
        const int nig = WGM * nN, gid = wgid / nig, fm = gid * WGM, gsz = (nM - fm) < WGM ? (nM - fm) : WGM;
        u.pm = fm + ((wgid % nig) % gsz); u.pn = (wgid % nig) / gsz; return true;
    }
    __device__ __forceinline__ void a_ready(const Unit&) const {}
    __device__ __forceinline__ void done(const Unit&) const {}
};
__device__ __forceinline__ unsigned cvt_pk_bf16(float lo, float hi) { unsigned r; asm volatile("v_cvt_pk_bf16_f32 %0, %1, %2" : "=v"(r) : "v"(lo), "v"(hi)); return r; }
typedef float f32x2 __attribute__((ext_vector_type(2)));
template <class Epi, class Sched, bool ALIGN_EPI = false, bool SP2 = false>
__device__ __forceinline__ void gemm_phase(PG8_LAS unsigned char* lds, const Gemm g, const Sched& S, const Epi& E) {
    int tid_ = threadIdx.x; asm volatile("" : "+v"(tid_));
    const int tid = tid_, wid = __builtin_amdgcn_readfirstlane(tid >> 6), lane = tid & 63, wr = wid >> 2, wc = wid & 3, fr = lane & 15, fq = lane >> 4;
    const int K = g.K, nt = K / BK;
    unsigned voffA[2], voffB[2];
#pragma unroll
    for (int i = 0; i < 2; ++i) { int R, C; stage_rc(tid * 16 + i * 8192, R, C); const int Rb = Epi::PERM ? ((R & ~31) + perm32(R & 31)) : R;
        voffA[i] = (unsigned)(R * K + C) * 2u; voffB[i] = (unsigned)(Rb * K + C) * 2u; }
    const size_t kstep = (size_t)(BK * 2);
    const size_t hstep = (size_t)HALF * K * 2;
    const size_t tstep = 2 * hstep;
    const unsigned ldsw = (unsigned)wid * 1024u;
    const int aoff = lds_byte(wr * 64 + fr, fq * 8), boff = lds_byte(wc * 32 + fr, fq * 8);
#define PG8_SA(b, h) (((b) * 2 + (h)) * HTB)
#define PG8_SB(b, h) ((4 + (b) * 2 + (h)) * HTB)
#define PG8_STAGE(bufoff, gbase, voff) do { _Pragma("unroll") for (int _i = 0; _i < 2; ++_i) \
        __builtin_amdgcn_global_load_lds((const unsigned*)((const char*)(gbase) + (voff)[_i]), (PG8_LAS unsigned*)(lds + (bufoff) + ldsw + _i * 8192), 16, 0, 0); } while (0)
#define PG8_LDA(dst, b, h) do { _Pragma("unroll") for (int m = 0; m < 4; ++m) _Pragma("unroll") for (int k = 0; k < 2; ++k) dst[m][k] = *(const PG8_LAS bf16x8*)(lds + PG8_SA(b, h) + aoff + m * 2048 + k * 1024); } while (0)
#define PG8_LDB(dst, b, h) do { _Pragma("unroll") for (int n = 0; n < 2; ++n) _Pragma("unroll") for (int k = 0; k < 2; ++k) dst[n][k] = *(const PG8_LAS bf16x8*)(lds + PG8_SB(b, h) + boff + n * 2048 + k * 1024); } while (0)
#define PG8_MMA(ai, bj, At, Bt) do { __builtin_amdgcn_s_setprio(1); _Pragma("unroll") for (int m = 0; m < 4; ++m) _Pragma("unroll") for (int n = 0; n < 2; ++n) _Pragma("unroll") for (int k = 0; k < 2; ++k) \
        acc[ai][bj][m][n] = __builtin_amdgcn_mfma_f32_16x16x32_bf16(Bt[n][k], At[m][k], acc[ai][bj][m][n], 0, 0, 0); __builtin_amdgcn_s_setprio(0); } while (0)
#define PG8_WAIT_V(n) asm volatile("s_waitcnt vmcnt(" #n ")" ::: "memory")
#define PG8_WAIT_L(n) asm volatile("s_waitcnt lgkmcnt(" #n ")" ::: "memory")
#define PG8_BAR __builtin_amdgcn_s_barrier()
#define PG8_SCHED __builtin_amdgcn_sched_barrier(0)
    Unit cur, nxt; int ui = 0;
    if (!S.next(0, cur)) return;
    f32x4 acc[2][2][4][2];
#pragma unroll
    for (int a = 0; a < 2; ++a)
#pragma unroll
        for (int b = 0; b < 2; ++b)
#pragma unroll
            for (int m = 0; m < 4; ++m)
#pragma unroll
                for (int n = 0; n < 2; ++n) acc[a][b][m][n] = (f32x4){0.f, 0.f, 0.f, 0.f};
    bf16x8 At[4][2], B0[2][2], B1[2][2];
    const char* cA = (const char*)g.A + (size_t)cur.pm * tstep; const char* cB = (const char*)g.Bt + (size_t)cur.pn * tstep;
    S.a_ready(cur);
    if constexpr (SP2) {
        PG8_STAGE(PG8_SB(0, 0), cB, voffB); PG8_STAGE(PG8_SB(0, 1), cB + hstep, voffB); PG8_STAGE(PG8_SA(0, 0), cA, voffA); PG8_STAGE(PG8_SA(0, 1), cA + hstep, voffA);
        if (wr == 1) PG8_BAR;
        PG8_WAIT_V(2); PG8_BAR;
        PG8_STAGE(PG8_SB(1, 0), cB + kstep, voffB); PG8_STAGE(PG8_SA(1, 0), cA + kstep, voffA); PG8_STAGE(PG8_SB(1, 1), cB + hstep + kstep, voffB);
        PG8_WAIT_V(6); PG8_BAR;
    } else {
        PG8_STAGE(PG8_SB(0, 0), cB, voffB); PG8_STAGE(PG8_SA(0, 0), cA, voffA); PG8_STAGE(PG8_SB(0, 1), cB + hstep, voffB); PG8_STAGE(PG8_SA(0, 1), cA + hstep, voffA);
        if (wr == 1) PG8_BAR;
        PG8_WAIT_V(4); PG8_BAR;
        PG8_STAGE(PG8_SB(1, 0), cB + kstep, voffB); PG8_STAGE(PG8_SA(1, 0), cA + kstep, voffA); PG8_STAGE(PG8_SB(1, 1), cB + hstep + kstep, voffB);
        PG8_WAIT_V(6); PG8_BAR;
    }
    for (;;) {
        const bool has_next = S.next(ui + 1, nxt);
        const char* nA = has_next ? (const char*)g.A + (size_t)nxt.pm * tstep : cA; const char* nB = has_next ? (const char*)g.Bt + (size_t)nxt.pn * tstep : cB;
        for (int t = 0; t < nt; t += 2) {
            const bool last = (t == nt - 2);
            const char* a1 = cA + (size_t)(t + 1) * kstep;
            const char* a2 = last ? nA : cA + (size_t)(t + 2) * kstep; const char* b2 = last ? nB : cB + (size_t)(t + 2) * kstep;
            const char* a3 = a2 + kstep; const char* b3 = b2 + kstep;
            if (last && has_next) S.a_ready(nxt);
            if constexpr (SP2) {
            PG8_LDB(B0, 0, 0); PG8_LDB(B1, 0, 1); PG8_SCHED; PG8_LDA(At, 0, 0); PG8_STAGE(PG8_SA(1, 1), a1 + hstep, voffA);
            PG8_WAIT_V(8); PG8_WAIT_L(0); PG8_BAR; PG8_MMA(0, 0, At, B0); PG8_MMA(0, 1, At, B1); PG8_BAR; PG8_SCHED;
            PG8_LDA(At, 0, 1); PG8_STAGE(PG8_SB(0, 0), b2, voffB); PG8_STAGE(PG8_SB(0, 1), b2 + hstep, voffB); PG8_STAGE(PG8_SA(0, 0), a2, voffA);
            PG8_WAIT_V(8); PG8_WAIT_L(0); PG8_BAR; PG8_MMA(1, 0, At, B0); PG8_MMA(1, 1, At, B1); PG8_BAR; PG8_SCHED;
            PG8_LDB(B0, 1, 0); PG8_LDB(B1, 1, 1); PG8_SCHED; PG8_LDA(At, 1, 0); PG8_STAGE(PG8_SA(0, 1), a2 + hstep, voffA);
            PG8_WAIT_V(8); PG8_WAIT_L(0); PG8_BAR; PG8_MMA(0, 0, At, B0); PG8_MMA(0, 1, At, B1); PG8_BAR; PG8_SCHED;
            PG8_LDA(At, 1, 1); PG8_STAGE(PG8_SB(1, 0), b3, voffB); PG8_STAGE(PG8_SB(1, 1), b3 + hstep, voffB); PG8_STAGE(PG8_SA(1, 0), a3, voffA);
            PG8_WAIT_V(8); PG8_WAIT_L(0); PG8_BAR; PG8_MMA(1, 0, At, B0); PG8_MMA(1, 1, At, B1); PG8_BAR; PG8_SCHED;
            } else {
            PG8_LDB(B0, 0, 0); PG8_SCHED; PG8_LDA(At, 0, 0); PG8_STAGE(PG8_SA(1, 1), a1 + hstep, voffA);
            PG8_WAIT_L(8); PG8_BAR; PG8_WAIT_L(0); PG8_MMA(0, 0, At, B0); PG8_BAR; PG8_SCHED;
            PG8_LDB(B1, 0, 1); PG8_STAGE(PG8_SB(0, 0), b2, voffB);
            PG8_BAR; PG8_WAIT_L(0); PG8_MMA(0, 1, At, B1); PG8_BAR;
            PG8_LDA(At, 0, 1); PG8_STAGE(PG8_SA(0, 0), a2, voffA);
            PG8_BAR; PG8_WAIT_L(0); PG8_MMA(1, 0, At, B0); PG8_BAR; PG8_SCHED;
            PG8_STAGE(PG8_SB(0, 1), b2 + hstep, voffB);
            PG8_WAIT_V(6); PG8_BAR; PG8_MMA(1, 1, At, B1); PG8_BAR;
            PG8_LDB(B0, 1, 0); PG8_SCHED; PG8_LDA(At, 1, 0); PG8_STAGE(PG8_SA(0, 1), a2 + hstep, voffA);
            PG8_WAIT_L(8); PG8_BAR; PG8_WAIT_L(0); PG8_MMA(0, 0, At, B0); PG8_BAR; PG8_SCHED;
            PG8_LDB(B1, 1, 1); PG8_STAGE(PG8_SB(1, 0), b3, voffB);
            PG8_BAR; PG8_WAIT_L(0); PG8_MMA(0, 1, At, B1); PG8_BAR;
            PG8_LDA(At, 1, 1); PG8_STAGE(PG8_SA(1, 0), a3, voffA);
            PG8_BAR; PG8_WAIT_L(0); PG8_MMA(1, 0, At, B0); PG8_BAR; PG8_SCHED;
            PG8_STAGE(PG8_SB(1, 1), b3 + hstep, voffB);
            PG8_WAIT_V(6); PG8_BAR; PG8_MMA(1, 1, At, B1); PG8_BAR;
            }
        }
        if constexpr (ALIGN_EPI) { if (wr == 0) PG8_BAR; }
        if constexpr (!Epi::AFTER_DRAIN) { E(acc, cur, wr, wc, fr, fq); S.done(cur); }
        if (!has_next) break;
#pragma unroll
        for (int a = 0; a < 2; ++a)
#pragma unroll
            for (int b = 0; b < 2; ++b)
#pragma unroll
                for (int m = 0; m < 4; ++m)
#pragma unroll
                    for (int n = 0; n < 2; ++n) acc[a][b][m][n] = (f32x4){0.f, 0.f, 0.f, 0.f};
        cur = nxt; cA = nA; cB = nB; ++ui;
        if constexpr (ALIGN_EPI) { if (wr == 1) PG8_BAR; }
    }
    PG8_WAIT_V(0);
    if constexpr (!ALIGN_EPI) { if (wr == 0) PG8_BAR; }
    PG8_BAR;
    if constexpr (Epi::AFTER_DRAIN) { E.fused(acc, cur, wr, wc, fr, fq, lds, wid, lane); S.done(cur); }
#undef PG8_SA
#undef PG8_SB
#undef PG8_STAGE
#undef PG8_LDA
#undef PG8_LDB
#undef PG8_MMA
#undef PG8_WAIT_V
#undef PG8_WAIT_L
#undef PG8_BAR
#undef PG8_SCHED
}
}
namespace att {
using bf16 = __hip_bfloat16;
constexpr int   D = 128, NW = 8, QBLK = 32, KVBLK = 64;
constexpr float SCALE = 0.088388347648318440f;
constexpr float THR = 8.f;
constexpr int LDQ = 7168, LDK = 7168, LDO = 1024;
constexpr size_t SHM_V = KVBLK * D * 2, SHM_K = KVBLK * D * 2, SHM_ATTN = 2 * SHM_V + 2 * SHM_K + NW * 64 * 4;
using bf16x8 = __attribute__((ext_vector_type(8))) short;
using s16x4  = __attribute__((ext_vector_type(4))) short;
using f32x16 = __attribute__((ext_vector_type(16))) float;
using u32x4  = __attribute__((ext_vector_type(4))) unsigned;
#define KSWZ(row, colB) ((row) * 256 + ((colB) ^ (((row) & 7) << 4)))
#define SBAR() __builtin_amdgcn_sched_barrier(0)
__device__ __forceinline__ int crow(int r, int hi) { return (r & 3) + 8 * (r >> 2) + 4 * hi; }
__device__ __forceinline__ unsigned cvtpk(float lo, float hi) {
  unsigned r; asm volatile("v_cvt_pk_bf16_f32 %0, %1, %2" : "=v"(r) : "v"(lo), "v"(hi)); return r;
}
__device__ __forceinline__ bf16x8 ld8(const bf16* p) { return *reinterpret_cast<const bf16x8*>(p); }
__device__ __forceinline__ void partialSM(f32x16& p0, f32x16& p1, float& m_reg, float& mn, float& alpha) {
  constexpr float C = SCALE * 1.4426950408889634f;
  float pmax = p0[0]; for (int r = 1; r < 16; ++r) pmax = fmaxf(pmax, p0[r]); for (int r = 0; r < 16; ++r) pmax = fmaxf(pmax, p1[r]);
  { auto rr = __builtin_amdgcn_permlane32_swap(__float_as_uint(pmax), __float_as_uint(pmax), false, false);
    pmax = fmaxf(__uint_as_float(rr[0]), __uint_as_float(rr[1])); }
  if (__builtin_expect(__all(pmax - m_reg <= THR / SCALE), 1)) { mn = m_reg; alpha = 1.f; }
  else { mn = fmaxf(m_reg, pmax); alpha = __builtin_amdgcn_exp2f((m_reg - mn) * C); m_reg = mn; }
  float mnC = -mn * C;
  for (int r = 0; r < 16; ++r) p0[r] = fmaf(p0[r], C, mnC); for (int r = 0; r < 16; ++r) p1[r] = fmaf(p1[r], C, mnC);
  for (int r = 0; r < 16; ++r) p0[r] = __builtin_amdgcn_exp2f(p0[r]);
}
__device__ __forceinline__ void finishSM(f32x16& p0, f32x16& p1, float alpha, float& l_reg, bf16x8& pa0, bf16x8& pa1, bf16x8& pa2, bf16x8& pa3) {
  for (int r = 0; r < 16; ++r) p1[r] = __builtin_amdgcn_exp2f(p1[r]);
  float ps = 0; for (int r = 0; r < 16; ++r) ps += p0[r]; for (int r = 0; r < 16; ++r) ps += p1[r];
  { auto rr = __builtin_amdgcn_permlane32_swap(__float_as_uint(ps), __float_as_uint(ps), false, false);
    ps = __uint_as_float(rr[0]) + __uint_as_float(rr[1]); }
  l_reg = l_reg * alpha + ps;
#define PK4(P, BASE, OUT) do { unsigned a0 = cvtpk(P[BASE + 0], P[BASE + 1]), a1 = cvtpk(P[BASE + 2], P[BASE + 3]);   \
    unsigned b0 = cvtpk(P[BASE + 4], P[BASE + 5]), b1 = cvtpk(P[BASE + 6], P[BASE + 7]);                              \
    auto r0 = __builtin_amdgcn_permlane32_swap(a0, b0, false, false); auto r1 = __builtin_amdgcn_permlane32_swap(a1, b1, false, false); \
    u32x4 w = {r0[0], r1[0], r0[1], r1[1]}; OUT = *reinterpret_cast<bf16x8*>(&w); } while (0)
  PK4(p0, 0, pa0); PK4(p0, 8, pa1); PK4(p1, 0, pa2); PK4(p1, 8, pa3);
#undef PK4
}
__device__ __forceinline__ void qkt(f32x16& p0, f32x16& p1, const bf16* Ks, const bf16x8* qr, int r32, int hi) {
  p0 = f32x16{}; p1 = f32x16{};
  for (int d0 = 0; d0 < 8; ++d0) { int cb = (d0 * 16 + hi * 8) * 2;
    bf16x8 b0 = *reinterpret_cast<const bf16x8*>((const char*)Ks + KSWZ(r32, cb));
    bf16x8 b1 = *reinterpret_cast<const bf16x8*>((const char*)Ks + KSWZ(32 + r32, cb));
    p0 = __builtin_amdgcn_mfma_f32_32x32x16_bf16(b0, qr[d0], p0, 0, 0, 0);
    p1 = __builtin_amdgcn_mfma_f32_32x32x16_bf16(b1, qr[d0], p1, 0, 0, 0); }
}
__device__ __forceinline__ int v_st(int k, int c) { const int kk = (k & ~0xC) | ((k & 4) << 1) | ((k & 8) >> 1); return ((kk >> 3) * 4 + (c >> 5)) * 512 + ((kk & 7) * 32 + (c & 31)) * 2; }
__device__ __forceinline__ int v_rd_base(int lane) { return ((lane & 3) << 3) | (((lane >> 2) & 3) << 6) | (((lane >> 4) & 1) << 5) | (((lane >> 5) & 1) << 8); }
constexpr int v_rd_off(int d0, int ks, int half) { return d0 * 512 + ks * 4096 + half * 2048; }
template <int OFF> __device__ __forceinline__ s16x4 tr_read(int vb) {
  s16x4 r; asm volatile("ds_read_b64_tr_b16 %0, %1 offset:%2" : "=&v"(r) : "v"(vb), "i"(OFF) : "memory"); return r;
}
template <int D0> __device__ __forceinline__ void pv_one(f32x16& od, int vb, bf16x8 pa0, bf16x8 pa1, bf16x8 pa2, bf16x8 pa3) {
  const s16x4 l0 = tr_read<v_rd_off(D0, 0, 0)>(vb), h0 = tr_read<v_rd_off(D0, 0, 1)>(vb), l1 = tr_read<v_rd_off(D0, 1, 0)>(vb), h1 = tr_read<v_rd_off(D0, 1, 1)>(vb);
  const s16x4 l2 = tr_read<v_rd_off(D0, 2, 0)>(vb), h2 = tr_read<v_rd_off(D0, 2, 1)>(vb), l3 = tr_read<v_rd_off(D0, 3, 0)>(vb), h3 = tr_read<v_rd_off(D0, 3, 1)>(vb);
  asm volatile("s_waitcnt lgkmcnt(0)" ::: "memory"); SBAR();
#define PK(L, H) (bf16x8){L[0], L[1], L[2], L[3], H[0], H[1], H[2], H[3]}
  od = __builtin_amdgcn_mfma_f32_32x32x16_bf16(pa0, PK(l0, h0), od, 0, 0, 0);
  od = __builtin_amdgcn_mfma_f32_32x32x16_bf16(pa1, PK(l1, h1), od, 0, 0, 0);
  od = __builtin_amdgcn_mfma_f32_32x32x16_bf16(pa2, PK(l2, h2), od, 0, 0, 0);
  od = __builtin_amdgcn_mfma_f32_32x32x16_bf16(pa3, PK(l3, h3), od, 0, 0, 0);
#undef PK
}
__device__ __forceinline__ void pv_d0(f32x16* o, int vb, bf16x8 pa0, bf16x8 pa1, bf16x8 pa2, bf16x8 pa3) {
  pv_one<0>(o[0], vb, pa0, pa1, pa2, pa3); pv_one<1>(o[1], vb, pa0, pa1, pa2, pa3); pv_one<2>(o[2], vb, pa0, pa1, pa2, pa3); pv_one<3>(o[3], vb, pa0, pa1, pa2, pa3);
}
__device__ __forceinline__ void attn_dense_body(const bf16* __restrict__ Qb, const bf16* __restrict__ Kh, const bf16* __restrict__ Vh,
                                                bf16* __restrict__ Ob, int seq, char* lds) {
  int tid_ = threadIdx.x; asm volatile("" : "+v"(tid_));
  const int tid = tid_, wid = tid >> 6, lane = tid & 63, r32 = lane & 31, hi = lane >> 5;
  bf16* V_lds = (bf16*)lds; bf16* K_lds = (bf16*)(lds + 2 * SHM_V);
  float* ws = (float*)(lds + 2 * SHM_V + 2 * SHM_K) + wid * 64; float* li_l = ws; float* al_l = ws + 32;
  float m_reg = -1e30f, l_reg = 0; f32x16 o[4] = {}; bf16x8 qr[8];
  const bf16* Qw = Qb + (long)(wid * QBLK + r32) * LDQ + hi * 8;
#pragma unroll
  for (int d0 = 0; d0 < 8; ++d0) qr[d0] = ld8(Qw + d0 * 16);
  const int sr = tid >> 4, sc = (tid & 15) * 8, vst0 = v_st(sr, sc), vst1 = v_st(32 + sr, sc);
  const int vb0 = (int)(uintptr_t)V_lds + v_rd_base(lane);
  struct { bf16x8 vs0, vs1, ks0, ks1; } sr_[2];
#define SLOAD(i, k0) do { sr_[i].vs0 = ld8(&Vh[(long)((k0) + sr) * LDK + sc]); sr_[i].vs1 = ld8(&Vh[(long)((k0) + 32 + sr) * LDK + sc]); \
    sr_[i].ks0 = ld8(&Kh[(long)((k0) + sr) * LDK + sc]); sr_[i].ks1 = ld8(&Kh[(long)((k0) + 32 + sr) * LDK + sc]); } while (0)
#define SWRITE(b, i) do { *(bf16x8*)((char*)V_lds + (b) * SHM_V + vst0) = sr_[i].vs0;          \
    *(bf16x8*)((char*)V_lds + (b) * SHM_V + vst1) = sr_[i].vs1; int kc = sc * 2;               \
    *(bf16x8*)((char*)K_lds + (b) * SHM_K + KSWZ(sr, kc)) = sr_[i].ks0;                       \
    *(bf16x8*)((char*)K_lds + (b) * SHM_K + KSWZ(32 + sr, kc)) = sr_[i].ks1; } while (0)
#define SWAIT() do { asm volatile("s_waitcnt vmcnt(4)" ::: "memory"); } while (0)
#define RESC(a) do { if (__any((a) < 1.f)) { if (hi == 0) al_l[r32] = (a); asm volatile("s_waitcnt lgkmcnt(0)" ::: "memory"); \
    for (int d = 0; d < 4; ++d) for (int r = 0; r < 16; ++r) o[d][r] *= al_l[crow(r, hi)]; } } while (0)
  f32x16 pA0, pA1, pB0, pB1; float mnA, mnB, alA, alB; bf16x8 pa0, pa1, pa2, pa3; const int NT = seq / KVBLK;
  constexpr int SE = 0, SO = 1;
  SLOAD(SE, 0); asm volatile("s_waitcnt vmcnt(0)" ::: "memory"); SWRITE(0, SE); __syncthreads();
  qkt(pA0, pA1, K_lds, qr, r32, hi); partialSM(pA0, pA1, m_reg, mnA, alA);
  SLOAD(SO, KVBLK); if (2 < NT) SLOAD(SE, 2 * KVBLK);
  SWAIT(); SWRITE(1, SO); __syncthreads();
  for (int j = 1; j + 1 < NT; j += 2) {
    SBAR(); qkt(pB0, pB1, (bf16*)((char*)K_lds + SHM_K), qr, r32, hi);
    finishSM(pA0, pA1, alA, l_reg, pa0, pa1, pa2, pa3); SBAR();
    SLOAD(SO, (j + 2) * KVBLK); SBAR();
    pv_d0(o, vb0, pa0, pa1, pa2, pa3); partialSM(pB0, pB1, m_reg, mnB, alB);
    __syncthreads(); SWAIT(); SWRITE(0, SE);
    RESC(alB); __syncthreads();
    SBAR(); qkt(pA0, pA1, K_lds, qr, r32, hi);
    finishSM(pB0, pB1, alB, l_reg, pa0, pa1, pa2, pa3); SBAR();
    if (j + 3 < NT) SLOAD(SE, (j + 3) * KVBLK); SBAR();
    pv_d0(o, vb0 + (int)SHM_V, pa0, pa1, pa2, pa3); partialSM(pA0, pA1, m_reg, mnA, alA);
    __syncthreads(); SWAIT(); SWRITE(1, SO);
    RESC(alA); __syncthreads();
  }
  SBAR(); qkt(pB0, pB1, (bf16*)((char*)K_lds + SHM_K), qr, r32, hi);
  finishSM(pA0, pA1, alA, l_reg, pa0, pa1, pa2, pa3); SBAR();
  pv_d0(o, vb0, pa0, pa1, pa2, pa3); partialSM(pB0, pB1, m_reg, mnB, alB);
  __syncthreads(); RESC(alB);
  finishSM(pB0, pB1, alB, l_reg, pa0, pa1, pa2, pa3); SBAR();
  pv_d0(o, vb0 + (int)SHM_V, pa0, pa1, pa2, pa3);
  if (hi == 0) li_l[r32] = l_reg; asm volatile("s_waitcnt lgkmcnt(0)" ::: "memory");
  float rli[16];
#pragma unroll
  for (int r = 0; r < 16; ++r) rli[r] = __builtin_amdgcn_rcpf(li_l[crow(r, hi)]);
  bf16* Ow = Ob + (long)(wid * QBLK) * LDO;
#pragma unroll
  for (int r = 0; r < 16; ++r) { int orow = crow(r, hi);
    for (int d0 = 0; d0 < 4; ++d0) Ow[(long)orow * LDO + d0 * 32 + r32] = __float2bfloat16(o[d0][r] * rli[r]); }
  __syncthreads();
#undef SLOAD
#undef SWRITE
#undef SWAIT
#undef RESC
}
#undef KSWZ
#undef SBAR
}
#define LAS __attribute__((address_space(3)))
typedef unsigned short bf16_t;
typedef float f32x4 __attribute__((ext_vector_type(4)));
typedef unsigned u32x4 __attribute__((ext_vector_type(4)));
typedef unsigned u32x2 __attribute__((ext_vector_type(2)));

#ifndef EXP_RW
#define EXP_RW 1.0f
#endif
#ifndef EXP_ATT
#define EXP_ATT 1.0f
#endif
#ifndef EXP_NOSCAN
#define EXP_NOSCAN 0
#endif
#ifndef EXP_ZFILL
#define EXP_ZFILL 0
#endif
#ifndef EXP_STATIC
#define EXP_STATIC 0
#endif
#ifndef EXP_TWICE
#define EXP_TWICE 0
#endif
#ifndef PROBE_REP3
#define PROBE_REP3 1
#endif
#ifndef PROBE_MASK
#define PROBE_MASK 0
#endif
#ifndef PREP_UNROLL
#define PREP_UNROLL 7
#endif
#ifndef EXP_MIX
#define EXP_MIX 1.0f
#endif
#ifndef EN_SCAN
#define EN_SCAN 1
#endif
#ifndef EN_ATT
#define EN_ATT 1
#endif
#ifndef EN_PREP
#define EN_PREP 1
#endif
#ifndef EN_GEMM
#define EN_GEMM 1
#endif
constexpr int NWAVES = 8, NTHREADS = 512;
constexpr int D = 1024, FF = 4096, NIN = 7040, NINP = 7168, RWC = 3456;
constexpr int MC = 16384, NCHUNK = 5, MTOT = 81920;
constexpr float ALPHA = 1.189207115002721f;
constexpr float LN_EPS = 1e-5f, GN_EPS = 64e-5f, RMS_EPS = 1e-6f;
constexpr float DECAY_SCALE = 0.6065306597126334f;

constexpr size_t MiB = 1u << 20;
constexpr size_t WS_CTL = 0;
constexpr size_t WS_WIN = 1 * MiB, WS_WPR = 15 * MiB, WS_WPA = 17 * MiB, WS_WOUT = 19 * MiB, WS_WF1 = 21 * MiB, WS_WF2 = 29 * MiB;
constexpr size_t WS_WUP = 37 * MiB, WS_AUP = 37 * MiB + 512 * 1024, WS_GUP = 38 * MiB;
constexpr size_t WS_XB = 40 * MiB, WS_OF = 40 * MiB;
constexpr size_t WS_Z = 72 * MiB;
constexpr size_t WS_OPR = 296 * MiB, WS_OPKH = 360 * MiB, WS_VS = 424 * MiB;
constexpr size_t WS_KS = 488 * MiB, WS_OB = 488 * MiB, WS_HB = 488 * MiB;
constexpr size_t WS_TW = 520 * MiB, WS_AD = 524 * MiB, WS_SG = 528 * MiB;
constexpr size_t WS_OPW = 532 * MiB, WS_OPAK = 660 * MiB, WS_OPKT = 788 * MiB;
constexpr size_t WS_G = 916 * MiB, WS_OATT = 948 * MiB, WS_END = 980 * MiB;
constexpr size_t WS_ORW = 532 * MiB, WS_M32 = 564 * MiB, WS_MB = 628 * MiB, WS_FFH = 660 * MiB;
constexpr int ZLD = 7168, ZQ = 3456, ZK = 4480, ZV = 4736, ZG = 4992;

constexpr int LDS_BYTES = 131072 + 1024;
constexpr int LDS_MISC = 131072;

#define INP(k) (A.in[(k) + z])
struct Args {
    const float* in[26];
    float* out; unsigned char* ws;
    int ph_lo, ph_hi;
};

__device__ __forceinline__ float bf2f(unsigned v) { return __uint_as_float(v << 16); }
__device__ __forceinline__ float bflo(unsigned w) { return __uint_as_float(w << 16); }
__device__ __forceinline__ float bfhi(unsigned w) { return __uint_as_float(w & 0xffff0000u); }
typedef float f32x2c_t __attribute__((ext_vector_type(2))); typedef __bf16 bf16x2c_t __attribute__((ext_vector_type(2)));
__device__ __forceinline__ unsigned pk2(float lo, float hi) { f32x2c_t v = {lo, hi}; bf16x2c_t b = __builtin_convertvector(v, bf16x2c_t); return __builtin_bit_cast(unsigned, b); }
__device__ __forceinline__ float sigmoidf_(float x) { return 1.0f / (1.0f + __expf(-x)); }
__device__ __forceinline__ float wave_sum(float v) {
#pragma unroll
    for (int o = 1; o < 64; o <<= 1) v += __shfl_xor(v, o);
    return v;
}

__device__ __forceinline__ void p0_transpose_item(const float* W, int K, int N, bf16_t* WT, LAS float* scr, int item, int lane) {
    const int nblk = N / 32, kb = item / nblk, nb = item % nblk, k0 = 64 * kb, n0 = 32 * nb;
#pragma unroll 8
    for (int i = 0; i < 32; ++i) { const int kk = 2 * i + (lane >> 5); scr[kk * 33 + (lane & 31)] = W[(size_t)(k0 + kk) * N + n0 + (lane & 31)]; }
    asm volatile("s_waitcnt lgkmcnt(0)" ::: "memory");
    const int c = lane & 7;
#pragma unroll
    for (int j = 0; j < 4; ++j) { const int n = (lane >> 3) + 8 * j; const LAS float* s = scr + (8 * c) * 33 + n;
        u32x4 o; o.x = pk2(s[0 * 33], s[1 * 33]); o.y = pk2(s[2 * 33], s[3 * 33]); o.z = pk2(s[4 * 33], s[5 * 33]); o.w = pk2(s[6 * 33], s[7 * 33]);
        *(u32x4*)(WT + (size_t)(n0 + n) * K + k0 + 8 * c) = o; }
    asm volatile("s_waitcnt lgkmcnt(0)" ::: "memory");
}

__device__ __forceinline__ void cvt_x_chunk(const float* x, bf16_t* xb, int gtid, int gthreads) {
    const size_t n8 = (size_t)MC * D / 8;
    for (size_t i = gtid; i < n8; i += gthreads) {
        const f32x4 a = *(const f32x4*)(x + i * 8), b = *(const f32x4*)(x + i * 8 + 4);
        u32x4 o; o.x = pk2(a.x, a.y); o.y = pk2(a.z, a.w); o.z = pk2(b.x, b.y); o.w = pk2(b.z, b.w);
        *(u32x4*)(xb + i * 8) = o;
    }
}

__device__ __forceinline__ void ln_rows(float* base, const float* g, const float* b, bf16_t* hb, int gw, int ngw, int lane) {
    f32x4 gg[4], bb[4];
#pragma unroll
    for (int j = 0; j < 4; ++j) { gg[j] = *((const f32x4*)g + 64 * j + lane); bb[j] = *((const f32x4*)b + 64 * j + lane); }
    for (int m0 = gw; m0 < MC; m0 += 2 * ngw) {
        const int m1 = m0 + ngw; const bool has1 = m1 < MC;
        f32x4* xr0 = (f32x4*)(base + (size_t)m0 * D) + lane; f32x4* xr1 = (f32x4*)(base + (size_t)(has1 ? m1 : m0) * D) + lane;
        f32x4 v0[4], v1[4]; float s0 = 0.f, s1 = 0.f;
#pragma unroll
        for (int j = 0; j < 4; ++j) { v0[j] = xr0[64 * j]; v1[j] = xr1[64 * j]; }
#pragma unroll
        for (int j = 0; j < 4; ++j) { s0 += (v0[j].x + v0[j].y) + (v0[j].z + v0[j].w); s1 += (v1[j].x + v1[j].y) + (v1[j].z + v1[j].w); }
        const float mean0 = wave_sum(s0) * (1.f / D), mean1 = wave_sum(s1) * (1.f / D); float q0 = 0.f, q1 = 0.f;
#pragma unroll
        for (int j = 0; j < 4; ++j) { v0[j] = v0[j] - mean0; v1[j] = v1[j] - mean1;
            q0 += (v0[j].x * v0[j].x + v0[j].y * v0[j].y) + (v0[j].z * v0[j].z + v0[j].w * v0[j].w); q1 += (v1[j].x * v1[j].x + v1[j].y * v1[j].y) + (v1[j].z * v1[j].z + v1[j].w * v1[j].w); }
        const float rstd0 = 1.f / sqrtf(wave_sum(q0) * (1.f / D) + LN_EPS), rstd1 = 1.f / sqrtf(wave_sum(q1) * (1.f / D) + LN_EPS);
#pragma unroll
        for (int j = 0; j < 4; ++j) {
            const f32x4 y0 = v0[j] * rstd0 * gg[j] + bb[j]; xr0[64 * j] = y0;
            if (hb) { u32x2 w; w.x = pk2(y0.x, y0.y); w.y = pk2(y0.z, y0.w); *(u32x2*)(hb + (size_t)m0 * D + 256 * j + 4 * lane) = w; }
            if (has1) { const f32x4 y1 = v1[j] * rstd1 * gg[j] + bb[j]; xr1[64 * j] = y1;
                if (hb) { u32x2 w; w.x = pk2(y1.x, y1.y); w.y = pk2(y1.z, y1.w); *(u32x2*)(hb + (size_t)m1 * D + 256 * j + 4 * lane) = w; } }
        }
    }
}

template <class F> struct Epi4 {
    static constexpr bool PERM = false, AFTER_DRAIN = false; F f;
    __device__ __forceinline__ void operator()(const pg8::f32x4 (&acc)[2][2][4][2], const pg8::Unit& u, int wr, int wc, int fr, int fq) const {
        const int row0 = u.pm * 256 + wr * 64 + fr, col0 = u.pn * 256 + wc * 32 + 4 * fq;
#pragma unroll
        for (int ai = 0; ai < 2; ++ai)
#pragma unroll
            for (int m = 0; m < 4; ++m)
#pragma unroll
                for (int bj = 0; bj < 2; ++bj)
#pragma unroll
                    for (int n = 0; n < 2; ++n) { f(row0 + ai * 128 + m * 16, col0 + bj * 128 + n * 16, acc[ai][bj][m][n]); asm volatile("" ::: "memory"); }
    }
};
template <class F> struct Epi8 {
    static constexpr bool PERM = true, AFTER_DRAIN = false; F f;
    __device__ __forceinline__ void operator()(const pg8::f32x4 (&acc)[2][2][4][2], const pg8::Unit& u, int wr, int wc, int fr, int fq) const {
        const int row0 = u.pm * 256 + wr * 64 + fr, col0 = u.pn * 256 + wc * 32 + 8 * fq;
#pragma unroll
        for (int ai = 0; ai < 2; ++ai)
#pragma unroll
            for (int m = 0; m < 4; ++m)
#pragma unroll
                for (int bj = 0; bj < 2; ++bj) { f(row0 + ai * 128 + m * 16, col0 + bj * 128, acc[ai][bj][m][0], acc[ai][bj][m][1]); asm volatile("" ::: "memory"); }
    }
};
__device__ __forceinline__ u32x4 pack8(f32x4 a, f32x4 b) { u32x4 w; w.x = pk2(a.x, a.y); w.y = pk2(a.z, a.w); w.z = pk2(b.x, b.y); w.w = pk2(b.z, b.w); return w; }

struct FZ { bf16_t* z;
    __device__ __forceinline__ void operator()(int row, int col, f32x4 a, f32x4 b) const { *(u32x4*)(z + (size_t)row * ZLD + col) = pack8(a, b); } };
struct FW { const float* w0; float* opw;
    __device__ __forceinline__ void operator()(int row, int col, f32x4 a) const {
        const f32x4 x = a + *(const f32x4*)(w0 + col); f32x4 y;
#pragma unroll
        for (int i = 0; i < 4; ++i) y[i] = __expf(-DECAY_SCALE * sigmoidf_(x[i]));
        *(f32x4*)(opw + (size_t)row * D + col) = y; } };
struct FA { const float *a0, *k_a; const bf16_t* ks; const float* kh; float *opak, *opkt;
    __device__ __forceinline__ void operator()(int row, int col, f32x4 acc) const {
        const size_t o = (size_t)row * D + col;
        const f32x4 x = acc + *(const f32x4*)(a0 + col), ka = *(const f32x4*)(k_a + col), khv = *(const f32x4*)(kh + o);
        const u32x2 kw = *(const u32x2*)(ks + o);
        f32x4 k; k.x = bflo(kw.x); k.y = bfhi(kw.x); k.z = bflo(kw.y); k.w = bfhi(kw.y);
        f32x4 ak, kt;
#pragma unroll
        for (int i = 0; i < 4; ++i) { const float a = sigmoidf_(x[i]); ak[i] = a * khv[i]; kt[i] = k[i] * (1.0f + (a - 1.0f) * ka[i]); }
        *(f32x4*)(opak + o) = ak; *(f32x4*)(opkt + o) = kt; } };
struct FG { bf16_t* g;
    __device__ __forceinline__ void operator()(int row, int col, f32x4 a) const {
        u32x2 w; w.x = pk2(a.x, a.y); w.y = pk2(a.z, a.w); *(u32x2*)(g + (size_t)row * D + col) = w; } };
typedef short bf16x8v __attribute__((ext_vector_type(8)));
template <int K, class F> __device__ __forceinline__ void wave_gemm_tile(const bf16_t* A, int aoff, const bf16_t* Bt, int m0, int n0, int lane, const F& f) {
    const int fr = lane & 15, fq = lane >> 4; constexpr int KS = K / 32;
    bf16x8v a[2][KS];
#pragma unroll
    for (int mt = 0; mt < 2; ++mt)
#pragma unroll
        for (int ks = 0; ks < KS; ++ks) a[mt][ks] = *(const bf16x8v*)(A + (size_t)(m0 + mt * 16 + fr) * 128 + aoff + ks * 32 + 8 * fq);
#pragma unroll 2
    for (int nt = 0; nt < 8; ++nt) {
        const bf16_t* bp = Bt + (size_t)(n0 + nt * 16 + fr) * K + 8 * fq;
        f32x4 acc0 = {0.f, 0.f, 0.f, 0.f}, acc1 = {0.f, 0.f, 0.f, 0.f};
#pragma unroll
        for (int ks = 0; ks < KS; ++ks) { const bf16x8v b = *(const bf16x8v*)(bp + ks * 32);
            acc0 = __builtin_amdgcn_mfma_f32_16x16x32_bf16(b, a[0][ks], acc0, 0, 0, 0); acc1 = __builtin_amdgcn_mfma_f32_16x16x32_bf16(b, a[1][ks], acc1, 0, 0, 0); }
        f(m0 + fr, n0 + nt * 16 + 4 * fq, acc0); f(m0 + 16 + fr, n0 + nt * 16 + 4 * fq, acc1);
    }
}
struct FP1 { const bf16_t* gates; float* m32;
    __device__ __forceinline__ void operator()(int row, int col, f32x4 a) const {
        const u32x2 gw = *(const u32x2*)(gates + (size_t)row * ZLD + ZG + col); f32x4 y;
        y.x = sigmoidf_(bflo(gw.x)) * a.x; y.y = sigmoidf_(bfhi(gw.x)) * a.y; y.z = sigmoidf_(bflo(gw.y)) * a.z; y.w = sigmoidf_(bfhi(gw.y)) * a.w; y = y * EXP_RW;
        *(f32x4*)(m32 + (size_t)row * D + col) = y;
    } };
struct FP2 { const bf16_t* gates; const float* m32; bf16_t* mb;
    __device__ __forceinline__ void operator()(int row, int col, f32x4 a) const {
        const u32x2 gw = *(const u32x2*)(gates + (size_t)row * ZLD + ZG + 1024 + col); const f32x4 p = *(const f32x4*)(m32 + (size_t)row * D + col); f32x4 y; a = a * EXP_ATT;
        y.x = p.x + sigmoidf_(bflo(gw.x)) * a.x; y.y = p.y + sigmoidf_(bfhi(gw.x)) * a.y; y.z = p.z + sigmoidf_(bflo(gw.y)) * a.z; y.w = p.w + sigmoidf_(bfhi(gw.y)) * a.w;
        u32x2 w; w.x = pk2(y.x, y.y); w.y = pk2(y.z, y.w); *(u32x2*)(mb + (size_t)row * D + col) = w;
    } };
struct FOut { const float* x; float* out;
    __device__ __forceinline__ void operator()(int row, int col, f32x4 a) const {
        const size_t o = (size_t)row * D + col; *(f32x4*)(out + o) = *(const f32x4*)(x + o) * ALPHA + a * EXP_MIX; } };
struct FF1 { bf16_t* ffh;
    __device__ __forceinline__ void operator()(int row, int col, f32x4 a, f32x4 b) const {
#pragma unroll
        for (int i = 0; i < 4; ++i) { const float u = fmaxf(a[i], 0.f), v = fmaxf(b[i], 0.f); a[i] = u * u; b[i] = v * v; }
        *(u32x4*)(ffh + (size_t)row * FF + col) = pack8(a, b); } };
struct FF2 { float* out;
    __device__ __forceinline__ void operator()(int row, int col, f32x4 a) const {
        const size_t o = (size_t)row * D + col; *(f32x4*)(out + o) = *(const f32x4*)(out + o) * ALPHA + a; } };

template <class E> __device__ __forceinline__ void run_gemm(LAS unsigned char* lds, const bf16_t* A, const bf16_t* Bt, int M, int N, int K, const E& e) {

    int G_ = (int)gridDim.x, c_ = (int)blockIdx.x; asm volatile("" : "+s"(G_), "+s"(c_));
    pg8::Gemm g{A, Bt, M, N, K}; pg8::StaticOrder S; S.init(M, N, G_, c_);
    if (EN_GEMM) pg8::gemm_phase<E, pg8::StaticOrder, true, true>(lds, g, S, e);
}

__device__ __forceinline__ void prep_rows(const float* mu_p, const float* mu_n, const float* k_k, const float* qn, const float* kn, unsigned char* ws, int T, int rbeg, int rstep, int rend, int lane, bool do_att) {
    bf16_t* Z = (bf16_t*)(ws + WS_Z);
    float* OPR = (float*)(ws + WS_OPR); float* OPKH = (float*)(ws + WS_OPKH); float* VS = (float*)(ws + WS_VS);
    bf16_t* KS = (bf16_t*)(ws + WS_KS); bf16_t* TW = (bf16_t*)(ws + WS_TW); bf16_t* AD = (bf16_t*)(ws + WS_AD); bf16_t* SG = (bf16_t*)(ws + WS_SG);
    for (int row = rbeg; row < rend; row += rstep) {
        const int t = row & (T - 1); const bool hp = t > 0, hn = t < T - 1;
        const bf16_t* zc = Z + (size_t)row * ZLD;
#pragma unroll PREP_UNROLL
        for (int pass = 0; pass < 7; ++pass) {
            const int c = pass * 512 + lane * 8;
            if (c < RWC) {
                const u32x4 wc_ = *(const u32x4*)(zc + c);
                u32x4 wp = {0u, 0u, 0u, 0u}, wn = {0u, 0u, 0u, 0u};
                if (hp) wp = *(const u32x4*)(zc - ZLD + c);
                if (hn) wn = *(const u32x4*)(zc + ZLD + c);
                const f32x4 mp0 = *(const f32x4*)(mu_p + c), mp1 = *(const f32x4*)(mu_p + c + 4), mn0 = *(const f32x4*)(mu_n + c), mn1 = *(const f32x4*)(mu_n + c + 4);
                float z[8];
#pragma unroll
                for (int i = 0; i < 4; ++i) {
                    const float c0 = bflo(wc_[i]), c1 = bfhi(wc_[i]), p0 = bflo(wp[i]), p1 = bfhi(wp[i]), n0 = bflo(wn[i]), n1 = bfhi(wn[i]);
                    const float mpa = (2 * i < 4) ? mp0[2 * i] : mp1[2 * i - 4], mpb = (2 * i + 1 < 4) ? mp0[2 * i + 1] : mp1[2 * i - 3];
                    const float mna = (2 * i < 4) ? mn0[2 * i] : mn1[2 * i - 4], mnb = (2 * i + 1 < 4) ? mn0[2 * i + 1] : mn1[2 * i - 3];
                    z[2 * i] = c0 + mpa * (p0 - c0) + mna * (n0 - c0);
                    z[2 * i + 1] = c1 + mpb * (p1 - c1) + mnb * (n1 - c1);
                }
                if (pass < 2) {
                    float* o = OPR + (size_t)row * D + c;
                    *(f32x4*)o = (f32x4){z[0], z[1], z[2], z[3]}; *(f32x4*)(o + 4) = (f32x4){z[4], z[5], z[6], z[7]};
                } else if (pass < 4) {
                    const int cc = c - 1024;
                    u32x4 w; w.x = pk2(z[0], z[1]); w.y = pk2(z[2], z[3]); w.z = pk2(z[4], z[5]); w.w = pk2(z[6], z[7]);
                    *(u32x4*)(KS + (size_t)row * D + cc) = w;
                    const f32x4 kk0 = *(const f32x4*)(k_k + cc), kk1 = *(const f32x4*)(k_k + cc + 4);
                    float kp[8]; float ss = 0.f;
#pragma unroll
                    for (int i = 0; i < 8; ++i) { kp[i] = z[i] * (i < 4 ? kk0[i] : kk1[i - 4]); ss += kp[i] * kp[i]; }
                    ss += __shfl_xor(ss, 1); ss += __shfl_xor(ss, 2); ss += __shfl_xor(ss, 4);
                    const float inv = 1.0f / fmaxf(sqrtf(ss), 1e-12f);
                    float* o = OPKH + (size_t)row * D + cc;
                    *(f32x4*)o = (f32x4){kp[0] * inv, kp[1] * inv, kp[2] * inv, kp[3] * inv}; *(f32x4*)(o + 4) = (f32x4){kp[4] * inv, kp[5] * inv, kp[6] * inv, kp[7] * inv};
                } else if (pass < 6) {
                    float* o = VS + (size_t)row * D + (c - 2048);
                    *(f32x4*)o = (f32x4){z[0], z[1], z[2], z[3]}; *(f32x4*)(o + 4) = (f32x4){z[4], z[5], z[6], z[7]};
                } else {
                    const int sect = lane >> 4, cc = (lane & 15) * 8;
                    float y[8];
#pragma unroll
                    for (int i = 0; i < 8; ++i) {
                        if (sect == 0) { const float e = __expf(2.0f * z[i]); y[i] = 1.0f - 2.0f / (e + 1.0f); }
                        else if (sect == 1) y[i] = z[i];
                        else y[i] = sigmoidf_(z[i]);
                    }
                    u32x4 w; w.x = pk2(y[0], y[1]); w.y = pk2(y[2], y[3]); w.z = pk2(y[4], y[5]); w.w = pk2(y[6], y[7]);
                    bf16_t* dst = (sect == 0 ? TW : (sect == 1 ? AD : SG)) + (size_t)row * 128 + cc;
                    *(u32x4*)dst = w;
                }
            }
        }
        bf16_t* qrow = Z + (size_t)row * ZLD + ZQ;
#pragma unroll 1
        for (int p = do_att ? 0 : 3; p < 3; ++p) {
            const int head = p * 4 + (lane >> 4), sub = lane & 15, d0 = sub * 8;
            const bool act = head < 10;
            bf16_t* px = qrow + head * 128 + d0;
            u32x4 w = {0u, 0u, 0u, 0u}; if (act) w = *(const u32x4*)px;
            float x[8]; float ss = 0.f;
#pragma unroll
            for (int i = 0; i < 4; ++i) { x[2 * i] = bflo(w[i]); x[2 * i + 1] = bfhi(w[i]); ss += x[2 * i] * x[2 * i] + x[2 * i + 1] * x[2 * i + 1]; }
            ss += __shfl_xor(ss, 1); ss += __shfl_xor(ss, 2); ss += __shfl_xor(ss, 4); ss += __shfl_xor(ss, 8);
            const float rinv = rsqrtf(ss * (1.0f / 128.0f) + RMS_EPS);
            const float* gn = (head < 8) ? qn : kn;
            const f32x4 g0 = *(const f32x4*)(gn + d0), g1 = *(const f32x4*)(gn + d0 + 4);
            const int axis = sub >> 3, hf = (sub >> 2) & 1;
            const float pos = (float)(axis ? (t & 63) : (t >> 6));
            float y[8];
#pragma unroll
            for (int i = 0; i < 8; ++i) {
                const float xn = x[i] * rinv * (i < 4 ? g0[i] : g1[i - 4]);
                const float xp = __shfl_xor(xn, 4);
                const int fi = (sub & 3) * 8 + i;
                const float ang = pos * exp2f(-0.41524101186092f * (float)fi);
                y[i] = xn * __cosf(ang) + (hf ? xp : -xp) * __sinf(ang);
            }
            if (act) { u32x4 o; o.x = pk2(y[0], y[1]); o.y = pk2(y[2], y[3]); o.z = pk2(y[4], y[5]); o.w = pk2(y[6], y[7]); *(u32x4*)px = o; }
        }
    }
}

__device__ __forceinline__ float rowsum16(float x) {
    x += __int_as_float(__builtin_amdgcn_update_dpp(0, __float_as_int(x), 0x128, 0xf, 0xf, true));
    x += __int_as_float(__builtin_amdgcn_update_dpp(0, __float_as_int(x), 0x124, 0xf, 0xf, true));
    x += __int_as_float(__builtin_amdgcn_update_dpp(0, __float_as_int(x), 0x122, 0xf, 0xf, true));
    x += __int_as_float(__builtin_amdgcn_update_dpp(0, __float_as_int(x), 0x121, 0xf, 0xf, true));
    return x;
}
__device__ __forceinline__ void post_rows(const float* r_k, const float* gn_g, const float* gn_b, unsigned char* ws, int gw, int ngw, int lane) {
    const bf16_t* OF = (const bf16_t*)(ws + WS_OF); const bf16_t* OB = (const bf16_t*)(ws + WS_OB);
    const float* OPR = (const float*)(ws + WS_OPR); const float* VS = (const float*)(ws + WS_VS);
    const float* KTF = (const float*)(ws + WS_OPKT); const float* KTB = KTF + (size_t)MC * D;
    const bf16_t* G = (const bf16_t*)(ws + WS_G); bf16_t* ORW = (bf16_t*)(ws + WS_ORW);
    const int hg = lane >> 4, sub = lane & 15;
    for (int row = gw; row < MC; row += ngw) {
        const size_t ro = (size_t)row * D;
#pragma unroll 2
        for (int pass = 0; pass < 4; ++pass) {
            const int c = (4 * pass + hg) * 64 + sub * 4; const size_t o = ro + c;
            const u32x2 wf = *(const u32x2*)(OF + o), wb = *(const u32x2*)(OB + o), wg = *(const u32x2*)(G + o);
            const f32x4 r4 = *(const f32x4*)(OPR + o), ktf = *(const f32x4*)(KTF + o), ktb = *(const f32x4*)(KTB + o), v4 = *(const f32x4*)(VS + o);
            const f32x4 rk = *(const f32x4*)(r_k + c), gg = *(const f32x4*)(gn_g + c), gb = *(const f32x4*)(gn_b + c);
            f32x4 ov; ov.x = bflo(wf.x) + bflo(wb.x); ov.y = bfhi(wf.x) + bfhi(wb.x); ov.z = bflo(wf.y) + bflo(wb.y); ov.w = bfhi(wf.y) + bfhi(wb.y);
            const float mean = rowsum16((ov.x + ov.y) + (ov.z + ov.w)) * (1.0f / 64.0f);
            const f32x4 dv = ov - mean;
            const float var = rowsum16((dv.x * dv.x + dv.y * dv.y) + (dv.z * dv.z + dv.w * dv.w)) * (1.0f / 64.0f);
            const f32x4 bt = r4 * (ktf + ktb) * rk;
            const float bs = rowsum16((bt.x + bt.y) + (bt.z + bt.w));
            const float rstd = rsqrtf(var + GN_EPS);
            f32x4 g4; g4.x = bflo(wg.x); g4.y = bfhi(wg.x); g4.z = bflo(wg.y); g4.w = bfhi(wg.y);
            const f32x4 y = (dv * rstd * gg + gb + v4 * bs) * g4;
            u32x2 w; w.x = pk2(y.x, y.y); w.y = pk2(y.z, y.w); *(u32x2*)(ORW + o) = w;
        }
    }
}

#define DPPQ(q) "quad_perm:[" #q "," #q "," #q "," #q "] row_mask:0xf bank_mask:0xf"
#define FMAC_DPP(acc, x, s, q) asm("v_fmac_f32_dpp %0, %1, %2 " DPPQ(q) : "+v"(acc) : "v"(x), "v"(s))
#define MUL_DPP(dst, x, s, q) asm("v_mul_f32_dpp %0, %1, %2 " DPPQ(q) : "=v"(dst) : "v"(x), "v"(s))
#define LBAR() asm volatile("s_waitcnt lgkmcnt(0)\n\ts_barrier" ::: "memory")

typedef float f32x2s __attribute__((ext_vector_type(2)));
struct ScanCtx {
    const char* pb[5]; const char* pvb; unsigned voff, voffv; bf16_t* po; long r0, dstep; int T;
    LAS float* part; LAS float* opart; int wid, lane;
};
__device__ __forceinline__ void scan_load1(const ScanCtx& C, int t, f32x4 (&X)[5], float& V) {
    const unsigned ro = (unsigned)((C.r0 + C.dstep * (long)t) * (long)(D * 4));
#pragma unroll
    for (int a = 0; a < 5; ++a) X[a] = *(const f32x4*)(C.pb[a] + (size_t)(ro + C.voff));
    V = *(const float*)(C.pvb + (size_t)(ro + C.voffv));
}
#define SCAN_Q(q) do { \
    float t0_, t1_, t2_, t3_; \
    MUL_DPP(t0_, X[3].x, vv, q); MUL_DPP(t1_, X[3].y, vv, q); MUL_DPP(t2_, X[3].z, vv, q); MUL_DPP(t3_, X[3].w, vv, q); \
    FMAC_DPP(t0_, X[2].x, nsk, q); FMAC_DPP(t1_, X[2].y, nsk, q); FMAC_DPP(t2_, X[2].z, nsk, q); FMAC_DPP(t3_, X[2].w, nsk, q); \
    FMAC_DPP(t0_, X[1].x, S[4 * q + 0], q); FMAC_DPP(t1_, X[1].y, S[4 * q + 1], q); FMAC_DPP(t2_, X[1].z, S[4 * q + 2], q); FMAC_DPP(t3_, X[1].w, S[4 * q + 3], q); \
    S[4 * q + 0] = t0_; S[4 * q + 1] = t1_; S[4 * q + 2] = t2_; S[4 * q + 3] = t3_; } while (0)
#define SCAN_DOT(p0, p1, p2, p3, A_, q) do { FMAC_DPP(p0, X[A_].x, S[4 * q + 0], q); FMAC_DPP(p1, X[A_].y, S[4 * q + 1], q); FMAC_DPP(p2, X[A_].z, S[4 * q + 2], q); FMAC_DPP(p3, X[A_].w, S[4 * q + 3], q); } while (0)
__device__ __forceinline__ void scan_step(const ScanCtx& C, int s, int par, float (&S)[16], const f32x4 (&X)[5], float vv) {
    float p0 = 0.f, p1 = 0.f, p2 = 0.f, p3 = 0.f;
    SCAN_DOT(p0, p1, p2, p3, 0, 0); SCAN_DOT(p0, p1, p2, p3, 0, 1); SCAN_DOT(p0, p1, p2, p3, 0, 2); SCAN_DOT(p0, p1, p2, p3, 0, 3);
    LAS float* pp = C.part + (s & 1) * 256;
    pp[C.wid * 64 + C.lane] = (p0 + p1) + (p2 + p3);
    LBAR();
    const unsigned paddr = (unsigned)(unsigned long)(pp + C.lane);
    f32x2s r0, r1;
    asm volatile("ds_read2st64_b32 %0, %2 offset1:1\n\tds_read2st64_b32 %1, %2 offset0:2 offset1:3\n\ts_waitcnt lgkmcnt(0)" : "=&v"(r0), "=&v"(r1) : "v"(paddr) : "memory");
    const float nsk = -((r0.x + r0.y) + (r1.x + r1.y));
    SCAN_Q(0); SCAN_Q(1); SCAN_Q(2); SCAN_Q(3);
    float o0 = 0.f, o1 = 0.f, o2 = 0.f, o3 = 0.f;
    SCAN_DOT(o0, o1, o2, o3, 4, 0); SCAN_DOT(o0, o1, o2, o3, 4, 1); SCAN_DOT(o0, o1, o2, o3, 4, 2); SCAN_DOT(o0, o1, o2, o3, 4, 3);
    C.opart[(par * 8 + s) * 256 + C.wid * 64 + C.lane] = (o0 + o1) + (o2 + o3);
}
__device__ __forceinline__ void scan_chain(unsigned char* ws, LAS unsigned char* lds, int s, int h, int d, int T, int rep) {
    int tid_ = threadIdx.x; asm volatile("" : "+v"(tid_));
    const int tid = tid_, lane = tid & 63, wid = __builtin_amdgcn_readfirstlane(tid >> 6);
    ScanCtx C; C.T = T; C.wid = wid; C.lane = lane; (void)rep;
    const int col = h * 64; const size_t dofs = (size_t)d * MC * D;
    const size_t ub = (size_t)(col + (wid & 3) * 16) * 4;
    C.pb[0] = (const char*)(ws + WS_OPKH) + ub; C.pb[1] = (const char*)(ws + WS_OPW) + dofs * 4 + ub; C.pb[2] = (const char*)(ws + WS_OPAK) + dofs * 4 + ub;
    C.pb[3] = (const char*)(ws + WS_OPKT) + dofs * 4 + ub; C.pb[4] = (const char*)(ws + WS_OPR) + ub;
    C.pvb = (const char*)(ws + WS_VS) + (size_t)col * 4; C.voff = (unsigned)(lane & 3) * 16u; C.voffv = (unsigned)lane * 4u;
    C.po = (bf16_t*)(ws + (d ? WS_OB : WS_OF)) + col + lane;
    C.r0 = d ? (long)s * T + T - 1 : (long)s * T; C.dstep = d ? -1 : 1;
    C.part = (LAS float*)lds; C.opart = (LAS float*)(lds + 2048);
    if (wid < 4) {
        float S[16];
#pragma unroll
        for (int i = 0; i < 16; ++i) S[i] = 0.f;
        f32x4 X[8][5]; float V[8];
#pragma unroll
        for (int i = 0; i < 8; ++i) scan_load1(C, i, X[i], V[i]);
        int par = 0;
        for (int t0 = 0; t0 < T; t0 += 8) {
            const bool more = t0 + 8 < T;
#pragma unroll
            for (int i = 0; i < 8; ++i) {
                scan_step(C, i, par, S, X[i], V[i]);
                if (more) scan_load1(C, t0 + 8 + i, X[i], V[i]);
            }
            LBAR();
            par ^= 1;
        }
    } else {
        const int hsl = wid - 4; int par = 0;
        for (int t0 = 0; t0 < T; t0 += 8) {
#pragma unroll
            for (int i = 0; i < 8; ++i) LBAR();
            LBAR();
#pragma unroll
            for (int k = 0; k < 2; ++k) { const int slot = hsl + 4 * k; const LAS float* op = C.opart + (par * 8 + slot) * 256 + lane;
                const float o = (op[0] + op[64]) + (op[128] + op[192]);
                C.po[(C.r0 + C.dstep * (long)(t0 + slot)) * D] = (bf16_t)(pk2(o, o) & 0xffffu); }
            par ^= 1;
        }
    }
    LBAR();
}

#define RLX_AGENT __ATOMIC_RELAXED, __HIP_MEMORY_SCOPE_AGENT
#define XB_TMO      128
#define XB_XCNT(j)  (256  + 64 * (j))
#define XB_XSUB(j)  (1280 + 64 * (j))
#define XB_XGEN(j)  (2304 + 64 * (j))
#define XB_TOP      3328
#define XB_TOPGEN   3392
#define XCD_BAR_WORDS 3456
#define XB_SPIN_CAP (1u << 28)

__device__ __forceinline__ unsigned xb_ld(unsigned* p)              { return __hip_atomic_load(p, __ATOMIC_RELAXED, __HIP_MEMORY_SCOPE_AGENT); }
__device__ __forceinline__ unsigned xb_add(unsigned* p, unsigned v) { return __hip_atomic_fetch_add(p, v, __ATOMIC_RELAXED, __HIP_MEMORY_SCOPE_AGENT); }
__device__ __forceinline__ unsigned xb_xcc_id() { return (unsigned)__builtin_amdgcn_s_getreg((3 << 11) | 20) & 0xFu; }
#define XB_SPIN(cond, bar) do { unsigned _sp = 0; while (cond) { __builtin_amdgcn_s_sleep(1); \
    if ((++_sp & 255u) == 0u) { if (xb_ld(&(bar)[XB_TMO])) break; if (_sp > XB_SPIN_CAP) { atomicAdd(&(bar)[XB_TMO], 1u); break; } } } } while (0)

struct XcdBarrier {
    unsigned* bar; unsigned x;
    volatile LAS unsigned* st;
};

__device__ __forceinline__ XcdBarrier xcd_barrier_post(unsigned* bar, volatile LAS unsigned* st) {
    XcdBarrier b; b.bar = bar; b.x = xb_xcc_id(); b.st = st;
    if (threadIdx.x == 0) (void)xb_add(&bar[XB_XCNT(b.x)], 1u);
    return b;
}
__device__ __forceinline__ void xcd_barrier_complete(unsigned* bar, unsigned x, unsigned& nloc, unsigned& nx) {
    const unsigned G = gridDim.x * gridDim.y * gridDim.z;
    unsigned sum, cnt, mine, sp = 0u;
    for (;;) {
        sum = 0u; cnt = 0u; mine = 0u;
#pragma unroll
        for (unsigned j = 0; j < 16; ++j) { const unsigned c = xb_ld(&bar[XB_XCNT(j)]); sum += c; cnt += (c > 0u) ? 1u : 0u; mine = (j == x) ? c : mine; }
        if (sum == G) break;
        __builtin_amdgcn_s_sleep(1);
        if ((++sp & 255u) == 0u) { if (xb_ld(&bar[XB_TMO])) break; if (sp > XB_SPIN_CAP) { atomicAdd(&bar[XB_TMO], 1u); break; } }
    }
    nloc = mine > 0u ? mine : 1u; nx = cnt > 0u ? cnt : 1u;
}

__device__ __forceinline__ void xcd_barrier(const XcdBarrier& b) {
    asm volatile("s_waitcnt vmcnt(0)" ::: "memory");
    __syncthreads();
    if (threadIdx.x == 0) {
        unsigned* bar = b.bar;
        __builtin_amdgcn_s_waitcnt(0);
        unsigned nloc = b.st[0], nx = b.st[1];
        if (nloc == 0u) { xcd_barrier_complete(bar, b.x, nloc, nx); b.st[0] = nloc; b.st[1] = nx; }
        const unsigned old = xb_add(&bar[XB_XSUB(b.x)], 1u);
        const unsigned gen = old / nloc;
        if (old + 1u == (gen + 1u) * nloc) {
            __builtin_amdgcn_fence(__ATOMIC_RELEASE, "agent");
            asm volatile("s_waitcnt vmcnt(0)" ::: "memory");
            const unsigned og = xb_add(&bar[XB_TOP], 1u);
            const unsigned tg = og / nx;
            if (og + 1u == (tg + 1u) * nx) xb_add(&bar[XB_TOPGEN], 1u);
            else XB_SPIN(xb_ld(&bar[XB_TOPGEN]) == tg, bar);
            __builtin_amdgcn_fence(__ATOMIC_ACQUIRE, "agent");
            xb_add(&bar[XB_XGEN(b.x)], 1u);
            asm volatile("s_waitcnt vmcnt(0)" ::: "memory");
        } else {
            XB_SPIN(xb_ld(&bar[XB_XGEN(b.x)]) == gen, bar);
            __builtin_amdgcn_fence(__ATOMIC_ACQUIRE, "agent");
            asm volatile("s_waitcnt vmcnt(0)" ::: "memory");
        }
    }
    __syncthreads();
}
__global__ void __launch_bounds__(NTHREADS, 2) mega_fwd(Args A) {
    extern __shared__ __attribute__((aligned(16))) unsigned char lds_raw[];
    LAS unsigned char* lds = (LAS unsigned char*)lds_raw;
    cg::grid_group grid = cg::this_grid();
#define TIDV int tid_ = threadIdx.x; asm volatile("" : "+v"(tid_)); const int tid = tid_, lane = tid & 63, wave = __builtin_amdgcn_readfirstlane(tid >> 6); \
    const int G = gridDim.x, gw = blockIdx.x * NWAVES + wave, ngw = G * NWAVES, gtid = blockIdx.x * NTHREADS + tid, gthreads = G * NTHREADS; \
    (void)lane; (void)gw; (void)ngw; (void)gtid; (void)gthreads;

    if (A.ph_hi < 0) grid.sync();
    if (EXP_ZFILL) { for (int i = threadIdx.x; i < LDS_BYTES / 4; i += NTHREADS) ((LAS unsigned*)lds)[i] = 0u; __syncthreads(); }
    { volatile LAS unsigned* misc = (volatile LAS unsigned*)(lds + LDS_MISC);
      if (threadIdx.x < 32) misc[threadIdx.x] = 0u;
      __syncthreads(); }
    XcdBarrier bar = xcd_barrier_post((unsigned*)(A.ws + WS_CTL) + 4096, (volatile LAS unsigned*)(lds + LDS_MISC) + 8);
    for (int ph = A.ph_lo; ph < A.ph_hi; ++ph) {
        if (ph > A.ph_lo) xcd_barrier(bar);
        int z = 0; asm volatile("" : "+s"(z));
        unsigned char* ws = A.ws + z;
        if (ph == 0) {
            TIDV
            LAS float* scr = (LAS float*)(lds + wave * 16384);
            constexpr int I_IN = 16 * (NIN / 32), I_SQ = 16 * 32, I_F1 = 16 * 128, I_F2 = 64 * 32, I_G = 2 * 32, I_U = 32;
            constexpr int NITEMS = I_IN + 3 * I_SQ + I_F1 + I_F2 + I_G + 4 * I_U;
            for (int it = gw; it < NITEMS; it += ngw) {
                int r = it;
                if (r < I_IN) { p0_transpose_item(INP(2), D, NIN, (bf16_t*)(ws + WS_WIN), scr, r, lane); continue; } r -= I_IN;
                if (r < I_SQ) { p0_transpose_item(INP(17), D, D, (bf16_t*)(ws + WS_WPR), scr, r, lane); continue; } r -= I_SQ;
                if (r < I_SQ) { p0_transpose_item(INP(18), D, D, (bf16_t*)(ws + WS_WPA), scr, r, lane); continue; } r -= I_SQ;
                if (r < I_SQ) { p0_transpose_item(INP(19), D, D, (bf16_t*)(ws + WS_WOUT), scr, r, lane); continue; } r -= I_SQ;
                if (r < I_F1) { p0_transpose_item(INP(22), D, FF, (bf16_t*)(ws + WS_WF1), scr, r, lane); continue; } r -= I_F1;
                if (r < I_F2) { p0_transpose_item(INP(23), FF, D, (bf16_t*)(ws + WS_WF2), scr, r, lane); continue; } r -= I_F2;
                if (r < I_G) { p0_transpose_item(INP(9), 128, D, (bf16_t*)(ws + WS_GUP), scr, r, lane); continue; } r -= I_G;
                { const int which = r / I_U, it2 = r % I_U, dd = which & 1;
                  p0_transpose_item((which < 2 ? INP(6) : INP(8)) + (size_t)dd * 64 * 1024, 64, D, (bf16_t*)(ws + (which < 2 ? WS_WUP : WS_AUP)) + (size_t)dd * 1024 * 64, scr, it2, lane); }
            }
            cvt_x_chunk(INP(0), (bf16_t*)(ws + WS_XB), gtid, gthreads);
            if (EXP_ZFILL) { u32x4* zo = (u32x4*)A.out; const size_t no = (size_t)MTOT * D / 4; const u32x4 z0 = {0u, 0u, 0u, 0u};
                for (size_t i = gtid; i < no; i += gthreads) zo[i] = z0; }
            if (EXP_ZFILL) { u32x4* zp = (u32x4*)(ws + WS_Z); const size_t n16 = (WS_END - WS_Z) / 16; const u32x4 zz = {0u, 0u, 0u, 0u};
                for (size_t i = gtid; i < n16; i += gthreads) zp[i] = zz; }
            continue;
        }
        if (ph == 1 + 9 * NCHUNK) {
            TIDV
            ln_rows(A.out + (size_t)(NCHUNK - 1) * MC * D, INP(24), INP(25), nullptr, gw, ngw, lane);
            continue;
        }
        const int c = (ph - 1) / 9, sub = (ph - 1) % 9;
        const int T = (c < 4) ? 2048 : 8192;
        const float* xin = (c < 4) ? INP(0) + (size_t)c * MC * D : INP(1);
        float* outc = A.out + (size_t)c * MC * D;
        if (sub == 0) {
            { Epi8<FZ> e{{(bf16_t*)(ws + WS_Z)}};
              run_gemm(lds, (const bf16_t*)(ws + WS_XB), (const bf16_t*)(ws + WS_WIN), MC, NINP, D, e); }
            if (c > 0) { TIDV ln_rows(A.out + (size_t)(c - 1) * MC * D, INP(24), INP(25), nullptr, gw, ngw, lane); }
        } else if (sub == 1) {
            TIDV
            const int G_ = gridDim.x, b_ = blockIdx.x, tile_lo = (int)(((long)(MC / 32) * b_) / G_), tile_hi = (int)(((long)(MC / 32) * (b_ + 1)) / G_);
            prep_rows(INP(3), INP(4), INP(10), INP(15), INP(16), ws, T, tile_lo * 32 + wave, NWAVES, tile_hi * 32, lane, true);
            __syncthreads();
            const int nit = (tile_hi - tile_lo) * 40;
            for (int it = wave; it < nit; it += NWAVES) {
                const int mt = it / 40, r = it % 40, which = r >> 3, m0 = (tile_lo + mt) * 32, n0 = (r & 7) * 128;
                if (which < 2) { FW f{INP(5) + which * 1024, (float*)(ws + WS_OPW) + (size_t)which * MC * D};
                    wave_gemm_tile<64>((const bf16_t*)(ws + WS_TW), which * 64, (const bf16_t*)(ws + WS_WUP) + (size_t)which * 1024 * 64, m0, n0, lane, f); }
                else if (which < 4) { const int dd = which - 2;
                    FA f{INP(7) + dd * 1024, INP(11), (const bf16_t*)(ws + WS_KS), (const float*)(ws + WS_OPKH), (float*)(ws + WS_OPAK) + (size_t)dd * MC * D, (float*)(ws + WS_OPKT) + (size_t)dd * MC * D};
                    wave_gemm_tile<64>((const bf16_t*)(ws + WS_AD), dd * 64, (const bf16_t*)(ws + WS_AUP) + (size_t)dd * 1024 * 64, m0, n0, lane, f); }
                else { FG f{(bf16_t*)(ws + WS_G)};
                    wave_gemm_tile<128>((const bf16_t*)(ws + WS_SG), 0, (const bf16_t*)(ws + WS_GUP), m0, n0, lane, f); }
            }
        } else if (sub == 2) {
            const int nseq = MC / T, nchain = nseq * 32, nqb = T / 256, natt = nseq * 8 * nqb;
            LAS unsigned* qslot = (LAS unsigned*)(lds + LDS_MISC); const int tid = threadIdx.x;
            for (;;) {
                __syncthreads();
                if (tid == 0) qslot[0] = atomicAdd((unsigned*)(ws + WS_CTL) + 64 * c, 1u);
                __syncthreads();
                const int item = __builtin_amdgcn_readfirstlane((int)qslot[0]);
                if (item >= nchain + natt) break;
                if (item < nchain) scan_chain(ws, lds, item >> 5, (item >> 1) & 15, item & 1, T, 0);
                else {
                    const int u = item - nchain, qb = u % nqb, hq = (u / nqb) & 7, s = u / (nqb * 8);
                    const att::bf16* qkv = (const att::bf16*)(ws + WS_Z) + (size_t)s * T * ZLD;
                    att::attn_dense_body(qkv + (size_t)qb * 256 * ZLD + ZQ + hq * 128, qkv + ZK + (hq >> 2) * 128, qkv + ZV + (hq >> 2) * 128,
                                         (att::bf16*)(ws + WS_OATT) + ((size_t)s * T + (size_t)qb * 256) * D + hq * 128, T, (char*)lds_raw);
                }
            }
        } else if (sub == 3) {
            TIDV
            post_rows(INP(12), INP(13), INP(14), ws, gw, ngw, lane);
        } else if (sub == 4) {
            { Epi4<FP1> e{{(const bf16_t*)(ws + WS_Z), (float*)(ws + WS_M32)}};
              run_gemm(lds, (const bf16_t*)(ws + WS_ORW), (const bf16_t*)(ws + WS_WPR), MC, D, D, e); }
            { Epi4<FP2> e{{(const bf16_t*)(ws + WS_Z), (const float*)(ws + WS_M32), (bf16_t*)(ws + WS_MB)}};
              run_gemm(lds, (const bf16_t*)(ws + WS_OATT), (const bf16_t*)(ws + WS_WPA), MC, D, D, e); }
        } else if (sub == 5) {
            Epi4<FOut> e{{xin, outc}};
            run_gemm(lds, (const bf16_t*)(ws + WS_MB), (const bf16_t*)(ws + WS_WOUT), MC, D, D, e);
        } else if (sub == 6) {
            TIDV
            ln_rows(outc, INP(20), INP(21), (bf16_t*)(ws + WS_HB), gw, ngw, lane);
            if (c + 1 < NCHUNK) cvt_x_chunk((c + 1 < 4) ? INP(0) + (size_t)(c + 1) * MC * D : INP(1), (bf16_t*)(ws + WS_XB), gtid, gthreads);
        } else if (sub == 7) {
            Epi8<FF1> e{{(bf16_t*)(ws + WS_FFH)}};
            run_gemm(lds, (const bf16_t*)(ws + WS_HB), (const bf16_t*)(ws + WS_WF1), MC, FF, D, e);
        } else {
            Epi4<FF2> e{{outc}};
            run_gemm(lds, (const bf16_t*)(ws + WS_FFH), (const bf16_t*)(ws + WS_WF2), MC, D, FF, e);
        }
    }
}

constexpr int NPHASE = 2 + 9 * NCHUNK;

extern "C" void kernel_launch(void* const* d_in, const int* in_sizes, int n_in, void* d_out, int out_size, void* d_ws, size_t ws_size, hipStream_t stream) {
    static int grid = 0;
    if (grid == 0) {
        if (n_in != 26 || out_size != MTOT * D || ws_size < WS_END) { fprintf(stderr, "kernel_launch: unexpected shapes n_in %d out %d ws %zu\n", n_in, out_size, ws_size); grid = -1; return; }
        int dev = 0, cus = 0, per_cu = 0;
        hipGetDevice(&dev); hipDeviceGetAttribute(&cus, hipDeviceAttributeMultiprocessorCount, dev);
        if (hipFuncSetAttribute((const void*)mega_fwd, hipFuncAttributeMaxDynamicSharedMemorySize, LDS_BYTES) != hipSuccess) { fprintf(stderr, "kernel_launch: LDS attribute failed\n"); grid = -1; return; }
        if (hipOccupancyMaxActiveBlocksPerMultiprocessor(&per_cu, (const void*)mega_fwd, NTHREADS, LDS_BYTES) != hipSuccess || per_cu < 1) per_cu = 1;
        (void)hipGetLastError();
        grid = cus * (per_cu > 1 ? 1 : per_cu);
    }
    if (grid < 0) return;
    hipMemsetAsync((char*)d_ws + WS_CTL, 0, 64 * 1024, stream);
    Args a{};
    for (int i = 0; i < 26; ++i) a.in[i] = (const float*)d_in[i];
    a.out = (float*)d_out; a.ws = (unsigned char*)d_ws; a.ph_lo = 0; a.ph_hi = NPHASE;
    void* args[] = {&a};
    hipError_t e = hipLaunchCooperativeKernel((const void*)mega_fwd, dim3(grid), dim3(NTHREADS), args, LDS_BYTES, stream);
    if (e != hipSuccess) fprintf(stderr, "cooperative launch failed: %s (grid %d)\n", hipGetErrorString(e), grid);
}
```

```cpp
#include <hip/hip_runtime.h>
#include <hip/hip_bf16.h>
#include <hip/hip_cooperative_groups.h>
#include <cstdio>
#include <cstdint>
namespace cg = cooperative_groups;
namespace pg8 {
#define PG8_LAS __attribute__((address_space(3)))
typedef unsigned short bf16_t;
typedef short bf16x8 __attribute__((ext_vector_type(8)));
typedef float f32x4 __attribute__((ext_vector_type(4)));
typedef unsigned u32x4 __attribute__((ext_vector_type(4)));
constexpr int BM = 256, BK = 64, HALF = 128, HTB = HALF * BK * 2  , STAGE_BYTES = 8 * HTB, NXCD = 8, WGM = 8;

__host__ __device__ __forceinline__ int lds_byte(int r, int c) { const int st = (r >> 4) * 2 + (c >> 5), rr = r & 15, cc = c & 31, ob = rr * 64 + cc * 2; return st * 1024 + (ob ^ (((ob >> 9) & 1) << 5)); }
__host__ __device__ __forceinline__ void stage_rc(int b, int& R, int& C) { const int st = b / 1024, sb = b % 1024, swz = sb ^ (((sb >> 9) & 1) << 5); R = (st >> 1) * 16 + swz / 64; C = (st & 1) * 32 + (swz % 64) / 2; }
__host__ __device__ __forceinline__ int perm32(int rho) { const int n = rho >> 4, i = rho & 15; return 8 * (i >> 2) + 4 * n + (i & 3); }

struct Unit { int pm, pn; };
struct Gemm { const bf16_t* A; const bf16_t* Bt; int M, N, K; };

struct StaticOrder {
    int nM, nN, nwg, G, c;
    __host__ __device__ void init(int M, int N, int G_, int c_) { nM = M / BM; nN = N / BM; nwg = nM * nN; G = G_; c = c_; }
    __host__ __device__ bool next(int i, Unit& u) const {
        const long L = (long)i * G + c; if (L >= nwg) return false;
        int wgid = (int)L; { const int q = nwg / NXCD, r = nwg % NXCD, xcd = wgid % NXCD, off = wgid / NXCD; wgid = (xcd < r ? xcd * (q + 1) : r * (q + 1) + (xcd - r) * q) + off; }
        const int nig = WGM * nN, gid = wgid / nig, fm = gid * WGM, gsz = (nM - fm) < WGM ? (nM - fm) : WGM;
        u.pm = fm + ((wgid % nig) % gsz); u.pn = (wgid % nig) / gsz; return true;
    }
    __device__ __forceinline__ void a_ready(const Unit&) const {}
    __device__ __forceinline__ void done(const Unit&) const {}
};
__device__ __forceinline__ unsigned cvt_pk_bf16(float lo, float hi) { unsigned r; asm volatile("v_cvt_pk_bf16_f32 %0, %1, %2" : "=v"(r) : "v"(lo), "v"(hi)); return r; }
typedef float f32x2 __attribute__((ext_vector_type(2)));
template <class Epi, class Sched, bool ALIGN_EPI = false, bool SP2 = false>
__device__ __forceinline__ void gemm_phase(PG8_LAS unsigned char* lds, const Gemm g, const Sched& S, const Epi& E) {
    int tid_ = threadIdx.x; asm volatile("" : "+v"(tid_));
    const int tid = tid_, wid = __builtin_amdgcn_readfirstlane(tid >> 6), lane = tid & 63, wr = wid >> 2, wc = wid & 3, fr = lane & 15, fq = lane >> 4;
    const int K = g.K, nt = K / BK;
    unsigned voffA[2], voffB[2];
#pragma unroll
    for (int i = 0; i < 2; ++i) { int R, C; stage_rc(tid * 16 + i * 8192, R, C); const int Rb = Epi::PERM ? ((R & ~31) + perm32(R & 31)) : R;
        voffA[i] = (unsigned)(R * K + C) * 2u; voffB[i] = (unsigned)(Rb * K + C) * 2u; }
    const size_t kstep = (size_t)(BK * 2);
    const size_t hstep = (size_t)HALF * K * 2;
    const size_t tstep = 2 * hstep;
    const unsigned ldsw = (unsigned)wid * 1024u;
    const int aoff = lds_byte(wr * 64 + fr, fq * 8), boff = lds_byte(wc * 32 + fr, fq * 8);
#define PG8_SA(b, h) (((b) * 2 + (h)) * HTB)
#define PG8_SB(b, h) ((4 + (b) * 2 + (h)) * HTB)
#define PG8_STAGE(bufoff, gbase, voff) do { _Pragma("unroll") for (int _i = 0; _i < 2; ++_i) \
        __builtin_amdgcn_global_load_lds((const unsigned*)((const char*)(gbase) + (voff)[_i]), (PG8_LAS unsigned*)(lds + (bufoff) + ldsw + _i * 8192), 16, 0, 0); } while (0)
#define PG8_LDA(dst, b, h) do { _Pragma("unroll") for (int m = 0; m < 4; ++m) _Pragma("unroll") for (int k = 0; k < 2; ++k) dst[m][k] = *(const PG8_LAS bf16x8*)(lds + PG8_SA(b, h) + aoff + m * 2048 + k * 1024); } while (0)
#define PG8_LDB(dst, b, h) do { _Pragma("unroll") for (int n = 0; n < 2; ++n) _Pragma("unroll") for (int k = 0; k < 2; ++k) dst[n][k] = *(const PG8_LAS bf16x8*)(lds + PG8_SB(b, h) + boff + n * 2048 + k * 1024); } while (0)
#define PG8_MMA(ai, bj, At, Bt) do { __builtin_amdgcn_s_setprio(1); _Pragma("unroll") for (int m = 0; m < 4; ++m) _Pragma("unroll") for (int n = 0; n < 2; ++n) _Pragma("unroll") for (int k = 0; k < 2; ++k) \
        acc[ai][bj][m][n] = __builtin_amdgcn_mfma_f32_16x16x32_bf16(Bt[n][k], At[m][k], acc[ai][bj][m][n], 0, 0, 0); __builtin_amdgcn_s_setprio(0); } while (0)
#define PG8_WAIT_V(n) asm volatile("s_waitcnt vmcnt(" #n ")" ::: "memory")
#define PG8_WAIT_L(n) asm volatile("s_waitcnt lgkmcnt(" #n ")" ::: "memory")
#define PG8_BAR __builtin_amdgcn_s_barrier()
#define PG8_SCHED __builtin_amdgcn_sched_barrier(0)
    Unit cur, nxt; int ui = 0;
    if (!S.next(0, cur)) return;
    f32x4 acc[2][2][4][2];
#pragma unroll
    for (int a = 0; a < 2; ++a)
#pragma unroll
        for (int b = 0; b < 2; ++b)
#pragma unroll
            for (int m = 0; m < 4; ++m)
#pragma unroll
                for (int n = 0; n < 2; ++n) acc[a][b][m][n] = (f32x4){0.f, 0.f, 0.f, 0.f};
    bf16x8 At[4][2], B0[2][2], B1[2][2];
    const char* cA = (const char*)g.A + (size_t)cur.pm * tstep; const char* cB = (const char*)g.Bt + (size_t)cur.pn * tstep;
    S.a_ready(cur);
    if constexpr (SP2) {
        PG8_STAGE(PG8_SB(0, 0), cB, voffB); PG8_STAGE(PG8_SB(0, 1), cB + hstep, voffB); PG8_STAGE(PG8_SA(0, 0), cA, voffA); PG8_STAGE(PG8_SA(0, 1), cA + hstep, voffA);
        if (wr == 1) PG8_BAR;
        PG8_WAIT_V(2); PG8_BAR;
        PG8_STAGE(PG8_SB(1, 0), cB + kstep, voffB); PG8_STAGE(PG8_SA(1, 0), cA + kstep, voffA); PG8_STAGE(PG8_SB(1, 1), cB + hstep + kstep, voffB);
        PG8_WAIT_V(6); PG8_BAR;
    } else {
        PG8_STAGE(PG8_SB(0, 0), cB, voffB); PG8_STAGE(PG8_SA(0, 0), cA, voffA); PG8_STAGE(PG8_SB(0, 1), cB + hstep, voffB); PG8_STAGE(PG8_SA(0, 1), cA + hstep, voffA);
        if (wr == 1) PG8_BAR;
        PG8_WAIT_V(4); PG8_BAR;
        PG8_STAGE(PG8_SB(1, 0), cB + kstep, voffB); PG8_STAGE(PG8_SA(1, 0), cA + kstep, voffA); PG8_STAGE(PG8_SB(1, 1), cB + hstep + kstep, voffB);
        PG8_WAIT_V(6); PG8_BAR;
    }
    for (;;) {
        const bool has_next = S.next(ui + 1, nxt);
        const char* nA = has_next ? (const char*)g.A + (size_t)nxt.pm * tstep : cA; const char* nB = has_next ? (const char*)g.Bt + (size_t)nxt.pn * tstep : cB;
        for (int t = 0; t < nt; t += 2) {
            const bool last = (t == nt - 2);
            const char* a1 = cA + (size_t)(t + 1) * kstep;
            const char* a2 = last ? nA : cA + (size_t)(t + 2) * kstep; const char* b2 = last ? nB : cB + (size_t)(t + 2) * kstep;
            const char* a3 = a2 + kstep; const char* b3 = b2 + kstep;
            if (last && has_next) S.a_ready(nxt);
            if constexpr (SP2) {
            PG8_LDB(B0, 0, 0); PG8_LDB(B1, 0, 1); PG8_SCHED; PG8_LDA(At, 0, 0); PG8_STAGE(PG8_SA(1, 1), a1 + hstep, voffA);
            PG8_WAIT_V(8); PG8_WAIT_L(0); PG8_BAR; PG8_MMA(0, 0, At, B0); PG8_MMA(0, 1, At, B1); PG8_BAR; PG8_SCHED;
            PG8_LDA(At, 0, 1); PG8_STAGE(PG8_SB(0, 0), b2, voffB); PG8_STAGE(PG8_SB(0, 1), b2 + hstep, voffB); PG8_STAGE(PG8_SA(0, 0), a2, voffA);
            PG8_WAIT_V(8); PG8_WAIT_L(0); PG8_BAR; PG8_MMA(1, 0, At, B0); PG8_MMA(1, 1, At, B1); PG8_BAR; PG8_SCHED;
            PG8_LDB(B0, 1, 0); PG8_LDB(B1, 1, 1); PG8_SCHED; PG8_LDA(At, 1, 0); PG8_STAGE(PG8_SA(0, 1), a2 + hstep, voffA);
            PG8_WAIT_V(8); PG8_WAIT_L(0); PG8_BAR; PG8_MMA(0, 0, At, B0); PG8_MMA(0, 1, At, B1); PG8_BAR; PG8_SCHED;
            PG8_LDA(At, 1, 1); PG8_STAGE(PG8_SB(1, 0), b3, voffB); PG8_STAGE(PG8_SB(1, 1), b3 + hstep, voffB); PG8_STAGE(PG8_SA(1, 0), a3, voffA);
            PG8_WAIT_V(8); PG8_WAIT_L(0); PG8_BAR; PG8_MMA(1, 0, At, B0); PG8_MMA(1, 1, At, B1); PG8_BAR; PG8_SCHED;
            } else {
            PG8_LDB(B0, 0, 0); PG8_SCHED; PG8_LDA(At, 0, 0); PG8_STAGE(PG8_SA(1, 1), a1 + hstep, voffA);
            PG8_WAIT_L(8); PG8_BAR; PG8_WAIT_L(0); PG8_MMA(0, 0, At, B0); PG8_BAR; PG8_SCHED;
            PG8_LDB(B1, 0, 1); PG8_STAGE(PG8_SB(0, 0), b2, voffB);
            PG8_BAR; PG8_WAIT_L(0); PG8_MMA(0, 1, At, B1); PG8_BAR;
            PG8_LDA(At, 0, 1); PG8_STAGE(PG8_SA(0, 0), a2, voffA);
            PG8_BAR; PG8_WAIT_L(0); PG8_MMA(1, 0, At, B0); PG8_BAR; PG8_SCHED;
            PG8_STAGE(PG8_SB(0, 1), b2 + hstep, voffB);
            PG8_WAIT_V(6); PG8_BAR; PG8_MMA(1, 1, At, B1); PG8_BAR;
            PG8_LDB(B0, 1, 0); PG8_SCHED; PG8_LDA(At, 1, 0); PG8_STAGE(PG8_SA(0, 1), a2 + hstep, voffA);
            PG8_WAIT_L(8); PG8_BAR; PG8_WAIT_L(0); PG8_MMA(0, 0, At, B0); PG8_BAR; PG8_SCHED;
            PG8_LDB(B1, 1, 1); PG8_STAGE(PG8_SB(1, 0), b3, voffB);
            PG8_BAR; PG8_WAIT_L(0); PG8_MMA(0, 1, At, B1); PG8_BAR;
            PG8_LDA(At, 1, 1); PG8_STAGE(PG8_SA(1, 0), a3, voffA);
            PG8_BAR; PG8_WAIT_L(0); PG8_MMA(1, 0, At, B0); PG8_BAR; PG8_SCHED;
            PG8_STAGE(PG8_SB(1, 1), b3 + hstep, voffB);
            PG8_WAIT_V(6); PG8_BAR; PG8_MMA(1, 1, At, B1); PG8_BAR;
            }
        }
        if constexpr (ALIGN_EPI) { if (wr == 0) PG8_BAR; }
        if constexpr (!Epi::AFTER_DRAIN) { E(acc, cur, wr, wc, fr, fq); S.done(cur); }
        if (!has_next) break;
#pragma unroll
        for (int a = 0; a < 2; ++a)
#pragma unroll
            for (int b = 0; b < 2; ++b)
#pragma unroll
                for (int m = 0; m < 4; ++m)
#pragma unroll
                    for (int n = 0; n < 2; ++n) acc[a][b][m][n] = (f32x4){0.f, 0.f, 0.f, 0.f};
        cur = nxt; cA = nA; cB = nB; ++ui;
        if constexpr (ALIGN_EPI) { if (wr == 1) PG8_BAR; }
    }
    PG8_WAIT_V(0);
    if constexpr (!ALIGN_EPI) { if (wr == 0) PG8_BAR; }
    PG8_BAR;
    if constexpr (Epi::AFTER_DRAIN) { E.fused(acc, cur, wr, wc, fr, fq, lds, wid, lane); S.done(cur); }
#undef PG8_SA
#undef PG8_SB
#undef PG8_STAGE
#undef PG8_LDA
#undef PG8_LDB
#undef PG8_MMA
#undef PG8_WAIT_V
#undef PG8_WAIT_L
#undef PG8_BAR
#undef PG8_SCHED
}
}
namespace att {
using bf16 = __hip_bfloat16;
constexpr int   D = 128, NW = 8, QBLK = 32, KVBLK = 64;
constexpr float SCALE = 0.088388347648318440f;
constexpr float THR = 8.f;
constexpr int LDQ = 7168, LDK = 7168, LDO = 1024;
constexpr size_t SHM_V = KVBLK * D * 2, SHM_K = KVBLK * D * 2, SHM_ATTN = 2 * SHM_V + 2 * SHM_K + NW * 64 * 4;
using bf16x8 = __attribute__((ext_vector_type(8))) short;
using s16x4  = __attribute__((ext_vector_type(4))) short;
using f32x16 = __attribute__((ext_vector_type(16))) float;
using u32x4  = __attribute__((ext_vector_type(4))) unsigned;
#define KSWZ(row, colB) ((row) * 256 + ((colB) ^ (((row) & 7) << 4)))
#define SBAR() __builtin_amdgcn_sched_barrier(0)
__device__ __forceinline__ int crow(int r, int hi) { return (r & 3) + 8 * (r >> 2) + 4 * hi; }
__device__ __forceinline__ unsigned cvtpk(float lo, float hi) {
  unsigned r; asm volatile("v_cvt_pk_bf16_f32 %0, %1, %2" : "=v"(r) : "v"(lo), "v"(hi)); return r;
}
__device__ __forceinline__ bf16x8 ld8(const bf16* p) { return *reinterpret_cast<const bf16x8*>(p); }
__device__ __forceinline__ void partialSM(f32x16& p0, f32x16& p1, float& m_reg, float& mn, float& alpha) {
  constexpr float C = SCALE * 1.4426950408889634f;
  float pmax = p0[0]; for (int r = 1; r < 16; ++r) pmax = fmaxf(pmax, p0[r]); for (int r = 0; r < 16; ++r) pmax = fmaxf(pmax, p1[r]);
  { auto rr = __builtin_amdgcn_permlane32_swap(__float_as_uint(pmax), __float_as_uint(pmax), false, false);
    pmax = fmaxf(__uint_as_float(rr[0]), __uint_as_float(rr[1])); }
  if (__builtin_expect(__all(pmax - m_reg <= THR / SCALE), 1)) { mn = m_reg; alpha = 1.f; }
  else { mn = fmaxf(m_reg, pmax); alpha = __builtin_amdgcn_exp2f((m_reg - mn) * C); m_reg = mn; }
  float mnC = -mn * C;
  for (int r = 0; r < 16; ++r) p0[r] = fmaf(p0[r], C, mnC); for (int r = 0; r < 16; ++r) p1[r] = fmaf(p1[r], C, mnC);
  for (int r = 0; r < 16; ++r) p0[r] = __builtin_amdgcn_exp2f(p0[r]);
}
__device__ __forceinline__ void finishSM(f32x16& p0, f32x16& p1, float alpha, float& l_reg, bf16x8& pa0, bf16x8& pa1, bf16x8& pa2, bf16x8& pa3) {
  for (int r = 0; r < 16; ++r) p1[r] = __builtin_amdgcn_exp2f(p1[r]);
  float ps = 0; for (int r = 0; r < 16; ++r) ps += p0[r]; for (int r = 0; r < 16; ++r) ps += p1[r];
  { auto rr = __builtin_amdgcn_permlane32_swap(__float_as_uint(ps), __float_as_uint(ps), false, false);
    ps = __uint_as_float(rr[0]) + __uint_as_float(rr[1]); }
  l_reg = l_reg * alpha + ps;
#define PK4(P, BASE, OUT) do { unsigned a0 = cvtpk(P[BASE + 0], P[BASE + 1]), a1 = cvtpk(P[BASE + 2], P[BASE + 3]);   \
    unsigned b0 = cvtpk(P[BASE + 4], P[BASE + 5]), b1 = cvtpk(P[BASE + 6], P[BASE + 7]);                              \
    auto r0 = __builtin_amdgcn_permlane32_swap(a0, b0, false, false); auto r1 = __builtin_amdgcn_permlane32_swap(a1, b1, false, false); \
    u32x4 w = {r0[0], r1[0], r0[1], r1[1]}; OUT = *reinterpret_cast<bf16x8*>(&w); } while (0)
  PK4(p0, 0, pa0); PK4(p0, 8, pa1); PK4(p1, 0, pa2); PK4(p1, 8, pa3);
#undef PK4
}
__device__ __forceinline__ void qkt(f32x16& p0, f32x16& p1, const bf16* Ks, const bf16x8* qr, int r32, int hi) {
  p0 = f32x16{}; p1 = f32x16{};
  for (int d0 = 0; d0 < 8; ++d0) { int cb = (d0 * 16 + hi * 8) * 2;
    bf16x8 b0 = *reinterpret_cast<const bf16x8*>((const char*)Ks + KSWZ(r32, cb));
    bf16x8 b1 = *reinterpret_cast<const bf16x8*>((const char*)Ks + KSWZ(32 + r32, cb));
    p0 = __builtin_amdgcn_mfma_f32_32x32x16_bf16(b0, qr[d0], p0, 0, 0, 0);
    p1 = __builtin_amdgcn_mfma_f32_32x32x16_bf16(b1, qr[d0], p1, 0, 0, 0); }
}
__device__ __forceinline__ int v_st(int k, int c) { const int kk = (k & ~0xC) | ((k & 4) << 1) | ((k & 8) >> 1); return ((kk >> 3) * 4 + (c >> 5)) * 512 + ((kk & 7) * 32 + (c & 31)) * 2; }
__device__ __forceinline__ int v_rd_base(int lane) { return ((lane & 3) << 3) | (((lane >> 2) & 3) << 6) | (((lane >> 4) & 1) << 5) | (((lane >> 5) & 1) << 8); }
constexpr int v_rd_off(int d0, int ks, int half) { return d0 * 512 + ks * 4096 + half * 2048; }
template <int OFF> __device__ __forceinline__ s16x4 tr_read(int vb) {
  s16x4 r; asm volatile("ds_read_b64_tr_b16 %0, %1 offset:%2" : "=&v"(r) : "v"(vb), "i"(OFF) : "memory"); return r;
}
template <int D0> __device__ __forceinline__ void pv_one(f32x16& od, int vb, bf16x8 pa0, bf16x8 pa1, bf16x8 pa2, bf16x8 pa3) {
  const s16x4 l0 = tr_read<v_rd_off(D0, 0, 0)>(vb), h0 = tr_read<v_rd_off(D0, 0, 1)>(vb), l1 = tr_read<v_rd_off(D0, 1, 0)>(vb), h1 = tr_read<v_rd_off(D0, 1, 1)>(vb);
  const s16x4 l2 = tr_read<v_rd_off(D0, 2, 0)>(vb), h2 = tr_read<v_rd_off(D0, 2, 1)>(vb), l3 = tr_read<v_rd_off(D0, 3, 0)>(vb), h3 = tr_read<v_rd_off(D0, 3, 1)>(vb);
  asm volatile("s_waitcnt lgkmcnt(0)" ::: "memory"); SBAR();
#define PK(L, H) (bf16x8){L[0], L[1], L[2], L[3], H[0], H[1], H[2], H[3]}
  od = __builtin_amdgcn_mfma_f32_32x32x16_bf16(pa0, PK(l0, h0), od, 0, 0, 0);
  od = __builtin_amdgcn_mfma_f32_32x32x16_bf16(pa1, PK(l1, h1), od, 0, 0, 0);
  od = __builtin_amdgcn_mfma_f32_32x32x16_bf16(pa2, PK(l2, h2), od, 0, 0, 0);
  od = __builtin_amdgcn_mfma_f32_32x32x16_bf16(pa3, PK(l3, h3), od, 0, 0, 0);
#undef PK
}
__device__ __forceinline__ void pv_d0(f32x16* o, int vb, bf16x8 pa0, bf16x8 pa1, bf16x8 pa2, bf16x8 pa3) {
  pv_one<0>(o[0], vb, pa0, pa1, pa2, pa3); pv_one<1>(o[1], vb, pa0, pa1, pa2, pa3); pv_one<2>(o[2], vb, pa0, pa1, pa2, pa3); pv_one<3>(o[3], vb, pa0, pa1, pa2, pa3);
}
__device__ __forceinline__ void attn_dense_body(const bf16* __restrict__ Qb, const bf16* __restrict__ Kh, const bf16* __restrict__ Vh,
                                                bf16* __restrict__ Ob, int seq, char* lds) {
  int tid_ = threadIdx.x; asm volatile("" : "+v"(tid_));
  const int tid = tid_, wid = tid >> 6, lane = tid & 63, r32 = lane & 31, hi = lane >> 5;
  bf16* V_lds = (bf16*)lds; bf16* K_lds = (bf16*)(lds + 2 * SHM_V);
  float* ws = (float*)(lds + 2 * SHM_V + 2 * SHM_K) + wid * 64; float* li_l = ws; float* al_l = ws + 32;
  float m_reg = -1e30f, l_reg = 0; f32x16 o[4] = {}; bf16x8 qr[8];
  const bf16* Qw = Qb + (long)(wid * QBLK + r32) * LDQ + hi * 8;
#pragma unroll
  for (int d0 = 0; d0 < 8; ++d0) qr[d0] = ld8(Qw + d0 * 16);
  const int sr = tid >> 4, sc = (tid & 15) * 8, vst0 = v_st(sr, sc), vst1 = v_st(32 + sr, sc);
  const int vb0 = (int)(uintptr_t)V_lds + v_rd_base(lane);
  struct { bf16x8 vs0, vs1, ks0, ks1; } sr_[2];
#define SLOAD(i, k0) do { sr_[i].vs0 = ld8(&Vh[(long)((k0) + sr) * LDK + sc]); sr_[i].vs1 = ld8(&Vh[(long)((k0) + 32 + sr) * LDK + sc]); \
    sr_[i].ks0 = ld8(&Kh[(long)((k0) + sr) * LDK + sc]); sr_[i].ks1 = ld8(&Kh[(long)((k0) + 32 + sr) * LDK + sc]); } while (0)
#define SWRITE(b, i) do { *(bf16x8*)((char*)V_lds + (b) * SHM_V + vst0) = sr_[i].vs0;          \
    *(bf16x8*)((char*)V_lds + (b) * SHM_V + vst1) = sr_[i].vs1; int kc = sc * 2;               \
    *(bf16x8*)((char*)K_lds + (b) * SHM_K + KSWZ(sr, kc)) = sr_[i].ks0;                       \
    *(bf16x8*)((char*)K_lds + (b) * SHM_K + KSWZ(32 + sr, kc)) = sr_[i].ks1; } while (0)
#define SWAIT() do { asm volatile("s_waitcnt vmcnt(4)" ::: "memory"); } while (0)
#define RESC(a) do { if (__any((a) < 1.f)) { if (hi == 0) al_l[r32] = (a); asm volatile("s_waitcnt lgkmcnt(0)" ::: "memory"); \
    for (int d = 0; d < 4; ++d) for (int r = 0; r < 16; ++r) o[d][r] *= al_l[crow(r, hi)]; } } while (0)
  f32x16 pA0, pA1, pB0, pB1; float mnA, mnB, alA, alB; bf16x8 pa0, pa1, pa2, pa3; const int NT = seq / KVBLK;
  constexpr int SE = 0, SO = 1;
  SLOAD(SE, 0); asm volatile("s_waitcnt vmcnt(0)" ::: "memory"); SWRITE(0, SE); __syncthreads();
  qkt(pA0, pA1, K_lds, qr, r32, hi); partialSM(pA0, pA1, m_reg, mnA, alA);
  SLOAD(SO, KVBLK); if (2 < NT) SLOAD(SE, 2 * KVBLK);
  SWAIT(); SWRITE(1, SO); __syncthreads();
  for (int j = 1; j + 1 < NT; j += 2) {
    SBAR(); qkt(pB0, pB1, (bf16*)((char*)K_lds + SHM_K), qr, r32, hi);
    finishSM(pA0, pA1, alA, l_reg, pa0, pa1, pa2, pa3); SBAR();
    SLOAD(SO, (j + 2) * KVBLK); SBAR();
    pv_d0(o, vb0, pa0, pa1, pa2, pa3); partialSM(pB0, pB1, m_reg, mnB, alB);
    __syncthreads(); SWAIT(); SWRITE(0, SE);
    RESC(alB); __syncthreads();
    SBAR(); qkt(pA0, pA1, K_lds, qr, r32, hi);
    finishSM(pB0, pB1, alB, l_reg, pa0, pa1, pa2, pa3); SBAR();
    if (j + 3 < NT) SLOAD(SE, (j + 3) * KVBLK); SBAR();
    pv_d0(o, vb0 + (int)SHM_V, pa0, pa1, pa2, pa3); partialSM(pA0, pA1, m_reg, mnA, alA);
    __syncthreads(); SWAIT(); SWRITE(1, SO);
    RESC(alA); __syncthreads();
  }
  SBAR(); qkt(pB0, pB1, (bf16*)((char*)K_lds + SHM_K), qr, r32, hi);
  finishSM(pA0, pA1, alA, l_reg, pa0, pa1, pa2, pa3); SBAR();
  pv_d0(o, vb0, pa0, pa1, pa2, pa3); partialSM(pB0, pB1, m_reg, mnB, alB);
  __syncthreads(); RESC(alB);
  finishSM(pB0, pB1, alB, l_reg, pa0, pa1, pa2, pa3); SBAR();
  pv_d0(o, vb0 + (int)SHM_V, pa0, pa1, pa2, pa3);
  if (hi == 0) li_l[r32] = l_reg; asm volatile("s_waitcnt lgkmcnt(0)" ::: "memory");
  float rli[16];
#pragma unroll
  for (int r = 0; r < 16; ++r) rli[r] = __builtin_amdgcn_rcpf(li_l[crow(r, hi)]);
  bf16* Ow = Ob + (long)(wid * QBLK) * LDO;
#pragma unroll
  for (int r = 0; r < 16; ++r) { int orow = crow(r, hi);
    for (int d0 = 0; d0 < 4; ++d0) Ow[(long)orow * LDO + d0 * 32 + r32] = __float2bfloat16(o[d0][r] * rli[r]); }
  __syncthreads();
#undef SLOAD
#undef SWRITE
#undef SWAIT
#undef RESC
}
#undef KSWZ
#undef SBAR
}
#define LAS __attribute__((address_space(3)))
typedef unsigned short bf16_t;
typedef float f32x4 __attribute__((ext_vector_type(4)));
typedef unsigned u32x4 __attribute__((ext_vector_type(4)));
typedef unsigned u32x2 __attribute__((ext_vector_type(2)));

#ifndef EXP_RW
#define EXP_RW 1.0f
#endif
#ifndef EXP_ATT
#define EXP_ATT 1.0f
#endif
#ifndef EXP_NOSCAN
#define EXP_NOSCAN 0
#endif
#ifndef EXP_ZFILL
#define EXP_ZFILL 0
#endif
#ifndef EXP_STATIC
#define EXP_STATIC 0
#endif
#ifndef EXP_TWICE
#define EXP_TWICE 0
#endif
#ifndef PROBE_REP3
#define PROBE_REP3 1
#endif
#ifndef PROBE_MASK
#define PROBE_MASK 0
#endif
#ifndef PREP_UNROLL
#define PREP_UNROLL 7
#endif
#ifndef EXP_MIX
#define EXP_MIX 1.0f
#endif
#ifndef EN_SCAN
#define EN_SCAN 1
#endif
#ifndef EN_ATT
#define EN_ATT 1
#endif
#ifndef EN_PREP
#define EN_PREP 1
#endif
#ifndef EN_GEMM
#define EN_GEMM 1
#endif
constexpr int NWAVES = 8, NTHREADS = 512;
constexpr int D = 1024, FF = 4096, NIN = 7040, NINP = 7168, RWC = 3456;
constexpr int MC = 16384, NCHUNK = 5, MTOT = 81920;
constexpr float ALPHA = 1.189207115002721f;
constexpr float LN_EPS = 1e-5f, GN_EPS = 64e-5f, RMS_EPS = 1e-6f;
constexpr float DECAY_SCALE = 0.6065306597126334f;

constexpr size_t MiB = 1u << 20;
constexpr size_t WS_CTL = 0;
constexpr size_t WS_WIN = 1 * MiB, WS_WPR = 15 * MiB, WS_WPA = 17 * MiB, WS_WOUT = 19 * MiB, WS_WF1 = 21 * MiB, WS_WF2 = 29 * MiB;
constexpr size_t WS_WUP = 37 * MiB, WS_AUP = 37 * MiB + 512 * 1024, WS_GUP = 38 * MiB;
constexpr size_t WS_XB = 40 * MiB, WS_OF = 40 * MiB;
constexpr size_t WS_Z = 72 * MiB;
constexpr size_t WS_OPR = 296 * MiB, WS_OPKH = 360 * MiB, WS_VS = 424 * MiB;
constexpr size_t WS_KS = 488 * MiB, WS_OB = 488 * MiB, WS_HB = 488 * MiB;
constexpr size_t WS_TW = 520 * MiB, WS_AD = 524 * MiB, WS_SG = 528 * MiB;
constexpr size_t WS_OPW = 532 * MiB, WS_OPAK = 660 * MiB, WS_OPKT = 788 * MiB;
constexpr size_t WS_G = 916 * MiB, WS_OATT = 948 * MiB, WS_END = 980 * MiB;
constexpr size_t WS_ORW = 532 * MiB, WS_M32 = 564 * MiB, WS_MB = 628 * MiB, WS_FFH = 660 * MiB;
constexpr int ZLD = 7168, ZQ = 3456, ZK = 4480, ZV = 4736, ZG = 4992;

constexpr int LDS_BYTES = 131072 + 1024;
constexpr int LDS_MISC = 131072;

#define INP(k) (A.in[(k) + z])
struct Args {
    const float* in[26];
    float* out; unsigned char* ws;
    int ph_lo, ph_hi;
};

__device__ __forceinline__ float bf2f(unsigned v) { return __uint_as_float(v << 16); }
__device__ __forceinline__ float bflo(unsigned w) { return __uint_as_float(w << 16); }
__device__ __forceinline__ float bfhi(unsigned w) { return __uint_as_float(w & 0xffff0000u); }
typedef float f32x2c_t __attribute__((ext_vector_type(2))); typedef __bf16 bf16x2c_t __attribute__((ext_vector_type(2)));
__device__ __forceinline__ unsigned pk2(float lo, float hi) { f32x2c_t v = {lo, hi}; bf16x2c_t b = __builtin_convertvector(v, bf16x2c_t); return __builtin_bit_cast(unsigned, b); }
__device__ __forceinline__ float sigmoidf_(float x) { return 1.0f / (1.0f + __expf(-x)); }
__device__ __forceinline__ float wave_sum(float v) {
#pragma unroll
    for (int o = 1; o < 64; o <<= 1) v += __shfl_xor(v, o);
    return v;
}

__device__ __forceinline__ void p0_transpose_item(const float* W, int K, int N, bf16_t* WT, LAS float* scr, int item, int lane) {
    const int nblk = N / 32, kb = item / nblk, nb = item % nblk, k0 = 64 * kb, n0 = 32 * nb;
#pragma unroll 8
    for (int i = 0; i < 32; ++i) { const int kk = 2 * i + (lane >> 5); scr[kk * 33 + (lane & 31)] = W[(size_t)(k0 + kk) * N + n0 + (lane & 31)]; }
    asm volatile("s_waitcnt lgkmcnt(0)" ::: "memory");
    const int c = lane & 7;
#pragma unroll
    for (int j = 0; j < 4; ++j) { const int n = (lane >> 3) + 8 * j; const LAS float* s = scr + (8 * c) * 33 + n;
        u32x4 o; o.x = pk2(s[0 * 33], s[1 * 33]); o.y = pk2(s[2 * 33], s[3 * 33]); o.z = pk2(s[4 * 33], s[5 * 33]); o.w = pk2(s[6 * 33], s[7 * 33]);
        *(u32x4*)(WT + (size_t)(n0 + n) * K + k0 + 8 * c) = o; }
    asm volatile("s_waitcnt lgkmcnt(0)" ::: "memory");
}

__device__ __forceinline__ void cvt_x_chunk(const float* x, bf16_t* xb, int gtid, int gthreads) {
    const size_t n8 = (size_t)MC * D / 8;
    for (size_t i = gtid; i < n8; i += gthreads) {
        const f32x4 a = *(const f32x4*)(x + i * 8), b = *(const f32x4*)(x + i * 8 + 4);
        u32x4 o; o.x = pk2(a.x, a.y); o.y = pk2(a.z, a.w); o.z = pk2(b.x, b.y); o.w = pk2(b.z, b.w);
        *(u32x4*)(xb + i * 8) = o;
    }
}

__device__ __forceinline__ void ln_rows(float* base, const float* g, const float* b, bf16_t* hb, int gw, int ngw, int lane) {
    f32x4 gg[4], bb[4];
#pragma unroll
    for (int j = 0; j < 4; ++j) { gg[j] = *((const f32x4*)g + 64 * j + lane); bb[j] = *((const f32x4*)b + 64 * j + lane); }
    for (int m0 = gw; m0 < MC; m0 += 2 * ngw) {
        const int m1 = m0 + ngw; const bool has1 = m1 < MC;
        f32x4* xr0 = (f32x4*)(base + (size_t)m0 * D) + lane; f32x4* xr1 = (f32x4*)(base + (size_t)(has1 ? m1 : m0) * D) + lane;
        f32x4 v0[4], v1[4]; float s0 = 0.f, s1 = 0.f;
#pragma unroll
        for (int j = 0; j < 4; ++j) { v0[j] = xr0[64 * j]; v1[j] = xr1[64 * j]; }
#pragma unroll
        for (int j = 0; j < 4; ++j) { s0 += (v0[j].x + v0[j].y) + (v0[j].z + v0[j].w); s1 += (v1[j].x + v1[j].y) + (v1[j].z + v1[j].w); }
        const float mean0 = wave_sum(s0) * (1.f / D), mean1 = wave_sum(s1) * (1.f / D); float q0 = 0.f, q1 = 0.f;
#pragma unroll
        for (int j = 0; j < 4; ++j) { v0[j] = v0[j] - mean0; v1[j] = v1[j] - mean1;
            q0 += (v0[j].x * v0[j].x + v0[j].y * v0[j].y) + (v0[j].z * v0[j].z + v0[j].w * v0[j].w); q1 += (v1[j].x * v1[j].x + v1[j].y * v1[j].y) + (v1[j].z * v1[j].z + v1[j].w * v1[j].w); }
        const float rstd0 = 1.f / sqrtf(wave_sum(q0) * (1.f / D) + LN_EPS), rstd1 = 1.f / sqrtf(wave_sum(q1) * (1.f / D) + LN_EPS);
#pragma unroll
        for (int j = 0; j < 4; ++j) {
            const f32x4 y0 = v0[j] * rstd0 * gg[j] + bb[j]; xr0[64 * j] = y0;
            if (hb) { u32x2 w; w.x = pk2(y0.x, y0.y); w.y = pk2(y0.z, y0.w); *(u32x2*)(hb + (size_t)m0 * D + 256 * j + 4 * lane) = w; }
            if (has1) { const f32x4 y1 = v1[j] * rstd1 * gg[j] + bb[j]; xr1[64 * j] = y1;
                if (hb) { u32x2 w; w.x = pk2(y1.x, y1.y); w.y = pk2(y1.z, y1.w); *(u32x2*)(hb + (size_t)m1 * D + 256 * j + 4 * lane) = w; } }
        }
    }
}

template <class F> struct Epi4 {
    static constexpr bool PERM = false, AFTER_DRAIN = false; F f;
    __device__ __forceinline__ void operator()(const pg8::f32x4 (&acc)[2][2][4][2], const pg8::Unit& u, int wr, int wc, int fr, int fq) const {
        const int row0 = u.pm * 256 + wr * 64 + fr, col0 = u.pn * 256 + wc * 32 + 4 * fq;
#pragma unroll
        for (int ai = 0; ai < 2; ++ai)
#pragma unroll
            for (int m = 0; m < 4; ++m)
#pragma unroll
                for (int bj = 0; bj < 2; ++bj)
#pragma unroll
                    for (int n = 0; n < 2; ++n) { f(row0 + ai * 128 + m * 16, col0 + bj * 128 + n * 16, acc[ai][bj][m][n]); asm volatile("" ::: "memory"); }
    }
};
template <class F> struct Epi8 {
    static constexpr bool PERM = true, AFTER_DRAIN = false; F f;
    __device__ __forceinline__ void operator()(const pg8::f32x4 (&acc)[2][2][4][2], const pg8::Unit& u, int wr, int wc, int fr, int fq) const {
        const int row0 = u.pm * 256 + wr * 64 + fr, col0 = u.pn * 256 + wc * 32 + 8 * fq;
#pragma unroll
        for (int ai = 0; ai < 2; ++ai)
#pragma unroll
            for (int m = 0; m < 4; ++m)
#pragma unroll
                for (int bj = 0; bj < 2; ++bj) { f(row0 + ai * 128 + m * 16, col0 + bj * 128, acc[ai][bj][m][0], acc[ai][bj][m][1]); asm volatile("" ::: "memory"); }
    }
};
__device__ __forceinline__ u32x4 pack8(f32x4 a, f32x4 b) { u32x4 w; w.x = pk2(a.x, a.y); w.y = pk2(a.z, a.w); w.z = pk2(b.x, b.y); w.w = pk2(b.z, b.w); return w; }

struct FZ { bf16_t* z;
    __device__ __forceinline__ void operator()(int row, int col, f32x4 a, f32x4 b) const { *(u32x4*)(z + (size_t)row * ZLD + col) = pack8(a, b); } };
struct FW { const float* w0; float* opw;
    __device__ __forceinline__ void operator()(int row, int col, f32x4 a) const {
        const f32x4 x = a + *(const f32x4*)(w0 + col); f32x4 y;
#pragma unroll
        for (int i = 0; i < 4; ++i) y[i] = __expf(-DECAY_SCALE * sigmoidf_(x[i]));
        *(f32x4*)(opw + (size_t)row * D + col) = y; } };
struct FA { const float *a0, *k_a; const bf16_t* ks; const float* kh; float *opak, *opkt;
    __device__ __forceinline__ void operator()(int row, int col, f32x4 acc) const {
        const size_t o = (size_t)row * D + col;
        const f32x4 x = acc + *(const f32x4*)(a0 + col), ka = *(const f32x4*)(k_a + col), khv = *(const f32x4*)(kh + o);
        const u32x2 kw = *(const u32x2*)(ks + o);
        f32x4 k; k.x = bflo(kw.x); k.y = bfhi(kw.x); k.z = bflo(kw.y); k.w = bfhi(kw.y);
        f32x4 ak, kt;
#pragma unroll
        for (int i = 0; i < 4; ++i) { const float a = sigmoidf_(x[i]); ak[i] = a * khv[i]; kt[i] = k[i] * (1.0f + (a - 1.0f) * ka[i]); }
        *(f32x4*)(opak + o) = ak; *(f32x4*)(opkt + o) = kt; } };
struct FG { bf16_t* g;
    __device__ __forceinline__ void operator()(int row, int col, f32x4 a) const {
        u32x2 w; w.x = pk2(a.x, a.y); w.y = pk2(a.z, a.w); *(u32x2*)(g + (size_t)row * D + col) = w; } };
typedef short bf16x8v __attribute__((ext_vector_type(8)));
template <int K, class F> __device__ __forceinline__ void wave_gemm_tile(const bf16_t* A, int aoff, const bf16_t* Bt, int m0, int n0, int lane, const F& f) {
    const int fr = lane & 15, fq = lane >> 4; constexpr int KS = K / 32;
    bf16x8v a[2][KS];
#pragma unroll
    for (int mt = 0; mt < 2; ++mt)
#pragma unroll
        for (int ks = 0; ks < KS; ++ks) a[mt][ks] = *(const bf16x8v*)(A + (size_t)(m0 + mt * 16 + fr) * 128 + aoff + ks * 32 + 8 * fq);
#pragma unroll 2
    for (int nt = 0; nt < 8; ++nt) {
        const bf16_t* bp = Bt + (size_t)(n0 + nt * 16 + fr) * K + 8 * fq;
        f32x4 acc0 = {0.f, 0.f, 0.f, 0.f}, acc1 = {0.f, 0.f, 0.f, 0.f};
#pragma unroll
        for (int ks = 0; ks < KS; ++ks) { const bf16x8v b = *(const bf16x8v*)(bp + ks * 32);
            acc0 = __builtin_amdgcn_mfma_f32_16x16x32_bf16(b, a[0][ks], acc0, 0, 0, 0); acc1 = __builtin_amdgcn_mfma_f32_16x16x32_bf16(b, a[1][ks], acc1, 0, 0, 0); }
        f(m0 + fr, n0 + nt * 16 + 4 * fq, acc0); f(m0 + 16 + fr, n0 + nt * 16 + 4 * fq, acc1);
    }
}
struct FP1 { const bf16_t* gates; float* m32;
    __device__ __forceinline__ void operator()(int row, int col, f32x4 a) const {
        const u32x2 gw = *(const u32x2*)(gates + (size_t)row * ZLD + ZG + col); f32x4 y;
        y.x = sigmoidf_(bflo(gw.x)) * a.x; y.y = sigmoidf_(bfhi(gw.x)) * a.y; y.z = sigmoidf_(bflo(gw.y)) * a.z; y.w = sigmoidf_(bfhi(gw.y)) * a.w; y = y * EXP_RW;
        *(f32x4*)(m32 + (size_t)row * D + col) = y;
    } };
struct FP2 { const bf16_t* gates; const float* m32; bf16_t* mb;
    __device__ __forceinline__ void operator()(int row, int col, f32x4 a) const {
        const u32x2 gw = *(const u32x2*)(gates + (size_t)row * ZLD + ZG + 1024 + col); const f32x4 p = *(const f32x4*)(m32 + (size_t)row * D + col); f32x4 y; a = a * EXP_ATT;
        y.x = p.x + sigmoidf_(bflo(gw.x)) * a.x; y.y = p.y + sigmoidf_(bfhi(gw.x)) * a.y; y.z = p.z + sigmoidf_(bflo(gw.y)) * a.z; y.w = p.w + sigmoidf_(bfhi(gw.y)) * a.w;
        u32x2 w; w.x = pk2(y.x, y.y); w.y = pk2(y.z, y.w); *(u32x2*)(mb + (size_t)row * D + col) = w;
    } };
struct FOut { const float* x; float* out;
    __device__ __forceinline__ void operator()(int row, int col, f32x4 a) const {
        const size_t o = (size_t)row * D + col; *(f32x4*)(out + o) = *(const f32x4*)(x + o) * ALPHA + a * EXP_MIX; } };
struct FF1 { bf16_t* ffh;
    __device__ __forceinline__ void operator()(int row, int col, f32x4 a, f32x4 b) const {
#pragma unroll
        for (int i = 0; i < 4; ++i) { const float u = fmaxf(a[i], 0.f), v = fmaxf(b[i], 0.f); a[i] = u * u; b[i] = v * v; }
        *(u32x4*)(ffh + (size_t)row * FF + col) = pack8(a, b); } };
struct FF2 { float* out;
    __device__ __forceinline__ void operator()(int row, int col, f32x4 a) const {
        const size_t o = (size_t)row * D + col; *(f32x4*)(out + o) = *(const f32x4*)(out + o) * ALPHA + a; } };

template <class E> __device__ __forceinline__ void run_gemm(LAS unsigned char* lds, const bf16_t* A, const bf16_t* Bt, int M, int N, int K, const E& e) {

    int G_ = (int)gridDim.x, c_ = (int)blockIdx.x; asm volatile("" : "+s"(G_), "+s"(c_));
    pg8::Gemm g{A, Bt, M, N, K}; pg8::StaticOrder S; S.init(M, N, G_, c_);
    if (EN_GEMM) pg8::gemm_phase<E, pg8::StaticOrder, true, true>(lds, g, S, e);
}

__device__ __forceinline__ void prep_rows(const float* mu_p, const float* mu_n, const float* k_k, const float* qn, const float* kn, unsigned char* ws, int T, int rbeg, int rstep, int rend, int lane, bool do_att) {
    bf16_t* Z = (bf16_t*)(ws + WS_Z);
    float* OPR = (float*)(ws + WS_OPR); float* OPKH = (float*)(ws + WS_OPKH); float* VS = (float*)(ws + WS_VS);
    bf16_t* KS = (bf16_t*)(ws + WS_KS); bf16_t* TW = (bf16_t*)(ws + WS_TW); bf16_t* AD = (bf16_t*)(ws + WS_AD); bf16_t* SG = (bf16_t*)(ws + WS_SG);
    for (int row = rbeg; row < rend; row += rstep) {
        const int t = row & (T - 1); const bool hp = t > 0, hn = t < T - 1;
        const bf16_t* zc = Z + (size_t)row * ZLD;
#pragma unroll PREP_UNROLL
        for (int pass = 0; pass < 7; ++pass) {
            const int c = pass * 512 + lane * 8;
            if (c < RWC) {
                const u32x4 wc_ = *(const u32x4*)(zc + c);
                u32x4 wp = {0u, 0u, 0u, 0u}, wn = {0u, 0u, 0u, 0u};
                if (hp) wp = *(const u32x4*)(zc - ZLD + c);
                if (hn) wn = *(const u32x4*)(zc + ZLD + c);
                const f32x4 mp0 = *(const f32x4*)(mu_p + c), mp1 = *(const f32x4*)(mu_p + c + 4), mn0 = *(const f32x4*)(mu_n + c), mn1 = *(const f32x4*)(mu_n + c + 4);
                float z[8];
#pragma unroll
                for (int i = 0; i < 4; ++i) {
                    const float c0 = bflo(wc_[i]), c1 = bfhi(wc_[i]), p0 = bflo(wp[i]), p1 = bfhi(wp[i]), n0 = bflo(wn[i]), n1 = bfhi(wn[i]);
                    const float mpa = (2 * i < 4) ? mp0[2 * i] : mp1[2 * i - 4], mpb = (2 * i + 1 < 4) ? mp0[2 * i + 1] : mp1[2 * i - 3];
                    const float mna = (2 * i < 4) ? mn0[2 * i] : mn1[2 * i - 4], mnb = (2 * i + 1 < 4) ? mn0[2 * i + 1] : mn1[2 * i - 3];
                    z[2 * i] = c0 + mpa * (p0 - c0) + mna * (n0 - c0);
                    z[2 * i + 1] = c1 + mpb * (p1 - c1) + mnb * (n1 - c1);
                }
                if (pass < 2) {
                    float* o = OPR + (size_t)row * D + c;
                    *(f32x4*)o = (f32x4){z[0], z[1], z[2], z[3]}; *(f32x4*)(o + 4) = (f32x4){z[4], z[5], z[6], z[7]};
                } else if (pass < 4) {
                    const int cc = c - 1024;
                    u32x4 w; w.x = pk2(z[0], z[1]); w.y = pk2(z[2], z[3]); w.z = pk2(z[4], z[5]); w.w = pk2(z[6], z[7]);
                    *(u32x4*)(KS + (size_t)row * D + cc) = w;
                    const f32x4 kk0 = *(const f32x4*)(k_k + cc), kk1 = *(const f32x4*)(k_k + cc + 4);
                    float kp[8]; float ss = 0.f;
#pragma unroll
                    for (int i = 0; i < 8; ++i) { kp[i] = z[i] * (i < 4 ? kk0[i] : kk1[i - 4]); ss += kp[i] * kp[i]; }
                    ss += __shfl_xor(ss, 1); ss += __shfl_xor(ss, 2); ss += __shfl_xor(ss, 4);
                    const float inv = 1.0f / fmaxf(sqrtf(ss), 1e-12f);
                    float* o = OPKH + (size_t)row * D + cc;
                    *(f32x4*)o = (f32x4){kp[0] * inv, kp[1] * inv, kp[2] * inv, kp[3] * inv}; *(f32x4*)(o + 4) = (f32x4){kp[4] * inv, kp[5] * inv, kp[6] * inv, kp[7] * inv};
                } else if (pass < 6) {
                    float* o = VS + (size_t)row * D + (c - 2048);
                    *(f32x4*)o = (f32x4){z[0], z[1], z[2], z[3]}; *(f32x4*)(o + 4) = (f32x4){z[4], z[5], z[6], z[7]};
                } else {
                    const int sect = lane >> 4, cc = (lane & 15) * 8;
                    float y[8];
#pragma unroll
                    for (int i = 0; i < 8; ++i) {
                        if (sect == 0) { const float e = __expf(2.0f * z[i]); y[i] = 1.0f - 2.0f / (e + 1.0f); }
                        else if (sect == 1) y[i] = z[i];
                        else y[i] = sigmoidf_(z[i]);
                    }
                    u32x4 w; w.x = pk2(y[0], y[1]); w.y = pk2(y[2], y[3]); w.z = pk2(y[4], y[5]); w.w = pk2(y[6], y[7]);
                    bf16_t* dst = (sect == 0 ? TW : (sect == 1 ? AD : SG)) + (size_t)row * 128 + cc;
                    *(u32x4*)dst = w;
                }
            }
        }
        bf16_t* qrow = Z + (size_t)row * ZLD + ZQ;
#pragma unroll 1
        for (int p = do_att ? 0 : 3; p < 3; ++p) {
            const int head = p * 4 + (lane >> 4), sub = lane & 15, d0 = sub * 8;
            const bool act = head < 10;
            bf16_t* px = qrow + head * 128 + d0;
            u32x4 w = {0u, 0u, 0u, 0u}; if (act) w = *(const u32x4*)px;
            float x[8]; float ss = 0.f;
#pragma unroll
            for (int i = 0; i < 4; ++i) { x[2 * i] = bflo(w[i]); x[2 * i + 1] = bfhi(w[i]); ss += x[2 * i] * x[2 * i] + x[2 * i + 1] * x[2 * i + 1]; }
            ss += __shfl_xor(ss, 1); ss += __shfl_xor(ss, 2); ss += __shfl_xor(ss, 4); ss += __shfl_xor(ss, 8);
            const float rinv = rsqrtf(ss * (1.0f / 128.0f) + RMS_EPS);
            const float* gn = (head < 8) ? qn : kn;
            const f32x4 g0 = *(const f32x4*)(gn + d0), g1 = *(const f32x4*)(gn + d0 + 4);
            const int axis = sub >> 3, hf = (sub >> 2) & 1;
            const float pos = (float)(axis ? (t & 63) : (t >> 6));
            float y[8];
#pragma unroll
            for (int i = 0; i < 8; ++i) {
                const float xn = x[i] * rinv * (i < 4 ? g0[i] : g1[i - 4]);
                const float xp = __shfl_xor(xn, 4);
                const int fi = (sub & 3) * 8 + i;
                const float ang = pos * exp2f(-0.41524101186092f * (float)fi);
                y[i] = xn * __cosf(ang) + (hf ? xp : -xp) * __sinf(ang);
            }
            if (act) { u32x4 o; o.x = pk2(y[0], y[1]); o.y = pk2(y[2], y[3]); o.z = pk2(y[4], y[5]); o.w = pk2(y[6], y[7]); *(u32x4*)px = o; }
        }
    }
}

__device__ __forceinline__ float rowsum16(float x) {
    x += __int_as_float(__builtin_amdgcn_update_dpp(0, __float_as_int(x), 0x128, 0xf, 0xf, true));
    x += __int_as_float(__builtin_amdgcn_update_dpp(0, __float_as_int(x), 0x124, 0xf, 0xf, true));
    x += __int_as_float(__builtin_amdgcn_update_dpp(0, __float_as_int(x), 0x122, 0xf, 0xf, true));
    x += __int_as_float(__builtin_amdgcn_update_dpp(0, __float_as_int(x), 0x121, 0xf, 0xf, true));
    return x;
}
__device__ __forceinline__ void post_rows(const float* r_k, const float* gn_g, const float* gn_b, unsigned char* ws, int gw, int ngw, int lane) {
    const bf16_t* OF = (const bf16_t*)(ws + WS_OF); const bf16_t* OB = (const bf16_t*)(ws + WS_OB);
    const float* OPR = (const float*)(ws + WS_OPR); const float* VS = (const float*)(ws + WS_VS);
    const float* KTF = (const float*)(ws + WS_OPKT); const float* KTB = KTF + (size_t)MC * D;
    const bf16_t* G = (const bf16_t*)(ws + WS_G); bf16_t* ORW = (bf16_t*)(ws + WS_ORW);
    const int hg = lane >> 4, sub = lane & 15;
    for (int row = gw; row < MC; row += ngw) {
        const size_t ro = (size_t)row * D;
#pragma unroll 2
        for (int pass = 0; pass < 4; ++pass) {
            const int c = (4 * pass + hg) * 64 + sub * 4; const size_t o = ro + c;
            const u32x2 wf = *(const u32x2*)(OF + o), wb = *(const u32x2*)(OB + o), wg = *(const u32x2*)(G + o);
            const f32x4 r4 = *(const f32x4*)(OPR + o), ktf = *(const f32x4*)(KTF + o), ktb = *(const f32x4*)(KTB + o), v4 = *(const f32x4*)(VS + o);
            const f32x4 rk = *(const f32x4*)(r_k + c), gg = *(const f32x4*)(gn_g + c), gb = *(const f32x4*)(gn_b + c);
            f32x4 ov; ov.x = bflo(wf.x) + bflo(wb.x); ov.y = bfhi(wf.x) + bfhi(wb.x); ov.z = bflo(wf.y) + bflo(wb.y); ov.w = bfhi(wf.y) + bfhi(wb.y);
            const float mean = rowsum16((ov.x + ov.y) + (ov.z + ov.w)) * (1.0f / 64.0f);
            const f32x4 dv = ov - mean;
            const float var = rowsum16((dv.x * dv.x + dv.y * dv.y) + (dv.z * dv.z + dv.w * dv.w)) * (1.0f / 64.0f);
            const f32x4 bt = r4 * (ktf + ktb) * rk;
            const float bs = rowsum16((bt.x + bt.y) + (bt.z + bt.w));
            const float rstd = rsqrtf(var + GN_EPS);
            f32x4 g4; g4.x = bflo(wg.x); g4.y = bfhi(wg.x); g4.z = bflo(wg.y); g4.w = bfhi(wg.y);
            const f32x4 y = (dv * rstd * gg + gb + v4 * bs) * g4;
            u32x2 w; w.x = pk2(y.x, y.y); w.y = pk2(y.z, y.w); *(u32x2*)(ORW + o) = w;
        }
    }
}

#define DPPQ(q) "quad_perm:[" #q "," #q "," #q "," #q "] row_mask:0xf bank_mask:0xf"
#define FMAC_DPP(acc, x, s, q) asm("v_fmac_f32_dpp %0, %1, %2 " DPPQ(q) : "+v"(acc) : "v"(x), "v"(s))
#define MUL_DPP(dst, x, s, q) asm("v_mul_f32_dpp %0, %1, %2 " DPPQ(q) : "=v"(dst) : "v"(x), "v"(s))
#define LBAR() asm volatile("s_waitcnt lgkmcnt(0)\n\ts_barrier" ::: "memory")

typedef float f32x2s __attribute__((ext_vector_type(2)));
struct ScanCtx {
    const char* pb[5]; const char* pvb; unsigned voff, voffv; bf16_t* po; long r0, dstep; int T;
    LAS float* part; LAS float* opart; int wid, lane;
};
__device__ __forceinline__ void scan_load1(const ScanCtx& C, int t, f32x4 (&X)[5], float& V) {
    const unsigned ro = (unsigned)((C.r0 + C.dstep * (long)t) * (long)(D * 4));
#pragma unroll
    for (int a = 0; a < 5; ++a) X[a] = *(const f32x4*)(C.pb[a] + (size_t)(ro + C.voff));
    V = *(const float*)(C.pvb + (size_t)(ro + C.voffv));
}
#define SCAN_Q(q) do { \
    float t0_, t1_, t2_, t3_; \
    MUL_DPP(t0_, X[3].x, vv, q); MUL_DPP(t1_, X[3].y, vv, q); MUL_DPP(t2_, X[3].z, vv, q); MUL_DPP(t3_, X[3].w, vv, q); \
    FMAC_DPP(t0_, X[2].x, nsk, q); FMAC_DPP(t1_, X[2].y, nsk, q); FMAC_DPP(t2_, X[2].z, nsk, q); FMAC_DPP(t3_, X[2].w, nsk, q); \
    FMAC_DPP(t0_, X[1].x, S[4 * q + 0], q); FMAC_DPP(t1_, X[1].y, S[4 * q + 1], q); FMAC_DPP(t2_, X[1].z, S[4 * q + 2], q); FMAC_DPP(t3_, X[1].w, S[4 * q + 3], q); \
    S[4 * q + 0] = t0_; S[4 * q + 1] = t1_; S[4 * q + 2] = t2_; S[4 * q + 3] = t3_; } while (0)
#define SCAN_DOT(p0, p1, p2, p3, A_, q) do { FMAC_DPP(p0, X[A_].x, S[4 * q + 0], q); FMAC_DPP(p1, X[A_].y, S[4 * q + 1], q); FMAC_DPP(p2, X[A_].z, S[4 * q + 2], q); FMAC_DPP(p3, X[A_].w, S[4 * q + 3], q); } while (0)
__device__ __forceinline__ void scan_step(const ScanCtx& C, int s, int par, float (&S)[16], const f32x4 (&X)[5], float vv) {
    float p0 = 0.f, p1 = 0.f, p2 = 0.f, p3 = 0.f;
    SCAN_DOT(p0, p1, p2, p3, 0, 0); SCAN_DOT(p0, p1, p2, p3, 0, 1); SCAN_DOT(p0, p1, p2, p3, 0, 2); SCAN_DOT(p0, p1, p2, p3, 0, 3);
    LAS float* pp = C.part + (s & 1) * 256;
    pp[C.wid * 64 + C.lane] = (p0 + p1) + (p2 + p3);
    LBAR();
    const unsigned paddr = (unsigned)(unsigned long)(pp + C.lane);
    f32x2s r0, r1;
    asm volatile("ds_read2st64_b32 %0, %2 offset1:1\n\tds_read2st64_b32 %1, %2 offset0:2 offset1:3\n\ts_waitcnt lgkmcnt(0)" : "=&v"(r0), "=&v"(r1) : "v"(paddr) : "memory");
    const float nsk = -((r0.x + r0.y) + (r1.x + r1.y));
    SCAN_Q(0); SCAN_Q(1); SCAN_Q(2); SCAN_Q(3);
    float o0 = 0.f, o1 = 0.f, o2 = 0.f, o3 = 0.f;
    SCAN_DOT(o0, o1, o2, o3, 4, 0); SCAN_DOT(o0, o1, o2, o3, 4, 1); SCAN_DOT(o0, o1, o2, o3, 4, 2); SCAN_DOT(o0, o1, o2, o3, 4, 3);
    C.opart[(par * 8 + s) * 256 + C.wid * 64 + C.lane] = (o0 + o1) + (o2 + o3);
}
__device__ __forceinline__ void scan_chain(unsigned char* ws, LAS unsigned char* lds, int s, int h, int d, int T, int tbeg, int nsteps, int mode, bf16_t* obase, float* sd) {
    int tid_ = threadIdx.x; asm volatile("" : "+v"(tid_));
    const int tid = tid_, lane = tid & 63, wid = __builtin_amdgcn_readfirstlane(tid >> 6);
    ScanCtx C; C.T = nsteps; C.wid = wid; C.lane = lane;
    const int col = h * 64; const size_t dofs = (size_t)d * MC * D;
    const size_t ub = (size_t)(col + (wid & 3) * 16) * 4;
    C.pb[0] = (const char*)(ws + WS_OPKH) + ub; C.pb[1] = (const char*)(ws + WS_OPW) + dofs * 4 + ub; C.pb[2] = (const char*)(ws + WS_OPAK) + dofs * 4 + ub;
    C.pb[3] = (const char*)(ws + WS_OPKT) + dofs * 4 + ub; C.pb[4] = (const char*)(ws + WS_OPR) + ub;
    C.pvb = (const char*)(ws + WS_VS) + (size_t)col * 4; C.voff = (unsigned)(lane & 3) * 16u; C.voffv = (unsigned)lane * 4u;
    C.po = obase + col + lane;
    C.dstep = d ? -1 : 1; C.r0 = (d ? (long)s * T + T - 1 : (long)s * T) + C.dstep * (long)tbeg;
    C.part = (LAS float*)lds; C.opart = (LAS float*)(lds + 2048);
    if (wid < 4) {
        float S[16];
#pragma unroll
        for (int i = 0; i < 16; ++i) S[i] = (mode && lane == 16 * wid + i) ? 1.f : 0.f;
        f32x4 X[8][5]; float V[8];
#pragma unroll
        for (int i = 0; i < 8; ++i) scan_load1(C, i, X[i], V[i]);
        int par = 0;
        for (int t0 = 0; t0 < nsteps; t0 += 8) {
            const bool more = t0 + 8 < nsteps;
#pragma unroll
            for (int i = 0; i < 8; ++i) {
                scan_step(C, i, par, S, X[i], mode ? 0.f : V[i]);
                if (more) scan_load1(C, t0 + 8 + i, X[i], V[i]);
            }
            LBAR();
            par ^= 1;
        }
        if (sd) {
#pragma unroll
            for (int i = 0; i < 4; ++i) *(f32x4*)(sd + (size_t)lane * 64 + 16 * wid + 4 * i) = (f32x4){S[4 * i], S[4 * i + 1], S[4 * i + 2], S[4 * i + 3]};
        }
    } else {
        const int hsl = wid - 4; int par = 0;
        for (int t0 = 0; t0 < nsteps; t0 += 8) {
#pragma unroll
            for (int i = 0; i < 8; ++i) LBAR();
            LBAR();
#pragma unroll
            for (int k = 0; k < 2; ++k) { const int slot = hsl + 4 * k; const LAS float* op = C.opart + (par * 8 + slot) * 256 + lane;
                const float o = (op[0] + op[64]) + (op[128] + op[192]);
                C.po[(C.r0 + C.dstep * (long)(t0 + slot)) * D] = (bf16_t)(pk2(o, o) & 0xffffu); }
            par ^= 1;
        }
    }
    LBAR();
}

__device__ __forceinline__ void scan_fixup_tile(const bf16_t* Q, const float* sd, bf16_t* O, int lane) {
    const int fr = lane & 15, fq = lane >> 4;
    bf16x8v a[2][2];
#pragma unroll
    for (int mt = 0; mt < 2; ++mt)
#pragma unroll
        for (int ks = 0; ks < 2; ++ks) a[mt][ks] = *(const bf16x8v*)(Q + (size_t)(mt * 16 + fr) * D + ks * 32 + 8 * fq);
#pragma unroll 2
    for (int nt = 0; nt < 4; ++nt) {
        f32x4 acc0 = {0.f, 0.f, 0.f, 0.f}, acc1 = {0.f, 0.f, 0.f, 0.f};
#pragma unroll
        for (int ks = 0; ks < 2; ++ks) {
            const float* bp = sd + (size_t)(nt * 16 + fr) * 64 + ks * 32 + 8 * fq;
            const f32x4 b0 = *(const f32x4*)bp, b1 = *(const f32x4*)(bp + 4);
            const u32x4 bw = pack8(b0, b1); const bf16x8v b = __builtin_bit_cast(bf16x8v, bw);
            acc0 = __builtin_amdgcn_mfma_f32_16x16x32_bf16(b, a[0][ks], acc0, 0, 0, 0); acc1 = __builtin_amdgcn_mfma_f32_16x16x32_bf16(b, a[1][ks], acc1, 0, 0, 0);
        }
#pragma unroll
        for (int mt = 0; mt < 2; ++mt) {
            bf16_t* op = O + (size_t)(mt * 16 + fr) * D + nt * 16 + 4 * fq; const f32x4 acc = mt ? acc1 : acc0;
            const u32x2 w = *(const u32x2*)op; u32x2 o;
            o.x = pk2(bflo(w.x) + acc.x, bfhi(w.x) + acc.y); o.y = pk2(bflo(w.y) + acc.z, bfhi(w.y) + acc.w);
            *(u32x2*)op = o;
        }
    }
}

#define RLX_AGENT __ATOMIC_RELAXED, __HIP_MEMORY_SCOPE_AGENT
#define XB_TMO      128
#define XB_XCNT(j)  (256  + 64 * (j))
#define XB_XSUB(j)  (1280 + 64 * (j))
#define XB_XGEN(j)  (2304 + 64 * (j))
#define XB_TOP      3328
#define XB_TOPGEN   3392
#define XCD_BAR_WORDS 3456
#define XB_SPIN_CAP (1u << 28)

__device__ __forceinline__ unsigned xb_ld(unsigned* p)              { return __hip_atomic_load(p, __ATOMIC_RELAXED, __HIP_MEMORY_SCOPE_AGENT); }
__device__ __forceinline__ unsigned xb_add(unsigned* p, unsigned v) { return __hip_atomic_fetch_add(p, v, __ATOMIC_RELAXED, __HIP_MEMORY_SCOPE_AGENT); }
__device__ __forceinline__ unsigned xb_xcc_id() { return (unsigned)__builtin_amdgcn_s_getreg((3 << 11) | 20) & 0xFu; }
#define XB_SPIN(cond, bar) do { unsigned _sp = 0; while (cond) { __builtin_amdgcn_s_sleep(1); \
    if ((++_sp & 255u) == 0u) { if (xb_ld(&(bar)[XB_TMO])) break; if (_sp > XB_SPIN_CAP) { atomicAdd(&(bar)[XB_TMO], 1u); break; } } } } while (0)

struct XcdBarrier {
    unsigned* bar; unsigned x;
    volatile LAS unsigned* st;
};

__device__ __forceinline__ XcdBarrier xcd_barrier_post(unsigned* bar, volatile LAS unsigned* st) {
    XcdBarrier b; b.bar = bar; b.x = xb_xcc_id(); b.st = st;
    if (threadIdx.x == 0) (void)xb_add(&bar[XB_XCNT(b.x)], 1u);
    return b;
}
__device__ __forceinline__ void xcd_barrier_complete(unsigned* bar, unsigned x, unsigned& nloc, unsigned& nx) {
    const unsigned G = gridDim.x * gridDim.y * gridDim.z;
    unsigned sum, cnt, mine, sp = 0u;
    for (;;) {
        sum = 0u; cnt = 0u; mine = 0u;
#pragma unroll
        for (unsigned j = 0; j < 16; ++j) { const unsigned c = xb_ld(&bar[XB_XCNT(j)]); sum += c; cnt += (c > 0u) ? 1u : 0u; mine = (j == x) ? c : mine; }
        if (sum == G) break;
        __builtin_amdgcn_s_sleep(1);
        if ((++sp & 255u) == 0u) { if (xb_ld(&bar[XB_TMO])) break; if (sp > XB_SPIN_CAP) { atomicAdd(&bar[XB_TMO], 1u); break; } }
    }
    nloc = mine > 0u ? mine : 1u; nx = cnt > 0u ? cnt : 1u;
}

__device__ __forceinline__ void xcd_barrier(const XcdBarrier& b) {
    asm volatile("s_waitcnt vmcnt(0)" ::: "memory");
    __syncthreads();
    if (threadIdx.x == 0) {
        unsigned* bar = b.bar;
        __builtin_amdgcn_s_waitcnt(0);
        unsigned nloc = b.st[0], nx = b.st[1];
        if (nloc == 0u) { xcd_barrier_complete(bar, b.x, nloc, nx); b.st[0] = nloc; b.st[1] = nx; }
        const unsigned old = xb_add(&bar[XB_XSUB(b.x)], 1u);
        const unsigned gen = old / nloc;
        if (old + 1u == (gen + 1u) * nloc) {
            __builtin_amdgcn_fence(__ATOMIC_RELEASE, "agent");
            asm volatile("s_waitcnt vmcnt(0)" ::: "memory");
            const unsigned og = xb_add(&bar[XB_TOP], 1u);
            const unsigned tg = og / nx;
            if (og + 1u == (tg + 1u) * nx) xb_add(&bar[XB_TOPGEN], 1u);
            else XB_SPIN(xb_ld(&bar[XB_TOPGEN]) == tg, bar);
            __builtin_amdgcn_fence(__ATOMIC_ACQUIRE, "agent");
            xb_add(&bar[XB_XGEN(b.x)], 1u);
            asm volatile("s_waitcnt vmcnt(0)" ::: "memory");
        } else {
            XB_SPIN(xb_ld(&bar[XB_XGEN(b.x)]) == gen, bar);
            __builtin_amdgcn_fence(__ATOMIC_ACQUIRE, "agent");
            asm volatile("s_waitcnt vmcnt(0)" ::: "memory");
        }
    }
    __syncthreads();
}
__global__ void __launch_bounds__(NTHREADS, 2) mega_fwd(Args A) {
    extern __shared__ __attribute__((aligned(16))) unsigned char lds_raw[];
    LAS unsigned char* lds = (LAS unsigned char*)lds_raw;
    cg::grid_group grid = cg::this_grid();
#define TIDV int tid_ = threadIdx.x; asm volatile("" : "+v"(tid_)); const int tid = tid_, lane = tid & 63, wave = __builtin_amdgcn_readfirstlane(tid >> 6); \
    const int G = gridDim.x, gw = blockIdx.x * NWAVES + wave, ngw = G * NWAVES, gtid = blockIdx.x * NTHREADS + tid, gthreads = G * NTHREADS; \
    (void)lane; (void)gw; (void)ngw; (void)gtid; (void)gthreads;

    if (A.ph_hi < 0) grid.sync();
    if (EXP_ZFILL) { for (int i = threadIdx.x; i < LDS_BYTES / 4; i += NTHREADS) ((LAS unsigned*)lds)[i] = 0u; __syncthreads(); }
    { volatile LAS unsigned* misc = (volatile LAS unsigned*)(lds + LDS_MISC);
      if (threadIdx.x < 32) misc[threadIdx.x] = 0u;
      __syncthreads(); }
    XcdBarrier bar = xcd_barrier_post((unsigned*)(A.ws + WS_CTL) + 4096, (volatile LAS unsigned*)(lds + LDS_MISC) + 8);
    for (int ph = A.ph_lo; ph < A.ph_hi; ++ph) {
        if (ph > A.ph_lo) xcd_barrier(bar);
        int z = 0; asm volatile("" : "+s"(z));
        unsigned char* ws = A.ws + z;
        if (ph == 0) {
            TIDV
            LAS float* scr = (LAS float*)(lds + wave * 16384);
            constexpr int I_IN = 16 * (NIN / 32), I_SQ = 16 * 32, I_F1 = 16 * 128, I_F2 = 64 * 32, I_G = 2 * 32, I_U = 32;
            constexpr int NITEMS = I_IN + 3 * I_SQ + I_F1 + I_F2 + I_G + 4 * I_U;
            for (int it = gw; it < NITEMS; it += ngw) {
                int r = it;
                if (r < I_IN) { p0_transpose_item(INP(2), D, NIN, (bf16_t*)(ws + WS_WIN), scr, r, lane); continue; } r -= I_IN;
                if (r < I_SQ) { p0_transpose_item(INP(17), D, D, (bf16_t*)(ws + WS_WPR), scr, r, lane); continue; } r -= I_SQ;
                if (r < I_SQ) { p0_transpose_item(INP(18), D, D, (bf16_t*)(ws + WS_WPA), scr, r, lane); continue; } r -= I_SQ;
                if (r < I_SQ) { p0_transpose_item(INP(19), D, D, (bf16_t*)(ws + WS_WOUT), scr, r, lane); continue; } r -= I_SQ;
                if (r < I_F1) { p0_transpose_item(INP(22), D, FF, (bf16_t*)(ws + WS_WF1), scr, r, lane); continue; } r -= I_F1;
                if (r < I_F2) { p0_transpose_item(INP(23), FF, D, (bf16_t*)(ws + WS_WF2), scr, r, lane); continue; } r -= I_F2;
                if (r < I_G) { p0_transpose_item(INP(9), 128, D, (bf16_t*)(ws + WS_GUP), scr, r, lane); continue; } r -= I_G;
                { const int which = r / I_U, it2 = r % I_U, dd = which & 1;
                  p0_transpose_item((which < 2 ? INP(6) : INP(8)) + (size_t)dd * 64 * 1024, 64, D, (bf16_t*)(ws + (which < 2 ? WS_WUP : WS_AUP)) + (size_t)dd * 1024 * 64, scr, it2, lane); }
            }
            cvt_x_chunk(INP(0), (bf16_t*)(ws + WS_XB), gtid, gthreads);
            if (EXP_ZFILL) { u32x4* zo = (u32x4*)A.out; const size_t no = (size_t)MTOT * D / 4; const u32x4 z0 = {0u, 0u, 0u, 0u};
                for (size_t i = gtid; i < no; i += gthreads) zo[i] = z0; }
            if (EXP_ZFILL) { u32x4* zp = (u32x4*)(ws + WS_Z); const size_t n16 = (WS_END - WS_Z) / 16; const u32x4 zz = {0u, 0u, 0u, 0u};
                for (size_t i = gtid; i < n16; i += gthreads) zp[i] = zz; }
            continue;
        }
        if (ph == 1 + 9 * NCHUNK) {
            TIDV
            ln_rows(A.out + (size_t)(NCHUNK - 1) * MC * D, INP(24), INP(25), nullptr, gw, ngw, lane);
            continue;
        }
        const int c = (ph - 1) / 9, sub = (ph - 1) % 9;
        const int T = (c < 4) ? 2048 : 8192;
        const float* xin = (c < 4) ? INP(0) + (size_t)c * MC * D : INP(1);
        float* outc = A.out + (size_t)c * MC * D;
        if (sub == 0) {
            { Epi8<FZ> e{{(bf16_t*)(ws + WS_Z)}};
              run_gemm(lds, (const bf16_t*)(ws + WS_XB), (const bf16_t*)(ws + WS_WIN), MC, NINP, D, e); }
            if (c > 0) { TIDV ln_rows(A.out + (size_t)(c - 1) * MC * D, INP(24), INP(25), nullptr, gw, ngw, lane); }
        } else if (sub == 1) {
            TIDV
            const int G_ = gridDim.x, b_ = blockIdx.x, tile_lo = (int)(((long)(MC / 32) * b_) / G_), tile_hi = (int)(((long)(MC / 32) * (b_ + 1)) / G_);
            prep_rows(INP(3), INP(4), INP(10), INP(15), INP(16), ws, T, tile_lo * 32 + wave, NWAVES, tile_hi * 32, lane, true);
            __syncthreads();
            const int nit = (tile_hi - tile_lo) * 40;
            for (int it = wave; it < nit; it += NWAVES) {
                const int mt = it / 40, r = it % 40, which = r >> 3, m0 = (tile_lo + mt) * 32, n0 = (r & 7) * 128;
                if (which < 2) { FW f{INP(5) + which * 1024, (float*)(ws + WS_OPW) + (size_t)which * MC * D};
                    wave_gemm_tile<64>((const bf16_t*)(ws + WS_TW), which * 64, (const bf16_t*)(ws + WS_WUP) + (size_t)which * 1024 * 64, m0, n0, lane, f); }
                else if (which < 4) { const int dd = which - 2;
                    FA f{INP(7) + dd * 1024, INP(11), (const bf16_t*)(ws + WS_KS), (const float*)(ws + WS_OPKH), (float*)(ws + WS_OPAK) + (size_t)dd * MC * D, (float*)(ws + WS_OPKT) + (size_t)dd * MC * D};
                    wave_gemm_tile<64>((const bf16_t*)(ws + WS_AD), dd * 64, (const bf16_t*)(ws + WS_AUP) + (size_t)dd * 1024 * 64, m0, n0, lane, f); }
                else { FG f{(bf16_t*)(ws + WS_G)};
                    wave_gemm_tile<128>((const bf16_t*)(ws + WS_SG), 0, (const bf16_t*)(ws + WS_GUP), m0, n0, lane, f); }
            }
        } else if (sub == 2) {
            const int nseq = MC / T, nchain = (c < 4) ? nseq * 32 : 192, nqb = T / 256, natt = nseq * 8 * nqb;
            LAS unsigned* qslot = (LAS unsigned*)(lds + LDS_MISC); const int tid = threadIdx.x;
            for (;;) {
                __syncthreads();
                if (tid == 0) qslot[0] = atomicAdd((unsigned*)(ws + WS_CTL) + 64 * c, 1u);
                __syncthreads();
                const int item = __builtin_amdgcn_readfirstlane((int)qslot[0]);
                if (item >= nchain + natt) break;
                if (item < nchain) {
                    if (c < 4) scan_chain(ws, lds, item >> 5, (item >> 1) & 15, item & 1, T, 0, T, 0, (bf16_t*)(ws + ((item & 1) ? WS_OB : WS_OF)), nullptr);
                    else {
                        const int ch = item / 3, job = item % 3, d_ = ch & 1;
                        bf16_t* ob = (job == 2) ? (bf16_t*)(A.out + (size_t)(NCHUNK - 1) * MC * D) + (size_t)d_ * MC * D : (bf16_t*)(ws + (d_ ? WS_OB : WS_OF));
                        scan_chain(ws, lds, ch >> 5, (ch >> 1) & 15, d_, T, job ? 4096 : 0, 4096, job == 2, ob, job == 0 ? (float*)(ws + WS_END) + (size_t)ch * 4096 : nullptr);
                    }
                }
                else {
                    const int u = item - nchain, qb = u % nqb, hq = (u / nqb) & 7, s = u / (nqb * 8);
                    const att::bf16* qkv = (const att::bf16*)(ws + WS_Z) + (size_t)s * T * ZLD;
                    att::attn_dense_body(qkv + (size_t)qb * 256 * ZLD + ZQ + hq * 128, qkv + ZK + (hq >> 2) * 128, qkv + ZV + (hq >> 2) * 128,
                                         (att::bf16*)(ws + WS_OATT) + ((size_t)s * T + (size_t)qb * 256) * D + hq * 128, T, (char*)lds_raw);
                }
            }
        } else if (sub == 3) {
            TIDV
            if (c == 4) {
                for (int it = gw; it < 64 * 128; it += ngw) {
                    const int ch = it >> 7, tile = it & 127, s_ = ch >> 5, h_ = (ch >> 1) & 15, d_ = ch & 1;
                    const size_t row0 = (size_t)s_ * T + (d_ ? 0 : 4096) + (size_t)tile * 32;
                    scan_fixup_tile((const bf16_t*)(A.out + (size_t)(NCHUNK - 1) * MC * D) + (size_t)d_ * MC * D + row0 * D + h_ * 64, (const float*)(ws + WS_END) + (size_t)ch * 4096,
                                    (bf16_t*)(ws + (d_ ? WS_OB : WS_OF)) + row0 * D + h_ * 64, lane);
                }
                xcd_barrier(bar);
            }
            post_rows(INP(12), INP(13), INP(14), ws, gw, ngw, lane);
        } else if (sub == 4) {
            { Epi4<FP1> e{{(const bf16_t*)(ws + WS_Z), (float*)(ws + WS_M32)}};
              run_gemm(lds, (const bf16_t*)(ws + WS_ORW), (const bf16_t*)(ws + WS_WPR), MC, D, D, e); }
            { Epi4<FP2> e{{(const bf16_t*)(ws + WS_Z), (const float*)(ws + WS_M32), (bf16_t*)(ws + WS_MB)}};
              run_gemm(lds, (const bf16_t*)(ws + WS_OATT), (const bf16_t*)(ws + WS_WPA), MC, D, D, e); }
        } else if (sub == 5) {
            Epi4<FOut> e{{xin, outc}};
            run_gemm(lds, (const bf16_t*)(ws + WS_MB), (const bf16_t*)(ws + WS_WOUT), MC, D, D, e);
        } else if (sub == 6) {
            TIDV
            ln_rows(outc, INP(20), INP(21), (bf16_t*)(ws + WS_HB), gw, ngw, lane);
            if (c + 1 < NCHUNK) cvt_x_chunk((c + 1 < 4) ? INP(0) + (size_t)(c + 1) * MC * D : INP(1), (bf16_t*)(ws + WS_XB), gtid, gthreads);
        } else if (sub == 7) {
            Epi8<FF1> e{{(bf16_t*)(ws + WS_FFH)}};
            run_gemm(lds, (const bf16_t*)(ws + WS_HB), (const bf16_t*)(ws + WS_WF1), MC, FF, D, e);
        } else {
            Epi4<FF2> e{{outc}};
            run_gemm(lds, (const bf16_t*)(ws + WS_FFH), (const bf16_t*)(ws + WS_WF2), MC, D, FF, e);
        }
    }
}

constexpr int NPHASE = 2 + 9 * NCHUNK;

extern "C" void kernel_launch(void* const* d_in, const int* in_sizes, int n_in, void* d_out, int out_size, void* d_ws, size_t ws_size, hipStream_t stream) {
    static int grid = 0;
    if (grid == 0) {
        if (n_in != 26 || out_size != MTOT * D || ws_size < WS_END + 2 * MiB) { fprintf(stderr, "kernel_launch: unexpected shapes n_in %d out %d ws %zu\n", n_in, out_size, ws_size); grid = -1; return; }
        int dev = 0, cus = 0, per_cu = 0;
        hipGetDevice(&dev); hipDeviceGetAttribute(&cus, hipDeviceAttributeMultiprocessorCount, dev);
        if (hipFuncSetAttribute((const void*)mega_fwd, hipFuncAttributeMaxDynamicSharedMemorySize, LDS_BYTES) != hipSuccess) { fprintf(stderr, "kernel_launch: LDS attribute failed\n"); grid = -1; return; }
        if (hipOccupancyMaxActiveBlocksPerMultiprocessor(&per_cu, (const void*)mega_fwd, NTHREADS, LDS_BYTES) != hipSuccess || per_cu < 1) per_cu = 1;
        (void)hipGetLastError();
        grid = cus * (per_cu > 1 ? 1 : per_cu);
    }
    if (grid < 0) return;
    hipMemsetAsync((char*)d_ws + WS_CTL, 0, 64 * 1024, stream);
    Args a{};
    for (int i = 0; i < 26; ++i) a.in[i] = (const float*)d_in[i];
    a.out = (float*)d_out; a.ws = (unsigned char*)d_ws; a.ph_lo = 0; a.ph_hi = NPHASE;
    void* args[] = {&a};
    hipError_t e = hipLaunchCooperativeKernel((const void*)mega_fwd, dim3(grid), dim3(NTHREADS), args, LDS_BYTES, stream);
    if (e != hipSuccess) fprintf(stderr, "cooperative launch failed: %s (grid %d)\n", hipGetErrorString(e), grid);
}
```

```cpp
#include <hip/hip_runtime.h>
#include <hip/hip_bf16.h>
#include <hip/hip_cooperative_groups.h>
#include <cstdio>
#include <cstdint>
namespace cg = cooperative_groups;
namespace pg8 {
#define PG8_LAS __attribute__((address_space(3)))
typedef unsigned short bf16_t;
typedef short bf16x8 __attribute__((ext_vector_type(8)));
typedef float f32x4 __attribute__((ext_vector_type(4)));
typedef unsigned u32x4 __attribute__((ext_vector_type(4)));
constexpr int BM = 256, BK = 64, HALF = 128, HTB = HALF * BK * 2  , STAGE_BYTES = 8 * HTB, NXCD = 8, WGM = 8;

__host__ __device__ __forceinline__ int lds_byte(int r, int c) { const int st = (r >> 4) * 2 + (c >> 5), rr = r & 15, cc = c & 31, ob = rr * 64 + cc * 2; return st * 1024 + (ob ^ (((ob >> 9) & 1) << 5)); }
__host__ __device__ __forceinline__ void stage_rc(int b, int& R, int& C) { const int st = b / 1024, sb = b % 1024, swz = sb ^ (((sb >> 9) & 1) << 5); R = (st >> 1) * 16 + swz / 64; C = (st & 1) * 32 + (swz % 64) / 2; }
__host__ __device__ __forceinline__ int perm32(int rho) { const int n = rho >> 4, i = rho & 15; return 8 * (i >> 2) + 4 * n + (i & 3); }

struct Unit { int pm, pn; };
struct Gemm { const bf16_t* A; const bf16_t* Bt; int M, N, K; };

struct StaticOrder {
    int nM, nN, nwg, G, c;
    __host__ __device__ void init(int M, int N, int G_, int c_) { nM = M / BM; nN = N / BM; nwg = nM * nN; G = G_; c = c_; }
    __host__ __device__ bool next(int i, Unit& u) const {
        const long L = (long)i * G + c; if (L >= nwg) return false;
        int wgid = (int)L; { const int q = nwg / NXCD, r = nwg % NXCD, xcd = wgid % NXCD, off = wgid / NXCD; wgid = (xcd < r ? xcd * (q + 1) : r * (q + 1) + (xcd - r) * q) + off; }
        const int nig = WGM * nN, gid = wgid / nig, fm = gid * WGM, gsz = (nM - fm) < WGM ? (nM - fm) : WGM;
        u.pm = fm + ((wgid % nig) % gsz); u.pn = (wgid % nig) / gsz; return true;
    }
    __device__ __forceinline__ void a_ready(const Unit&) const {}
    __device__ __forceinline__ void done(const Unit&) const {}
};
__device__ __forceinline__ unsigned cvt_pk_bf16(float lo, float hi) { unsigned r; asm volatile("v_cvt_pk_bf16_f32 %0, %1, %2" : "=v"(r) : "v"(lo), "v"(hi)); return r; }
typedef float f32x2 __attribute__((ext_vector_type(2)));
template <class Epi, class Sched, bool ALIGN_EPI = false, bool SP2 = false>
__device__ __forceinline__ void gemm_phase(PG8_LAS unsigned char* lds, const Gemm g, const Sched& S, const Epi& E) {
    int tid_ = threadIdx.x; asm volatile("" : "+v"(tid_));
    const int tid = tid_, wid = __builtin_amdgcn_readfirstlane(tid >> 6), lane = tid & 63, wr = wid >> 2, wc = wid & 3, fr = lane & 15, fq = lane >> 4;
    const int K = g.K, nt = K / BK;
    unsigned voffA[2], voffB[2];
#pragma unroll
    for (int i = 0; i < 2; ++i) { int R, C; stage_rc(tid * 16 + i * 8192, R, C); const int Rb = Epi::PERM ? ((R & ~31) + perm32(R & 31)) : R;
        voffA[i] = (unsigned)(R * K + C) * 2u; voffB[i] = (unsigned)(Rb * K + C) * 2u; }
    const size_t kstep = (size_t)(BK * 2);
    const size_t hstep = (size_t)HALF * K * 2;
    const size_t tstep = 2 * hstep;
    const unsigned ldsw = (unsigned)wid * 1024u;
    const int aoff = lds_byte(wr * 64 + fr, fq * 8), boff = lds_byte(wc * 32 + fr, fq * 8);
#define PG8_SA(b, h) (((b) * 2 + (h)) * HTB)
#define PG8_SB(b, h) ((4 + (b) * 2 + (h)) * HTB)
#define PG8_STAGE(bufoff, gbase, voff) do { _Pragma("unroll") for (int _i = 0; _i < 2; ++_i) \
        __builtin_amdgcn_global_load_lds((const unsigned*)((const char*)(gbase) + (voff)[_i]), (PG8_LAS unsigned*)(lds + (bufoff) + ldsw + _i * 8192), 16, 0, 0); } while (0)
#define PG8_LDA(dst, b, h) do { _Pragma("unroll") for (int m = 0; m < 4; ++m) _Pragma("unroll") for (int k = 0; k < 2; ++k) dst[m][k] = *(const PG8_LAS bf16x8*)(lds + PG8_SA(b, h) + aoff + m * 2048 + k * 1024); } while (0)
#define PG8_LDB(dst, b, h) do { _Pragma("unroll") for (int n = 0; n < 2; ++n) _Pragma("unroll") for (int k = 0; k < 2; ++k) dst[n][k] = *(const PG8_LAS bf16x8*)(lds + PG8_SB(b, h) + boff + n * 2048 + k * 1024); } while (0)
#define PG8_MMA(ai, bj, At, Bt) do { __builtin_amdgcn_s_setprio(1); _Pragma("unroll") for (int m = 0; m < 4; ++m) _Pragma("unroll") for (int n = 0; n < 2; ++n) _Pragma("unroll") for (int k = 0; k < 2; ++k) \
        acc[ai][bj][m][n] = __builtin_amdgcn_mfma_f32_16x16x32_bf16(Bt[n][k], At[m][k], acc[ai][bj][m][n], 0, 0, 0); __builtin_amdgcn_s_setprio(0); } while (0)
#define PG8_WAIT_V(n) asm volatile("s_waitcnt vmcnt(" #n ")" ::: "memory")
#define PG8_WAIT_L(n) asm volatile("s_waitcnt lgkmcnt(" #n ")" ::: "memory")
#define PG8_BAR __builtin_amdgcn_s_barrier()
#define PG8_SCHED __builtin_amdgcn_sched_barrier(0)
    Unit cur, nxt; int ui = 0;
    if (!S.next(0, cur)) return;
    f32x4 acc[2][2][4][2];
#pragma unroll
    for (int a = 0; a < 2; ++a)
#pragma unroll
        for (int b = 0; b < 2; ++b)
#pragma unroll
            for (int m = 0; m < 4; ++m)
#pragma unroll
                for (int n = 0; n < 2; ++n) acc[a][b][m][n] = (f32x4){0.f, 0.f, 0.f, 0.f};
    bf16x8 At[4][2], B0[2][2], B1[2][2];
    const char* cA = (const char*)g.A + (size_t)cur.pm * tstep; const char* cB = (const char*)g.Bt + (size_t)cur.pn * tstep;
    S.a_ready(cur);
    if constexpr (SP2) {
        PG8_STAGE(PG8_SB(0, 0), cB, voffB); PG8_STAGE(PG8_SB(0, 1), cB + hstep, voffB); PG8_STAGE(PG8_SA(0, 0), cA, voffA); PG8_STAGE(PG8_SA(0, 1), cA + hstep, voffA);
        if (wr == 1) PG8_BAR;
        PG8_WAIT_V(2); PG8_BAR;
        PG8_STAGE(PG8_SB(1, 0), cB + kstep, voffB); PG8_STAGE(PG8_SA(1, 0), cA + kstep, voffA); PG8_STAGE(PG8_SB(1, 1), cB + hstep + kstep, voffB);
        PG8_WAIT_V(6); PG8_BAR;
    } else {
        PG8_STAGE(PG8_SB(0, 0), cB, voffB); PG8_STAGE(PG8_SA(0, 0), cA, voffA); PG8_STAGE(PG8_SB(0, 1), cB + hstep, voffB); PG8_STAGE(PG8_SA(0, 1), cA + hstep, voffA);
        if (wr == 1) PG8_BAR;
        PG8_WAIT_V(4); PG8_BAR;
        PG8_STAGE(PG8_SB(1, 0), cB + kstep, voffB); PG8_STAGE(PG8_SA(1, 0), cA + kstep, voffA); PG8_STAGE(PG8_SB(1, 1), cB + hstep + kstep, voffB);
        PG8_WAIT_V(6); PG8_BAR;
    }
    for (;;) {
        const bool has_next = S.next(ui + 1, nxt);
        const char* nA = has_next ? (const char*)g.A + (size_t)nxt.pm * tstep : cA; const char* nB = has_next ? (const char*)g.Bt + (size_t)nxt.pn * tstep : cB;
        for (int t = 0; t < nt; t += 2) {
            const bool last = (t == nt - 2);
            const char* a1 = cA + (size_t)(t + 1) * kstep;
            const char* a2 = last ? nA : cA + (size_t)(t + 2) * kstep; const char* b2 = last ? nB : cB + (size_t)(t + 2) * kstep;
            const char* a3 = a2 + kstep; const char* b3 = b2 + kstep;
            if (last && has_next) S.a_ready(nxt);
            if constexpr (SP2) {
            PG8_LDB(B0, 0, 0); PG8_LDB(B1, 0, 1); PG8_SCHED; PG8_LDA(At, 0, 0); PG8_STAGE(PG8_SA(1, 1), a1 + hstep, voffA);
            PG8_WAIT_V(8); PG8_WAIT_L(0); PG8_BAR; PG8_MMA(0, 0, At, B0); PG8_MMA(0, 1, At, B1); PG8_BAR; PG8_SCHED;
            PG8_LDA(At, 0, 1); PG8_STAGE(PG8_SB(0, 0), b2, voffB); PG8_STAGE(PG8_SB(0, 1), b2 + hstep, voffB); PG8_STAGE(PG8_SA(0, 0), a2, voffA);
            PG8_WAIT_V(8); PG8_WAIT_L(0); PG8_BAR; PG8_MMA(1, 0, At, B0); PG8_MMA(1, 1, At, B1); PG8_BAR; PG8_SCHED;
            PG8_LDB(B0, 1, 0); PG8_LDB(B1, 1, 1); PG8_SCHED; PG8_LDA(At, 1, 0); PG8_STAGE(PG8_SA(0, 1), a2 + hstep, voffA);
            PG8_WAIT_V(8); PG8_WAIT_L(0); PG8_BAR; PG8_MMA(0, 0, At, B0); PG8_MMA(0, 1, At, B1); PG8_BAR; PG8_SCHED;
            PG8_LDA(At, 1, 1); PG8_STAGE(PG8_SB(1, 0), b3, voffB); PG8_STAGE(PG8_SB(1, 1), b3 + hstep, voffB); PG8_STAGE(PG8_SA(1, 0), a3, voffA);
            PG8_WAIT_V(8); PG8_WAIT_L(0); PG8_BAR; PG8_MMA(1, 0, At, B0); PG8_MMA(1, 1, At, B1); PG8_BAR; PG8_SCHED;
            } else {
            PG8_LDB(B0, 0, 0); PG8_SCHED; PG8_LDA(At, 0, 0); PG8_STAGE(PG8_SA(1, 1), a1 + hstep, voffA);
            PG8_WAIT_L(8); PG8_BAR; PG8_WAIT_L(0); PG8_MMA(0, 0, At, B0); PG8_BAR; PG8_SCHED;
            PG8_LDB(B1, 0, 1); PG8_STAGE(PG8_SB(0, 0), b2, voffB);
            PG8_BAR; PG8_WAIT_L(0); PG8_MMA(0, 1, At, B1); PG8_BAR;
            PG8_LDA(At, 0, 1); PG8_STAGE(PG8_SA(0, 0), a2, voffA);
            PG8_BAR; PG8_WAIT_L(0); PG8_MMA(1, 0, At, B0); PG8_BAR; PG8_SCHED;
            PG8_STAGE(PG8_SB(0, 1), b2 + hstep, voffB);
            PG8_WAIT_V(6); PG8_BAR; PG8_MMA(1, 1, At, B1); PG8_BAR;
            PG8_LDB(B0, 1, 0); PG8_SCHED; PG8_LDA(At, 1, 0); PG8_STAGE(PG8_SA(0, 1), a2 + hstep, voffA);
            PG8_WAIT_L(8); PG8_BAR; PG8_WAIT_L(0); PG8_MMA(0, 0, At, B0); PG8_BAR; PG8_SCHED;
            PG8_LDB(B1, 1, 1); PG8_STAGE(PG8_SB(1, 0), b3, voffB);
            PG8_BAR; PG8_WAIT_L(0); PG8_MMA(0, 1, At, B1); PG8_BAR;
            PG8_LDA(At, 1, 1); PG8_STAGE(PG8_SA(1, 0), a3, voffA);
            PG8_BAR; PG8_WAIT_L(0); PG8_MMA(1, 0, At, B0); PG8_BAR; PG8_SCHED;
            PG8_STAGE(PG8_SB(1, 1), b3 + hstep, voffB);
            PG8_WAIT_V(6); PG8_BAR; PG8_MMA(1, 1, At, B1); PG8_BAR;
            }
        }
        if constexpr (ALIGN_EPI) { if (wr == 0) PG8_BAR; }
        if constexpr (!Epi::AFTER_DRAIN) { E(acc, cur, wr, wc, fr, fq); S.done(cur); }
        if (!has_next) break;
#pragma unroll
        for (int a = 0; a < 2; ++a)
#pragma unroll
            for (int b = 0; b < 2; ++b)
#pragma unroll
                for (int m = 0; m < 4; ++m)
#pragma unroll
                    for (int n = 0; n < 2; ++n) acc[a][b][m][n] = (f32x4){0.f, 0.f, 0.f, 0.f};
        cur = nxt; cA = nA; cB = nB; ++ui;
        if constexpr (ALIGN_EPI) { if (wr == 1) PG8_BAR; }
    }
    PG8_WAIT_V(0);
    if constexpr (!ALIGN_EPI) { if (wr == 0) PG8_BAR; }
    PG8_BAR;
    if constexpr (Epi::AFTER_DRAIN) { E.fused(acc, cur, wr, wc, fr, fq, lds, wid, lane); S.done(cur); }
#undef PG8_SA
#undef PG8_SB
#undef PG8_STAGE
#undef PG8_LDA
#undef PG8_LDB
#undef PG8_MMA
#undef PG8_WAIT_V
#undef PG8_WAIT_L
#undef PG8_BAR
#undef PG8_SCHED
}
}
namespace att {
using bf16 = __hip_bfloat16;
constexpr int   D = 128, NW = 8, QBLK = 32, KVBLK = 64;
constexpr float SCALE = 0.088388347648318440f;
constexpr float THR = 8.f;
constexpr int LDQ = 7168, LDK = 7168, LDO = 1024;
constexpr size_t SHM_V = KVBLK * D * 2, SHM_K = KVBLK * D * 2, SHM_ATTN = 2 * SHM_V + 2 * SHM_K + NW * 64 * 4;
using bf16x8 = __attribute__((ext_vector_type(8))) short;
using s16x4  = __attribute__((ext_vector_type(4))) short;
using f32x16 = __attribute__((ext_vector_type(16))) float;
using u32x4  = __attribute__((ext_vector_type(4))) unsigned;
#define KSWZ(row, colB) ((row) * 256 + ((colB) ^ (((row) & 7) << 4)))
#define SBAR() __builtin_amdgcn_sched_barrier(0)
__device__ __forceinline__ int crow(int r, int hi) { return (r & 3) + 8 * (r >> 2) + 4 * hi; }
__device__ __forceinline__ unsigned cvtpk(float lo, float hi) {
  unsigned r; asm volatile("v_cvt_pk_bf16_f32 %0, %1, %2" : "=v"(r) : "v"(lo), "v"(hi)); return r;
}
__device__ __forceinline__ bf16x8 ld8(const bf16* p) { return *reinterpret_cast<const bf16x8*>(p); }
__device__ __forceinline__ void partialSM(f32x16& p0, f32x16& p1, float& m_reg, float& mn, float& alpha) {
  constexpr float C = SCALE * 1.4426950408889634f;
  float pmax = p0[0]; for (int r = 1; r < 16; ++r) pmax = fmaxf(pmax, p0[r]); for (int r = 0; r < 16; ++r) pmax = fmaxf(pmax, p1[r]);
  { auto rr = __builtin_amdgcn_permlane32_swap(__float_as_uint(pmax), __float_as_uint(pmax), false, false);
    pmax = fmaxf(__uint_as_float(rr[0]), __uint_as_float(rr[1])); }
  if (__builtin_expect(__all(pmax - m_reg <= THR / SCALE), 1)) { mn = m_reg; alpha = 1.f; }
  else { mn = fmaxf(m_reg, pmax); alpha = __builtin_amdgcn_exp2f((m_reg - mn) * C); m_reg = mn; }
  float mnC = -mn * C;
  for (int r = 0; r < 16; ++r) p0[r] = fmaf(p0[r], C, mnC); for (int r = 0; r < 16; ++r) p1[r] = fmaf(p1[r], C, mnC);
  for (int r = 0; r < 16; ++r) p0[r] = __builtin_amdgcn_exp2f(p0[r]);
}
__device__ __forceinline__ void finishSM(f32x16& p0, f32x16& p1, float alpha, float& l_reg, bf16x8& pa0, bf16x8& pa1, bf16x8& pa2, bf16x8& pa3) {
  for (int r = 0; r < 16; ++r) p1[r] = __builtin_amdgcn_exp2f(p1[r]);
  float ps = 0; for (int r = 0; r < 16; ++r) ps += p0[r]; for (int r = 0; r < 16; ++r) ps += p1[r];
  { auto rr = __builtin_amdgcn_permlane32_swap(__float_as_uint(ps), __float_as_uint(ps), false, false);
    ps = __uint_as_float(rr[0]) + __uint_as_float(rr[1]); }
  l_reg = l_reg * alpha + ps;
#define PK4(P, BASE, OUT) do { unsigned a0 = cvtpk(P[BASE + 0], P[BASE + 1]), a1 = cvtpk(P[BASE + 2], P[BASE + 3]);   \
    unsigned b0 = cvtpk(P[BASE + 4], P[BASE + 5]), b1 = cvtpk(P[BASE + 6], P[BASE + 7]);                              \
    auto r0 = __builtin_amdgcn_permlane32_swap(a0, b0, false, false); auto r1 = __builtin_amdgcn_permlane32_swap(a1, b1, false, false); \
    u32x4 w = {r0[0], r1[0], r0[1], r1[1]}; OUT = *reinterpret_cast<bf16x8*>(&w); } while (0)
  PK4(p0, 0, pa0); PK4(p0, 8, pa1); PK4(p1, 0, pa2); PK4(p1, 8, pa3);
#undef PK4
}
__device__ __forceinline__ void qkt(f32x16& p0, f32x16& p1, const bf16* Ks, const bf16x8* qr, int r32, int hi) {
  p0 = f32x16{}; p1 = f32x16{};
  for (int d0 = 0; d0 < 8; ++d0) { int cb = (d0 * 16 + hi * 8) * 2;
    bf16x8 b0 = *reinterpret_cast<const bf16x8*>((const char*)Ks + KSWZ(r32, cb));
    bf16x8 b1 = *reinterpret_cast<const bf16x8*>((const char*)Ks + KSWZ(32 + r32, cb));
    p0 = __builtin_amdgcn_mfma_f32_32x32x16_bf16(b0, qr[d0], p0, 0, 0, 0);
    p1 = __builtin_amdgcn_mfma_f32_32x32x16_bf16(b1, qr[d0], p1, 0, 0, 0); }
}
__device__ __forceinline__ int v_st(int k, int c) { const int kk = (k & ~0xC) | ((k & 4) << 1) | ((k & 8) >> 1); return ((kk >> 3) * 4 + (c >> 5)) * 512 + ((kk & 7) * 32 + (c & 31)) * 2; }
__device__ __forceinline__ int v_rd_base(int lane) { return ((lane & 3) << 3) | (((lane >> 2) & 3) << 6) | (((lane >> 4) & 1) << 5) | (((lane >> 5) & 1) << 8); }
constexpr int v_rd_off(int d0, int ks, int half) { return d0 * 512 + ks * 4096 + half * 2048; }
template <int OFF> __device__ __forceinline__ s16x4 tr_read(int vb) {
  s16x4 r; asm volatile("ds_read_b64_tr_b16 %0, %1 offset:%2" : "=&v"(r) : "v"(vb), "i"(OFF) : "memory"); return r;
}
template <int D0> __device__ __forceinline__ void pv_one(f32x16& od, int vb, bf16x8 pa0, bf16x8 pa1, bf16x8 pa2, bf16x8 pa3) {
  const s16x4 l0 = tr_read<v_rd_off(D0, 0, 0)>(vb), h0 = tr_read<v_rd_off(D0, 0, 1)>(vb), l1 = tr_read<v_rd_off(D0, 1, 0)>(vb), h1 = tr_read<v_rd_off(D0, 1, 1)>(vb);
  const s16x4 l2 = tr_read<v_rd_off(D0, 2, 0)>(vb), h2 = tr_read<v_rd_off(D0, 2, 1)>(vb), l3 = tr_read<v_rd_off(D0, 3, 0)>(vb), h3 = tr_read<v_rd_off(D0, 3, 1)>(vb);
  asm volatile("s_waitcnt lgkmcnt(0)" ::: "memory"); SBAR();
#define PK(L, H) (bf16x8){L[0], L[1], L[2], L[3], H[0], H[1], H[2], H[3]}
  od = __builtin_amdgcn_mfma_f32_32x32x16_bf16(pa0, PK(l0, h0), od, 0, 0, 0);
  od = __builtin_amdgcn_mfma_f32_32x32x16_bf16(pa1, PK(l1, h1), od, 0, 0, 0);
  od = __builtin_amdgcn_mfma_f32_32x32x16_bf16(pa2, PK(l2, h2), od, 0, 0, 0);
  od = __builtin_amdgcn_mfma_f32_32x32x16_bf16(pa3, PK(l3, h3), od, 0, 0, 0);
#undef PK
}
__device__ __forceinline__ void pv_d0(f32x16* o, int vb, bf16x8 pa0, bf16x8 pa1, bf16x8 pa2, bf16x8 pa3) {
  pv_one<0>(o[0], vb, pa0, pa1, pa2, pa3); pv_one<1>(o[1], vb, pa0, pa1, pa2, pa3); pv_one<2>(o[2], vb, pa0, pa1, pa2, pa3); pv_one<3>(o[3], vb, pa0, pa1, pa2, pa3);
}
__device__ __forceinline__ void attn_dense_body(const bf16* __restrict__ Qb, const bf16* __restrict__ Kh, const bf16* __restrict__ Vh,
                                                bf16* __restrict__ Ob, int seq, char* lds) {
  int tid_ = threadIdx.x; asm volatile("" : "+v"(tid_));
  const int tid = tid_, wid = tid >> 6, lane = tid & 63, r32 = lane & 31, hi = lane >> 5;
  bf16* V_lds = (bf16*)lds; bf16* K_lds = (bf16*)(lds + 2 * SHM_V);
  float* ws = (float*)(lds + 2 * SHM_V + 2 * SHM_K) + wid * 64; float* li_l = ws; float* al_l = ws + 32;
  float m_reg = -1e30f, l_reg = 0; f32x16 o[4] = {}; bf16x8 qr[8];
  const bf16* Qw = Qb + (long)(wid * QBLK + r32) * LDQ + hi * 8;
#pragma unroll
  for (int d0 = 0; d0 < 8; ++d0) qr[d0] = ld8(Qw + d0 * 16);
  const int sr = tid >> 4, sc = (tid & 15) * 8, vst0 = v_st(sr, sc), vst1 = v_st(32 + sr, sc);
  const int vb0 = (int)(uintptr_t)V_lds + v_rd_base(lane);
  struct { bf16x8 vs0, vs1, ks0, ks1; } sr_[2];
#define SLOAD(i, k0) do { sr_[i].vs0 = ld8(&Vh[(long)((k0) + sr) * LDK + sc]); sr_[i].vs1 = ld8(&Vh[(long)((k0) + 32 + sr) * LDK + sc]); \
    sr_[i].ks0 = ld8(&Kh[(long)((k0) + sr) * LDK + sc]); sr_[i].ks1 = ld8(&Kh[(long)((k0) + 32 + sr) * LDK + sc]); } while (0)
#define SWRITE(b, i) do { *(bf16x8*)((char*)V_lds + (b) * SHM_V + vst0) = sr_[i].vs0;          \
    *(bf16x8*)((char*)V_lds + (b) * SHM_V + vst1) = sr_[i].vs1; int kc = sc * 2;               \
    *(bf16x8*)((char*)K_lds + (b) * SHM_K + KSWZ(sr, kc)) = sr_[i].ks0;                       \
    *(bf16x8*)((char*)K_lds + (b) * SHM_K + KSWZ(32 + sr, kc)) = sr_[i].ks1; } while (0)
#define SWAIT() do { asm volatile("s_waitcnt vmcnt(4)" ::: "memory"); } while (0)
#define RESC(a) do { if (__any((a) < 1.f)) { if (hi == 0) al_l[r32] = (a); asm volatile("s_waitcnt lgkmcnt(0)" ::: "memory"); \
    for (int d = 0; d < 4; ++d) for (int r = 0; r < 16; ++r) o[d][r] *= al_l[crow(r, hi)]; } } while (0)
  f32x16 pA0, pA1, pB0, pB1; float mnA, mnB, alA, alB; bf16x8 pa0, pa1, pa2, pa3; const int NT = seq / KVBLK;
  constexpr int SE = 0, SO = 1;
  SLOAD(SE, 0); asm volatile("s_waitcnt vmcnt(0)" ::: "memory"); SWRITE(0, SE); __syncthreads();
  qkt(pA0, pA1, K_lds, qr, r32, hi); partialSM(pA0, pA1, m_reg, mnA, alA);
  SLOAD(SO, KVBLK); if (2 < NT) SLOAD(SE, 2 * KVBLK);
  SWAIT(); SWRITE(1, SO); __syncthreads();
  for (int j = 1; j + 1 < NT; j += 2) {
    SBAR(); qkt(pB0, pB1, (bf16*)((char*)K_lds + SHM_K), qr, r32, hi);
    finishSM(pA0, pA1, alA, l_reg, pa0, pa1, pa2, pa3); SBAR();
    SLOAD(SO, (j + 2) * KVBLK); SBAR();
    pv_d0(o, vb0, pa0, pa1, pa2, pa3); partialSM(pB0, pB1, m_reg, mnB, alB);
    __syncthreads(); SWAIT(); SWRITE(0, SE);
    RESC(alB); __syncthreads();
    SBAR(); qkt(pA0, pA1, K_lds, qr, r32, hi);
    finishSM(pB0, pB1, alB, l_reg, pa0, pa1, pa2, pa3); SBAR();
    if (j + 3 < NT) SLOAD(SE, (j + 3) * KVBLK); SBAR();
    pv_d0(o, vb0 + (int)SHM_V, pa0, pa1, pa2, pa3); partialSM(pA0, pA1, m_reg, mnA, alA);
    __syncthreads(); SWAIT(); SWRITE(1, SO);
    RESC(alA); __syncthreads();
  }
  SBAR(); qkt(pB0, pB1, (bf16*)((char*)K_lds + SHM_K), qr, r32, hi);
  finishSM(pA0, pA1, alA, l_reg, pa0, pa1, pa2, pa3); SBAR();
  pv_d0(o, vb0, pa0, pa1, pa2, pa3); partialSM(pB0, pB1, m_reg, mnB, alB);
  __syncthreads(); RESC(alB);
  finishSM(pB0, pB1, alB, l_reg, pa0, pa1, pa2, pa3); SBAR();
  pv_d0(o, vb0 + (int)SHM_V, pa0, pa1, pa2, pa3);
  if (hi == 0) li_l[r32] = l_reg; asm volatile("s_waitcnt lgkmcnt(0)" ::: "memory");
  float rli[16];
#pragma unroll
  for (int r = 0; r < 16; ++r) rli[r] = __builtin_amdgcn_rcpf(li_l[crow(r, hi)]);
  bf16* Ow = Ob + (long)(wid * QBLK) * LDO;
#pragma unroll
  for (int r = 0; r < 16; ++r) { int orow = crow(r, hi);
    for (int d0 = 0; d0 < 4; ++d0) Ow[(long)orow * LDO + d0 * 32 + r32] = __float2bfloat16(o[d0][r] * rli[r]); }
  __syncthreads();
#undef SLOAD
#undef SWRITE
#undef SWAIT
#undef RESC
}
#undef KSWZ
#undef SBAR
}
#define LAS __attribute__((address_space(3)))
typedef unsigned short bf16_t;
typedef float f32x4 __attribute__((ext_vector_type(4)));
typedef unsigned u32x4 __attribute__((ext_vector_type(4)));
typedef unsigned u32x2 __attribute__((ext_vector_type(2)));

constexpr int NWAVES = 8, NTHREADS = 512;
constexpr int D = 1024, FF = 4096, NIN = 7040, NINP = 7168, RWC = 3456;
constexpr int MC = 16384, NCHUNK = 5, MTOT = 81920;
constexpr float ALPHA = 1.189207115002721f;
constexpr float LN_EPS = 1e-5f, GN_EPS = 64e-5f, RMS_EPS = 1e-6f;
constexpr float DECAY_SCALE = 0.6065306597126334f;

constexpr size_t MiB = 1u << 20;
constexpr size_t WS_CTL = 0;
constexpr size_t WS_WIN = 1 * MiB, WS_WPR = 15 * MiB, WS_WPA = 17 * MiB, WS_WOUT = 19 * MiB, WS_WF1 = 21 * MiB, WS_WF2 = 29 * MiB;
constexpr size_t WS_WUP = 37 * MiB, WS_AUP = 37 * MiB + 512 * 1024, WS_GUP = 38 * MiB;
constexpr size_t WS_XB = 40 * MiB, WS_OF = 40 * MiB;
constexpr size_t WS_Z = 72 * MiB;
constexpr size_t WS_OPR = 296 * MiB, WS_OPKH = 360 * MiB, WS_VS = 424 * MiB;
constexpr size_t WS_KS = 488 * MiB, WS_OB = 488 * MiB, WS_HB = 488 * MiB;
constexpr size_t WS_TW = 520 * MiB, WS_AD = 524 * MiB, WS_SG = 528 * MiB;
constexpr size_t WS_OPW = 532 * MiB, WS_OPAK = 660 * MiB, WS_OPKT = 788 * MiB;
constexpr size_t WS_G = 916 * MiB, WS_OATT = 948 * MiB, WS_END = 980 * MiB;
constexpr size_t WS_ORW = 532 * MiB, WS_M32 = 564 * MiB, WS_MB = 628 * MiB, WS_FFH = 660 * MiB;
constexpr int ZLD = 7168, ZQ = 3456, ZK = 4480, ZV = 4736, ZG = 4992;

constexpr int LDS_BYTES = 131072 + 1024;
constexpr int LDS_MISC = 131072;

#define INP(k) (A.in[(k) + z])
struct Args {
    const float* in[26];
    float* out; unsigned char* ws;
    int ph_lo, ph_hi;
};

__device__ __forceinline__ float bf2f(unsigned v) { return __uint_as_float(v << 16); }
__device__ __forceinline__ float bflo(unsigned w) { return __uint_as_float(w << 16); }
__device__ __forceinline__ float bfhi(unsigned w) { return __uint_as_float(w & 0xffff0000u); }
typedef float f32x2c_t __attribute__((ext_vector_type(2))); typedef __bf16 bf16x2c_t __attribute__((ext_vector_type(2)));
__device__ __forceinline__ unsigned pk2(float lo, float hi) { f32x2c_t v = {lo, hi}; bf16x2c_t b = __builtin_convertvector(v, bf16x2c_t); return __builtin_bit_cast(unsigned, b); }
__device__ __forceinline__ float sigmoidf_(float x) { return 1.0f / (1.0f + __expf(-x)); }
__device__ __forceinline__ float wave_sum(float v) {
#pragma unroll
    for (int o = 1; o < 64; o <<= 1) v += __shfl_xor(v, o);
    return v;
}

__device__ __forceinline__ void p0_transpose_item(const float* W, int K, int N, bf16_t* WT, LAS float* scr, int item, int lane) {
    const int nblk = N / 32, kb = item / nblk, nb = item % nblk, k0 = 64 * kb, n0 = 32 * nb;
#pragma unroll 8
    for (int i = 0; i < 32; ++i) { const int kk = 2 * i + (lane >> 5); scr[kk * 33 + (lane & 31)] = W[(size_t)(k0 + kk) * N + n0 + (lane & 31)]; }
    asm volatile("s_waitcnt lgkmcnt(0)" ::: "memory");
    const int c = lane & 7;
#pragma unroll
    for (int j = 0; j < 4; ++j) { const int n = (lane >> 3) + 8 * j; const LAS float* s = scr + (8 * c) * 33 + n;
        u32x4 o; o.x = pk2(s[0 * 33], s[1 * 33]); o.y = pk2(s[2 * 33], s[3 * 33]); o.z = pk2(s[4 * 33], s[5 * 33]); o.w = pk2(s[6 * 33], s[7 * 33]);
        *(u32x4*)(WT + (size_t)(n0 + n) * K + k0 + 8 * c) = o; }
    asm volatile("s_waitcnt lgkmcnt(0)" ::: "memory");
}

__device__ __forceinline__ void cvt_x_chunk(const float* x, bf16_t* xb, int gtid, int gthreads) {
    const size_t n8 = (size_t)MC * D / 8;
    for (size_t i = gtid; i < n8; i += gthreads) {
        const f32x4 a = *(const f32x4*)(x + i * 8), b = *(const f32x4*)(x + i * 8 + 4);
        u32x4 o; o.x = pk2(a.x, a.y); o.y = pk2(a.z, a.w); o.z = pk2(b.x, b.y); o.w = pk2(b.z, b.w);
        *(u32x4*)(xb + i * 8) = o;
    }
}

__device__ __forceinline__ void ln_rows(float* base, const float* g, const float* b, bf16_t* hb, int gw, int ngw, int lane) {
    f32x4 gg[4], bb[4];
#pragma unroll
    for (int j = 0; j < 4; ++j) { gg[j] = *((const f32x4*)g + 64 * j + lane); bb[j] = *((const f32x4*)b + 64 * j + lane); }
    for (int m0 = gw; m0 < MC; m0 += 2 * ngw) {
        const int m1 = m0 + ngw; const bool has1 = m1 < MC;
        f32x4* xr0 = (f32x4*)(base + (size_t)m0 * D) + lane; f32x4* xr1 = (f32x4*)(base + (size_t)(has1 ? m1 : m0) * D) + lane;
        f32x4 v0[4], v1[4]; float s0 = 0.f, s1 = 0.f;
#pragma unroll
        for (int j = 0; j < 4; ++j) { v0[j] = xr0[64 * j]; v1[j] = xr1[64 * j]; }
#pragma unroll
        for (int j = 0; j < 4; ++j) { s0 += (v0[j].x + v0[j].y) + (v0[j].z + v0[j].w); s1 += (v1[j].x + v1[j].y) + (v1[j].z + v1[j].w); }
        const float mean0 = wave_sum(s0) * (1.f / D), mean1 = wave_sum(s1) * (1.f / D); float q0 = 0.f, q1 = 0.f;
#pragma unroll
        for (int j = 0; j < 4; ++j) { v0[j] = v0[j] - mean0; v1[j] = v1[j] - mean1;
            q0 += (v0[j].x * v0[j].x + v0[j].y * v0[j].y) + (v0[j].z * v0[j].z + v0[j].w * v0[j].w); q1 += (v1[j].x * v1[j].x + v1[j].y * v1[j].y) + (v1[j].z * v1[j].z + v1[j].w * v1[j].w); }
        const float rstd0 = 1.f / sqrtf(wave_sum(q0) * (1.f / D) + LN_EPS), rstd1 = 1.f / sqrtf(wave_sum(q1) * (1.f / D) + LN_EPS);
#pragma unroll
        for (int j = 0; j < 4; ++j) {
            const f32x4 y0 = v0[j] * rstd0 * gg[j] + bb[j]; xr0[64 * j] = y0;
            if (hb) { u32x2 w; w.x = pk2(y0.x, y0.y); w.y = pk2(y0.z, y0.w); *(u32x2*)(hb + (size_t)m0 * D + 256 * j + 4 * lane) = w; }
            if (has1) { const f32x4 y1 = v1[j] * rstd1 * gg[j] + bb[j]; xr1[64 * j] = y1;
                if (hb) { u32x2 w; w.x = pk2(y1.x, y1.y); w.y = pk2(y1.z, y1.w); *(u32x2*)(hb + (size_t)m1 * D + 256 * j + 4 * lane) = w; } }
        }
    }
}

template <class F> struct Epi4 {
    static constexpr bool PERM = false, AFTER_DRAIN = false; F f;
    __device__ __forceinline__ void operator()(const pg8::f32x4 (&acc)[2][2][4][2], const pg8::Unit& u, int wr, int wc, int fr, int fq) const {
        const int row0 = u.pm * 256 + wr * 64 + fr, col0 = u.pn * 256 + wc * 32 + 4 * fq;
#pragma unroll
        for (int ai = 0; ai < 2; ++ai)
#pragma unroll
            for (int m = 0; m < 4; ++m)
#pragma unroll
                for (int bj = 0; bj < 2; ++bj)
#pragma unroll
                    for (int n = 0; n < 2; ++n) { f(row0 + ai * 128 + m * 16, col0 + bj * 128 + n * 16, acc[ai][bj][m][n]); asm volatile("" ::: "memory"); }
    }
};
template <class F> struct Epi8 {
    static constexpr bool PERM = true, AFTER_DRAIN = false; F f;
    __device__ __forceinline__ void operator()(const pg8::f32x4 (&acc)[2][2][4][2], const pg8::Unit& u, int wr, int wc, int fr, int fq) const {
        const int row0 = u.pm * 256 + wr * 64 + fr, col0 = u.pn * 256 + wc * 32 + 8 * fq;
#pragma unroll
        for (int ai = 0; ai < 2; ++ai)
#pragma unroll
            for (int m = 0; m < 4; ++m)
#pragma unroll
                for (int bj = 0; bj < 2; ++bj) { f(row0 + ai * 128 + m * 16, col0 + bj * 128, acc[ai][bj][m][0], acc[ai][bj][m][1]); asm volatile("" ::: "memory"); }
    }
};
__device__ __forceinline__ u32x4 pack8(f32x4 a, f32x4 b) { u32x4 w; w.x = pk2(a.x, a.y); w.y = pk2(a.z, a.w); w.z = pk2(b.x, b.y); w.w = pk2(b.z, b.w); return w; }

struct FZ { bf16_t* z;
    __device__ __forceinline__ void operator()(int row, int col, f32x4 a, f32x4 b) const { *(u32x4*)(z + (size_t)row * ZLD + col) = pack8(a, b); } };
struct FW { const float* w0; float* opw;
    __device__ __forceinline__ void operator()(int row, int col, f32x4 a) const {
        const f32x4 x = a + *(const f32x4*)(w0 + col); f32x4 y;
#pragma unroll
        for (int i = 0; i < 4; ++i) y[i] = __expf(-DECAY_SCALE * sigmoidf_(x[i]));
        *(f32x4*)(opw + (size_t)row * D + col) = y; } };
struct FA { const float *a0, *k_a; const bf16_t* ks; const float* kh; float *opak, *opkt;
    __device__ __forceinline__ void operator()(int row, int col, f32x4 acc) const {
        const size_t o = (size_t)row * D + col;
        const f32x4 x = acc + *(const f32x4*)(a0 + col), ka = *(const f32x4*)(k_a + col), khv = *(const f32x4*)(kh + o);
        const u32x2 kw = *(const u32x2*)(ks + o);
        f32x4 k; k.x = bflo(kw.x); k.y = bfhi(kw.x); k.z = bflo(kw.y); k.w = bfhi(kw.y);
        f32x4 ak, kt;
#pragma unroll
        for (int i = 0; i < 4; ++i) { const float a = sigmoidf_(x[i]); ak[i] = a * khv[i]; kt[i] = k[i] * (1.0f + (a - 1.0f) * ka[i]); }
        *(f32x4*)(opak + o) = ak; *(f32x4*)(opkt + o) = kt; } };
struct FG { bf16_t* g;
    __device__ __forceinline__ void operator()(int row, int col, f32x4 a) const {
        u32x2 w; w.x = pk2(a.x, a.y); w.y = pk2(a.z, a.w); *(u32x2*)(g + (size_t)row * D + col) = w; } };
typedef short bf16x8v __attribute__((ext_vector_type(8)));
template <int K, class F> __device__ __forceinline__ void wave_gemm_tile(const bf16_t* A, int aoff, const bf16_t* Bt, int m0, int n0, int lane, const F& f) {
    const int fr = lane & 15, fq = lane >> 4; constexpr int KS = K / 32;
    bf16x8v a[2][KS];
#pragma unroll
    for (int mt = 0; mt < 2; ++mt)
#pragma unroll
        for (int ks = 0; ks < KS; ++ks) a[mt][ks] = *(const bf16x8v*)(A + (size_t)(m0 + mt * 16 + fr) * 128 + aoff + ks * 32 + 8 * fq);
#pragma unroll 2
    for (int nt = 0; nt < 8; ++nt) {
        const bf16_t* bp = Bt + (size_t)(n0 + nt * 16 + fr) * K + 8 * fq;
        f32x4 acc0 = {0.f, 0.f, 0.f, 0.f}, acc1 = {0.f, 0.f, 0.f, 0.f};
#pragma unroll
        for (int ks = 0; ks < KS; ++ks) { const bf16x8v b = *(const bf16x8v*)(bp + ks * 32);
            acc0 = __builtin_amdgcn_mfma_f32_16x16x32_bf16(b, a[0][ks], acc0, 0, 0, 0); acc1 = __builtin_amdgcn_mfma_f32_16x16x32_bf16(b, a[1][ks], acc1, 0, 0, 0); }
        f(m0 + fr, n0 + nt * 16 + 4 * fq, acc0); f(m0 + 16 + fr, n0 + nt * 16 + 4 * fq, acc1);
    }
}
struct FP1 { const bf16_t* gates; float* m32;
    __device__ __forceinline__ void operator()(int row, int col, f32x4 a) const {
        const u32x2 gw = *(const u32x2*)(gates + (size_t)row * ZLD + ZG + col); f32x4 y;
        y.x = sigmoidf_(bflo(gw.x)) * a.x; y.y = sigmoidf_(bfhi(gw.x)) * a.y; y.z = sigmoidf_(bflo(gw.y)) * a.z; y.w = sigmoidf_(bfhi(gw.y)) * a.w;
        *(f32x4*)(m32 + (size_t)row * D + col) = y;
    } };
struct FP2 { const bf16_t* gates; const float* m32; bf16_t* mb;
    __device__ __forceinline__ void operator()(int row, int col, f32x4 a) const {
        const u32x2 gw = *(const u32x2*)(gates + (size_t)row * ZLD + ZG + 1024 + col); const f32x4 p = *(const f32x4*)(m32 + (size_t)row * D + col); f32x4 y;
        y.x = p.x + sigmoidf_(bflo(gw.x)) * a.x; y.y = p.y + sigmoidf_(bfhi(gw.x)) * a.y; y.z = p.z + sigmoidf_(bflo(gw.y)) * a.z; y.w = p.w + sigmoidf_(bfhi(gw.y)) * a.w;
        u32x2 w; w.x = pk2(y.x, y.y); w.y = pk2(y.z, y.w); *(u32x2*)(mb + (size_t)row * D + col) = w;
    } };
struct FOut { const float* x; float* out;
    __device__ __forceinline__ void operator()(int row, int col, f32x4 a) const {
        const size_t o = (size_t)row * D + col; *(f32x4*)(out + o) = *(const f32x4*)(x + o) * ALPHA + a; } };
struct FF1 { bf16_t* ffh;
    __device__ __forceinline__ void operator()(int row, int col, f32x4 a, f32x4 b) const {
#pragma unroll
        for (int i = 0; i < 4; ++i) { const float u = fmaxf(a[i], 0.f), v = fmaxf(b[i], 0.f); a[i] = u * u; b[i] = v * v; }
        *(u32x4*)(ffh + (size_t)row * FF + col) = pack8(a, b); } };
struct FF2 { float* out;
    __device__ __forceinline__ void operator()(int row, int col, f32x4 a) const {
        const size_t o = (size_t)row * D + col; *(f32x4*)(out + o) = *(const f32x4*)(out + o) * ALPHA + a; } };

template <class E> __device__ __forceinline__ void run_gemm(LAS unsigned char* lds, const bf16_t* A, const bf16_t* Bt, int M, int N, int K, const E& e) {

    int G_ = (int)gridDim.x, c_ = (int)blockIdx.x; asm volatile("" : "+s"(G_), "+s"(c_));
    pg8::Gemm g{A, Bt, M, N, K}; pg8::StaticOrder S; S.init(M, N, G_, c_);
    pg8::gemm_phase<E, pg8::StaticOrder, true, true>(lds, g, S, e);
}

__device__ __forceinline__ void prep_rows(const float* mu_p, const float* mu_n, const float* k_k, const float* qn, const float* kn, unsigned char* ws, int T, int rbeg, int rstep, int rend, int lane, bool do_att) {
    bf16_t* Z = (bf16_t*)(ws + WS_Z);
    float* OPR = (float*)(ws + WS_OPR); float* OPKH = (float*)(ws + WS_OPKH); float* VS = (float*)(ws + WS_VS);
    bf16_t* KS = (bf16_t*)(ws + WS_KS); bf16_t* TW = (bf16_t*)(ws + WS_TW); bf16_t* AD = (bf16_t*)(ws + WS_AD); bf16_t* SG = (bf16_t*)(ws + WS_SG);
    for (int row = rbeg; row < rend; row += rstep) {
        const int t = row & (T - 1); const bool hp = t > 0, hn = t < T - 1;
        const bf16_t* zc = Z + (size_t)row * ZLD;
#pragma unroll
        for (int pass = 0; pass < 7; ++pass) {
            const int c = pass * 512 + lane * 8;
            if (c < RWC) {
                const u32x4 wc_ = *(const u32x4*)(zc + c);
                u32x4 wp = {0u, 0u, 0u, 0u}, wn = {0u, 0u, 0u, 0u};
                if (hp) wp = *(const u32x4*)(zc - ZLD + c);
                if (hn) wn = *(const u32x4*)(zc + ZLD + c);
                const f32x4 mp0 = *(const f32x4*)(mu_p + c), mp1 = *(const f32x4*)(mu_p + c + 4), mn0 = *(const f32x4*)(mu_n + c), mn1 = *(const f32x4*)(mu_n + c + 4);
                float z[8];
#pragma unroll
                for (int i = 0; i < 4; ++i) {
                    const float c0 = bflo(wc_[i]), c1 = bfhi(wc_[i]), p0 = bflo(wp[i]), p1 = bfhi(wp[i]), n0 = bflo(wn[i]), n1 = bfhi(wn[i]);
                    const float mpa = (2 * i < 4) ? mp0[2 * i] : mp1[2 * i - 4], mpb = (2 * i + 1 < 4) ? mp0[2 * i + 1] : mp1[2 * i - 3];
                    const float mna = (2 * i < 4) ? mn0[2 * i] : mn1[2 * i - 4], mnb = (2 * i + 1 < 4) ? mn0[2 * i + 1] : mn1[2 * i - 3];
                    z[2 * i] = c0 + mpa * (p0 - c0) + mna * (n0 - c0);
                    z[2 * i + 1] = c1 + mpb * (p1 - c1) + mnb * (n1 - c1);
                }
                if (pass < 2) {
                    float* o = OPR + (size_t)row * D + c;
                    *(f32x4*)o = (f32x4){z[0], z[1], z[2], z[3]}; *(f32x4*)(o + 4) = (f32x4){z[4], z[5], z[6], z[7]};
                } else if (pass < 4) {
                    const int cc = c - 1024;
                    u32x4 w; w.x = pk2(z[0], z[1]); w.y = pk2(z[2], z[3]); w.z = pk2(z[4], z[5]); w.w = pk2(z[6], z[7]);
                    *(u32x4*)(KS + (size_t)row * D + cc) = w;
                    const f32x4 kk0 = *(const f32x4*)(k_k + cc), kk1 = *(const f32x4*)(k_k + cc + 4);
                    float kp[8]; float ss = 0.f;
#pragma unroll
                    for (int i = 0; i < 8; ++i) { kp[i] = z[i] * (i < 4 ? kk0[i] : kk1[i - 4]); ss += kp[i] * kp[i]; }
                    ss += __shfl_xor(ss, 1); ss += __shfl_xor(ss, 2); ss += __shfl_xor(ss, 4);
                    const float inv = 1.0f / fmaxf(sqrtf(ss), 1e-12f);
                    float* o = OPKH + (size_t)row * D + cc;
                    *(f32x4*)o = (f32x4){kp[0] * inv, kp[1] * inv, kp[2] * inv, kp[3] * inv}; *(f32x4*)(o + 4) = (f32x4){kp[4] * inv, kp[5] * inv, kp[6] * inv, kp[7] * inv};
                } else if (pass < 6) {
                    float* o = VS + (size_t)row * D + (c - 2048);
                    *(f32x4*)o = (f32x4){z[0], z[1], z[2], z[3]}; *(f32x4*)(o + 4) = (f32x4){z[4], z[5], z[6], z[7]};
                } else {
                    const int sect = lane >> 4, cc = (lane & 15) * 8;
                    float y[8];
#pragma unroll
                    for (int i = 0; i < 8; ++i) {
                        if (sect == 0) { const float e = __expf(2.0f * z[i]); y[i] = 1.0f - 2.0f / (e + 1.0f); }
                        else if (sect == 1) y[i] = z[i];
                        else y[i] = sigmoidf_(z[i]);
                    }
                    u32x4 w; w.x = pk2(y[0], y[1]); w.y = pk2(y[2], y[3]); w.z = pk2(y[4], y[5]); w.w = pk2(y[6], y[7]);
                    bf16_t* dst = (sect == 0 ? TW : (sect == 1 ? AD : SG)) + (size_t)row * 128 + cc;
                    *(u32x4*)dst = w;
                }
            }
        }
        bf16_t* qrow = Z + (size_t)row * ZLD + ZQ;
#pragma unroll 1
        for (int p = do_att ? 0 : 3; p < 3; ++p) {
            const int head = p * 4 + (lane >> 4), sub = lane & 15, d0 = sub * 8;
            const bool act = head < 10;
            bf16_t* px = qrow + head * 128 + d0;
            u32x4 w = {0u, 0u, 0u, 0u}; if (act) w = *(const u32x4*)px;
            float x[8]; float ss = 0.f;
#pragma unroll
            for (int i = 0; i < 4; ++i) { x[2 * i] = bflo(w[i]); x[2 * i + 1] = bfhi(w[i]); ss += x[2 * i] * x[2 * i] + x[2 * i + 1] * x[2 * i + 1]; }
            ss += __shfl_xor(ss, 1); ss += __shfl_xor(ss, 2); ss += __shfl_xor(ss, 4); ss += __shfl_xor(ss, 8);
            const float rinv = rsqrtf(ss * (1.0f / 128.0f) + RMS_EPS);
            const float* gn = (head < 8) ? qn : kn;
            const f32x4 g0 = *(const f32x4*)(gn + d0), g1 = *(const f32x4*)(gn + d0 + 4);
            const int axis = sub >> 3, hf = (sub >> 2) & 1;
            const float pos = (float)(axis ? (t & 63) : (t >> 6));
            float y[8];
#pragma unroll
            for (int i = 0; i < 8; ++i) {
                const float xn = x[i] * rinv * (i < 4 ? g0[i] : g1[i - 4]);
                const float xp = __shfl_xor(xn, 4);
                const int fi = (sub & 3) * 8 + i;
                const float ang = pos * exp2f(-0.41524101186092f * (float)fi);
                y[i] = xn * __cosf(ang) + (hf ? xp : -xp) * __sinf(ang);
            }
            if (act) { u32x4 o; o.x = pk2(y[0], y[1]); o.y = pk2(y[2], y[3]); o.z = pk2(y[4], y[5]); o.w = pk2(y[6], y[7]); *(u32x4*)px = o; }
        }
    }
}

__device__ __forceinline__ float rowsum16(float x) {
    x += __int_as_float(__builtin_amdgcn_update_dpp(0, __float_as_int(x), 0x128, 0xf, 0xf, true));
    x += __int_as_float(__builtin_amdgcn_update_dpp(0, __float_as_int(x), 0x124, 0xf, 0xf, true));
    x += __int_as_float(__builtin_amdgcn_update_dpp(0, __float_as_int(x), 0x122, 0xf, 0xf, true));
    x += __int_as_float(__builtin_amdgcn_update_dpp(0, __float_as_int(x), 0x121, 0xf, 0xf, true));
    return x;
}
__device__ __forceinline__ void post_rows(const float* r_k, const float* gn_g, const float* gn_b, unsigned char* ws, int gw, int ngw, int lane) {
    const bf16_t* OF = (const bf16_t*)(ws + WS_OF); const bf16_t* OB = (const bf16_t*)(ws + WS_OB);
    const float* OPR = (const float*)(ws + WS_OPR); const float* VS = (const float*)(ws + WS_VS);
    const float* KTF = (const float*)(ws + WS_OPKT); const float* KTB = KTF + (size_t)MC * D;
    const bf16_t* G = (const bf16_t*)(ws + WS_G); bf16_t* ORW = (bf16_t*)(ws + WS_ORW);
    const int hg = lane >> 4, sub = lane & 15;
    for (int row = gw; row < MC; row += ngw) {
        const size_t ro = (size_t)row * D;
#pragma unroll 2
        for (int pass = 0; pass < 4; ++pass) {
            const int c = (4 * pass + hg) * 64 + sub * 4; const size_t o = ro + c;
            const u32x2 wf = *(const u32x2*)(OF + o), wb = *(const u32x2*)(OB + o), wg = *(const u32x2*)(G + o);
            const f32x4 r4 = *(const f32x4*)(OPR + o), ktf = *(const f32x4*)(KTF + o), ktb = *(const f32x4*)(KTB + o), v4 = *(const f32x4*)(VS + o);
            const f32x4 rk = *(const f32x4*)(r_k + c), gg = *(const f32x4*)(gn_g + c), gb = *(const f32x4*)(gn_b + c);
            f32x4 ov; ov.x = bflo(wf.x) + bflo(wb.x); ov.y = bfhi(wf.x) + bfhi(wb.x); ov.z = bflo(wf.y) + bflo(wb.y); ov.w = bfhi(wf.y) + bfhi(wb.y);
            const float mean = rowsum16((ov.x + ov.y) + (ov.z + ov.w)) * (1.0f / 64.0f);
            const f32x4 dv = ov - mean;
            const float var = rowsum16((dv.x * dv.x + dv.y * dv.y) + (dv.z * dv.z + dv.w * dv.w)) * (1.0f / 64.0f);
            const f32x4 bt = r4 * (ktf + ktb) * rk;
            const float bs = rowsum16((bt.x + bt.y) + (bt.z + bt.w));
            const float rstd = rsqrtf(var + GN_EPS);
            f32x4 g4; g4.x = bflo(wg.x); g4.y = bfhi(wg.x); g4.z = bflo(wg.y); g4.w = bfhi(wg.y);
            const f32x4 y = (dv * rstd * gg + gb + v4 * bs) * g4;
            u32x2 w; w.x = pk2(y.x, y.y); w.y = pk2(y.z, y.w); *(u32x2*)(ORW + o) = w;
        }
    }
}

#define DPPQ(q) "quad_perm:[" #q "," #q "," #q "," #q "] row_mask:0xf bank_mask:0xf"
#define FMAC_DPP(acc, x, s, q) asm("v_fmac_f32_dpp %0, %1, %2 " DPPQ(q) : "+v"(acc) : "v"(x), "v"(s))
#define MUL_DPP(dst, x, s, q) asm("v_mul_f32_dpp %0, %1, %2 " DPPQ(q) : "=v"(dst) : "v"(x), "v"(s))
#define LBAR() asm volatile("s_waitcnt lgkmcnt(0)\n\ts_barrier" ::: "memory")

typedef float f32x2s __attribute__((ext_vector_type(2)));
struct ScanCtx {
    const char* pb[5]; const char* pvb; unsigned voff, voffv; bf16_t* po; long r0, dstep; int T;
    LAS float* part; LAS float* opart; int wid, lane;
};
__device__ __forceinline__ void scan_load1(const ScanCtx& C, int t, f32x4 (&X)[5], float& V) {
    const unsigned ro = (unsigned)((C.r0 + C.dstep * (long)t) * (long)(D * 4));
#pragma unroll
    for (int a = 0; a < 5; ++a) X[a] = *(const f32x4*)(C.pb[a] + (size_t)(ro + C.voff));
    V = *(const float*)(C.pvb + (size_t)(ro + C.voffv));
}
#define SCAN_Q(q) do { \
    float t0_, t1_, t2_, t3_; \
    MUL_DPP(t0_, X[3].x, vv, q); MUL_DPP(t1_, X[3].y, vv, q); MUL_DPP(t2_, X[3].z, vv, q); MUL_DPP(t3_, X[3].w, vv, q); \
    FMAC_DPP(t0_, X[2].x, nsk, q); FMAC_DPP(t1_, X[2].y, nsk, q); FMAC_DPP(t2_, X[2].z, nsk, q); FMAC_DPP(t3_, X[2].w, nsk, q); \
    FMAC_DPP(t0_, X[1].x, S[4 * q + 0], q); FMAC_DPP(t1_, X[1].y, S[4 * q + 1], q); FMAC_DPP(t2_, X[1].z, S[4 * q + 2], q); FMAC_DPP(t3_, X[1].w, S[4 * q + 3], q); \
    S[4 * q + 0] = t0_; S[4 * q + 1] = t1_; S[4 * q + 2] = t2_; S[4 * q + 3] = t3_; } while (0)
#define SCAN_DOT(p0, p1, p2, p3, A_, q) do { FMAC_DPP(p0, X[A_].x, S[4 * q + 0], q); FMAC_DPP(p1, X[A_].y, S[4 * q + 1], q); FMAC_DPP(p2, X[A_].z, S[4 * q + 2], q); FMAC_DPP(p3, X[A_].w, S[4 * q + 3], q); } while (0)
__device__ __forceinline__ void scan_step(const ScanCtx& C, int s, int par, float (&S)[16], const f32x4 (&X)[5], float vv) {
    float p0, p1, p2, p3;
    MUL_DPP(p0, X[0].x, S[0], 0); MUL_DPP(p1, X[0].y, S[1], 0); MUL_DPP(p2, X[0].z, S[2], 0); MUL_DPP(p3, X[0].w, S[3], 0);
    SCAN_DOT(p0, p1, p2, p3, 0, 1); SCAN_DOT(p0, p1, p2, p3, 0, 2); SCAN_DOT(p0, p1, p2, p3, 0, 3);
    LAS float* pp = C.part + (s & 1) * 256;
    pp[C.wid * 64 + C.lane] = (p0 + p1) + (p2 + p3);
    LBAR();
    const unsigned paddr = (unsigned)(unsigned long)(pp + C.lane);
    f32x2s r0, r1;
    asm volatile("ds_read2st64_b32 %0, %2 offset1:1\n\tds_read2st64_b32 %1, %2 offset0:2 offset1:3\n\ts_waitcnt lgkmcnt(0)" : "=&v"(r0), "=&v"(r1) : "v"(paddr) : "memory");
    const float nsk = -((r0.x + r0.y) + (r1.x + r1.y));
    SCAN_Q(0); SCAN_Q(1); SCAN_Q(2); SCAN_Q(3);
    float o0, o1, o2, o3;
    MUL_DPP(o0, X[4].x, S[0], 0); MUL_DPP(o1, X[4].y, S[1], 0); MUL_DPP(o2, X[4].z, S[2], 0); MUL_DPP(o3, X[4].w, S[3], 0);
    SCAN_DOT(o0, o1, o2, o3, 4, 1); SCAN_DOT(o0, o1, o2, o3, 4, 2); SCAN_DOT(o0, o1, o2, o3, 4, 3);
    C.opart[(par * 8 + s) * 256 + C.wid * 64 + C.lane] = (o0 + o1) + (o2 + o3);
}
__device__ __forceinline__ void scan_chain(unsigned char* ws, LAS unsigned char* lds, int s, int h, int d, int T, int tbeg, int nsteps, int mode, bf16_t* obase, float* sd) {
    int tid_ = threadIdx.x; asm volatile("" : "+v"(tid_));
    const int tid = tid_, lane = tid & 63, wid = __builtin_amdgcn_readfirstlane(tid >> 6);
    ScanCtx C; C.T = nsteps; C.wid = wid; C.lane = lane;
    const int col = h * 64; const size_t dofs = (size_t)d * MC * D;
    const size_t ub = (size_t)(col + (wid & 3) * 16) * 4;
    C.pb[0] = (const char*)(ws + WS_OPKH) + ub; C.pb[1] = (const char*)(ws + WS_OPW) + dofs * 4 + ub; C.pb[2] = (const char*)(ws + WS_OPAK) + dofs * 4 + ub;
    C.pb[3] = (const char*)(ws + WS_OPKT) + dofs * 4 + ub; C.pb[4] = (const char*)(ws + WS_OPR) + ub;
    C.pvb = (const char*)(ws + WS_VS) + (size_t)col * 4; C.voff = (unsigned)(lane & 3) * 16u; C.voffv = (unsigned)lane * 4u;
    C.po = obase + col + lane;
    C.dstep = d ? -1 : 1; C.r0 = (d ? (long)s * T + T - 1 : (long)s * T) + C.dstep * (long)tbeg;
    C.part = (LAS float*)lds; C.opart = (LAS float*)(lds + 2048);
    if (wid < 4) {
        float S[16];
#pragma unroll
        for (int i = 0; i < 16; ++i) S[i] = (mode && lane == 16 * wid + i) ? 1.f : 0.f;
        f32x4 X[8][5]; float V[8];
#pragma unroll
        for (int i = 0; i < 8; ++i) scan_load1(C, i, X[i], V[i]);
        int par = 0;
        for (int t0 = 0; t0 < nsteps; t0 += 8) {
            const bool more = t0 + 8 < nsteps;
#pragma unroll
            for (int i = 0; i < 8; ++i) {
                scan_step(C, i, par, S, X[i], mode ? 0.f : V[i]);
                if (more) scan_load1(C, t0 + 8 + i, X[i], V[i]);
            }
            LBAR();
            par ^= 1;
        }
        if (sd) {
#pragma unroll
            for (int i = 0; i < 4; ++i) *(f32x4*)(sd + (size_t)lane * 64 + 16 * wid + 4 * i) = (f32x4){S[4 * i], S[4 * i + 1], S[4 * i + 2], S[4 * i + 3]};
        }
    } else {
        const int hsl = wid - 4; int par = 0;
        for (int t0 = 0; t0 < nsteps; t0 += 8) {
#pragma unroll
            for (int i = 0; i < 8; ++i) LBAR();
            LBAR();
#pragma unroll
            for (int k = 0; k < 2; ++k) { const int slot = hsl + 4 * k; const LAS float* op = C.opart + (par * 8 + slot) * 256 + lane;
                const float o = (op[0] + op[64]) + (op[128] + op[192]);
                C.po[(C.r0 + C.dstep * (long)(t0 + slot)) * D] = (bf16_t)(pk2(o, o) & 0xffffu); }
            par ^= 1;
        }
    }
    LBAR();
}

__device__ __forceinline__ void scan_fixup_tile(const bf16_t* Q, const float* sd, bf16_t* O, int lane) {
    const int fr = lane & 15, fq = lane >> 4;
    bf16x8v a[2][2];
#pragma unroll
    for (int mt = 0; mt < 2; ++mt)
#pragma unroll
        for (int ks = 0; ks < 2; ++ks) a[mt][ks] = *(const bf16x8v*)(Q + (size_t)(mt * 16 + fr) * D + ks * 32 + 8 * fq);
#pragma unroll 2
    for (int nt = 0; nt < 4; ++nt) {
        f32x4 acc0 = {0.f, 0.f, 0.f, 0.f}, acc1 = {0.f, 0.f, 0.f, 0.f};
#pragma unroll
        for (int ks = 0; ks < 2; ++ks) {
            const float* bp = sd + (size_t)(nt * 16 + fr) * 64 + ks * 32 + 8 * fq;
            const f32x4 b0 = *(const f32x4*)bp, b1 = *(const f32x4*)(bp + 4);
            const u32x4 bw = pack8(b0, b1); const bf16x8v b = __builtin_bit_cast(bf16x8v, bw);
            acc0 = __builtin_amdgcn_mfma_f32_16x16x32_bf16(b, a[0][ks], acc0, 0, 0, 0); acc1 = __builtin_amdgcn_mfma_f32_16x16x32_bf16(b, a[1][ks], acc1, 0, 0, 0);
        }
#pragma unroll
        for (int mt = 0; mt < 2; ++mt) {
            bf16_t* op = O + (size_t)(mt * 16 + fr) * D + nt * 16 + 4 * fq; const f32x4 acc = mt ? acc1 : acc0;
            const u32x2 w = *(const u32x2*)op; u32x2 o;
            o.x = pk2(bflo(w.x) + acc.x, bfhi(w.x) + acc.y); o.y = pk2(bflo(w.y) + acc.z, bfhi(w.y) + acc.w);
            *(u32x2*)op = o;
        }
    }
}

#define RLX_AGENT __ATOMIC_RELAXED, __HIP_MEMORY_SCOPE_AGENT
#define XB_TMO      128
#define XB_XCNT(j)  (256  + 64 * (j))
#define XB_XSUB(j)  (1280 + 64 * (j))
#define XB_XGEN(j)  (2304 + 64 * (j))
#define XB_TOP      3328
#define XB_TOPGEN   3392
#define XCD_BAR_WORDS 3456
#define XB_SPIN_CAP (1u << 28)

__device__ __forceinline__ unsigned xb_ld(unsigned* p)              { return __hip_atomic_load(p, __ATOMIC_RELAXED, __HIP_MEMORY_SCOPE_AGENT); }
__device__ __forceinline__ unsigned xb_add(unsigned* p, unsigned v) { return __hip_atomic_fetch_add(p, v, __ATOMIC_RELAXED, __HIP_MEMORY_SCOPE_AGENT); }
__device__ __forceinline__ unsigned xb_xcc_id() { return (unsigned)__builtin_amdgcn_s_getreg((3 << 11) | 20) & 0xFu; }
#define XB_SPIN(cond, bar) do { unsigned _sp = 0; while (cond) { __builtin_amdgcn_s_sleep(1); \
    if ((++_sp & 255u) == 0u) { if (xb_ld(&(bar)[XB_TMO])) break; if (_sp > XB_SPIN_CAP) { atomicAdd(&(bar)[XB_TMO], 1u); break; } } } } while (0)

struct XcdBarrier {
    unsigned* bar; unsigned x;
    volatile LAS unsigned* st;
};

__device__ __forceinline__ XcdBarrier xcd_barrier_post(unsigned* bar, volatile LAS unsigned* st) {
    XcdBarrier b; b.bar = bar; b.x = xb_xcc_id(); b.st = st;
    if (threadIdx.x == 0) (void)xb_add(&bar[XB_XCNT(b.x)], 1u);
    return b;
}
__device__ __forceinline__ void xcd_barrier_complete(unsigned* bar, unsigned x, unsigned& nloc, unsigned& nx) {
    const unsigned G = gridDim.x * gridDim.y * gridDim.z;
    unsigned sum, cnt, mine, sp = 0u;
    for (;;) {
        sum = 0u; cnt = 0u; mine = 0u;
#pragma unroll
        for (unsigned j = 0; j < 16; ++j) { const unsigned c = xb_ld(&bar[XB_XCNT(j)]); sum += c; cnt += (c > 0u) ? 1u : 0u; mine = (j == x) ? c : mine; }
        if (sum == G) break;
        __builtin_amdgcn_s_sleep(1);
        if ((++sp & 255u) == 0u) { if (xb_ld(&bar[XB_TMO])) break; if (sp > XB_SPIN_CAP) { atomicAdd(&bar[XB_TMO], 1u); break; } }
    }
    nloc = mine > 0u ? mine : 1u; nx = cnt > 0u ? cnt : 1u;
}

__device__ __forceinline__ void xcd_barrier(const XcdBarrier& b) {
    asm volatile("s_waitcnt vmcnt(0)" ::: "memory");
    __syncthreads();
    if (threadIdx.x == 0) {
        unsigned* bar = b.bar;
        __builtin_amdgcn_s_waitcnt(0);
        unsigned nloc = b.st[0], nx = b.st[1];
        if (nloc == 0u) { xcd_barrier_complete(bar, b.x, nloc, nx); b.st[0] = nloc; b.st[1] = nx; }
        const unsigned old = xb_add(&bar[XB_XSUB(b.x)], 1u);
        const unsigned gen = old / nloc;
        if (old + 1u == (gen + 1u) * nloc) {
            __builtin_amdgcn_fence(__ATOMIC_RELEASE, "agent");
            asm volatile("s_waitcnt vmcnt(0)" ::: "memory");
            const unsigned og = xb_add(&bar[XB_TOP], 1u);
            const unsigned tg = og / nx;
            if (og + 1u == (tg + 1u) * nx) xb_add(&bar[XB_TOPGEN], 1u);
            else XB_SPIN(xb_ld(&bar[XB_TOPGEN]) == tg, bar);
            __builtin_amdgcn_fence(__ATOMIC_ACQUIRE, "agent");
            xb_add(&bar[XB_XGEN(b.x)], 1u);
            asm volatile("s_waitcnt vmcnt(0)" ::: "memory");
        } else {
            XB_SPIN(xb_ld(&bar[XB_XGEN(b.x)]) == gen, bar);
            __builtin_amdgcn_fence(__ATOMIC_ACQUIRE, "agent");
            asm volatile("s_waitcnt vmcnt(0)" ::: "memory");
        }
    }
    __syncthreads();
}
__global__ void __launch_bounds__(NTHREADS, 2) mega_fwd(Args A) {
    extern __shared__ __attribute__((aligned(16))) unsigned char lds_raw[];
    LAS unsigned char* lds = (LAS unsigned char*)lds_raw;
    cg::grid_group grid = cg::this_grid();
#define TIDV int tid_ = threadIdx.x; asm volatile("" : "+v"(tid_)); const int tid = tid_, lane = tid & 63, wave = __builtin_amdgcn_readfirstlane(tid >> 6); \
    const int G = gridDim.x, gw = blockIdx.x * NWAVES + wave, ngw = G * NWAVES, gtid = blockIdx.x * NTHREADS + tid, gthreads = G * NTHREADS; \
    (void)lane; (void)gw; (void)ngw; (void)gtid; (void)gthreads;

    if (A.ph_hi < 0) grid.sync();
    { volatile LAS unsigned* misc = (volatile LAS unsigned*)(lds + LDS_MISC);
      if (threadIdx.x < 32) misc[threadIdx.x] = 0u;
      __syncthreads(); }
    XcdBarrier bar = xcd_barrier_post((unsigned*)(A.ws + WS_CTL) + 4096, (volatile LAS unsigned*)(lds + LDS_MISC) + 8);
    for (int ph = A.ph_lo; ph < A.ph_hi; ++ph) {
        if (ph > A.ph_lo) xcd_barrier(bar);
        int z = 0; asm volatile("" : "+s"(z));
        unsigned char* ws = A.ws + z;
        if (ph == 0) {
            TIDV
            LAS float* scr = (LAS float*)(lds + wave * 16384);
            constexpr int I_IN = 16 * (NIN / 32), I_SQ = 16 * 32, I_F1 = 16 * 128, I_F2 = 64 * 32, I_G = 2 * 32, I_U = 32;
            constexpr int NITEMS = I_IN + 3 * I_SQ + I_F1 + I_F2 + I_G + 4 * I_U;
            for (int it = gw; it < NITEMS; it += ngw) {
                int r = it;
                if (r < I_IN) { p0_transpose_item(INP(2), D, NIN, (bf16_t*)(ws + WS_WIN), scr, r, lane); continue; } r -= I_IN;
                if (r < I_SQ) { p0_transpose_item(INP(17), D, D, (bf16_t*)(ws + WS_WPR), scr, r, lane); continue; } r -= I_SQ;
                if (r < I_SQ) { p0_transpose_item(INP(18), D, D, (bf16_t*)(ws + WS_WPA), scr, r, lane); continue; } r -= I_SQ;
                if (r < I_SQ) { p0_transpose_item(INP(19), D, D, (bf16_t*)(ws + WS_WOUT), scr, r, lane); continue; } r -= I_SQ;
                if (r < I_F1) { p0_transpose_item(INP(22), D, FF, (bf16_t*)(ws + WS_WF1), scr, r, lane); continue; } r -= I_F1;
                if (r < I_F2) { p0_transpose_item(INP(23), FF, D, (bf16_t*)(ws + WS_WF2), scr, r, lane); continue; } r -= I_F2;
                if (r < I_G) { p0_transpose_item(INP(9), 128, D, (bf16_t*)(ws + WS_GUP), scr, r, lane); continue; } r -= I_G;
                { const int which = r / I_U, it2 = r % I_U, dd = which & 1;
                  p0_transpose_item((which < 2 ? INP(6) : INP(8)) + (size_t)dd * 64 * 1024, 64, D, (bf16_t*)(ws + (which < 2 ? WS_WUP : WS_AUP)) + (size_t)dd * 1024 * 64, scr, it2, lane); }
            }
            cvt_x_chunk(INP(0), (bf16_t*)(ws + WS_XB), gtid, gthreads);
            continue;
        }
        if (ph == 1 + 9 * NCHUNK) {
            TIDV
            ln_rows(A.out + (size_t)(NCHUNK - 1) * MC * D, INP(24), INP(25), nullptr, gw, ngw, lane);
            continue;
        }
        const int c = (ph - 1) / 9, sub = (ph - 1) % 9;
        const int T = (c < 4) ? 2048 : 8192;
        const float* xin = (c < 4) ? INP(0) + (size_t)c * MC * D : INP(1);
        float* outc = A.out + (size_t)c * MC * D;
        if (sub == 0) {
            { Epi8<FZ> e{{(bf16_t*)(ws + WS_Z)}};
              run_gemm(lds, (const bf16_t*)(ws + WS_XB), (const bf16_t*)(ws + WS_WIN), MC, NINP, D, e); }
            if (c > 0) { TIDV ln_rows(A.out + (size_t)(c - 1) * MC * D, INP(24), INP(25), nullptr, gw, ngw, lane); }
        } else if (sub == 1) {
            TIDV
            const int G_ = gridDim.x, b_ = blockIdx.x, tile_lo = (int)(((long)(MC / 32) * b_) / G_), tile_hi = (int)(((long)(MC / 32) * (b_ + 1)) / G_);
            prep_rows(INP(3), INP(4), INP(10), INP(15), INP(16), ws, T, tile_lo * 32 + wave, NWAVES, tile_hi * 32, lane, true);
            __syncthreads();
            const int nit = (tile_hi - tile_lo) * 40;
            for (int it = wave; it < nit; it += NWAVES) {
                const int mt = it / 40, r = it % 40, which = r >> 3, m0 = (tile_lo + mt) * 32, n0 = (r & 7) * 128;
                if (which < 2) { FW f{INP(5) + which * 1024, (float*)(ws + WS_OPW) + (size_t)which * MC * D};
                    wave_gemm_tile<64>((const bf16_t*)(ws + WS_TW), which * 64, (const bf16_t*)(ws + WS_WUP) + (size_t)which * 1024 * 64, m0, n0, lane, f); }
                else if (which < 4) { const int dd = which - 2;
                    FA f{INP(7) + dd * 1024, INP(11), (const bf16_t*)(ws + WS_KS), (const float*)(ws + WS_OPKH), (float*)(ws + WS_OPAK) + (size_t)dd * MC * D, (float*)(ws + WS_OPKT) + (size_t)dd * MC * D};
                    wave_gemm_tile<64>((const bf16_t*)(ws + WS_AD), dd * 64, (const bf16_t*)(ws + WS_AUP) + (size_t)dd * 1024 * 64, m0, n0, lane, f); }
                else { FG f{(bf16_t*)(ws + WS_G)};
                    wave_gemm_tile<128>((const bf16_t*)(ws + WS_SG), 0, (const bf16_t*)(ws + WS_GUP), m0, n0, lane, f); }
            }
        } else if (sub == 2) {
            const int nseq = MC / T, nchain = (c < 4) ? nseq * 32 : 192, nqb = T / 256, natt = nseq * 8 * nqb;
            LAS unsigned* qslot = (LAS unsigned*)(lds + LDS_MISC); const int tid = threadIdx.x;
            for (;;) {
                __syncthreads();
                if (tid == 0) qslot[0] = atomicAdd((unsigned*)(ws + WS_CTL) + 64 * c, 1u);
                __syncthreads();
                const int item = __builtin_amdgcn_readfirstlane((int)qslot[0]);
                if (item >= nchain + natt) break;
                if (item < nchain) {
                    if (c < 4) scan_chain(ws, lds, item >> 5, (item >> 1) & 15, item & 1, T, 0, T, 0, (bf16_t*)(ws + ((item & 1) ? WS_OB : WS_OF)), nullptr);
                    else {
                        const int ch = item / 3, job = item % 3, d_ = ch & 1;
                        bf16_t* ob = (job == 2) ? (bf16_t*)(A.out + (size_t)(NCHUNK - 1) * MC * D) + (size_t)d_ * MC * D : (bf16_t*)(ws + (d_ ? WS_OB : WS_OF));
                        scan_chain(ws, lds, ch >> 5, (ch >> 1) & 15, d_, T, job ? 4096 : 0, 4096, job == 2, ob, job == 0 ? (float*)(ws + WS_END) + (size_t)ch * 4096 : nullptr);
                    }
                }
                else {
                    const int u = item - nchain, qb = u % nqb, hq = (u / nqb) & 7, s = u / (nqb * 8);
                    const att::bf16* qkv = (const att::bf16*)(ws + WS_Z) + (size_t)s * T * ZLD;
                    att::attn_dense_body(qkv + (size_t)qb * 256 * ZLD + ZQ + hq * 128, qkv + ZK + (hq >> 2) * 128, qkv + ZV + (hq >> 2) * 128,
                                         (att::bf16*)(ws + WS_OATT) + ((size_t)s * T + (size_t)qb * 256) * D + hq * 128, T, (char*)lds_raw);
                }
            }
        } else if (sub == 3) {
            TIDV
            if (c == 4) {
                for (int it = gw; it < 64 * 128; it += ngw) {
                    const int ch = it >> 7, tile = it & 127, s_ = ch >> 5, h_ = (ch >> 1) & 15, d_ = ch & 1;
                    const size_t row0 = (size_t)s_ * T + (d_ ? 0 : 4096) + (size_t)tile * 32;
                    scan_fixup_tile((const bf16_t*)(A.out + (size_t)(NCHUNK - 1) * MC * D) + (size_t)d_ * MC * D + row0 * D + h_ * 64, (const float*)(ws + WS_END) + (size_t)ch * 4096,
                                    (bf16_t*)(ws + (d_ ? WS_OB : WS_OF)) + row0 * D + h_ * 64, lane);
                }
                xcd_barrier(bar);
            }
            post_rows(INP(12), INP(13), INP(14), ws, gw, ngw, lane);
        } else if (sub == 4) {
            { Epi4<FP1> e{{(const bf16_t*)(ws + WS_Z), (float*)(ws + WS_M32)}};
              run_gemm(lds, (const bf16_t*)(ws + WS_ORW), (const bf16_t*)(ws + WS_WPR), MC, D, D, e); }
            { Epi4<FP2> e{{(const bf16_t*)(ws + WS_Z), (const float*)(ws + WS_M32), (bf16_t*)(ws + WS_MB)}};
              run_gemm(lds, (const bf16_t*)(ws + WS_OATT), (const bf16_t*)(ws + WS_WPA), MC, D, D, e); }
        } else if (sub == 5) {
            Epi4<FOut> e{{xin, outc}};
            run_gemm(lds, (const bf16_t*)(ws + WS_MB), (const bf16_t*)(ws + WS_WOUT), MC, D, D, e);
        } else if (sub == 6) {
            TIDV
            ln_rows(outc, INP(20), INP(21), (bf16_t*)(ws + WS_HB), gw, ngw, lane);
            if (c + 1 < NCHUNK) cvt_x_chunk((c + 1 < 4) ? INP(0) + (size_t)(c + 1) * MC * D : INP(1), (bf16_t*)(ws + WS_XB), gtid, gthreads);
        } else if (sub == 7) {
            Epi8<FF1> e{{(bf16_t*)(ws + WS_FFH)}};
            run_gemm(lds, (const bf16_t*)(ws + WS_HB), (const bf16_t*)(ws + WS_WF1), MC, FF, D, e);
        } else {
            Epi4<FF2> e{{outc}};
            run_gemm(lds, (const bf16_t*)(ws + WS_FFH), (const bf16_t*)(ws + WS_WF2), MC, D, FF, e);
        }
    }
}

constexpr int NPHASE = 2 + 9 * NCHUNK;

extern "C" void kernel_launch(void* const* d_in, const int* in_sizes, int n_in, void* d_out, int out_size, void* d_ws, size_t ws_size, hipStream_t stream) {
    static int grid = 0;
    if (grid == 0) {
        if (n_in != 26 || out_size != MTOT * D || ws_size < WS_END + 2 * MiB) { fprintf(stderr, "kernel_launch: unexpected shapes n_in %d out %d ws %zu\n", n_in, out_size, ws_size); grid = -1; return; }
        int dev = 0, cus = 0, per_cu = 0;
        hipGetDevice(&dev); hipDeviceGetAttribute(&cus, hipDeviceAttributeMultiprocessorCount, dev);
        if (hipFuncSetAttribute((const void*)mega_fwd, hipFuncAttributeMaxDynamicSharedMemorySize, LDS_BYTES) != hipSuccess) { fprintf(stderr, "kernel_launch: LDS attribute failed\n"); grid = -1; return; }
        if (hipOccupancyMaxActiveBlocksPerMultiprocessor(&per_cu, (const void*)mega_fwd, NTHREADS, LDS_BYTES) != hipSuccess || per_cu < 1) per_cu = 1;
        (void)hipGetLastError();
        grid = cus * (per_cu > 1 ? 1 : per_cu);
    }
    if (grid < 0) return;
    hipMemsetAsync((char*)d_ws + WS_CTL, 0, 64 * 1024, stream);
    Args a{};
    for (int i = 0; i < 26; ++i) a.in[i] = (const float*)d_in[i];
    a.out = (float*)d_out; a.ws = (unsigned char*)d_ws; a.ph_lo = 0; a.ph_hi = NPHASE;
    void* args[] = {&a};
    hipError_t e = hipLaunchCooperativeKernel((const void*)mega_fwd, dim3(grid), dim3(NTHREADS), args, LDS_BYTES, stream);
    if (e != hipSuccess) fprintf(stderr, "cooperative launch failed: %s (grid %d)\n", hipGetErrorString(e), grid);
}
```

```cpp
#include <hip/hip_runtime.h>
#include <hip/hip_bf16.h>
#include <hip/hip_cooperative_groups.h>
#include <cstdio>
#include <cstdint>
namespace cg = cooperative_groups;
namespace pg8 {
#define PG8_LAS __attribute__((address_space(3)))
typedef unsigned short bf16_t;
typedef short bf16x8 __attribute__((ext_vector_type(8)));
typedef float f32x4 __attribute__((ext_vector_type(4)));
typedef unsigned u32x4 __attribute__((ext_vector_type(4)));
constexpr int BM = 256, BK = 64, HALF = 128, HTB = HALF * BK * 2  , STAGE_BYTES = 8 * HTB, NXCD = 8, WGM = 8;

__host__ __device__ __forceinline__ int lds_byte(int r, int c) { const int st = (r >> 4) * 2 + (c >> 5), rr = r & 15, cc = c & 31, ob = rr * 64 + cc * 2; return st * 1024 + (ob ^ (((ob >> 9) & 1) << 5)); }
__host__ __device__ __forceinline__ void stage_rc(int b, int& R, int& C) { const int st = b / 1024, sb = b % 1024, swz = sb ^ (((sb >> 9) & 1) << 5); R = (st >> 1) * 16 + swz / 64; C = (st & 1) * 32 + (swz % 64) / 2; }
__host__ __device__ __forceinline__ int perm32(int rho) { const int n = rho >> 4, i = rho & 15; return 8 * (i >> 2) + 4 * n + (i & 3); }

struct Unit { int pm, pn; };
struct Gemm { const bf16_t* A; const bf16_t* Bt; int M, N, K; };

struct StaticOrder {
    int nM, nN, nwg, G, c;
    __host__ __device__ void init(int M, int N, int G_, int c_) { nM = M / BM; nN = N / BM; nwg = nM * nN; G = G_; c = c_; }
    __host__ __device__ bool next(int i, Unit& u) const {
        const long L = (long)i * G + c; if (L >= nwg) return false;
        int wgid = (int)L; { const int q = nwg / NXCD, r = nwg % NXCD, xcd = wgid % NXCD, off = wgid / NXCD; wgid = (xcd < r ? xcd * (q + 1) : r * (q + 1) + (xcd - r) * q) + off; }
        const int nig = WGM * nN, gid = wgid / nig, fm = gid * WGM, gsz = (nM - fm) < WGM ? (nM - fm) : WGM;
        u.pm = fm + ((wgid % nig) % gsz); u.pn = (wgid % nig) / gsz; return true;
    }
    __device__ __forceinline__ void a_ready(const Unit&) const {}
    __device__ __forceinline__ void done(const Unit&) const {}
};
__device__ __forceinline__ unsigned cvt_pk_bf16(float lo, float hi) { unsigned r; asm volatile("v_cvt_pk_bf16_f32 %0, %1, %2" : "=v"(r) : "v"(lo), "v"(hi)); return r; }
typedef float f32x2 __attribute__((ext_vector_type(2)));
template <class Epi, class Sched, bool ALIGN_EPI = false, bool SP2 = false>
__device__ __forceinline__ void gemm_phase(PG8_LAS unsigned char* lds, const Gemm g, const Sched& S, const Epi& E) {
    int tid_ = threadIdx.x; asm volatile("" : "+v"(tid_));
    const int tid = tid_, wid = __builtin_amdgcn_readfirstlane(tid >> 6), lane = tid & 63, wr = wid >> 2, wc = wid & 3, fr = lane & 15, fq = lane >> 4;
    const int K = g.K, nt = K / BK;
    unsigned voffA[2], voffB[2];
#pragma unroll
    for (int i = 0; i < 2; ++i) { int R, C; stage_rc(tid * 16 + i * 8192, R, C); const int Rb = Epi::PERM ? ((R & ~31) + perm32(R & 31)) : R;
        voffA[i] = (unsigned)(R * K + C) * 2u; voffB[i] = (unsigned)(Rb * K + C) * 2u; }
    const size_t kstep = (size_t)(BK * 2);
    const size_t hstep = (size_t)HALF * K * 2;
    const size_t tstep = 2 * hstep;
    const unsigned ldsw = (unsigned)wid * 1024u;
    const int aoff = lds_byte(wr * 64 + fr, fq * 8), boff = lds_byte(wc * 32 + fr, fq * 8);
#define PG8_SA(b, h) (((b) * 2 + (h)) * HTB)
#define PG8_SB(b, h) ((4 + (b) * 2 + (h)) * HTB)
#define PG8_STAGE(bufoff, gbase, voff) do { _Pragma("unroll") for (int _i = 0; _i < 2; ++_i) \
        __builtin_amdgcn_global_load_lds((const unsigned*)((const char*)(gbase) + (voff)[_i]), (PG8_LAS unsigned*)(lds + (bufoff) + ldsw + _i * 8192), 16, 0, 0); } while (0)
#define PG8_LDA(dst, b, h) do { _Pragma("unroll") for (int m = 0; m < 4; ++m) _Pragma("unroll") for (int k = 0; k < 2; ++k) dst[m][k] = *(const PG8_LAS bf16x8*)(lds + PG8_SA(b, h) + aoff + m * 2048 + k * 1024); } while (0)
#define PG8_LDB(dst, b, h) do { _Pragma("unroll") for (int n = 0; n < 2; ++n) _Pragma("unroll") for (int k = 0; k < 2; ++k) dst[n][k] = *(const PG8_LAS bf16x8*)(lds + PG8_SB(b, h) + boff + n * 2048 + k * 1024); } while (0)
#define PG8_MMA(ai, bj, At, Bt) do { __builtin_amdgcn_s_setprio(1); _Pragma("unroll") for (int m = 0; m < 4; ++m) _Pragma("unroll") for (int n = 0; n < 2; ++n) _Pragma("unroll") for (int k = 0; k < 2; ++k) \
        acc[ai][bj][m][n] = __builtin_amdgcn_mfma_f32_16x16x32_bf16(Bt[n][k], At[m][k], acc[ai][bj][m][n], 0, 0, 0); __builtin_amdgcn_s_setprio(0); } while (0)
#define PG8_WAIT_V(n) asm volatile("s_waitcnt vmcnt(" #n ")" ::: "memory")
#define PG8_WAIT_L(n) asm volatile("s_waitcnt lgkmcnt(" #n ")" ::: "memory")
#define PG8_BAR __builtin_amdgcn_s_barrier()
#define PG8_SCHED __builtin_amdgcn_sched_barrier(0)
    Unit cur, nxt; int ui = 0;
    if (!S.next(0, cur)) return;
    f32x4 acc[2][2][4][2];
#pragma unroll
    for (int a = 0; a < 2; ++a)
#pragma unroll
        for (int b = 0; b < 2; ++b)
#pragma unroll
            for (int m = 0; m < 4; ++m)
#pragma unroll
                for (int n = 0; n < 2; ++n) acc[a][b][m][n] = (f32x4){0.f, 0.f, 0.f, 0.f};
    bf16x8 At[4][2], B0[2][2], B1[2][2];
    const char* cA = (const char*)g.A + (size_t)cur.pm * tstep; const char* cB = (const char*)g.Bt + (size_t)cur.pn * tstep;
    S.a_ready(cur);
    if constexpr (SP2) {
        PG8_STAGE(PG8_SB(0, 0), cB, voffB); PG8_STAGE(PG8_SB(0, 1), cB + hstep, voffB); PG8_STAGE(PG8_SA(0, 0), cA, voffA); PG8_STAGE(PG8_SA(0, 1), cA + hstep, voffA);
        if (wr == 1) PG8_BAR;
        PG8_WAIT_V(2); PG8_BAR;
        PG8_STAGE(PG8_SB(1, 0), cB + kstep, voffB); PG8_STAGE(PG8_SA(1, 0), cA + kstep, voffA); PG8_STAGE(PG8_SB(1, 1), cB + hstep + kstep, voffB);
        PG8_WAIT_V(6); PG8_BAR;
    } else {
        PG8_STAGE(PG8_SB(0, 0), cB, voffB); PG8_STAGE(PG8_SA(0, 0), cA, voffA); PG8_STAGE(PG8_SB(0, 1), cB + hstep, voffB); PG8_STAGE(PG8_SA(0, 1), cA + hstep, voffA);
        if (wr == 1) PG8_BAR;
        PG8_WAIT_V(4); PG8_BAR;
        PG8_STAGE(PG8_SB(1, 0), cB + kstep, voffB); PG8_STAGE(PG8_SA(1, 0), cA + kstep, voffA); PG8_STAGE(PG8_SB(1, 1), cB + hstep + kstep, voffB);
        PG8_WAIT_V(6); PG8_BAR;
    }
    for (;;) {
        const bool has_next = S.next(ui + 1, nxt);
        const char* nA = has_next ? (const char*)g.A + (size_t)nxt.pm * tstep : cA; const char* nB = has_next ? (const char*)g.Bt + (size_t)nxt.pn * tstep : cB;
        for (int t = 0; t < nt; t += 2) {
            const bool last = (t == nt - 2);
            const char* a1 = cA + (size_t)(t + 1) * kstep;
            const char* a2 = last ? nA : cA + (size_t)(t + 2) * kstep; const char* b2 = last ? nB : cB + (size_t)(t + 2) * kstep;
            const char* a3 = a2 + kstep; const char* b3 = b2 + kstep;
            if (last && has_next) S.a_ready(nxt);
            if constexpr (SP2) {
            PG8_LDB(B0, 0, 0); PG8_LDB(B1, 0, 1); PG8_SCHED; PG8_LDA(At, 0, 0); PG8_STAGE(PG8_SA(1, 1), a1 + hstep, voffA);
            PG8_WAIT_V(8); PG8_WAIT_L(0); PG8_BAR; PG8_MMA(0, 0, At, B0); PG8_MMA(0, 1, At, B1); PG8_BAR; PG8_SCHED;
            PG8_LDA(At, 0, 1); PG8_STAGE(PG8_SB(0, 0), b2, voffB); PG8_STAGE(PG8_SB(0, 1), b2 + hstep, voffB); PG8_STAGE(PG8_SA(0, 0), a2, voffA);
            PG8_WAIT_V(8); PG8_WAIT_L(0); PG8_BAR; PG8_MMA(1, 0, At, B0); PG8_MMA(1, 1, At, B1); PG8_BAR; PG8_SCHED;
            PG8_LDB(B0, 1, 0); PG8_LDB(B1, 1, 1); PG8_SCHED; PG8_LDA(At, 1, 0); PG8_STAGE(PG8_SA(0, 1), a2 + hstep, voffA);
            PG8_WAIT_V(8); PG8_WAIT_L(0); PG8_BAR; PG8_MMA(0, 0, At, B0); PG8_MMA(0, 1, At, B1); PG8_BAR; PG8_SCHED;
            PG8_LDA(At, 1, 1); PG8_STAGE(PG8_SB(1, 0), b3, voffB); PG8_STAGE(PG8_SB(1, 1), b3 + hstep, voffB); PG8_STAGE(PG8_SA(1, 0), a3, voffA);
            PG8_WAIT_V(8); PG8_WAIT_L(0); PG8_BAR; PG8_MMA(1, 0, At, B0); PG8_MMA(1, 1, At, B1); PG8_BAR; PG8_SCHED;
            } else {
            PG8_LDB(B0, 0, 0); PG8_SCHED; PG8_LDA(At, 0, 0); PG8_STAGE(PG8_SA(1, 1), a1 + hstep, voffA);
            PG8_WAIT_L(8); PG8_BAR; PG8_WAIT_L(0); PG8_MMA(0, 0, At, B0); PG8_BAR; PG8_SCHED;
            PG8_LDB(B1, 0, 1); PG8_STAGE(PG8_SB(0, 0), b2, voffB);
            PG8_BAR; PG8_WAIT_L(0); PG8_MMA(0, 1, At, B1); PG8_BAR;
            PG8_LDA(At, 0, 1); PG8_STAGE(PG8_SA(0, 0), a2, voffA);
            PG8_BAR; PG8_WAIT_L(0); PG8_MMA(1, 0, At, B0); PG8_BAR; PG8_SCHED;
            PG8_STAGE(PG8_SB(0, 1), b2 + hstep, voffB);
            PG8_WAIT_V(6); PG8_BAR; PG8_MMA(1, 1, At, B1); PG8_BAR;
            PG8_LDB(B0, 1, 0); PG8_SCHED; PG8_LDA(At, 1, 0); PG8_STAGE(PG8_SA(0, 1), a2 + hstep, voffA);
            PG8_WAIT_L(8); PG8_BAR; PG8_WAIT_L(0); PG8_MMA(0, 0, At, B0); PG8_BAR; PG8_SCHED;
            PG8_LDB(B1, 1, 1); PG8_STAGE(PG8_SB(1, 0), b3, voffB);
            PG8_BAR; PG8_WAIT_L(0); PG8_MMA(0, 1, At, B1); PG8_BAR;
            PG8_LDA(At, 1, 1); PG8_STAGE(PG8_SA(1, 0), a3, voffA);
            PG8_BAR; PG8_WAIT_L(0); PG8_MMA(1, 0, At, B0); PG8_BAR; PG8_SCHED;
            PG8_STAGE(PG8_SB(1, 1), b3 + hstep, voffB);
            PG8_WAIT_V(6); PG8_BAR; PG8_MMA(1, 1, At, B1); PG8_BAR;
            }
        }
        if constexpr (ALIGN_EPI) { if (wr == 0) PG8_BAR; }
        if constexpr (!Epi::AFTER_DRAIN) { E(acc, cur, wr, wc, fr, fq); S.done(cur); }
        if (!has_next) break;
#pragma unroll
        for (int a = 0; a < 2; ++a)
#pragma unroll
            for (int b = 0; b < 2; ++b)
#pragma unroll
                for (int m = 0; m < 4; ++m)
#pragma unroll
                    for (int n = 0; n < 2; ++n) acc[a][b][m][n] = (f32x4){0.f, 0.f, 0.f, 0.f};
        cur = nxt; cA = nA; cB = nB; ++ui;
        if constexpr (ALIGN_EPI) { if (wr == 1) PG8_BAR; }
    }
    PG8_WAIT_V(0);
    if constexpr (!ALIGN_EPI) { if (wr == 0) PG8_BAR; }
    PG8_BAR;
    if constexpr (Epi::AFTER_DRAIN) { E.fused(acc, cur, wr, wc, fr, fq, lds, wid, lane); S.done(cur); }
#undef PG8_SA
#undef PG8_SB
#undef PG8_STAGE
#undef PG8_LDA
#undef PG8_LDB
#undef PG8_MMA
#undef PG8_WAIT_V
#undef PG8_WAIT_L
#undef PG8_BAR
#undef PG8_SCHED
}
}
namespace att {
using bf16 = __hip_bfloat16;
constexpr int   D = 128, NW = 8, QBLK = 32, KVBLK = 64;
constexpr float SCALE = 0.088388347648318440f;
constexpr float THR = 8.f;
constexpr int LDQ = 7168, LDK = 7168, LDO = 1024;
constexpr size_t SHM_V = KVBLK * D * 2, SHM_K = KVBLK * D * 2, SHM_ATTN = 2 * SHM_V + 2 * SHM_K + NW * 64 * 4;
using bf16x8 = __attribute__((ext_vector_type(8))) short;
using s16x4  = __attribute__((ext_vector_type(4))) short;
using f32x16 = __attribute__((ext_vector_type(16))) float;
using u32x4  = __attribute__((ext_vector_type(4))) unsigned;
#define KSWZ(row, colB) ((row) * 256 + ((colB) ^ (((row) & 7) << 4)))
#define SBAR() __builtin_amdgcn_sched_barrier(0)
__device__ __forceinline__ int crow(int r, int hi) { return (r & 3) + 8 * (r >> 2) + 4 * hi; }
__device__ __forceinline__ unsigned cvtpk(float lo, float hi) {
  unsigned r; asm volatile("v_cvt_pk_bf16_f32 %0, %1, %2" : "=v"(r) : "v"(lo), "v"(hi)); return r;
}
__device__ __forceinline__ bf16x8 ld8(const bf16* p) { return *reinterpret_cast<const bf16x8*>(p); }
__device__ __forceinline__ void partialSM(f32x16& p0, f32x16& p1, float& m_reg, float& mn, float& alpha) {
  constexpr float C = SCALE * 1.4426950408889634f;
  float pmax = p0[0]; for (int r = 1; r < 16; ++r) pmax = fmaxf(pmax, p0[r]); for (int r = 0; r < 16; ++r) pmax = fmaxf(pmax, p1[r]);
  { auto rr = __builtin_amdgcn_permlane32_swap(__float_as_uint(pmax), __float_as_uint(pmax), false, false);
    pmax = fmaxf(__uint_as_float(rr[0]), __uint_as_float(rr[1])); }
  if (__builtin_expect(__all(pmax - m_reg <= THR / SCALE), 1)) { mn = m_reg; alpha = 1.f; }
  else { mn = fmaxf(m_reg, pmax); alpha = __builtin_amdgcn_exp2f((m_reg - mn) * C); m_reg = mn; }
  float mnC = -mn * C;
  for (int r = 0; r < 16; ++r) p0[r] = fmaf(p0[r], C, mnC); for (int r = 0; r < 16; ++r) p1[r] = fmaf(p1[r], C, mnC);
  for (int r = 0; r < 16; ++r) p0[r] = __builtin_amdgcn_exp2f(p0[r]);
}
__device__ __forceinline__ void finishSM(f32x16& p0, f32x16& p1, float alpha, float& l_reg, bf16x8& pa0, bf16x8& pa1, bf16x8& pa2, bf16x8& pa3) {
  for (int r = 0; r < 16; ++r) p1[r] = __builtin_amdgcn_exp2f(p1[r]);
  float ps = 0; for (int r = 0; r < 16; ++r) ps += p0[r]; for (int r = 0; r < 16; ++r) ps += p1[r];
  { auto rr = __builtin_amdgcn_permlane32_swap(__float_as_uint(ps), __float_as_uint(ps), false, false);
    ps = __uint_as_float(rr[0]) + __uint_as_float(rr[1]); }
  l_reg = l_reg * alpha + ps;
#define PK4(P, BASE, OUT) do { unsigned a0 = cvtpk(P[BASE + 0], P[BASE + 1]), a1 = cvtpk(P[BASE + 2], P[BASE + 3]);   \
    unsigned b0 = cvtpk(P[BASE + 4], P[BASE + 5]), b1 = cvtpk(P[BASE + 6], P[BASE + 7]);                              \
    auto r0 = __builtin_amdgcn_permlane32_swap(a0, b0, false, false); auto r1 = __builtin_amdgcn_permlane32_swap(a1, b1, false, false); \
    u32x4 w = {r0[0], r1[0], r0[1], r1[1]}; OUT = *reinterpret_cast<bf16x8*>(&w); } while (0)
  PK4(p0, 0, pa0); PK4(p0, 8, pa1); PK4(p1, 0, pa2); PK4(p1, 8, pa3);
#undef PK4
}
__device__ __forceinline__ void qkt(f32x16& p0, f32x16& p1, const bf16* Ks, const bf16x8* qr, int r32, int hi) {
  p0 = f32x16{}; p1 = f32x16{};
  for (int d0 = 0; d0 < 8; ++d0) { int cb = (d0 * 16 + hi * 8) * 2;
    bf16x8 b0 = *reinterpret_cast<const bf16x8*>((const char*)Ks + KSWZ(r32, cb));
    bf16x8 b1 = *reinterpret_cast<const bf16x8*>((const char*)Ks + KSWZ(32 + r32, cb));
    p0 = __builtin_amdgcn_mfma_f32_32x32x16_bf16(b0, qr[d0], p0, 0, 0, 0);
    p1 = __builtin_amdgcn_mfma_f32_32x32x16_bf16(b1, qr[d0], p1, 0, 0, 0); }
}
__device__ __forceinline__ int v_st(int k, int c) { const int kk = (k & ~0xC) | ((k & 4) << 1) | ((k & 8) >> 1); return ((kk >> 3) * 4 + (c >> 5)) * 512 + ((kk & 7) * 32 + (c & 31)) * 2; }
__device__ __forceinline__ int v_rd_base(int lane) { return ((lane & 3) << 3) | (((lane >> 2) & 3) << 6) | (((lane >> 4) & 1) << 5) | (((lane >> 5) & 1) << 8); }
constexpr int v_rd_off(int d0, int ks, int half) { return d0 * 512 + ks * 4096 + half * 2048; }
template <int OFF> __device__ __forceinline__ s16x4 tr_read(int vb) {
  s16x4 r; asm volatile("ds_read_b64_tr_b16 %0, %1 offset:%2" : "=&v"(r) : "v"(vb), "i"(OFF) : "memory"); return r;
}
template <int D0> __device__ __forceinline__ void pv_one(f32x16& od, int vb, bf16x8 pa0, bf16x8 pa1, bf16x8 pa2, bf16x8 pa3) {
  const s16x4 l0 = tr_read<v_rd_off(D0, 0, 0)>(vb), h0 = tr_read<v_rd_off(D0, 0, 1)>(vb), l1 = tr_read<v_rd_off(D0, 1, 0)>(vb), h1 = tr_read<v_rd_off(D0, 1, 1)>(vb);
  const s16x4 l2 = tr_read<v_rd_off(D0, 2, 0)>(vb), h2 = tr_read<v_rd_off(D0, 2, 1)>(vb), l3 = tr_read<v_rd_off(D0, 3, 0)>(vb), h3 = tr_read<v_rd_off(D0, 3, 1)>(vb);
  asm volatile("s_waitcnt lgkmcnt(0)" ::: "memory"); SBAR();
#define PK(L, H) (bf16x8){L[0], L[1], L[2], L[3], H[0], H[1], H[2], H[3]}
  od = __builtin_amdgcn_mfma_f32_32x32x16_bf16(pa0, PK(l0, h0), od, 0, 0, 0);
  od = __builtin_amdgcn_mfma_f32_32x32x16_bf16(pa1, PK(l1, h1), od, 0, 0, 0);
  od = __builtin_amdgcn_mfma_f32_32x32x16_bf16(pa2, PK(l2, h2), od, 0, 0, 0);
  od = __builtin_amdgcn_mfma_f32_32x32x16_bf16(pa3, PK(l3, h3), od, 0, 0, 0);
#undef PK
}
__device__ __forceinline__ void pv_d0(f32x16* o, int vb, bf16x8 pa0, bf16x8 pa1, bf16x8 pa2, bf16x8 pa3) {
  pv_one<0>(o[0], vb, pa0, pa1, pa2, pa3); pv_one<1>(o[1], vb, pa0, pa1, pa2, pa3); pv_one<2>(o[2], vb, pa0, pa1, pa2, pa3); pv_one<3>(o[3], vb, pa0, pa1, pa2, pa3);
}
__device__ __forceinline__ void attn_dense_body(const bf16* __restrict__ Qb, const bf16* __restrict__ Kh, const bf16* __restrict__ Vh,
                                                bf16* __restrict__ Ob, int seq, char* lds) {
  int tid_ = threadIdx.x; asm volatile("" : "+v"(tid_));
  const int tid = tid_, wid = tid >> 6, lane = tid & 63, r32 = lane & 31, hi = lane >> 5;
  bf16* V_lds = (bf16*)lds; bf16* K_lds = (bf16*)(lds + 2 * SHM_V);
  float* ws = (float*)(lds + 2 * SHM_V + 2 * SHM_K) + wid * 64; float* li_l = ws; float* al_l = ws + 32;
  float m_reg = -1e30f, l_reg = 0; f32x16 o[4] = {}; bf16x8 qr[8];
  const bf16* Qw = Qb + (long)(wid * QBLK + r32) * LDQ + hi * 8;
#pragma unroll
  for (int d0 = 0; d0 < 8; ++d0) qr[d0] = ld8(Qw + d0 * 16);
  const int sr = tid >> 4, sc = (tid & 15) * 8, vst0 = v_st(sr, sc), vst1 = v_st(32 + sr, sc);
  const int vb0 = (int)(uintptr_t)V_lds + v_rd_base(lane);
  struct { bf16x8 vs0, vs1, ks0, ks1; } sr_[2];
#define SLOAD(i, k0) do { sr_[i].vs0 = ld8(&Vh[(long)((k0) + sr) * LDK + sc]); sr_[i].vs1 = ld8(&Vh[(long)((k0) + 32 + sr) * LDK + sc]); \
    sr_[i].ks0 = ld8(&Kh[(long)((k0) + sr) * LDK + sc]); sr_[i].ks1 = ld8(&Kh[(long)((k0) + 32 + sr) * LDK + sc]); } while (0)
#define SWRITE(b, i) do { *(bf16x8*)((char*)V_lds + (b) * SHM_V + vst0) = sr_[i].vs0;          \
    *(bf16x8*)((char*)V_lds + (b) * SHM_V + vst1) = sr_[i].vs1; int kc = sc * 2;               \
    *(bf16x8*)((char*)K_lds + (b) * SHM_K + KSWZ(sr, kc)) = sr_[i].ks0;                       \
    *(bf16x8*)((char*)K_lds + (b) * SHM_K + KSWZ(32 + sr, kc)) = sr_[i].ks1; } while (0)
#define SWAIT() do { asm volatile("s_waitcnt vmcnt(4)" ::: "memory"); } while (0)
#define RESC(a) do { if (__any((a) < 1.f)) { if (hi == 0) al_l[r32] = (a); asm volatile("s_waitcnt lgkmcnt(0)" ::: "memory"); \
    for (int d = 0; d < 4; ++d) for (int r = 0; r < 16; ++r) o[d][r] *= al_l[crow(r, hi)]; } } while (0)
  f32x16 pA0, pA1, pB0, pB1; float mnA, mnB, alA, alB; bf16x8 pa0, pa1, pa2, pa3; const int NT = seq / KVBLK;
  constexpr int SE = 0, SO = 1;
  SLOAD(SE, 0); asm volatile("s_waitcnt vmcnt(0)" ::: "memory"); SWRITE(0, SE); __syncthreads();
  qkt(pA0, pA1, K_lds, qr, r32, hi); partialSM(pA0, pA1, m_reg, mnA, alA);
  SLOAD(SO, KVBLK); if (2 < NT) SLOAD(SE, 2 * KVBLK);
  SWAIT(); SWRITE(1, SO); __syncthreads();
  for (int j = 1; j + 1 < NT; j += 2) {
    SBAR(); qkt(pB0, pB1, (bf16*)((char*)K_lds + SHM_K), qr, r32, hi);
    finishSM(pA0, pA1, alA, l_reg, pa0, pa1, pa2, pa3); SBAR();
    SLOAD(SO, (j + 2) * KVBLK); SBAR();
    pv_d0(o, vb0, pa0, pa1, pa2, pa3); partialSM(pB0, pB1, m_reg, mnB, alB);
    __syncthreads(); SWAIT(); SWRITE(0, SE);
    RESC(alB); __syncthreads();
    SBAR(); qkt(pA0, pA1, K_lds, qr, r32, hi);
    finishSM(pB0, pB1, alB, l_reg, pa0, pa1, pa2, pa3); SBAR();
    if (j + 3 < NT) SLOAD(SE, (j + 3) * KVBLK); SBAR();
    pv_d0(o, vb0 + (int)SHM_V, pa0, pa1, pa2, pa3); partialSM(pA0, pA1, m_reg, mnA, alA);
    __syncthreads(); SWAIT(); SWRITE(1, SO);
    RESC(alA); __syncthreads();
  }
  SBAR(); qkt(pB0, pB1, (bf16*)((char*)K_lds + SHM_K), qr, r32, hi);
  finishSM(pA0, pA1, alA, l_reg, pa0, pa1, pa2, pa3); SBAR();
  pv_d0(o, vb0, pa0, pa1, pa2, pa3); partialSM(pB0, pB1, m_reg, mnB, alB);
  __syncthreads(); RESC(alB);
  finishSM(pB0, pB1, alB, l_reg, pa0, pa1, pa2, pa3); SBAR();
  pv_d0(o, vb0 + (int)SHM_V, pa0, pa1, pa2, pa3);
  if (hi == 0) li_l[r32] = l_reg; asm volatile("s_waitcnt lgkmcnt(0)" ::: "memory");
  float rli[16];
#pragma unroll
  for (int r = 0; r < 16; ++r) rli[r] = __builtin_amdgcn_rcpf(li_l[crow(r, hi)]);
  bf16* Ow = Ob + (long)(wid * QBLK) * LDO;
#pragma unroll
  for (int r = 0; r < 16; ++r) { int orow = crow(r, hi);
    for (int d0 = 0; d0 < 4; ++d0) Ow[(long)orow * LDO + d0 * 32 + r32] = __float2bfloat16(o[d0][r] * rli[r]); }
  __syncthreads();
#undef SLOAD
#undef SWRITE
#undef SWAIT
#undef RESC
}
#undef KSWZ
#undef SBAR
}
#define LAS __attribute__((address_space(3)))
typedef unsigned short bf16_t;
typedef float f32x4 __attribute__((ext_vector_type(4)));
typedef unsigned u32x4 __attribute__((ext_vector_type(4)));
typedef unsigned u32x2 __attribute__((ext_vector_type(2)));

constexpr int NWAVES = 8, NTHREADS = 512;
constexpr int D = 1024, FF = 4096, NIN = 7040, NINP = 7168, RWC = 3456;
constexpr int MC = 16384, NCHUNK = 5, MTOT = 81920;
constexpr float ALPHA = 1.189207115002721f;
constexpr float LN_EPS = 1e-5f, GN_EPS = 64e-5f, RMS_EPS = 1e-6f;
constexpr float DECAY_SCALE = 0.6065306597126334f;

constexpr size_t MiB = 1u << 20;
constexpr size_t WS_CTL = 0;
constexpr size_t WS_WIN = 1 * MiB, WS_WPR = 15 * MiB, WS_WPA = 17 * MiB, WS_WOUT = 19 * MiB, WS_WF1 = 21 * MiB, WS_WF2 = 29 * MiB;
constexpr size_t WS_WUP = 37 * MiB, WS_AUP = 37 * MiB + 512 * 1024, WS_GUP = 38 * MiB;
constexpr size_t WS_XB = 40 * MiB, WS_OF = 40 * MiB;
constexpr size_t WS_Z = 72 * MiB;
constexpr size_t WS_OPR = 296 * MiB, WS_OPKH = 360 * MiB, WS_VS = 424 * MiB;
constexpr size_t WS_KS = 488 * MiB, WS_OB = 488 * MiB, WS_HB = 488 * MiB;
constexpr size_t WS_TW = 520 * MiB, WS_AD = 524 * MiB, WS_SG = 528 * MiB;
constexpr size_t WS_OPW = 532 * MiB, WS_OPAK = 660 * MiB, WS_OPKT = 788 * MiB;
constexpr size_t WS_G = 916 * MiB, WS_OATT = 948 * MiB, WS_END = 980 * MiB;
constexpr size_t WS_ORW = 532 * MiB, WS_M32 = 564 * MiB, WS_MB = 628 * MiB, WS_FFH = 660 * MiB;
constexpr int ZLD = 7168, ZQ = 3456, ZK = 4480, ZV = 4736, ZG = 4992;

constexpr int LDS_BYTES = 131072 + 1024;
constexpr int LDS_MISC = 131072;

#define INP(k) (A.in[(k) + z])
struct Args {
    const float* in[26];
    float* out; unsigned char* ws;
    int ph_lo, ph_hi;
};

__device__ __forceinline__ float bf2f(unsigned v) { return __uint_as_float(v << 16); }
__device__ __forceinline__ float bflo(unsigned w) { return __uint_as_float(w << 16); }
__device__ __forceinline__ float bfhi(unsigned w) { return __uint_as_float(w & 0xffff0000u); }
typedef float f32x2c_t __attribute__((ext_vector_type(2))); typedef __bf16 bf16x2c_t __attribute__((ext_vector_type(2)));
__device__ __forceinline__ unsigned pk2(float lo, float hi) { f32x2c_t v = {lo, hi}; bf16x2c_t b = __builtin_convertvector(v, bf16x2c_t); return __builtin_bit_cast(unsigned, b); }
__device__ __forceinline__ float sigmoidf_(float x) { return 1.0f / (1.0f + __expf(-x)); }
__device__ __forceinline__ float wave_sum(float v) {
#pragma unroll
    for (int o = 1; o < 64; o <<= 1) v += __shfl_xor(v, o);
    return v;
}

__device__ __forceinline__ void p0_transpose_item(const float* W, int K, int N, bf16_t* WT, LAS float* scr, int item, int lane) {
    const int nblk = N / 32, kb = item / nblk, nb = item % nblk, k0 = 64 * kb, n0 = 32 * nb;
#pragma unroll 8
    for (int i = 0; i < 32; ++i) { const int kk = 2 * i + (lane >> 5); scr[kk * 33 + (lane & 31)] = W[(size_t)(k0 + kk) * N + n0 + (lane & 31)]; }
    asm volatile("s_waitcnt lgkmcnt(0)" ::: "memory");
    const int c = lane & 7;
#pragma unroll
    for (int j = 0; j < 4; ++j) { const int n = (lane >> 3) + 8 * j; const LAS float* s = scr + (8 * c) * 33 + n;
        u32x4 o; o.x = pk2(s[0 * 33], s[1 * 33]); o.y = pk2(s[2 * 33], s[3 * 33]); o.z = pk2(s[4 * 33], s[5 * 33]); o.w = pk2(s[6 * 33], s[7 * 33]);
        *(u32x4*)(WT + (size_t)(n0 + n) * K + k0 + 8 * c) = o; }
    asm volatile("s_waitcnt lgkmcnt(0)" ::: "memory");
}

__device__ __forceinline__ void cvt_x_chunk(const float* x, bf16_t* xb, int gtid, int gthreads) {
    const size_t n8 = (size_t)MC * D / 8;
    for (size_t i = gtid; i < n8; i += gthreads) {
        const f32x4 a = *(const f32x4*)(x + i * 8), b = *(const f32x4*)(x + i * 8 + 4);
        u32x4 o; o.x = pk2(a.x, a.y); o.y = pk2(a.z, a.w); o.z = pk2(b.x, b.y); o.w = pk2(b.z, b.w);
        *(u32x4*)(xb + i * 8) = o;
    }
}

__device__ __forceinline__ void ln_rows(float* base, const float* g, const float* b, bf16_t* hb, int gw, int ngw, int lane) {
    f32x4 gg[4], bb[4];
#pragma unroll
    for (int j = 0; j < 4; ++j) { gg[j] = *((const f32x4*)g + 64 * j + lane); bb[j] = *((const f32x4*)b + 64 * j + lane); }
    for (int m0 = gw; m0 < MC; m0 += 2 * ngw) {
        const int m1 = m0 + ngw; const bool has1 = m1 < MC;
        f32x4* xr0 = (f32x4*)(base + (size_t)m0 * D) + lane; f32x4* xr1 = (f32x4*)(base + (size_t)(has1 ? m1 : m0) * D) + lane;
        f32x4 v0[4], v1[4]; float s0 = 0.f, s1 = 0.f;
#pragma unroll
        for (int j = 0; j < 4; ++j) { v0[j] = xr0[64 * j]; v1[j] = xr1[64 * j]; }
#pragma unroll
        for (int j = 0; j < 4; ++j) { s0 += (v0[j].x + v0[j].y) + (v0[j].z + v0[j].w); s1 += (v1[j].x + v1[j].y) + (v1[j].z + v1[j].w); }
        const float mean0 = wave_sum(s0) * (1.f / D), mean1 = wave_sum(s1) * (1.f / D); float q0 = 0.f, q1 = 0.f;
#pragma unroll
        for (int j = 0; j < 4; ++j) { v0[j] = v0[j] - mean0; v1[j] = v1[j] - mean1;
            q0 += (v0[j].x * v0[j].x + v0[j].y * v0[j].y) + (v0[j].z * v0[j].z + v0[j].w * v0[j].w); q1 += (v1[j].x * v1[j].x + v1[j].y * v1[j].y) + (v1[j].z * v1[j].z + v1[j].w * v1[j].w); }
        const float rstd0 = 1.f / sqrtf(wave_sum(q0) * (1.f / D) + LN_EPS), rstd1 = 1.f / sqrtf(wave_sum(q1) * (1.f / D) + LN_EPS);
#pragma unroll
        for (int j = 0; j < 4; ++j) {
            const f32x4 y0 = v0[j] * rstd0 * gg[j] + bb[j]; xr0[64 * j] = y0;
            if (hb) { u32x2 w; w.x = pk2(y0.x, y0.y); w.y = pk2(y0.z, y0.w); *(u32x2*)(hb + (size_t)m0 * D + 256 * j + 4 * lane) = w; }
            if (has1) { const f32x4 y1 = v1[j] * rstd1 * gg[j] + bb[j]; xr1[64 * j] = y1;
                if (hb) { u32x2 w; w.x = pk2(y1.x, y1.y); w.y = pk2(y1.z, y1.w); *(u32x2*)(hb + (size_t)m1 * D + 256 * j + 4 * lane) = w; } }
        }
    }
}

template <class F> struct Epi4 {
    static constexpr bool PERM = false, AFTER_DRAIN = false; F f;
    __device__ __forceinline__ void operator()(const pg8::f32x4 (&acc)[2][2][4][2], const pg8::Unit& u, int wr, int wc, int fr, int fq) const {
        const int row0 = u.pm * 256 + wr * 64 + fr, col0 = u.pn * 256 + wc * 32 + 4 * fq;
#pragma unroll
        for (int ai = 0; ai < 2; ++ai)
#pragma unroll
            for (int m = 0; m < 4; ++m)
#pragma unroll
                for (int bj = 0; bj < 2; ++bj)
#pragma unroll
                    for (int n = 0; n < 2; ++n) { f(row0 + ai * 128 + m * 16, col0 + bj * 128 + n * 16, acc[ai][bj][m][n]); asm volatile("" ::: "memory"); }
    }
};
template <class F> struct Epi8 {
    static constexpr bool PERM = true, AFTER_DRAIN = false; F f;
    __device__ __forceinline__ void operator()(const pg8::f32x4 (&acc)[2][2][4][2], const pg8::Unit& u, int wr, int wc, int fr, int fq) const {
        const int row0 = u.pm * 256 + wr * 64 + fr, col0 = u.pn * 256 + wc * 32 + 8 * fq;
#pragma unroll
        for (int ai = 0; ai < 2; ++ai)
#pragma unroll
            for (int m = 0; m < 4; ++m)
#pragma unroll
                for (int bj = 0; bj < 2; ++bj) { f(row0 + ai * 128 + m * 16, col0 + bj * 128, acc[ai][bj][m][0], acc[ai][bj][m][1]); asm volatile("" ::: "memory"); }
    }
};
__device__ __forceinline__ u32x4 pack8(f32x4 a, f32x4 b) { u32x4 w; w.x = pk2(a.x, a.y); w.y = pk2(a.z, a.w); w.z = pk2(b.x, b.y); w.w = pk2(b.z, b.w); return w; }

struct FZ { bf16_t* z;
    __device__ __forceinline__ void operator()(int row, int col, f32x4 a, f32x4 b) const { *(u32x4*)(z + (size_t)row * ZLD + col) = pack8(a, b); } };
struct FW { const float* w0; float* opw;
    __device__ __forceinline__ void operator()(int row, int col, f32x4 a) const {
        const f32x4 x = a + *(const f32x4*)(w0 + col); f32x4 y;
#pragma unroll
        for (int i = 0; i < 4; ++i) y[i] = __expf(-DECAY_SCALE * sigmoidf_(x[i]));
        *(f32x4*)(opw + (size_t)row * D + col) = y; } };
struct FA { const float *a0, *k_a; const bf16_t* ks; const float* kh; float *opak, *opkt;
    __device__ __forceinline__ void operator()(int row, int col, f32x4 acc) const {
        const size_t o = (size_t)row * D + col;
        const f32x4 x = acc + *(const f32x4*)(a0 + col), ka = *(const f32x4*)(k_a + col), khv = *(const f32x4*)(kh + o);
        const u32x2 kw = *(const u32x2*)(ks + o);
        f32x4 k; k.x = bflo(kw.x); k.y = bfhi(kw.x); k.z = bflo(kw.y); k.w = bfhi(kw.y);
        f32x4 ak, kt;
#pragma unroll
        for (int i = 0; i < 4; ++i) { const float a = sigmoidf_(x[i]); ak[i] = a * khv[i]; kt[i] = k[i] * (1.0f + (a - 1.0f) * ka[i]); }
        *(f32x4*)(opak + o) = ak; *(f32x4*)(opkt + o) = kt; } };
struct FG { bf16_t* g;
    __device__ __forceinline__ void operator()(int row, int col, f32x4 a) const {
        u32x2 w; w.x = pk2(a.x, a.y); w.y = pk2(a.z, a.w); *(u32x2*)(g + (size_t)row * D + col) = w; } };
typedef short bf16x8v __attribute__((ext_vector_type(8)));
template <int K, class F> __device__ __forceinline__ void wave_gemm_tile(const bf16_t* A, int aoff, const bf16_t* Bt, int m0, int n0, int lane, const F& f) {
    const int fr = lane & 15, fq = lane >> 4; constexpr int KS = K / 32;
    bf16x8v a[2][KS];
#pragma unroll
    for (int mt = 0; mt < 2; ++mt)
#pragma unroll
        for (int ks = 0; ks < KS; ++ks) a[mt][ks] = *(const bf16x8v*)(A + (size_t)(m0 + mt * 16 + fr) * 128 + aoff + ks * 32 + 8 * fq);
#pragma unroll 2
    for (int nt = 0; nt < 8; ++nt) {
        const bf16_t* bp = Bt + (size_t)(n0 + nt * 16 + fr) * K + 8 * fq;
        f32x4 acc0 = {0.f, 0.f, 0.f, 0.f}, acc1 = {0.f, 0.f, 0.f, 0.f};
#pragma unroll
        for (int ks = 0; ks < KS; ++ks) { const bf16x8v b = *(const bf16x8v*)(bp + ks * 32);
            acc0 = __builtin_amdgcn_mfma_f32_16x16x32_bf16(b, a[0][ks], acc0, 0, 0, 0); acc1 = __builtin_amdgcn_mfma_f32_16x16x32_bf16(b, a[1][ks], acc1, 0, 0, 0); }
        f(m0 + fr, n0 + nt * 16 + 4 * fq, acc0); f(m0 + 16 + fr, n0 + nt * 16 + 4 * fq, acc1);
    }
}
struct FP1 { const bf16_t* gates; float* m32;
    __device__ __forceinline__ void operator()(int row, int col, f32x4 a) const {
        const u32x2 gw = *(const u32x2*)(gates + (size_t)row * ZLD + ZG + col); f32x4 y;
        y.x = sigmoidf_(bflo(gw.x)) * a.x; y.y = sigmoidf_(bfhi(gw.x)) * a.y; y.z = sigmoidf_(bflo(gw.y)) * a.z; y.w = sigmoidf_(bfhi(gw.y)) * a.w;
        *(f32x4*)(m32 + (size_t)row * D + col) = y;
    } };
struct FP2 { const bf16_t* gates; const float* m32; bf16_t* mb;
    __device__ __forceinline__ void operator()(int row, int col, f32x4 a) const {
        const u32x2 gw = *(const u32x2*)(gates + (size_t)row * ZLD + ZG + 1024 + col); const f32x4 p = *(const f32x4*)(m32 + (size_t)row * D + col); f32x4 y;
        y.x = p.x + sigmoidf_(bflo(gw.x)) * a.x; y.y = p.y + sigmoidf_(bfhi(gw.x)) * a.y; y.z = p.z + sigmoidf_(bflo(gw.y)) * a.z; y.w = p.w + sigmoidf_(bfhi(gw.y)) * a.w;
        u32x2 w; w.x = pk2(y.x, y.y); w.y = pk2(y.z, y.w); *(u32x2*)(mb + (size_t)row * D + col) = w;
    } };
struct FOut { const float* x; float* out;
    __device__ __forceinline__ void operator()(int row, int col, f32x4 a) const {
        const size_t o = (size_t)row * D + col; *(f32x4*)(out + o) = *(const f32x4*)(x + o) * ALPHA + a; } };
struct FF1 { bf16_t* ffh;
    __device__ __forceinline__ void operator()(int row, int col, f32x4 a, f32x4 b) const {
#pragma unroll
        for (int i = 0; i < 4; ++i) { const float u = fmaxf(a[i], 0.f), v = fmaxf(b[i], 0.f); a[i] = u * u; b[i] = v * v; }
        *(u32x4*)(ffh + (size_t)row * FF + col) = pack8(a, b); } };
struct FF2 { float* out;
    __device__ __forceinline__ void operator()(int row, int col, f32x4 a) const {
        const size_t o = (size_t)row * D + col; *(f32x4*)(out + o) = *(const f32x4*)(out + o) * ALPHA + a; } };

template <class E> __device__ __forceinline__ void run_gemm(LAS unsigned char* lds, const bf16_t* A, const bf16_t* Bt, int M, int N, int K, const E& e) {

    int G_ = (int)gridDim.x, c_ = (int)blockIdx.x; asm volatile("" : "+s"(G_), "+s"(c_));
    pg8::Gemm g{A, Bt, M, N, K}; pg8::StaticOrder S; S.init(M, N, G_, c_);
    pg8::gemm_phase<E, pg8::StaticOrder, true, true>(lds, g, S, e);
}

__device__ __forceinline__ void prep_rows(const float* mu_p, const float* mu_n, const float* k_k, const float* qn, const float* kn, unsigned char* ws, int T, int rbeg, int rstep, int rend, int lane, bool do_att) {
    bf16_t* Z = (bf16_t*)(ws + WS_Z);
    float* OPR = (float*)(ws + WS_OPR); float* OPKH = (float*)(ws + WS_OPKH); float* VS = (float*)(ws + WS_VS);
    bf16_t* KS = (bf16_t*)(ws + WS_KS); bf16_t* TW = (bf16_t*)(ws + WS_TW); bf16_t* AD = (bf16_t*)(ws + WS_AD); bf16_t* SG = (bf16_t*)(ws + WS_SG);
    for (int row = rbeg; row < rend; row += rstep) {
        const int t = row & (T - 1); const bool hp = t > 0, hn = t < T - 1;
        const bf16_t* zc = Z + (size_t)row * ZLD;
#pragma unroll
        for (int pass = 0; pass < 7; ++pass) {
            const int c = pass * 512 + lane * 8;
            if (c < RWC) {
                const u32x4 wc_ = *(const u32x4*)(zc + c);
                u32x4 wp = {0u, 0u, 0u, 0u}, wn = {0u, 0u, 0u, 0u};
                if (hp) wp = *(const u32x4*)(zc - ZLD + c);
                if (hn) wn = *(const u32x4*)(zc + ZLD + c);
                const f32x4 mp0 = *(const f32x4*)(mu_p + c), mp1 = *(const f32x4*)(mu_p + c + 4), mn0 = *(const f32x4*)(mu_n + c), mn1 = *(const f32x4*)(mu_n + c + 4);
                float z[8];
#pragma unroll
                for (int i = 0; i < 4; ++i) {
                    const float c0 = bflo(wc_[i]), c1 = bfhi(wc_[i]), p0 = bflo(wp[i]), p1 = bfhi(wp[i]), n0 = bflo(wn[i]), n1 = bfhi(wn[i]);
                    const float mpa = (2 * i < 4) ? mp0[2 * i] : mp1[2 * i - 4], mpb = (2 * i + 1 < 4) ? mp0[2 * i + 1] : mp1[2 * i - 3];
                    const float mna = (2 * i < 4) ? mn0[2 * i] : mn1[2 * i - 4], mnb = (2 * i + 1 < 4) ? mn0[2 * i + 1] : mn1[2 * i - 3];
                    z[2 * i] = c0 + mpa * (p0 - c0) + mna * (n0 - c0);
                    z[2 * i + 1] = c1 + mpb * (p1 - c1) + mnb * (n1 - c1);
                }
                if (pass < 2) {
                    float* o = OPR + (size_t)row * D + c;
                    *(f32x4*)o = (f32x4){z[0], z[1], z[2], z[3]}; *(f32x4*)(o + 4) = (f32x4){z[4], z[5], z[6], z[7]};
                } else if (pass < 4) {
                    const int cc = c - 1024;
                    u32x4 w; w.x = pk2(z[0], z[1]); w.y = pk2(z[2], z[3]); w.z = pk2(z[4], z[5]); w.w = pk2(z[6], z[7]);
                    *(u32x4*)(KS + (size_t)row * D + cc) = w;
                    const f32x4 kk0 = *(const f32x4*)(k_k + cc), kk1 = *(const f32x4*)(k_k + cc + 4);
                    float kp[8]; float ss = 0.f;
#pragma unroll
                    for (int i = 0; i < 8; ++i) { kp[i] = z[i] * (i < 4 ? kk0[i] : kk1[i - 4]); ss += kp[i] * kp[i]; }
                    ss += __shfl_xor(ss, 1); ss += __shfl_xor(ss, 2); ss += __shfl_xor(ss, 4);
                    const float inv = 1.0f / fmaxf(sqrtf(ss), 1e-12f);
                    float* o = OPKH + (size_t)row * D + cc;
                    *(f32x4*)o = (f32x4){kp[0] * inv, kp[1] * inv, kp[2] * inv, kp[3] * inv}; *(f32x4*)(o + 4) = (f32x4){kp[4] * inv, kp[5] * inv, kp[6] * inv, kp[7] * inv};
                } else if (pass < 6) {
                    float* o = VS + (size_t)row * D + (c - 2048);
                    *(f32x4*)o = (f32x4){z[0], z[1], z[2], z[3]}; *(f32x4*)(o + 4) = (f32x4){z[4], z[5], z[6], z[7]};
                } else {
                    const int sect = lane >> 4, cc = (lane & 15) * 8;
                    float y[8];
#pragma unroll
                    for (int i = 0; i < 8; ++i) {
                        if (sect == 0) { const float e = __expf(2.0f * z[i]); y[i] = 1.0f - 2.0f / (e + 1.0f); }
                        else if (sect == 1) y[i] = z[i];
                        else y[i] = sigmoidf_(z[i]);
                    }
                    u32x4 w; w.x = pk2(y[0], y[1]); w.y = pk2(y[2], y[3]); w.z = pk2(y[4], y[5]); w.w = pk2(y[6], y[7]);
                    bf16_t* dst = (sect == 0 ? TW : (sect == 1 ? AD : SG)) + (size_t)row * 128 + cc;
                    *(u32x4*)dst = w;
                }
            }
        }
        bf16_t* qrow = Z + (size_t)row * ZLD + ZQ;
#pragma unroll 1
        for (int p = do_att ? 0 : 3; p < 3; ++p) {
            const int head = p * 4 + (lane >> 4), sub = lane & 15, d0 = sub * 8;
            const bool act = head < 10;
            bf16_t* px = qrow + head * 128 + d0;
            u32x4 w = {0u, 0u, 0u, 0u}; if (act) w = *(const u32x4*)px;
            float x[8]; float ss = 0.f;
#pragma unroll
            for (int i = 0; i < 4; ++i) { x[2 * i] = bflo(w[i]); x[2 * i + 1] = bfhi(w[i]); ss += x[2 * i] * x[2 * i] + x[2 * i + 1] * x[2 * i + 1]; }
            ss += __shfl_xor(ss, 1); ss += __shfl_xor(ss, 2); ss += __shfl_xor(ss, 4); ss += __shfl_xor(ss, 8);
            const float rinv = rsqrtf(ss * (1.0f / 128.0f) + RMS_EPS);
            const float* gn = (head < 8) ? qn : kn;
            const f32x4 g0 = *(const f32x4*)(gn + d0), g1 = *(const f32x4*)(gn + d0 + 4);
            const int axis = sub >> 3, hf = (sub >> 2) & 1;
            const float pos = (float)(axis ? (t & 63) : (t >> 6));
            float y[8];
#pragma unroll
            for (int i = 0; i < 8; ++i) {
                const float xn = x[i] * rinv * (i < 4 ? g0[i] : g1[i - 4]);
                const float xp = __shfl_xor(xn, 4);
                const int fi = (sub & 3) * 8 + i;
                const float ang = pos * exp2f(-0.41524101186092f * (float)fi);
                y[i] = xn * __cosf(ang) + (hf ? xp : -xp) * __sinf(ang);
            }
            if (act) { u32x4 o; o.x = pk2(y[0], y[1]); o.y = pk2(y[2], y[3]); o.z = pk2(y[4], y[5]); o.w = pk2(y[6], y[7]); *(u32x4*)px = o; }
        }
    }
}

__device__ __forceinline__ float rowsum16(float x) {
    x += __int_as_float(__builtin_amdgcn_update_dpp(0, __float_as_int(x), 0x128, 0xf, 0xf, true));
    x += __int_as_float(__builtin_amdgcn_update_dpp(0, __float_as_int(x), 0x124, 0xf, 0xf, true));
    x += __int_as_float(__builtin_amdgcn_update_dpp(0, __float_as_int(x), 0x122, 0xf, 0xf, true));
    x += __int_as_float(__builtin_amdgcn_update_dpp(0, __float_as_int(x), 0x121, 0xf, 0xf, true));
    return x;
}
__device__ __forceinline__ void post_rows(const float* r_k, const float* gn_g, const float* gn_b, unsigned char* ws, int gw, int ngw, int lane) {
    const bf16_t* OF = (const bf16_t*)(ws + WS_OF); const bf16_t* OB = (const bf16_t*)(ws + WS_OB);
    const float* OPR = (const float*)(ws + WS_OPR); const float* VS = (const float*)(ws + WS_VS);
    const float* KTF = (const float*)(ws + WS_OPKT); const float* KTB = KTF + (size_t)MC * D;
    const bf16_t* G = (const bf16_t*)(ws + WS_G); bf16_t* ORW = (bf16_t*)(ws + WS_ORW);
    const int hg = lane >> 4, sub = lane & 15;
    for (int row = gw; row < MC; row += ngw) {
        const size_t ro = (size_t)row * D;
#pragma unroll 2
        for (int pass = 0; pass < 4; ++pass) {
            const int c = (4 * pass + hg) * 64 + sub * 4; const size_t o = ro + c;
            const u32x2 wf = *(const u32x2*)(OF + o), wb = *(const u32x2*)(OB + o), wg = *(const u32x2*)(G + o);
            const f32x4 r4 = *(const f32x4*)(OPR + o), ktf = *(const f32x4*)(KTF + o), ktb = *(const f32x4*)(KTB + o), v4 = *(const f32x4*)(VS + o);
            const f32x4 rk = *(const f32x4*)(r_k + c), gg = *(const f32x4*)(gn_g + c), gb = *(const f32x4*)(gn_b + c);
            f32x4 ov; ov.x = bflo(wf.x) + bflo(wb.x); ov.y = bfhi(wf.x) + bfhi(wb.x); ov.z = bflo(wf.y) + bflo(wb.y); ov.w = bfhi(wf.y) + bfhi(wb.y);
            const float mean = rowsum16((ov.x + ov.y) + (ov.z + ov.w)) * (1.0f / 64.0f);
            const f32x4 dv = ov - mean;
            const float var = rowsum16((dv.x * dv.x + dv.y * dv.y) + (dv.z * dv.z + dv.w * dv.w)) * (1.0f / 64.0f);
            const f32x4 bt = r4 * (ktf + ktb) * rk;
            const float bs = rowsum16((bt.x + bt.y) + (bt.z + bt.w));
            const float rstd = rsqrtf(var + GN_EPS);
            f32x4 g4; g4.x = bflo(wg.x); g4.y = bfhi(wg.x); g4.z = bflo(wg.y); g4.w = bfhi(wg.y);
            const f32x4 y = (dv * rstd * gg + gb + v4 * bs) * g4;
            u32x2 w; w.x = pk2(y.x, y.y); w.y = pk2(y.z, y.w); *(u32x2*)(ORW + o) = w;
        }
    }
}

#define DPPQ(q) "quad_perm:[" #q "," #q "," #q "," #q "] row_mask:0xf bank_mask:0xf"
#define FMAC_DPP(acc, x, s, q) asm("v_fmac_f32_dpp %0, %1, %2 " DPPQ(q) : "+v"(acc) : "v"(x), "v"(s))
#define MUL_DPP(dst, x, s, q) asm("v_mul_f32_dpp %0, %1, %2 " DPPQ(q) : "=v"(dst) : "v"(x), "v"(s))
#define LBAR() asm volatile("s_waitcnt lgkmcnt(0)\n\ts_barrier" ::: "memory")

typedef float f32x2s __attribute__((ext_vector_type(2)));
struct ScanCtx {
    const float* ga[6]; bf16_t* po; long r0, dstep; int T;
    LAS float* part; LAS float* opart; LAS float* ring; int wid, lane;
};
constexpr int SCAN_RING = 16, SCAN_SLOTF = 6 * 64;
__device__ __forceinline__ void scan_hload(const ScanCtx& C, int u, float (&R)[6]) {
    const int uu = u < C.T ? u : C.T - 1; const long ro = (C.r0 + C.dstep * (long)uu) * D;
#pragma unroll
    for (int a = 0; a < 6; ++a) R[a] = C.ga[a][ro];
}
__device__ __forceinline__ void scan_hwrite(const ScanCtx& C, int u, const float (&R)[6]) {
    LAS float* sl = C.ring + (u & (SCAN_RING - 1)) * SCAN_SLOTF + C.lane;
#pragma unroll
    for (int a = 0; a < 6; ++a) sl[a * 64] = R[a];
}
__device__ __forceinline__ void scan_ld4(const LAS float* p, f32x4 (&v)[4]) {
#pragma unroll
    for (int q = 0; q < 4; ++q) v[q] = *(const LAS f32x4*)(p + 4 * q);
}
__device__ __forceinline__ void scan_chain(unsigned char* ws, LAS unsigned char* lds, int s, int h, int d, int T, int tbeg, int nsteps, int mode, bf16_t* obase, float* sd) {
    int tid_ = threadIdx.x; asm volatile("" : "+v"(tid_));
    const int tid = tid_, lane = tid & 63, wid = __builtin_amdgcn_readfirstlane(tid >> 6);
    ScanCtx C; C.T = nsteps; C.wid = wid; C.lane = lane;
    const int col = h * 64; const size_t dofs = (size_t)d * MC * D;
    C.ga[0] = (const float*)(ws + WS_OPKH) + col + lane; C.ga[1] = (const float*)(ws + WS_OPW) + dofs + col + lane; C.ga[2] = (const float*)(ws + WS_OPAK) + dofs + col + lane;
    C.ga[3] = (const float*)(ws + WS_OPKT) + dofs + col + lane; C.ga[4] = (const float*)(ws + WS_OPR) + col + lane; C.ga[5] = (const float*)(ws + WS_VS) + col + lane;
    C.po = obase + col + lane;
    C.dstep = d ? -1 : 1; C.r0 = (d ? (long)s * T + T - 1 : (long)s * T) + C.dstep * (long)tbeg;
    C.part = (LAS float*)lds; C.opart = (LAS float*)(lds + 2048); C.ring = (LAS float*)(lds + 18432);
    if (wid < 4) {
        float S[16];
#pragma unroll
        for (int i = 0; i < 16; ++i) S[i] = (mode && lane == 16 * wid + i) ? 1.f : 0.f;
        LBAR();
        f32x4 kh[4]; scan_ld4(C.ring + wid * 16, kh);
        int par = 0;
        for (int t0 = 0; t0 < nsteps; t0 += 8) {
#pragma unroll
            for (int i = 0; i < 8; ++i) {
                const LAS float* sl = C.ring + (((t0 & 8) + i) & (SCAN_RING - 1)) * SCAN_SLOTF;
                f32x4 w4[4], ak[4], kt[4], r4[4];
                scan_ld4(sl + 64 + wid * 16, w4); scan_ld4(sl + 128 + wid * 16, ak); scan_ld4(sl + 192 + wid * 16, kt); scan_ld4(sl + 256 + wid * 16, r4);
                const float vraw = sl[320 + lane];
                f32x4 khn[4]; scan_ld4(C.ring + (((t0 & 8) + i + 1) & (SCAN_RING - 1)) * SCAN_SLOTF + wid * 16, khn);
                float p0 = 0.f, p1 = 0.f, p2 = 0.f, p3 = 0.f;
#pragma unroll
                for (int q = 0; q < 4; ++q) { p0 = fmaf(kh[q].x, S[4 * q], p0); p1 = fmaf(kh[q].y, S[4 * q + 1], p1); p2 = fmaf(kh[q].z, S[4 * q + 2], p2); p3 = fmaf(kh[q].w, S[4 * q + 3], p3); }
                LAS float* pp = C.part + (i & 1) * 256;
                pp[wid * 64 + lane] = (p0 + p1) + (p2 + p3);
                LBAR();
                const unsigned paddr = (unsigned)(unsigned long)(pp + lane);
                f32x2s r0, r1;
                asm volatile("ds_read2st64_b32 %0, %2 offset1:1\n\tds_read2st64_b32 %1, %2 offset0:2 offset1:3" : "=&v"(r0), "=&v"(r1) : "v"(paddr) : "memory");
                asm volatile("s_waitcnt lgkmcnt(0)" : "+v"(r0), "+v"(r1) :: "memory");
                const float nsk = -((r0.x + r0.y) + (r1.x + r1.y)), vv = mode ? 0.f : vraw;
                float o0 = 0.f, o1 = 0.f, o2 = 0.f, o3 = 0.f;
#pragma unroll
                for (int q = 0; q < 4; ++q) {
                    S[4 * q]     = fmaf(S[4 * q],     w4[q].x, fmaf(nsk, ak[q].x, vv * kt[q].x)); o0 = fmaf(r4[q].x, S[4 * q],     o0);
                    S[4 * q + 1] = fmaf(S[4 * q + 1], w4[q].y, fmaf(nsk, ak[q].y, vv * kt[q].y)); o1 = fmaf(r4[q].y, S[4 * q + 1], o1);
                    S[4 * q + 2] = fmaf(S[4 * q + 2], w4[q].z, fmaf(nsk, ak[q].z, vv * kt[q].z)); o2 = fmaf(r4[q].z, S[4 * q + 2], o2);
                    S[4 * q + 3] = fmaf(S[4 * q + 3], w4[q].w, fmaf(nsk, ak[q].w, vv * kt[q].w)); o3 = fmaf(r4[q].w, S[4 * q + 3], o3);
                }
                C.opart[(par * 8 + i) * 256 + wid * 64 + lane] = (o0 + o1) + (o2 + o3);
#pragma unroll
                for (int q = 0; q < 4; ++q) kh[q] = khn[q];
            }
            LBAR();
            par ^= 1;
        }
        if (sd) {
#pragma unroll
            for (int i = 0; i < 4; ++i) *(f32x4*)(sd + (size_t)lane * 64 + 16 * wid + 4 * i) = (f32x4){S[4 * i], S[4 * i + 1], S[4 * i + 2], S[4 * i + 3]};
        }
    } else {
        const int hsl = wid - 4; int par = 0;
        float R[6];
#pragma unroll
        for (int k = 0; k < 2; ++k) { scan_hload(C, hsl + 4 * k, R); scan_hwrite(C, hsl + 4 * k, R); }
        scan_hload(C, hsl + 8, R);
        LBAR();
        for (int t0 = 0; t0 < nsteps; t0 += 8) {
#pragma unroll
            for (int i = 0; i < 8; ++i) {
                if ((i & 3) == hsl) { scan_hwrite(C, t0 + i + 8, R); scan_hload(C, t0 + i + 12, R); }
                LBAR();
            }
            LBAR();
#pragma unroll
            for (int k = 0; k < 2; ++k) { const int slot = hsl + 4 * k; const LAS float* op = C.opart + (par * 8 + slot) * 256 + lane;
                const float o = (op[0] + op[64]) + (op[128] + op[192]);
                C.po[(C.r0 + C.dstep * (long)(t0 + slot)) * D] = (bf16_t)(pk2(o, o) & 0xffffu); }
            par ^= 1;
        }
    }
    LBAR();
}

__device__ __forceinline__ void scan_fixup_tile(const bf16_t* Q, const float* sd, bf16_t* O, int lane) {
    const int fr = lane & 15, fq = lane >> 4;
    bf16x8v a[2][2];
#pragma unroll
    for (int mt = 0; mt < 2; ++mt)
#pragma unroll
        for (int ks = 0; ks < 2; ++ks) a[mt][ks] = *(const bf16x8v*)(Q + (size_t)(mt * 16 + fr) * D + ks * 32 + 8 * fq);
#pragma unroll 2
    for (int nt = 0; nt < 4; ++nt) {
        f32x4 acc0 = {0.f, 0.f, 0.f, 0.f}, acc1 = {0.f, 0.f, 0.f, 0.f};
#pragma unroll
        for (int ks = 0; ks < 2; ++ks) {
            const float* bp = sd + (size_t)(nt * 16 + fr) * 64 + ks * 32 + 8 * fq;
            const f32x4 b0 = *(const f32x4*)bp, b1 = *(const f32x4*)(bp + 4);
            const u32x4 bw = pack8(b0, b1); const bf16x8v b = __builtin_bit_cast(bf16x8v, bw);
            acc0 = __builtin_amdgcn_mfma_f32_16x16x32_bf16(b, a[0][ks], acc0, 0, 0, 0); acc1 = __builtin_amdgcn_mfma_f32_16x16x32_bf16(b, a[1][ks], acc1, 0, 0, 0);
        }
#pragma unroll
        for (int mt = 0; mt < 2; ++mt) {
            bf16_t* op = O + (size_t)(mt * 16 + fr) * D + nt * 16 + 4 * fq; const f32x4 acc = mt ? acc1 : acc0;
            const u32x2 w = *(const u32x2*)op; u32x2 o;
            o.x = pk2(bflo(w.x) + acc.x, bfhi(w.x) + acc.y); o.y = pk2(bflo(w.y) + acc.z, bfhi(w.y) + acc.w);
            *(u32x2*)op = o;
        }
    }
}

#define RLX_AGENT __ATOMIC_RELAXED, __HIP_MEMORY_SCOPE_AGENT
#define XB_TMO      128
#define XB_XCNT(j)  (256  + 64 * (j))
#define XB_XSUB(j)  (1280 + 64 * (j))
#define XB_XGEN(j)  (2304 + 64 * (j))
#define XB_TOP      3328
#define XB_TOPGEN   3392
#define XCD_BAR_WORDS 3456
#define XB_SPIN_CAP (1u << 28)

__device__ __forceinline__ unsigned xb_ld(unsigned* p)              { return __hip_atomic_load(p, __ATOMIC_RELAXED, __HIP_MEMORY_SCOPE_AGENT); }
__device__ __forceinline__ unsigned xb_add(unsigned* p, unsigned v) { return __hip_atomic_fetch_add(p, v, __ATOMIC_RELAXED, __HIP_MEMORY_SCOPE_AGENT); }
__device__ __forceinline__ unsigned xb_xcc_id() { return (unsigned)__builtin_amdgcn_s_getreg((3 << 11) | 20) & 0xFu; }
#define XB_SPIN(cond, bar) do { unsigned _sp = 0; while (cond) { __builtin_amdgcn_s_sleep(1); \
    if ((++_sp & 255u) == 0u) { if (xb_ld(&(bar)[XB_TMO])) break; if (_sp > XB_SPIN_CAP) { atomicAdd(&(bar)[XB_TMO], 1u); break; } } } } while (0)

struct XcdBarrier {
    unsigned* bar; unsigned x;
    volatile LAS unsigned* st;
};

__device__ __forceinline__ XcdBarrier xcd_barrier_post(unsigned* bar, volatile LAS unsigned* st) {
    XcdBarrier b; b.bar = bar; b.x = xb_xcc_id(); b.st = st;
    if (threadIdx.x == 0) (void)xb_add(&bar[XB_XCNT(b.x)], 1u);
    return b;
}
__device__ __forceinline__ void xcd_barrier_complete(unsigned* bar, unsigned x, unsigned& nloc, unsigned& nx) {
    const unsigned G = gridDim.x * gridDim.y * gridDim.z;
    unsigned sum, cnt, mine, sp = 0u;
    for (;;) {
        sum = 0u; cnt = 0u; mine = 0u;
#pragma unroll
        for (unsigned j = 0; j < 16; ++j) { const unsigned c = xb_ld(&bar[XB_XCNT(j)]); sum += c; cnt += (c > 0u) ? 1u : 0u; mine = (j == x) ? c : mine; }
        if (sum == G) break;
        __builtin_amdgcn_s_sleep(1);
        if ((++sp & 255u) == 0u) { if (xb_ld(&bar[XB_TMO])) break; if (sp > XB_SPIN_CAP) { atomicAdd(&bar[XB_TMO], 1u); break; } }
    }
    nloc = mine > 0u ? mine : 1u; nx = cnt > 0u ? cnt : 1u;
}

__device__ __forceinline__ void xcd_barrier(const XcdBarrier& b) {
    asm volatile("s_waitcnt vmcnt(0)" ::: "memory");
    __syncthreads();
    if (threadIdx.x == 0) {
        unsigned* bar = b.bar;
        __builtin_amdgcn_s_waitcnt(0);
        unsigned nloc = b.st[0], nx = b.st[1];
        if (nloc == 0u) { xcd_barrier_complete(bar, b.x, nloc, nx); b.st[0] = nloc; b.st[1] = nx; }
        const unsigned old = xb_add(&bar[XB_XSUB(b.x)], 1u);
        const unsigned gen = old / nloc;
        if (old + 1u == (gen + 1u) * nloc) {
            __builtin_amdgcn_fence(__ATOMIC_RELEASE, "agent");
            asm volatile("s_waitcnt vmcnt(0)" ::: "memory");
            const unsigned og = xb_add(&bar[XB_TOP], 1u);
            const unsigned tg = og / nx;
            if (og + 1u == (tg + 1u) * nx) xb_add(&bar[XB_TOPGEN], 1u);
            else XB_SPIN(xb_ld(&bar[XB_TOPGEN]) == tg, bar);
            __builtin_amdgcn_fence(__ATOMIC_ACQUIRE, "agent");
            xb_add(&bar[XB_XGEN(b.x)], 1u);
            asm volatile("s_waitcnt vmcnt(0)" ::: "memory");
        } else {
            XB_SPIN(xb_ld(&bar[XB_XGEN(b.x)]) == gen, bar);
            __builtin_amdgcn_fence(__ATOMIC_ACQUIRE, "agent");
            asm volatile("s_waitcnt vmcnt(0)" ::: "memory");
        }
    }
    __syncthreads();
}
__global__ void __launch_bounds__(NTHREADS, 2) mega_fwd(Args A) {
    extern __shared__ __attribute__((aligned(16))) unsigned char lds_raw[];
    LAS unsigned char* lds = (LAS unsigned char*)lds_raw;
    cg::grid_group grid = cg::this_grid();
#define TIDV int tid_ = threadIdx.x; asm volatile("" : "+v"(tid_)); const int tid = tid_, lane = tid & 63, wave = __builtin_amdgcn_readfirstlane(tid >> 6); \
    const int G = gridDim.x, gw = blockIdx.x * NWAVES + wave, ngw = G * NWAVES, gtid = blockIdx.x * NTHREADS + tid, gthreads = G * NTHREADS; \
    (void)lane; (void)gw; (void)ngw; (void)gtid; (void)gthreads;

    if (A.ph_hi < 0) grid.sync();
    { volatile LAS unsigned* misc = (volatile LAS unsigned*)(lds + LDS_MISC);
      if (threadIdx.x < 32) misc[threadIdx.x] = 0u;
      __syncthreads(); }
    XcdBarrier bar = xcd_barrier_post((unsigned*)(A.ws + WS_CTL) + 4096, (volatile LAS unsigned*)(lds + LDS_MISC) + 8);
    for (int ph = A.ph_lo; ph < A.ph_hi; ++ph) {
        if (ph > A.ph_lo) xcd_barrier(bar);
        int z = 0; asm volatile("" : "+s"(z));
        unsigned char* ws = A.ws + z;
        if (ph == 0) {
            TIDV
            LAS float* scr = (LAS float*)(lds + wave * 16384);
            constexpr int I_IN = 16 * (NIN / 32), I_SQ = 16 * 32, I_F1 = 16 * 128, I_F2 = 64 * 32, I_G = 2 * 32, I_U = 32;
            constexpr int NITEMS = I_IN + 3 * I_SQ + I_F1 + I_F2 + I_G + 4 * I_U;
            for (int it = gw; it < NITEMS; it += ngw) {
                int r = it;
                if (r < I_IN) { p0_transpose_item(INP(2), D, NIN, (bf16_t*)(ws + WS_WIN), scr, r, lane); continue; } r -= I_IN;
                if (r < I_SQ) { p0_transpose_item(INP(17), D, D, (bf16_t*)(ws + WS_WPR), scr, r, lane); continue; } r -= I_SQ;
                if (r < I_SQ) { p0_transpose_item(INP(18), D, D, (bf16_t*)(ws + WS_WPA), scr, r, lane); continue; } r -= I_SQ;
                if (r < I_SQ) { p0_transpose_item(INP(19), D, D, (bf16_t*)(ws + WS_WOUT), scr, r, lane); continue; } r -= I_SQ;
                if (r < I_F1) { p0_transpose_item(INP(22), D, FF, (bf16_t*)(ws + WS_WF1), scr, r, lane); continue; } r -= I_F1;
                if (r < I_F2) { p0_transpose_item(INP(23), FF, D, (bf16_t*)(ws + WS_WF2), scr, r, lane); continue; } r -= I_F2;
                if (r < I_G) { p0_transpose_item(INP(9), 128, D, (bf16_t*)(ws + WS_GUP), scr, r, lane); continue; } r -= I_G;
                { const int which = r / I_U, it2 = r % I_U, dd = which & 1;
                  p0_transpose_item((which < 2 ? INP(6) : INP(8)) + (size_t)dd * 64 * 1024, 64, D, (bf16_t*)(ws + (which < 2 ? WS_WUP : WS_AUP)) + (size_t)dd * 1024 * 64, scr, it2, lane); }
            }
            cvt_x_chunk(INP(0), (bf16_t*)(ws + WS_XB), gtid, gthreads);
            continue;
        }
        if (ph == 1 + 9 * NCHUNK) {
            TIDV
            ln_rows(A.out + (size_t)(NCHUNK - 1) * MC * D, INP(24), INP(25), nullptr, gw, ngw, lane);
            continue;
        }
        const int c = (ph - 1) / 9, sub = (ph - 1) % 9;
        const int T = (c < 4) ? 2048 : 8192;
        const float* xin = (c < 4) ? INP(0) + (size_t)c * MC * D : INP(1);
        float* outc = A.out + (size_t)c * MC * D;
        if (sub == 0) {
            { Epi8<FZ> e{{(bf16_t*)(ws + WS_Z)}};
              run_gemm(lds, (const bf16_t*)(ws + WS_XB), (const bf16_t*)(ws + WS_WIN), MC, NINP, D, e); }
            if (c > 0) { TIDV ln_rows(A.out + (size_t)(c - 1) * MC * D, INP(24), INP(25), nullptr, gw, ngw, lane); }
        } else if (sub == 1) {
            TIDV
            const int G_ = gridDim.x, b_ = blockIdx.x, tile_lo = (int)(((long)(MC / 32) * b_) / G_), tile_hi = (int)(((long)(MC / 32) * (b_ + 1)) / G_);
            prep_rows(INP(3), INP(4), INP(10), INP(15), INP(16), ws, T, tile_lo * 32 + wave, NWAVES, tile_hi * 32, lane, true);
            __syncthreads();
            const int nit = (tile_hi - tile_lo) * 40;
            for (int it = wave; it < nit; it += NWAVES) {
                const int mt = it / 40, r = it % 40, which = r >> 3, m0 = (tile_lo + mt) * 32, n0 = (r & 7) * 128;
                if (which < 2) { FW f{INP(5) + which * 1024, (float*)(ws + WS_OPW) + (size_t)which * MC * D};
                    wave_gemm_tile<64>((const bf16_t*)(ws + WS_TW), which * 64, (const bf16_t*)(ws + WS_WUP) + (size_t)which * 1024 * 64, m0, n0, lane, f); }
                else if (which < 4) { const int dd = which - 2;
                    FA f{INP(7) + dd * 1024, INP(11), (const bf16_t*)(ws + WS_KS), (const float*)(ws + WS_OPKH), (float*)(ws + WS_OPAK) + (size_t)dd * MC * D, (float*)(ws + WS_OPKT) + (size_t)dd * MC * D};
                    wave_gemm_tile<64>((const bf16_t*)(ws + WS_AD), dd * 64, (const bf16_t*)(ws + WS_AUP) + (size_t)dd * 1024 * 64, m0, n0, lane, f); }
                else { FG f{(bf16_t*)(ws + WS_G)};
                    wave_gemm_tile<128>((const bf16_t*)(ws + WS_SG), 0, (const bf16_t*)(ws + WS_GUP), m0, n0, lane, f); }
            }
        } else if (sub == 2) {
            const int nseq = MC / T, nchain = (c < 4) ? nseq * 32 : 192, nqb = T / 256, natt = nseq * 8 * nqb;
            LAS unsigned* qslot = (LAS unsigned*)(lds + LDS_MISC); const int tid = threadIdx.x;
            for (;;) {
                __syncthreads();
                if (tid == 0) qslot[0] = atomicAdd((unsigned*)(ws + WS_CTL) + 64 * c, 1u);
                __syncthreads();
                const int item = __builtin_amdgcn_readfirstlane((int)qslot[0]);
                if (item >= nchain + natt) break;
                if (item < nchain) {
                    if (c < 4) scan_chain(ws, lds, item >> 5, (item >> 1) & 15, item & 1, T, 0, T, 0, (bf16_t*)(ws + ((item & 1) ? WS_OB : WS_OF)), nullptr);
                    else {
                        const int ch = item / 3, job = item % 3, d_ = ch & 1;
                        bf16_t* ob = (job == 2) ? (bf16_t*)(A.out + (size_t)(NCHUNK - 1) * MC * D) + (size_t)d_ * MC * D : (bf16_t*)(ws + (d_ ? WS_OB : WS_OF));
                        scan_chain(ws, lds, ch >> 5, (ch >> 1) & 15, d_, T, job ? 4096 : 0, 4096, job == 2, ob, job == 0 ? (float*)(ws + WS_END) + (size_t)ch * 4096 : nullptr);
                    }
                }
                else {
                    const int u = item - nchain, qb = u % nqb, hq = (u / nqb) & 7, s = u / (nqb * 8);
                    const att::bf16* qkv = (const att::bf16*)(ws + WS_Z) + (size_t)s * T * ZLD;
                    att::attn_dense_body(qkv + (size_t)qb * 256 * ZLD + ZQ + hq * 128, qkv + ZK + (hq >> 2) * 128, qkv + ZV + (hq >> 2) * 128,
                                         (att::bf16*)(ws + WS_OATT) + ((size_t)s * T + (size_t)qb * 256) * D + hq * 128, T, (char*)lds_raw);
                }
            }
        } else if (sub == 3) {
            TIDV
            if (c == 4) {
                for (int it = gw; it < 64 * 128; it += ngw) {
                    const int ch = it >> 7, tile = it & 127, s_ = ch >> 5, h_ = (ch >> 1) & 15, d_ = ch & 1;
                    const size_t row0 = (size_t)s_ * T + (d_ ? 0 : 4096) + (size_t)tile * 32;
                    scan_fixup_tile((const bf16_t*)(A.out + (size_t)(NCHUNK - 1) * MC * D) + (size_t)d_ * MC * D + row0 * D + h_ * 64, (const float*)(ws + WS_END) + (size_t)ch * 4096,
                                    (bf16_t*)(ws + (d_ ? WS_OB : WS_OF)) + row0 * D + h_ * 64, lane);
                }
                xcd_barrier(bar);
            }
            post_rows(INP(12), INP(13), INP(14), ws, gw, ngw, lane);
        } else if (sub == 4) {
            { Epi4<FP1> e{{(const bf16_t*)(ws + WS_Z), (float*)(ws + WS_M32)}};
              run_gemm(lds, (const bf16_t*)(ws + WS_ORW), (const bf16_t*)(ws + WS_WPR), MC, D, D, e); }
            { Epi4<FP2> e{{(const bf16_t*)(ws + WS_Z), (const float*)(ws + WS_M32), (bf16_t*)(ws + WS_MB)}};
              run_gemm(lds, (const bf16_t*)(ws + WS_OATT), (const bf16_t*)(ws + WS_WPA), MC, D, D, e); }
        } else if (sub == 5) {
            Epi4<FOut> e{{xin, outc}};
            run_gemm(lds, (const bf16_t*)(ws + WS_MB), (const bf16_t*)(ws + WS_WOUT), MC, D, D, e);
        } else if (sub == 6) {
            TIDV
            ln_rows(outc, INP(20), INP(21), (bf16_t*)(ws + WS_HB), gw, ngw, lane);
            if (c + 1 < NCHUNK) cvt_x_chunk((c + 1 < 4) ? INP(0) + (size_t)(c + 1) * MC * D : INP(1), (bf16_t*)(ws + WS_XB), gtid, gthreads);
        } else if (sub == 7) {
            Epi8<FF1> e{{(bf16_t*)(ws + WS_FFH)}};
            run_gemm(lds, (const bf16_t*)(ws + WS_HB), (const bf16_t*)(ws + WS_WF1), MC, FF, D, e);
        } else {
            Epi4<FF2> e{{outc}};
            run_gemm(lds, (const bf16_t*)(ws + WS_FFH), (const bf16_t*)(ws + WS_WF2), MC, D, FF, e);
        }
    }
}

constexpr int NPHASE = 2 + 9 * NCHUNK;

extern "C" void kernel_launch(void* const* d_in, const int* in_sizes, int n_in, void* d_out, int out_size, void* d_ws, size_t ws_size, hipStream_t stream) {
    static int grid = 0;
    if (grid == 0) {
        if (n_in != 26 || out_size != MTOT * D || ws_size < WS_END + 2 * MiB) { fprintf(stderr, "kernel_launch: unexpected shapes n_in %d out %d ws %zu\n", n_in, out_size, ws_size); grid = -1; return; }
        int dev = 0, cus = 0, per_cu = 0;
        hipGetDevice(&dev); hipDeviceGetAttribute(&cus, hipDeviceAttributeMultiprocessorCount, dev);
        if (hipFuncSetAttribute((const void*)mega_fwd, hipFuncAttributeMaxDynamicSharedMemorySize, LDS_BYTES) != hipSuccess) { fprintf(stderr, "kernel_launch: LDS attribute failed\n"); grid = -1; return; }
        if (hipOccupancyMaxActiveBlocksPerMultiprocessor(&per_cu, (const void*)mega_fwd, NTHREADS, LDS_BYTES) != hipSuccess || per_cu < 1) per_cu = 1;
        (void)hipGetLastError();
        grid = cus * (per_cu > 1 ? 1 : per_cu);
    }
    if (grid < 0) return;
    hipMemsetAsync((char*)d_ws + WS_CTL, 0, 64 * 1024, stream);
    Args a{};
    for (int i = 0; i < 26; ++i) a.in[i] = (const float*)d_in[i];
    a.out = (float*)d_out; a.ws = (unsigned char*)d_ws; a.ph_lo = 0; a.ph_hi = NPHASE;
    void* args[] = {&a};
    hipError_t e = hipLaunchCooperativeKernel((const void*)mega_fwd, dim3(grid), dim3(NTHREADS), args, LDS_BYTES, stream);
    if (e != hipSuccess) fprintf(stderr, "cooperative launch failed: %s (grid %d)\n", hipGetErrorString(e), grid);
}
```

```cpp
#include <hip/hip_runtime.h>
#include <hip/hip_bf16.h>
#include <hip/hip_cooperative_groups.h>
#include <cstdio>
#include <cstdint>
namespace cg = cooperative_groups;
namespace pg8 {
#define PG8_LAS __attribute__((address_space(3)))
typedef unsigned short bf16_t;
typedef short bf16x8 __attribute__((ext_vector_type(8)));
typedef float f32x4 __attribute__((ext_vector_type(4)));
typedef unsigned u32x4 __attribute__((ext_vector_type(4)));
constexpr int BM = 256, BK = 64, HALF = 128, HTB = HALF * BK * 2  , STAGE_BYTES = 8 * HTB, NXCD = 8, WGM = 8;

__host__ __device__ __forceinline__ int lds_byte(int r, int c) { const int st = (r >> 4) * 2 + (c >> 5), rr = r & 15, cc = c & 31, ob = rr * 64 + cc * 2; return st * 1024 + (ob ^ (((ob >> 9) & 1) << 5)); }
__host__ __device__ __forceinline__ void stage_rc(int b, int& R, int& C) { const int st = b / 1024, sb = b % 1024, swz = sb ^ (((sb >> 9) & 1) << 5); R = (st >> 1) * 16 + swz / 64; C = (st & 1) * 32 + (swz % 64) / 2; }
__host__ __device__ __forceinline__ int perm32(int rho) { const int n = rho >> 4, i = rho & 15; return 8 * (i >> 2) + 4 * n + (i & 3); }

struct Unit { int pm, pn; };
struct Gemm { const bf16_t* A; const bf16_t* Bt; int M, N, K; };

struct StaticOrder {
    int nM, nN, nwg, G, c;
    __host__ __device__ void init(int M, int N, int G_, int c_) { nM = M / BM; nN = N / BM; nwg = nM * nN; G = G_; c = c_; }
    __host__ __device__ bool next(int i, Unit& u) const {
        const long L = (long)i * G + c; if (L >= nwg) return false;
        int wgid = (int)L; { const int q = nwg / NXCD, r = nwg % NXCD, xcd = wgid % NXCD, off = wgid / NXCD; wgid = (xcd < r ? xcd * (q + 1) : r * (q + 1) + (xcd - r) * q) + off; }
        const int nig = WGM * nN, gid = wgid / nig, fm = gid * WGM, gsz = (nM - fm) < WGM ? (nM - fm) : WGM;
        u.pm = fm + ((wgid % nig) % gsz); u.pn = (wgid % nig) / gsz; return true;
    }
    __device__ __forceinline__ void a_ready(const Unit&) const {}
    __device__ __forceinline__ void done(const Unit&) const {}
};
__device__ __forceinline__ unsigned cvt_pk_bf16(float lo, float hi) { unsigned r; asm volatile("v_cvt_pk_bf16_f32 %0, %1, %2" : "=v"(r) : "v"(lo), "v"(hi)); return r; }
typedef float f32x2 __attribute__((ext_vector_type(2)));
template <class Epi, class Sched, bool ALIGN_EPI = false, bool SP2 = false>
__device__ __forceinline__ void gemm_phase(PG8_LAS unsigned char* lds, const Gemm g, const Sched& S, const Epi& E) {
    int tid_ = threadIdx.x; asm volatile("" : "+v"(tid_));
    const int tid = tid_, wid = __builtin_amdgcn_readfirstlane(tid >> 6), lane = tid & 63, wr = wid >> 2, wc = wid & 3, fr = lane & 15, fq = lane >> 4;
    const int K = g.K, nt = K / BK;
    unsigned voffA[2], voffB[2];
#pragma unroll
    for (int i = 0; i < 2; ++i) { int R, C; stage_rc(tid * 16 + i * 8192, R, C); const int Rb = Epi::PERM ? ((R & ~31) + perm32(R & 31)) : R;
        voffA[i] = (unsigned)(R * K + C) * 2u; voffB[i] = (unsigned)(Rb * K + C) * 2u; }
    const size_t kstep = (size_t)(BK * 2);
    const size_t hstep = (size_t)HALF * K * 2;
    const size_t tstep = 2 * hstep;
    const unsigned ldsw = (unsigned)wid * 1024u;
    const int aoff = lds_byte(wr * 64 + fr, fq * 8), boff = lds_byte(wc * 32 + fr, fq * 8);
#define PG8_SA(b, h) (((b) * 2 + (h)) * HTB)
#define PG8_SB(b, h) ((4 + (b) * 2 + (h)) * HTB)
#define PG8_STAGE(bufoff, gbase, voff) do { _Pragma("unroll") for (int _i = 0; _i < 2; ++_i) \
        __builtin_amdgcn_global_load_lds((const unsigned*)((const char*)(gbase) + (voff)[_i]), (PG8_LAS unsigned*)(lds + (bufoff) + ldsw + _i * 8192), 16, 0, 0); } while (0)
#define PG8_LDA(dst, b, h) do { _Pragma("unroll") for (int m = 0; m < 4; ++m) _Pragma("unroll") for (int k = 0; k < 2; ++k) dst[m][k] = *(const PG8_LAS bf16x8*)(lds + PG8_SA(b, h) + aoff + m * 2048 + k * 1024); } while (0)
#define PG8_LDB(dst, b, h) do { _Pragma("unroll") for (int n = 0; n < 2; ++n) _Pragma("unroll") for (int k = 0; k < 2; ++k) dst[n][k] = *(const PG8_LAS bf16x8*)(lds + PG8_SB(b, h) + boff + n * 2048 + k * 1024); } while (0)
#define PG8_MMA(ai, bj, At, Bt) do { __builtin_amdgcn_s_setprio(1); _Pragma("unroll") for (int m = 0; m < 4; ++m) _Pragma("unroll") for (int n = 0; n < 2; ++n) _Pragma("unroll") for (int k = 0; k < 2; ++k) \
        acc[ai][bj][m][n] = __builtin_amdgcn_mfma_f32_16x16x32_bf16(Bt[n][k], At[m][k], acc[ai][bj][m][n], 0, 0, 0); __builtin_amdgcn_s_setprio(0); } while (0)
#define PG8_WAIT_V(n) asm volatile("s_waitcnt vmcnt(" #n ")" ::: "memory")
#define PG8_WAIT_L(n) asm volatile("s_waitcnt lgkmcnt(" #n ")" ::: "memory")
#define PG8_BAR __builtin_amdgcn_s_barrier()
#define PG8_SCHED __builtin_amdgcn_sched_barrier(0)
    Unit cur, nxt; int ui = 0;
    if (!S.next(0, cur)) return;
    f32x4 acc[2][2][4][2];
#pragma unroll
    for (int a = 0; a < 2; ++a)
#pragma unroll
        for (int b = 0; b < 2; ++b)
#pragma unroll
            for (int m = 0; m < 4; ++m)
#pragma unroll
                for (int n = 0; n < 2; ++n) acc[a][b][m][n] = (f32x4){0.f, 0.f, 0.f, 0.f};
    bf16x8 At[4][2], B0[2][2], B1[2][2];
    const char* cA = (const char*)g.A + (size_t)cur.pm * tstep; const char* cB = (const char*)g.Bt + (size_t)cur.pn * tstep;
    S.a_ready(cur);
    if constexpr (SP2) {
        PG8_STAGE(PG8_SB(0, 0), cB, voffB); PG8_STAGE(PG8_SB(0, 1), cB + hstep, voffB); PG8_STAGE(PG8_SA(0, 0), cA, voffA); PG8_STAGE(PG8_SA(0, 1), cA + hstep, voffA);
        if (wr == 1) PG8_BAR;
        PG8_WAIT_V(2); PG8_BAR;
        PG8_STAGE(PG8_SB(1, 0), cB + kstep, voffB); PG8_STAGE(PG8_SA(1, 0), cA + kstep, voffA); PG8_STAGE(PG8_SB(1, 1), cB + hstep + kstep, voffB);
        PG8_WAIT_V(6); PG8_BAR;
    } else {
        PG8_STAGE(PG8_SB(0, 0), cB, voffB); PG8_STAGE(PG8_SA(0, 0), cA, voffA); PG8_STAGE(PG8_SB(0, 1), cB + hstep, voffB); PG8_STAGE(PG8_SA(0, 1), cA + hstep, voffA);
        if (wr == 1) PG8_BAR;
        PG8_WAIT_V(4); PG8_BAR;
        PG8_STAGE(PG8_SB(1, 0), cB + kstep, voffB); PG8_STAGE(PG8_SA(1, 0), cA + kstep, voffA); PG8_STAGE(PG8_SB(1, 1), cB + hstep + kstep, voffB);
        PG8_WAIT_V(6); PG8_BAR;
    }
    for (;;) {
        const bool has_next = S.next(ui + 1, nxt);
        const char* nA = has_next ? (const char*)g.A + (size_t)nxt.pm * tstep : cA; const char* nB = has_next ? (const char*)g.Bt + (size_t)nxt.pn * tstep : cB;
        for (int t = 0; t < nt; t += 2) {
            const bool last = (t == nt - 2);
            const char* a1 = cA + (size_t)(t + 1) * kstep;
            const char* a2 = last ? nA : cA + (size_t)(t + 2) * kstep; const char* b2 = last ? nB : cB + (size_t)(t + 2) * kstep;
            const char* a3 = a2 + kstep; const char* b3 = b2 + kstep;
            if (last && has_next) S.a_ready(nxt);
            if constexpr (SP2) {
            PG8_LDB(B0, 0, 0); PG8_LDB(B1, 0, 1); PG8_SCHED; PG8_LDA(At, 0, 0); PG8_STAGE(PG8_SA(1, 1), a1 + hstep, voffA);
            PG8_WAIT_V(8); PG8_WAIT_L(0); PG8_BAR; PG8_MMA(0, 0, At, B0); PG8_MMA(0, 1, At, B1); PG8_BAR; PG8_SCHED;
            PG8_LDA(At, 0, 1); PG8_STAGE(PG8_SB(0, 0), b2, voffB); PG8_STAGE(PG8_SB(0, 1), b2 + hstep, voffB); PG8_STAGE(PG8_SA(0, 0), a2, voffA);
            PG8_WAIT_V(8); PG8_WAIT_L(0); PG8_BAR; PG8_MMA(1, 0, At, B0); PG8_MMA(1, 1, At, B1); PG8_BAR; PG8_SCHED;
            PG8_LDB(B0, 1, 0); PG8_LDB(B1, 1, 1); PG8_SCHED; PG8_LDA(At, 1, 0); PG8_STAGE(PG8_SA(0, 1), a2 + hstep, voffA);
            PG8_WAIT_V(8); PG8_WAIT_L(0); PG8_BAR; PG8_MMA(0, 0, At, B0); PG8_MMA(0, 1, At, B1); PG8_BAR; PG8_SCHED;
            PG8_LDA(At, 1, 1); PG8_STAGE(PG8_SB(1, 0), b3, voffB); PG8_STAGE(PG8_SB(1, 1), b3 + hstep, voffB); PG8_STAGE(PG8_SA(1, 0), a3, voffA);
            PG8_WAIT_V(8); PG8_WAIT_L(0); PG8_BAR; PG8_MMA(1, 0, At, B0); PG8_MMA(1, 1, At, B1); PG8_BAR; PG8_SCHED;
            } else {
            PG8_LDB(B0, 0, 0); PG8_SCHED; PG8_LDA(At, 0, 0); PG8_STAGE(PG8_SA(1, 1), a1 + hstep, voffA);
            PG8_WAIT_L(8); PG8_BAR; PG8_WAIT_L(0); PG8_MMA(0, 0, At, B0); PG8_BAR; PG8_SCHED;
            PG8_LDB(B1, 0, 1); PG8_STAGE(PG8_SB(0, 0), b2, voffB);
            PG8_BAR; PG8_WAIT_L(0); PG8_MMA(0, 1, At, B1); PG8_BAR;
            PG8_LDA(At, 0, 1); PG8_STAGE(PG8_SA(0, 0), a2, voffA);
            PG8_BAR; PG8_WAIT_L(0); PG8_MMA(1, 0, At, B0); PG8_BAR; PG8_SCHED;
            PG8_STAGE(PG8_SB(0, 1), b2 + hstep, voffB);
            PG8_WAIT_V(6); PG8_BAR; PG8_MMA(1, 1, At, B1); PG8_BAR;
            PG8_LDB(B0, 1, 0); PG8_SCHED; PG8_LDA(At, 1, 0); PG8_STAGE(PG8_SA(0, 1), a2 + hstep, voffA);
            PG8_WAIT_L(8); PG8_BAR; PG8_WAIT_L(0); PG8_MMA(0, 0, At, B0); PG8_BAR; PG8_SCHED;
            PG8_LDB(B1, 1, 1); PG8_STAGE(PG8_SB(1, 0), b3, voffB);
            PG8_BAR; PG8_WAIT_L(0); PG8_MMA(0, 1, At, B1); PG8_BAR;
            PG8_LDA(At, 1, 1); PG8_STAGE(PG8_SA(1, 0), a3, voffA);
            PG8_BAR; PG8_WAIT_L(0); PG8_MMA(1, 0, At, B0); PG8_BAR; PG8_SCHED;
            PG8_STAGE(PG8_SB(1, 1), b3 + hstep, voffB);
            PG8_WAIT_V(6); PG8_BAR; PG8_MMA(1, 1, At, B1); PG8_BAR;
            }
        }
        if constexpr (ALIGN_EPI) { if (wr == 0) PG8_BAR; }
        if constexpr (!Epi::AFTER_DRAIN) { E(acc, cur, wr, wc, fr, fq); S.done(cur); }
        if (!has_next) break;
#pragma unroll
        for (int a = 0; a < 2; ++a)
#pragma unroll
            for (int b = 0; b < 2; ++b)
#pragma unroll
                for (int m = 0; m < 4; ++m)
#pragma unroll
                    for (int n = 0; n < 2; ++n) acc[a][b][m][n] = (f32x4){0.f, 0.f, 0.f, 0.f};
        cur = nxt; cA = nA; cB = nB; ++ui;
        if constexpr (ALIGN_EPI) { if (wr == 1) PG8_BAR; }
    }
    PG8_WAIT_V(0);
    if constexpr (!ALIGN_EPI) { if (wr == 0) PG8_BAR; }
    PG8_BAR;
    if constexpr (Epi::AFTER_DRAIN) { E.fused(acc, cur, wr, wc, fr, fq, lds, wid, lane); S.done(cur); }
#undef PG8_SA
#undef PG8_SB
#undef PG8_STAGE
#undef PG8_LDA
#undef PG8_LDB
#undef PG8_MMA
#undef PG8_WAIT_V
#undef PG8_WAIT_L
#undef PG8_BAR
#undef PG8_SCHED
}
}
namespace att {
using bf16 = __hip_bfloat16;
constexpr int   D = 128, NW = 8, QBLK = 32, KVBLK = 64;
constexpr float SCALE = 0.088388347648318440f;
constexpr float THR = 8.f;
constexpr int LDQ = 7168, LDK = 7168, LDO = 1024;
constexpr size_t SHM_V = KVBLK * D * 2, SHM_K = KVBLK * D * 2, SHM_ATTN = 2 * SHM_V + 2 * SHM_K + NW * 64 * 4;
using bf16x8 = __attribute__((ext_vector_type(8))) short;
using s16x4  = __attribute__((ext_vector_type(4))) short;
using f32x16 = __attribute__((ext_vector_type(16))) float;
using u32x4  = __attribute__((ext_vector_type(4))) unsigned;
#define KSWZ(row, colB) ((row) * 256 + ((colB) ^ (((row) & 7) << 4)))
#define SBAR() __builtin_amdgcn_sched_barrier(0)
__device__ __forceinline__ int crow(int r, int hi) { return (r & 3) + 8 * (r >> 2) + 4 * hi; }
__device__ __forceinline__ unsigned cvtpk(float lo, float hi) {
  unsigned r; asm volatile("v_cvt_pk_bf16_f32 %0, %1, %2" : "=v"(r) : "v"(lo), "v"(hi)); return r;
}
__device__ __forceinline__ bf16x8 ld8(const bf16* p) { return *reinterpret_cast<const bf16x8*>(p); }
__device__ __forceinline__ void partialSM(f32x16& p0, f32x16& p1, float& m_reg, float& mn, float& alpha) {
  constexpr float C = SCALE * 1.4426950408889634f;
  float pmax = p0[0]; for (int r = 1; r < 16; ++r) pmax = fmaxf(pmax, p0[r]); for (int r = 0; r < 16; ++r) pmax = fmaxf(pmax, p1[r]);
  { auto rr = __builtin_amdgcn_permlane32_swap(__float_as_uint(pmax), __float_as_uint(pmax), false, false);
    pmax = fmaxf(__uint_as_float(rr[0]), __uint_as_float(rr[1])); }
  if (__builtin_expect(__all(pmax - m_reg <= THR / SCALE), 1)) { mn = m_reg; alpha = 1.f; }
  else { mn = fmaxf(m_reg, pmax); alpha = __builtin_amdgcn_exp2f((m_reg - mn) * C); m_reg = mn; }
  float mnC = -mn * C;
  for (int r = 0; r < 16; ++r) p0[r] = fmaf(p0[r], C, mnC); for (int r = 0; r < 16; ++r) p1[r] = fmaf(p1[r], C, mnC);
  for (int r = 0; r < 16; ++r) p0[r] = __builtin_amdgcn_exp2f(p0[r]);
}
__device__ __forceinline__ void finishSM(f32x16& p0, f32x16& p1, float alpha, float& l_reg, bf16x8& pa0, bf16x8& pa1, bf16x8& pa2, bf16x8& pa3) {
  for (int r = 0; r < 16; ++r) p1[r] = __builtin_amdgcn_exp2f(p1[r]);
  float ps = 0; for (int r = 0; r < 16; ++r) ps += p0[r]; for (int r = 0; r < 16; ++r) ps += p1[r];
  { auto rr = __builtin_amdgcn_permlane32_swap(__float_as_uint(ps), __float_as_uint(ps), false, false);
    ps = __uint_as_float(rr[0]) + __uint_as_float(rr[1]); }
  l_reg = l_reg * alpha + ps;
#define PK4(P, BASE, OUT) do { unsigned a0 = cvtpk(P[BASE + 0], P[BASE + 1]), a1 = cvtpk(P[BASE + 2], P[BASE + 3]);   \
    unsigned b0 = cvtpk(P[BASE + 4], P[BASE + 5]), b1 = cvtpk(P[BASE + 6], P[BASE + 7]);                              \
    auto r0 = __builtin_amdgcn_permlane32_swap(a0, b0, false, false); auto r1 = __builtin_amdgcn_permlane32_swap(a1, b1, false, false); \
    u32x4 w = {r0[0], r1[0], r0[1], r1[1]}; OUT = *reinterpret_cast<bf16x8*>(&w); } while (0)
  PK4(p0, 0, pa0); PK4(p0, 8, pa1); PK4(p1, 0, pa2); PK4(p1, 8, pa3);
#undef PK4
}
__device__ __forceinline__ void qkt(f32x16& p0, f32x16& p1, const bf16* Ks, const bf16x8* qr, int r32, int hi) {
  p0 = f32x16{}; p1 = f32x16{};
  for (int d0 = 0; d0 < 8; ++d0) { int cb = (d0 * 16 + hi * 8) * 2;
    bf16x8 b0 = *reinterpret_cast<const bf16x8*>((const char*)Ks + KSWZ(r32, cb));
    bf16x8 b1 = *reinterpret_cast<const bf16x8*>((const char*)Ks + KSWZ(32 + r32, cb));
    p0 = __builtin_amdgcn_mfma_f32_32x32x16_bf16(b0, qr[d0], p0, 0, 0, 0);
    p1 = __builtin_amdgcn_mfma_f32_32x32x16_bf16(b1, qr[d0], p1, 0, 0, 0); }
}
__device__ __forceinline__ int v_st(int k, int c) { const int kk = (k & ~0xC) | ((k & 4) << 1) | ((k & 8) >> 1); return ((kk >> 3) * 4 + (c >> 5)) * 512 + ((kk & 7) * 32 + (c & 31)) * 2; }
__device__ __forceinline__ int v_rd_base(int lane) { return ((lane & 3) << 3) | (((lane >> 2) & 3) << 6) | (((lane >> 4) & 1) << 5) | (((lane >> 5) & 1) << 8); }
constexpr int v_rd_off(int d0, int ks, int half) { return d0 * 512 + ks * 4096 + half * 2048; }
template <int OFF> __device__ __forceinline__ s16x4 tr_read(int vb) {
  s16x4 r; asm volatile("ds_read_b64_tr_b16 %0, %1 offset:%2" : "=&v"(r) : "v"(vb), "i"(OFF) : "memory"); return r;
}
template <int D0> __device__ __forceinline__ void pv_one(f32x16& od, int vb, bf16x8 pa0, bf16x8 pa1, bf16x8 pa2, bf16x8 pa3) {
  const s16x4 l0 = tr_read<v_rd_off(D0, 0, 0)>(vb), h0 = tr_read<v_rd_off(D0, 0, 1)>(vb), l1 = tr_read<v_rd_off(D0, 1, 0)>(vb), h1 = tr_read<v_rd_off(D0, 1, 1)>(vb);
  const s16x4 l2 = tr_read<v_rd_off(D0, 2, 0)>(vb), h2 = tr_read<v_rd_off(D0, 2, 1)>(vb), l3 = tr_read<v_rd_off(D0, 3, 0)>(vb), h3 = tr_read<v_rd_off(D0, 3, 1)>(vb);
  asm volatile("s_waitcnt lgkmcnt(0)" ::: "memory"); SBAR();
#define PK(L, H) (bf16x8){L[0], L[1], L[2], L[3], H[0], H[1], H[2], H[3]}
  od = __builtin_amdgcn_mfma_f32_32x32x16_bf16(pa0, PK(l0, h0), od, 0, 0, 0);
  od = __builtin_amdgcn_mfma_f32_32x32x16_bf16(pa1, PK(l1, h1), od, 0, 0, 0);
  od = __builtin_amdgcn_mfma_f32_32x32x16_bf16(pa2, PK(l2, h2), od, 0, 0, 0);
  od = __builtin_amdgcn_mfma_f32_32x32x16_bf16(pa3, PK(l3, h3), od, 0, 0, 0);
#undef PK
}
__device__ __forceinline__ void pv_d0(f32x16* o, int vb, bf16x8 pa0, bf16x8 pa1, bf16x8 pa2, bf16x8 pa3) {
  pv_one<0>(o[0], vb, pa0, pa1, pa2, pa3); pv_one<1>(o[1], vb, pa0, pa1, pa2, pa3); pv_one<2>(o[2], vb, pa0, pa1, pa2, pa3); pv_one<3>(o[3], vb, pa0, pa1, pa2, pa3);
}
__device__ __forceinline__ void attn_dense_body(const bf16* __restrict__ Qb, const bf16* __restrict__ Kh, const bf16* __restrict__ Vh,
                                                bf16* __restrict__ Ob, int seq, char* lds) {
  int tid_ = threadIdx.x; asm volatile("" : "+v"(tid_));
  const int tid = tid_, wid = tid >> 6, lane = tid & 63, r32 = lane & 31, hi = lane >> 5;
  bf16* V_lds = (bf16*)lds; bf16* K_lds = (bf16*)(lds + 2 * SHM_V);
  float* ws = (float*)(lds + 2 * SHM_V + 2 * SHM_K) + wid * 64; float* li_l = ws; float* al_l = ws + 32;
  float m_reg = -1e30f, l_reg = 0; f32x16 o[4] = {}; bf16x8 qr[8];
  const bf16* Qw = Qb + (long)(wid * QBLK + r32) * LDQ + hi * 8;
#pragma unroll
  for (int d0 = 0; d0 < 8; ++d0) qr[d0] = ld8(Qw + d0 * 16);
  const int sr = tid >> 4, sc = (tid & 15) * 8, vst0 = v_st(sr, sc), vst1 = v_st(32 + sr, sc);
  const int vb0 = (int)(uintptr_t)V_lds + v_rd_base(lane);
  struct { bf16x8 vs0, vs1, ks0, ks1; } sr_[2];
#define SLOAD(i, k0) do { sr_[i].vs0 = ld8(&Vh[(long)((k0) + sr) * LDK + sc]); sr_[i].vs1 = ld8(&Vh[(long)((k0) + 32 + sr) * LDK + sc]); \
    sr_[i].ks0 = ld8(&Kh[(long)((k0) + sr) * LDK + sc]); sr_[i].ks1 = ld8(&Kh[(long)((k0) + 32 + sr) * LDK + sc]); } while (0)
#define SWRITE(b, i) do { *(bf16x8*)((char*)V_lds + (b) * SHM_V + vst0) = sr_[i].vs0;          \
    *(bf16x8*)((char*)V_lds + (b) * SHM_V + vst1) = sr_[i].vs1; int kc = sc * 2;               \
    *(bf16x8*)((char*)K_lds + (b) * SHM_K + KSWZ(sr, kc)) = sr_[i].ks0;                       \
    *(bf16x8*)((char*)K_lds + (b) * SHM_K + KSWZ(32 + sr, kc)) = sr_[i].ks1; } while (0)
#define SWAIT() do { asm volatile("s_waitcnt vmcnt(4)" ::: "memory"); } while (0)
#define RESC(a) do { if (__any((a) < 1.f)) { if (hi == 0) al_l[r32] = (a); asm volatile("s_waitcnt lgkmcnt(0)" ::: "memory"); \
    for (int d = 0; d < 4; ++d) for (int r = 0; r < 16; ++r) o[d][r] *= al_l[crow(r, hi)]; } } while (0)
  f32x16 pA0, pA1, pB0, pB1; float mnA, mnB, alA, alB; bf16x8 pa0, pa1, pa2, pa3; const int NT = seq / KVBLK;
  constexpr int SE = 0, SO = 1;
  SLOAD(SE, 0); asm volatile("s_waitcnt vmcnt(0)" ::: "memory"); SWRITE(0, SE); __syncthreads();
  qkt(pA0, pA1, K_lds, qr, r32, hi); partialSM(pA0, pA1, m_reg, mnA, alA);
  SLOAD(SO, KVBLK); if (2 < NT) SLOAD(SE, 2 * KVBLK);
  SWAIT(); SWRITE(1, SO); __syncthreads();
  for (int j = 1; j + 1 < NT; j += 2) {
    SBAR(); qkt(pB0, pB1, (bf16*)((char*)K_lds + SHM_K), qr, r32, hi);
    finishSM(pA0, pA1, alA, l_reg, pa0, pa1, pa2, pa3); SBAR();
    SLOAD(SO, (j + 2) * KVBLK); SBAR();
    pv_d0(o, vb0, pa0, pa1, pa2, pa3); partialSM(pB0, pB1, m_reg, mnB, alB);
    __syncthreads(); SWAIT(); SWRITE(0, SE);
    RESC(alB); __syncthreads();
    SBAR(); qkt(pA0, pA1, K_lds, qr, r32, hi);
    finishSM(pB0, pB1, alB, l_reg, pa0, pa1, pa2, pa3); SBAR();
    if (j + 3 < NT) SLOAD(SE, (j + 3) * KVBLK); SBAR();
    pv_d0(o, vb0 + (int)SHM_V, pa0, pa1, pa2, pa3); partialSM(pA0, pA1, m_reg, mnA, alA);
    __syncthreads(); SWAIT(); SWRITE(1, SO);
    RESC(alA); __syncthreads();
  }
  SBAR(); qkt(pB0, pB1, (bf16*)((char*)K_lds + SHM_K), qr, r32, hi);
  finishSM(pA0, pA1, alA, l_reg, pa0, pa1, pa2, pa3); SBAR();
  pv_d0(o, vb0, pa0, pa1, pa2, pa3); partialSM(pB0, pB1, m_reg, mnB, alB);
  __syncthreads(); RESC(alB);
  finishSM(pB0, pB1, alB, l_reg, pa0, pa1, pa2, pa3); SBAR();
  pv_d0(o, vb0 + (int)SHM_V, pa0, pa1, pa2, pa3);
  if (hi == 0) li_l[r32] = l_reg; asm volatile("s_waitcnt lgkmcnt(0)" ::: "memory");
  float rli[16];
#pragma unroll
  for (int r = 0; r < 16; ++r) rli[r] = __builtin_amdgcn_rcpf(li_l[crow(r, hi)]);
  bf16* Ow = Ob + (long)(wid * QBLK) * LDO;
#pragma unroll
  for (int r = 0; r < 16; ++r) { int orow = crow(r, hi);
    for (int d0 = 0; d0 < 4; ++d0) Ow[(long)orow * LDO + d0 * 32 + r32] = __float2bfloat16(o[d0][r] * rli[r]); }
  __syncthreads();
#undef SLOAD
#undef SWRITE
#undef SWAIT
#undef RESC
}
#undef KSWZ
#undef SBAR
}
#define LAS __attribute__((address_space(3)))
typedef unsigned short bf16_t;
typedef float f32x4 __attribute__((ext_vector_type(4)));
typedef unsigned u32x4 __attribute__((ext_vector_type(4)));
typedef unsigned u32x2 __attribute__((ext_vector_type(2)));

constexpr int NWAVES = 8, NTHREADS = 512;
constexpr int D = 1024, FF = 4096, NIN = 7040, NINP = 7168, RWC = 3456;
constexpr int MC = 16384, NCHUNK = 5, MTOT = 81920;
constexpr float ALPHA = 1.189207115002721f;
constexpr float LN_EPS = 1e-5f, GN_EPS = 64e-5f, RMS_EPS = 1e-6f;
constexpr float DECAY_SCALE = 0.6065306597126334f;

constexpr size_t MiB = 1u << 20;
constexpr size_t WS_CTL = 0;
constexpr size_t WS_WIN = 1 * MiB, WS_WPR = 15 * MiB, WS_WPA = 17 * MiB, WS_WOUT = 19 * MiB, WS_WF1 = 21 * MiB, WS_WF2 = 29 * MiB;
constexpr size_t WS_WUP = 37 * MiB, WS_AUP = 37 * MiB + 512 * 1024, WS_GUP = 38 * MiB;
constexpr size_t WS_XB = 40 * MiB, WS_OF = 40 * MiB;
constexpr size_t WS_Z = 72 * MiB;
constexpr size_t WS_OPR = 296 * MiB, WS_OPKH = 360 * MiB, WS_VS = 424 * MiB;
constexpr size_t WS_KS = 488 * MiB, WS_OB = 488 * MiB, WS_HB = 488 * MiB;
constexpr size_t WS_TW = 520 * MiB, WS_AD = 524 * MiB, WS_SG = 528 * MiB;
constexpr size_t WS_OPW = 532 * MiB, WS_OPAK = 660 * MiB, WS_OPKT = 788 * MiB;
constexpr size_t WS_G = 916 * MiB, WS_OATT = 948 * MiB, WS_END = 980 * MiB;
constexpr size_t WS_ORW = 532 * MiB, WS_M32 = 564 * MiB, WS_MB = 628 * MiB, WS_FFH = 660 * MiB;
constexpr int ZLD = 7168, ZQ = 3456, ZK = 4480, ZV = 4736, ZG = 4992;

constexpr int LDS_BYTES = 131072 + 1024;
constexpr int LDS_MISC = 131072;

#define INP(k) (A.in[(k) + z])
struct Args {
    const float* in[26];
    float* out; unsigned char* ws;
    int ph_lo, ph_hi;
};

__device__ __forceinline__ float bf2f(unsigned v) { return __uint_as_float(v << 16); }
__device__ __forceinline__ float bflo(unsigned w) { return __uint_as_float(w << 16); }
__device__ __forceinline__ float bfhi(unsigned w) { return __uint_as_float(w & 0xffff0000u); }
typedef float f32x2c_t __attribute__((ext_vector_type(2))); typedef __bf16 bf16x2c_t __attribute__((ext_vector_type(2)));
__device__ __forceinline__ unsigned pk2(float lo, float hi) { f32x2c_t v = {lo, hi}; bf16x2c_t b = __builtin_convertvector(v, bf16x2c_t); return __builtin_bit_cast(unsigned, b); }
__device__ __forceinline__ float sigmoidf_(float x) { return 1.0f / (1.0f + __expf(-x)); }
__device__ __forceinline__ float wave_sum(float v) {
#pragma unroll
    for (int o = 1; o < 64; o <<= 1) v += __shfl_xor(v, o);
    return v;
}

__device__ __forceinline__ void p0_transpose_item(const float* W, int K, int N, bf16_t* WT, LAS float* scr, int item, int lane) {
    const int nblk = N / 32, kb = item / nblk, nb = item % nblk, k0 = 64 * kb, n0 = 32 * nb;
#pragma unroll 8
    for (int i = 0; i < 32; ++i) { const int kk = 2 * i + (lane >> 5); scr[kk * 33 + (lane & 31)] = W[(size_t)(k0 + kk) * N + n0 + (lane & 31)]; }
    asm volatile("s_waitcnt lgkmcnt(0)" ::: "memory");
    const int c = lane & 7;
#pragma unroll
    for (int j = 0; j < 4; ++j) { const int n = (lane >> 3) + 8 * j; const LAS float* s = scr + (8 * c) * 33 + n;
        u32x4 o; o.x = pk2(s[0 * 33], s[1 * 33]); o.y = pk2(s[2 * 33], s[3 * 33]); o.z = pk2(s[4 * 33], s[5 * 33]); o.w = pk2(s[6 * 33], s[7 * 33]);
        *(u32x4*)(WT + (size_t)(n0 + n) * K + k0 + 8 * c) = o; }
    asm volatile("s_waitcnt lgkmcnt(0)" ::: "memory");
}

__device__ __forceinline__ void cvt_x_chunk(const float* x, bf16_t* xb, int gtid, int gthreads) {
    const size_t n8 = (size_t)MC * D / 8;
    for (size_t i = gtid; i < n8; i += gthreads) {
        const f32x4 a = *(const f32x4*)(x + i * 8), b = *(const f32x4*)(x + i * 8 + 4);
        u32x4 o; o.x = pk2(a.x, a.y); o.y = pk2(a.z, a.w); o.z = pk2(b.x, b.y); o.w = pk2(b.z, b.w);
        *(u32x4*)(xb + i * 8) = o;
    }
}

__device__ __forceinline__ void ln_rows(float* base, const float* g, const float* b, bf16_t* hb, int gw, int ngw, int lane) {
    f32x4 gg[4], bb[4];
#pragma unroll
    for (int j = 0; j < 4; ++j) { gg[j] = *((const f32x4*)g + 64 * j + lane); bb[j] = *((const f32x4*)b + 64 * j + lane); }
    for (int m0 = gw; m0 < MC; m0 += 2 * ngw) {
        const int m1 = m0 + ngw; const bool has1 = m1 < MC;
        f32x4* xr0 = (f32x4*)(base + (size_t)m0 * D) + lane; f32x4* xr1 = (f32x4*)(base + (size_t)(has1 ? m1 : m0) * D) + lane;
        f32x4 v0[4], v1[4]; float s0 = 0.f, s1 = 0.f;
#pragma unroll
        for (int j = 0; j < 4; ++j) { v0[j] = xr0[64 * j]; v1[j] = xr1[64 * j]; }
#pragma unroll
        for (int j = 0; j < 4; ++j) { s0 += (v0[j].x + v0[j].y) + (v0[j].z + v0[j].w); s1 += (v1[j].x + v1[j].y) + (v1[j].z + v1[j].w); }
        const float mean0 = wave_sum(s0) * (1.f / D), mean1 = wave_sum(s1) * (1.f / D); float q0 = 0.f, q1 = 0.f;
#pragma unroll
        for (int j = 0; j < 4; ++j) { v0[j] = v0[j] - mean0; v1[j] = v1[j] - mean1;
            q0 += (v0[j].x * v0[j].x + v0[j].y * v0[j].y) + (v0[j].z * v0[j].z + v0[j].w * v0[j].w); q1 += (v1[j].x * v1[j].x + v1[j].y * v1[j].y) + (v1[j].z * v1[j].z + v1[j].w * v1[j].w); }
        const float rstd0 = 1.f / sqrtf(wave_sum(q0) * (1.f / D) + LN_EPS), rstd1 = 1.f / sqrtf(wave_sum(q1) * (1.f / D) + LN_EPS);
#pragma unroll
        for (int j = 0; j < 4; ++j) {
            const f32x4 y0 = v0[j] * rstd0 * gg[j] + bb[j]; xr0[64 * j] = y0;
            if (hb) { u32x2 w; w.x = pk2(y0.x, y0.y); w.y = pk2(y0.z, y0.w); *(u32x2*)(hb + (size_t)m0 * D + 256 * j + 4 * lane) = w; }
            if (has1) { const f32x4 y1 = v1[j] * rstd1 * gg[j] + bb[j]; xr1[64 * j] = y1;
                if (hb) { u32x2 w; w.x = pk2(y1.x, y1.y); w.y = pk2(y1.z, y1.w); *(u32x2*)(hb + (size_t)m1 * D + 256 * j + 4 * lane) = w; } }
        }
    }
}

template <class F> struct Epi4 {
    static constexpr bool PERM = false, AFTER_DRAIN = false; F f;
    __device__ __forceinline__ void operator()(const pg8::f32x4 (&acc)[2][2][4][2], const pg8::Unit& u, int wr, int wc, int fr, int fq) const {
        const int row0 = u.pm * 256 + wr * 64 + fr, col0 = u.pn * 256 + wc * 32 + 4 * fq;
#pragma unroll
        for (int ai = 0; ai < 2; ++ai)
#pragma unroll
            for (int m = 0; m < 4; ++m)
#pragma unroll
                for (int bj = 0; bj < 2; ++bj)
#pragma unroll
                    for (int n = 0; n < 2; ++n) { f(row0 + ai * 128 + m * 16, col0 + bj * 128 + n * 16, acc[ai][bj][m][n]); asm volatile("" ::: "memory"); }
    }
};
template <class F> struct Epi8 {
    static constexpr bool PERM = true, AFTER_DRAIN = false; F f;
    __device__ __forceinline__ void operator()(const pg8::f32x4 (&acc)[2][2][4][2], const pg8::Unit& u, int wr, int wc, int fr, int fq) const {
        const int row0 = u.pm * 256 + wr * 64 + fr, col0 = u.pn * 256 + wc * 32 + 8 * fq;
#pragma unroll
        for (int ai = 0; ai < 2; ++ai)
#pragma unroll
            for (int m = 0; m < 4; ++m)
#pragma unroll
                for (int bj = 0; bj < 2; ++bj) { f(row0 + ai * 128 + m * 16, col0 + bj * 128, acc[ai][bj][m][0], acc[ai][bj][m][1]); asm volatile("" ::: "memory"); }
    }
};
__device__ __forceinline__ u32x4 pack8(f32x4 a, f32x4 b) { u32x4 w; w.x = pk2(a.x, a.y); w.y = pk2(a.z, a.w); w.z = pk2(b.x, b.y); w.w = pk2(b.z, b.w); return w; }

struct FZ { bf16_t* z;
    __device__ __forceinline__ void operator()(int row, int col, f32x4 a, f32x4 b) const { *(u32x4*)(z + (size_t)row * ZLD + col) = pack8(a, b); } };
struct FW { const float* w0; float* opw;
    __device__ __forceinline__ void operator()(int row, int col, f32x4 a) const {
        const f32x4 x = a + *(const f32x4*)(w0 + col); f32x4 y;
#pragma unroll
        for (int i = 0; i < 4; ++i) y[i] = __expf(-DECAY_SCALE * sigmoidf_(x[i]));
        *(f32x4*)(opw + (size_t)row * D + col) = y; } };
struct FA { const float *a0, *k_a; const bf16_t* ks; const float* kh; float *opak, *opkt;
    __device__ __forceinline__ void operator()(int row, int col, f32x4 acc) const {
        const size_t o = (size_t)row * D + col;
        const f32x4 x = acc + *(const f32x4*)(a0 + col), ka = *(const f32x4*)(k_a + col), khv = *(const f32x4*)(kh + o);
        const u32x2 kw = *(const u32x2*)(ks + o);
        f32x4 k; k.x = bflo(kw.x); k.y = bfhi(kw.x); k.z = bflo(kw.y); k.w = bfhi(kw.y);
        f32x4 ak, kt;
#pragma unroll
        for (int i = 0; i < 4; ++i) { const float a = sigmoidf_(x[i]); ak[i] = a * khv[i]; kt[i] = k[i] * (1.0f + (a - 1.0f) * ka[i]); }
        *(f32x4*)(opak + o) = ak; *(f32x4*)(opkt + o) = kt; } };
struct FG { bf16_t* g;
    __device__ __forceinline__ void operator()(int row, int col, f32x4 a) const {
        u32x2 w; w.x = pk2(a.x, a.y); w.y = pk2(a.z, a.w); *(u32x2*)(g + (size_t)row * D + col) = w; } };
typedef short bf16x8v __attribute__((ext_vector_type(8)));
template <int K, class F> __device__ __forceinline__ void wave_gemm_tile(const bf16_t* A, int aoff, const bf16_t* Bt, int m0, int n0, int lane, const F& f) {
    const int fr = lane & 15, fq = lane >> 4; constexpr int KS = K / 32;
    bf16x8v a[2][KS];
#pragma unroll
    for (int mt = 0; mt < 2; ++mt)
#pragma unroll
        for (int ks = 0; ks < KS; ++ks) a[mt][ks] = *(const bf16x8v*)(A + (size_t)(m0 + mt * 16 + fr) * 128 + aoff + ks * 32 + 8 * fq);
#pragma unroll 2
    for (int nt = 0; nt < 8; ++nt) {
        const bf16_t* bp = Bt + (size_t)(n0 + nt * 16 + fr) * K + 8 * fq;
        f32x4 acc0 = {0.f, 0.f, 0.f, 0.f}, acc1 = {0.f, 0.f, 0.f, 0.f};
#pragma unroll
        for (int ks = 0; ks < KS; ++ks) { const bf16x8v b = *(const bf16x8v*)(bp + ks * 32);
            acc0 = __builtin_amdgcn_mfma_f32_16x16x32_bf16(b, a[0][ks], acc0, 0, 0, 0); acc1 = __builtin_amdgcn_mfma_f32_16x16x32_bf16(b, a[1][ks], acc1, 0, 0, 0); }
        f(m0 + fr, n0 + nt * 16 + 4 * fq, acc0); f(m0 + 16 + fr, n0 + nt * 16 + 4 * fq, acc1);
    }
}
struct FP1 { const bf16_t* gates; float* m32;
    __device__ __forceinline__ void operator()(int row, int col, f32x4 a) const {
        const u32x2 gw = *(const u32x2*)(gates + (size_t)row * ZLD + ZG + col); f32x4 y;
        y.x = sigmoidf_(bflo(gw.x)) * a.x; y.y = sigmoidf_(bfhi(gw.x)) * a.y; y.z = sigmoidf_(bflo(gw.y)) * a.z; y.w = sigmoidf_(bfhi(gw.y)) * a.w;
        *(f32x4*)(m32 + (size_t)row * D + col) = y;
    } };
struct FP2 { const bf16_t* gates; const float* m32; bf16_t* mb;
    __device__ __forceinline__ void operator()(int row, int col, f32x4 a) const {
        const u32x2 gw = *(const u32x2*)(gates + (size_t)row * ZLD + ZG + 1024 + col); const f32x4 p = *(const f32x4*)(m32 + (size_t)row * D + col); f32x4 y;
        y.x = p.x + sigmoidf_(bflo(gw.x)) * a.x; y.y = p.y + sigmoidf_(bfhi(gw.x)) * a.y; y.z = p.z + sigmoidf_(bflo(gw.y)) * a.z; y.w = p.w + sigmoidf_(bfhi(gw.y)) * a.w;
        u32x2 w; w.x = pk2(y.x, y.y); w.y = pk2(y.z, y.w); *(u32x2*)(mb + (size_t)row * D + col) = w;
    } };
struct FOut { const float* x; float* out;
    __device__ __forceinline__ void operator()(int row, int col, f32x4 a) const {
        const size_t o = (size_t)row * D + col; *(f32x4*)(out + o) = *(const f32x4*)(x + o) * ALPHA + a; } };
struct FF1 { bf16_t* ffh;
    __device__ __forceinline__ void operator()(int row, int col, f32x4 a, f32x4 b) const {
#pragma unroll
        for (int i = 0; i < 4; ++i) { const float u = fmaxf(a[i], 0.f), v = fmaxf(b[i], 0.f); a[i] = u * u; b[i] = v * v; }
        *(u32x4*)(ffh + (size_t)row * FF + col) = pack8(a, b); } };
struct FF2 { float* out;
    __device__ __forceinline__ void operator()(int row, int col, f32x4 a) const {
        const size_t o = (size_t)row * D + col; *(f32x4*)(out + o) = *(const f32x4*)(out + o) * ALPHA + a; } };

template <class E> __device__ __forceinline__ void run_gemm(LAS unsigned char* lds, const bf16_t* A, const bf16_t* Bt, int M, int N, int K, const E& e) {

    int G_ = (int)gridDim.x, c_ = (int)blockIdx.x; asm volatile("" : "+s"(G_), "+s"(c_));
    pg8::Gemm g{A, Bt, M, N, K}; pg8::StaticOrder S; S.init(M, N, G_, c_);
    pg8::gemm_phase<E, pg8::StaticOrder, true, true>(lds, g, S, e);
}

__device__ __forceinline__ void prep_rows(const float* mu_p, const float* mu_n, const float* k_k, const float* qn, const float* kn, unsigned char* ws, int T, int rbeg, int rstep, int rend, int lane, bool do_att) {
    bf16_t* Z = (bf16_t*)(ws + WS_Z);
    float* OPR = (float*)(ws + WS_OPR); float* OPKH = (float*)(ws + WS_OPKH); float* VS = (float*)(ws + WS_VS);
    bf16_t* KS = (bf16_t*)(ws + WS_KS); bf16_t* TW = (bf16_t*)(ws + WS_TW); bf16_t* AD = (bf16_t*)(ws + WS_AD); bf16_t* SG = (bf16_t*)(ws + WS_SG);
    for (int row = rbeg; row < rend; row += rstep) {
        const int t = row & (T - 1); const bool hp = t > 0, hn = t < T - 1;
        const bf16_t* zc = Z + (size_t)row * ZLD;
#pragma unroll
        for (int pass = 0; pass < 7; ++pass) {
            const int c = pass * 512 + lane * 8;
            if (c < RWC) {
                const u32x4 wc_ = *(const u32x4*)(zc + c);
                u32x4 wp = {0u, 0u, 0u, 0u}, wn = {0u, 0u, 0u, 0u};
                if (hp) wp = *(const u32x4*)(zc - ZLD + c);
                if (hn) wn = *(const u32x4*)(zc + ZLD + c);
                const f32x4 mp0 = *(const f32x4*)(mu_p + c), mp1 = *(const f32x4*)(mu_p + c + 4), mn0 = *(const f32x4*)(mu_n + c), mn1 = *(const f32x4*)(mu_n + c + 4);
                float z[8];
#pragma unroll
                for (int i = 0; i < 4; ++i) {
                    const float c0 = bflo(wc_[i]), c1 = bfhi(wc_[i]), p0 = bflo(wp[i]), p1 = bfhi(wp[i]), n0 = bflo(wn[i]), n1 = bfhi(wn[i]);
                    const float mpa = (2 * i < 4) ? mp0[2 * i] : mp1[2 * i - 4], mpb = (2 * i + 1 < 4) ? mp0[2 * i + 1] : mp1[2 * i - 3];
                    const float mna = (2 * i < 4) ? mn0[2 * i] : mn1[2 * i - 4], mnb = (2 * i + 1 < 4) ? mn0[2 * i + 1] : mn1[2 * i - 3];
                    z[2 * i] = c0 + mpa * (p0 - c0) + mna * (n0 - c0);
                    z[2 * i + 1] = c1 + mpb * (p1 - c1) + mnb * (n1 - c1);
                }
                if (pass < 2) {
                    float* o = OPR + (size_t)row * D + c;
                    *(f32x4*)o = (f32x4){z[0], z[1], z[2], z[3]}; *(f32x4*)(o + 4) = (f32x4){z[4], z[5], z[6], z[7]};
                } else if (pass < 4) {
                    const int cc = c - 1024;
                    u32x4 w; w.x = pk2(z[0], z[1]); w.y = pk2(z[2], z[3]); w.z = pk2(z[4], z[5]); w.w = pk2(z[6], z[7]);
                    *(u32x4*)(KS + (size_t)row * D + cc) = w;
                    const f32x4 kk0 = *(const f32x4*)(k_k + cc), kk1 = *(const f32x4*)(k_k + cc + 4);
                    float kp[8]; float ss = 0.f;
#pragma unroll
                    for (int i = 0; i < 8; ++i) { kp[i] = z[i] * (i < 4 ? kk0[i] : kk1[i - 4]); ss += kp[i] * kp[i]; }
                    ss += __shfl_xor(ss, 1); ss += __shfl_xor(ss, 2); ss += __shfl_xor(ss, 4);
                    const float inv = 1.0f / fmaxf(sqrtf(ss), 1e-12f);
                    float* o = OPKH + (size_t)row * D + cc;
                    *(f32x4*)o = (f32x4){kp[0] * inv, kp[1] * inv, kp[2] * inv, kp[3] * inv}; *(f32x4*)(o + 4) = (f32x4){kp[4] * inv, kp[5] * inv, kp[6] * inv, kp[7] * inv};
                } else if (pass < 6) {
                    float* o = VS + (size_t)row * D + (c - 2048);
                    *(f32x4*)o = (f32x4){z[0], z[1], z[2], z[3]}; *(f32x4*)(o + 4) = (f32x4){z[4], z[5], z[6], z[7]};
                } else {
                    const int sect = lane >> 4, cc = (lane & 15) * 8;
                    float y[8];
#pragma unroll
                    for (int i = 0; i < 8; ++i) {
                        if (sect == 0) { const float e = __expf(2.0f * z[i]); y[i] = 1.0f - 2.0f / (e + 1.0f); }
                        else if (sect == 1) y[i] = z[i];
                        else y[i] = sigmoidf_(z[i]);
                    }
                    u32x4 w; w.x = pk2(y[0], y[1]); w.y = pk2(y[2], y[3]); w.z = pk2(y[4], y[5]); w.w = pk2(y[6], y[7]);
                    bf16_t* dst = (sect == 0 ? TW : (sect == 1 ? AD : SG)) + (size_t)row * 128 + cc;
                    *(u32x4*)dst = w;
                }
            }
        }
        bf16_t* qrow = Z + (size_t)row * ZLD + ZQ;
#pragma unroll 1
        for (int p = do_att ? 0 : 3; p < 3; ++p) {
            const int head = p * 4 + (lane >> 4), sub = lane & 15, d0 = sub * 8;
            const bool act = head < 10;
            bf16_t* px = qrow + head * 128 + d0;
            u32x4 w = {0u, 0u, 0u, 0u}; if (act) w = *(const u32x4*)px;
            float x[8]; float ss = 0.f;
#pragma unroll
            for (int i = 0; i < 4; ++i) { x[2 * i] = bflo(w[i]); x[2 * i + 1] = bfhi(w[i]); ss += x[2 * i] * x[2 * i] + x[2 * i + 1] * x[2 * i + 1]; }
            ss += __shfl_xor(ss, 1); ss += __shfl_xor(ss, 2); ss += __shfl_xor(ss, 4); ss += __shfl_xor(ss, 8);
            const float rinv = rsqrtf(ss * (1.0f / 128.0f) + RMS_EPS);
            const float* gn = (head < 8) ? qn : kn;
            const f32x4 g0 = *(const f32x4*)(gn + d0), g1 = *(const f32x4*)(gn + d0 + 4);
            const int axis = sub >> 3, hf = (sub >> 2) & 1;
            const float pos = (float)(axis ? (t & 63) : (t >> 6));
            float y[8];
#pragma unroll
            for (int i = 0; i < 8; ++i) {
                const float xn = x[i] * rinv * (i < 4 ? g0[i] : g1[i - 4]);
                const float xp = __shfl_xor(xn, 4);
                const int fi = (sub & 3) * 8 + i;
                const float ang = pos * exp2f(-0.41524101186092f * (float)fi);
                y[i] = xn * __cosf(ang) + (hf ? xp : -xp) * __sinf(ang);
            }
            if (act) { u32x4 o; o.x = pk2(y[0], y[1]); o.y = pk2(y[2], y[3]); o.z = pk2(y[4], y[5]); o.w = pk2(y[6], y[7]); *(u32x4*)px = o; }
        }
    }
}

__device__ __forceinline__ float rowsum16(float x) {
    x += __int_as_float(__builtin_amdgcn_update_dpp(0, __float_as_int(x), 0x128, 0xf, 0xf, true));
    x += __int_as_float(__builtin_amdgcn_update_dpp(0, __float_as_int(x), 0x124, 0xf, 0xf, true));
    x += __int_as_float(__builtin_amdgcn_update_dpp(0, __float_as_int(x), 0x122, 0xf, 0xf, true));
    x += __int_as_float(__builtin_amdgcn_update_dpp(0, __float_as_int(x), 0x121, 0xf, 0xf, true));
    return x;
}
__device__ __forceinline__ void post_rows(const float* r_k, const float* gn_g, const float* gn_b, unsigned char* ws, int gw, int ngw, int lane) {
    const bf16_t* OF = (const bf16_t*)(ws + WS_OF); const bf16_t* OB = (const bf16_t*)(ws + WS_OB);
    const float* OPR = (const float*)(ws + WS_OPR); const float* VS = (const float*)(ws + WS_VS);
    const float* KTF = (const float*)(ws + WS_OPKT); const float* KTB = KTF + (size_t)MC * D;
    const bf16_t* G = (const bf16_t*)(ws + WS_G); bf16_t* ORW = (bf16_t*)(ws + WS_ORW);
    const int hg = lane >> 4, sub = lane & 15;
    for (int row = gw; row < MC; row += ngw) {
        const size_t ro = (size_t)row * D;
#pragma unroll 2
        for (int pass = 0; pass < 4; ++pass) {
            const int c = (4 * pass + hg) * 64 + sub * 4; const size_t o = ro + c;
            const u32x2 wf = *(const u32x2*)(OF + o), wb = *(const u32x2*)(OB + o), wg = *(const u32x2*)(G + o);
            const f32x4 r4 = *(const f32x4*)(OPR + o), ktf = *(const f32x4*)(KTF + o), ktb = *(const f32x4*)(KTB + o), v4 = *(const f32x4*)(VS + o);
            const f32x4 rk = *(const f32x4*)(r_k + c), gg = *(const f32x4*)(gn_g + c), gb = *(const f32x4*)(gn_b + c);
            f32x4 ov; ov.x = bflo(wf.x) + bflo(wb.x); ov.y = bfhi(wf.x) + bfhi(wb.x); ov.z = bflo(wf.y) + bflo(wb.y); ov.w = bfhi(wf.y) + bfhi(wb.y);
            const float mean = rowsum16((ov.x + ov.y) + (ov.z + ov.w)) * (1.0f / 64.0f);
            const f32x4 dv = ov - mean;
            const float var = rowsum16((dv.x * dv.x + dv.y * dv.y) + (dv.z * dv.z + dv.w * dv.w)) * (1.0f / 64.0f);
            const f32x4 bt = r4 * (ktf + ktb) * rk;
            const float bs = rowsum16((bt.x + bt.y) + (bt.z + bt.w));
            const float rstd = rsqrtf(var + GN_EPS);
            f32x4 g4; g4.x = bflo(wg.x); g4.y = bfhi(wg.x); g4.z = bflo(wg.y); g4.w = bfhi(wg.y);
            const f32x4 y = (dv * rstd * gg + gb + v4 * bs) * g4;
            u32x2 w; w.x = pk2(y.x, y.y); w.y = pk2(y.z, y.w); *(u32x2*)(ORW + o) = w;
        }
    }
}

#define DPPQ(q) "quad_perm:[" #q "," #q "," #q "," #q "] row_mask:0xf bank_mask:0xf"
#define FMAC_DPP(acc, x, s, q) asm("v_fmac_f32_dpp %0, %1, %2 " DPPQ(q) : "+v"(acc) : "v"(x), "v"(s))
#define MUL_DPP(dst, x, s, q) asm("v_mul_f32_dpp %0, %1, %2 " DPPQ(q) : "=v"(dst) : "v"(x), "v"(s))
#define LBAR() asm volatile("s_waitcnt lgkmcnt(0)\n\ts_barrier" ::: "memory")

typedef float f32x2s __attribute__((ext_vector_type(2)));
struct ScanCtx {
    const float* ga[6]; bf16_t* po; long r0, dstep; int T;
    LAS float* part; LAS float* opart; LAS float* ring; int wid, lane;
};
constexpr int SCAN_RING = 16, SCAN_SLOTF = 6 * 64;
__device__ __forceinline__ void scan_hload(const ScanCtx& C, int u, float (&R)[6]) {
    const int uu = u < C.T ? u : C.T - 1; const long ro = (C.r0 + C.dstep * (long)uu) * D;
#pragma unroll
    for (int a = 0; a < 6; ++a) R[a] = C.ga[a][ro];
}
__device__ __forceinline__ void scan_hwrite(const ScanCtx& C, int u, const float (&R)[6]) {
    LAS float* sl = C.ring + (u & (SCAN_RING - 1)) * SCAN_SLOTF + C.lane;
#pragma unroll
    for (int a = 0; a < 6; ++a) sl[a * 64] = R[a];
}
__device__ __forceinline__ void scan_ld4(const LAS float* p, f32x4 (&v)[4]) {
#pragma unroll
    for (int q = 0; q < 4; ++q) v[q] = *(const LAS f32x4*)(p + 4 * q);
}
__device__ __forceinline__ void scan_chain(unsigned char* ws, LAS unsigned char* lds, int s, int h, int d, int T, int tbeg, int nsteps, int mode, bf16_t* obase, float* sd) {
    int tid_ = threadIdx.x; asm volatile("" : "+v"(tid_));
    const int tid = tid_, lane = tid & 63, wid = __builtin_amdgcn_readfirstlane(tid >> 6);
    ScanCtx C; C.T = nsteps; C.wid = wid; C.lane = lane;
    const int col = h * 64; const size_t dofs = (size_t)d * MC * D;
    C.ga[0] = (const float*)(ws + WS_OPKH) + col + lane; C.ga[1] = (const float*)(ws + WS_OPW) + dofs + col + lane; C.ga[2] = (const float*)(ws + WS_OPAK) + dofs + col + lane;
    C.ga[3] = (const float*)(ws + WS_OPKT) + dofs + col + lane; C.ga[4] = (const float*)(ws + WS_OPR) + col + lane; C.ga[5] = (const float*)(ws + WS_VS) + col + lane;
    C.po = obase + col + lane;
    C.dstep = d ? -1 : 1; C.r0 = (d ? (long)s * T + T - 1 : (long)s * T) + C.dstep * (long)tbeg;
    C.part = (LAS float*)lds; C.opart = (LAS float*)(lds + 2048); C.ring = (LAS float*)(lds + 18432);
    if (wid < 4) {
        f32x2s S2[8];
#pragma unroll
        for (int j = 0; j < 8; ++j) { S2[j].x = (mode && lane == 16 * wid + 2 * j) ? 1.f : 0.f; S2[j].y = (mode && lane == 16 * wid + 2 * j + 1) ? 1.f : 0.f; }
        LBAR();
        f32x4 kh[4]; scan_ld4(C.ring + wid * 16, kh);
        int par = 0;
        for (int t0 = 0; t0 < nsteps; t0 += 8) {
#pragma unroll
            for (int i = 0; i < 8; ++i) {
                const LAS float* sl = C.ring + (((t0 & 8) + i) & (SCAN_RING - 1)) * SCAN_SLOTF;
                f32x4 w4[4], ak[4], kt[4], r4[4];
                scan_ld4(sl + 64 + wid * 16, w4); scan_ld4(sl + 128 + wid * 16, ak); scan_ld4(sl + 192 + wid * 16, kt); scan_ld4(sl + 256 + wid * 16, r4);
                const float vraw = sl[320 + lane];
                f32x4 khn[4]; scan_ld4(C.ring + (((t0 & 8) + i + 1) & (SCAN_RING - 1)) * SCAN_SLOTF + wid * 16, khn);
                f32x2s pa = {0.f, 0.f}, pb = {0.f, 0.f};
#pragma unroll
                for (int q = 0; q < 4; ++q) { pa = kh[q].xy * S2[2 * q] + pa; pb = kh[q].zw * S2[2 * q + 1] + pb; }
                LAS float* pp = C.part + (i & 1) * 256;
                pp[wid * 64 + lane] = (pa.x + pa.y) + (pb.x + pb.y);
                LBAR();
                const unsigned paddr = (unsigned)(unsigned long)(pp + lane);
                f32x2s r0, r1;
                asm volatile("ds_read2st64_b32 %0, %2 offset1:1\n\tds_read2st64_b32 %1, %2 offset0:2 offset1:3" : "=&v"(r0), "=&v"(r1) : "v"(paddr) : "memory");
                asm volatile("s_waitcnt lgkmcnt(0)" : "+v"(r0), "+v"(r1) :: "memory");
                const float nsk = -((r0.x + r0.y) + (r1.x + r1.y)), vv = mode ? 0.f : vraw;
                const f32x2s nsk2 = {nsk, nsk}, vv2 = {vv, vv};
                f32x2s oa = {0.f, 0.f}, ob = {0.f, 0.f};
#pragma unroll
                for (int q = 0; q < 4; ++q) {
                    S2[2 * q]     = S2[2 * q]     * w4[q].xy + (nsk2 * ak[q].xy + vv2 * kt[q].xy); oa = r4[q].xy * S2[2 * q]     + oa;
                    S2[2 * q + 1] = S2[2 * q + 1] * w4[q].zw + (nsk2 * ak[q].zw + vv2 * kt[q].zw); ob = r4[q].zw * S2[2 * q + 1] + ob;
                }
                C.opart[(par * 8 + i) * 256 + wid * 64 + lane] = (oa.x + oa.y) + (ob.x + ob.y);
#pragma unroll
                for (int q = 0; q < 4; ++q) kh[q] = khn[q];
            }
            LBAR();
            par ^= 1;
        }
        if (sd) {
#pragma unroll
            for (int i = 0; i < 4; ++i) *(f32x4*)(sd + (size_t)lane * 64 + 16 * wid + 4 * i) = (f32x4){S2[2 * i].x, S2[2 * i].y, S2[2 * i + 1].x, S2[2 * i + 1].y};
        }
    } else {
        const int hsl = wid - 4; int par = 0;
        float R[6];
#pragma unroll
        for (int k = 0; k < 2; ++k) { scan_hload(C, hsl + 4 * k, R); scan_hwrite(C, hsl + 4 * k, R); }
        scan_hload(C, hsl + 8, R);
        LBAR();
        for (int t0 = 0; t0 < nsteps; t0 += 8) {
#pragma unroll
            for (int i = 0; i < 8; ++i) {
                if ((i & 3) == hsl) { scan_hwrite(C, t0 + i + 8, R); scan_hload(C, t0 + i + 12, R); }
                LBAR();
            }
            LBAR();
#pragma unroll
            for (int k = 0; k < 2; ++k) { const int slot = hsl + 4 * k; const LAS float* op = C.opart + (par * 8 + slot) * 256 + lane;
                const float o = (op[0] + op[64]) + (op[128] + op[192]);
                C.po[(C.r0 + C.dstep * (long)(t0 + slot)) * D] = (bf16_t)(pk2(o, o) & 0xffffu); }
            par ^= 1;
        }
    }
    LBAR();
}

__device__ __forceinline__ void scan_fixup_tile(const bf16_t* Q, const float* sd, bf16_t* O, int lane) {
    const int fr = lane & 15, fq = lane >> 4;
    bf16x8v a[2][2];
#pragma unroll
    for (int mt = 0; mt < 2; ++mt)
#pragma unroll
        for (int ks = 0; ks < 2; ++ks) a[mt][ks] = *(const bf16x8v*)(Q + (size_t)(mt * 16 + fr) * D + ks * 32 + 8 * fq);
#pragma unroll 2
    for (int nt = 0; nt < 4; ++nt) {
        f32x4 acc0 = {0.f, 0.f, 0.f, 0.f}, acc1 = {0.f, 0.f, 0.f, 0.f};
#pragma unroll
        for (int ks = 0; ks < 2; ++ks) {
            const float* bp = sd + (size_t)(nt * 16 + fr) * 64 + ks * 32 + 8 * fq;
            const f32x4 b0 = *(const f32x4*)bp, b1 = *(const f32x4*)(bp + 4);
            const u32x4 bw = pack8(b0, b1); const bf16x8v b = __builtin_bit_cast(bf16x8v, bw);
            acc0 = __builtin_amdgcn_mfma_f32_16x16x32_bf16(b, a[0][ks], acc0, 0, 0, 0); acc1 = __builtin_amdgcn_mfma_f32_16x16x32_bf16(b, a[1][ks], acc1, 0, 0, 0);
        }
#pragma unroll
        for (int mt = 0; mt < 2; ++mt) {
            bf16_t* op = O + (size_t)(mt * 16 + fr) * D + nt * 16 + 4 * fq; const f32x4 acc = mt ? acc1 : acc0;
            const u32x2 w = *(const u32x2*)op; u32x2 o;
            o.x = pk2(bflo(w.x) + acc.x, bfhi(w.x) + acc.y); o.y = pk2(bflo(w.y) + acc.z, bfhi(w.y) + acc.w);
            *(u32x2*)op = o;
        }
    }
}

#define RLX_AGENT __ATOMIC_RELAXED, __HIP_MEMORY_SCOPE_AGENT
#define XB_TMO      128
#define XB_XCNT(j)  (256  + 64 * (j))
#define XB_XSUB(j)  (1280 + 64 * (j))
#define XB_XGEN(j)  (2304 + 64 * (j))
#define XB_TOP      3328
#define XB_TOPGEN   3392
#define XCD_BAR_WORDS 3456
#define XB_SPIN_CAP (1u << 28)

__device__ __forceinline__ unsigned xb_ld(unsigned* p)              { return __hip_atomic_load(p, __ATOMIC_RELAXED, __HIP_MEMORY_SCOPE_AGENT); }
__device__ __forceinline__ unsigned xb_add(unsigned* p, unsigned v) { return __hip_atomic_fetch_add(p, v, __ATOMIC_RELAXED, __HIP_MEMORY_SCOPE_AGENT); }
__device__ __forceinline__ unsigned xb_xcc_id() { return (unsigned)__builtin_amdgcn_s_getreg((3 << 11) | 20) & 0xFu; }
#define XB_SPIN(cond, bar) do { unsigned _sp = 0; while (cond) { __builtin_amdgcn_s_sleep(1); \
    if ((++_sp & 255u) == 0u) { if (xb_ld(&(bar)[XB_TMO])) break; if (_sp > XB_SPIN_CAP) { atomicAdd(&(bar)[XB_TMO], 1u); break; } } } } while (0)

struct XcdBarrier {
    unsigned* bar; unsigned x;
    volatile LAS unsigned* st;
};

__device__ __forceinline__ XcdBarrier xcd_barrier_post(unsigned* bar, volatile LAS unsigned* st) {
    XcdBarrier b; b.bar = bar; b.x = xb_xcc_id(); b.st = st;
    if (threadIdx.x == 0) (void)xb_add(&bar[XB_XCNT(b.x)], 1u);
    return b;
}
__device__ __forceinline__ void xcd_barrier_complete(unsigned* bar, unsigned x, unsigned& nloc, unsigned& nx) {
    const unsigned G = gridDim.x * gridDim.y * gridDim.z;
    unsigned sum, cnt, mine, sp = 0u;
    for (;;) {
        sum = 0u; cnt = 0u; mine = 0u;
#pragma unroll
        for (unsigned j = 0; j < 16; ++j) { const unsigned c = xb_ld(&bar[XB_XCNT(j)]); sum += c; cnt += (c > 0u) ? 1u : 0u; mine = (j == x) ? c : mine; }
        if (sum == G) break;
        __builtin_amdgcn_s_sleep(1);
        if ((++sp & 255u) == 0u) { if (xb_ld(&bar[XB_TMO])) break; if (sp > XB_SPIN_CAP) { atomicAdd(&bar[XB_TMO], 1u); break; } }
    }
    nloc = mine > 0u ? mine : 1u; nx = cnt > 0u ? cnt : 1u;
}

__device__ __forceinline__ void xcd_barrier(const XcdBarrier& b) {
    asm volatile("s_waitcnt vmcnt(0)" ::: "memory");
    __syncthreads();
    if (threadIdx.x == 0) {
        unsigned* bar = b.bar;
        __builtin_amdgcn_s_waitcnt(0);
        unsigned nloc = b.st[0], nx = b.st[1];
        if (nloc == 0u) { xcd_barrier_complete(bar, b.x, nloc, nx); b.st[0] = nloc; b.st[1] = nx; }
        const unsigned old = xb_add(&bar[XB_XSUB(b.x)], 1u);
        const unsigned gen = old / nloc;
        if (old + 1u == (gen + 1u) * nloc) {
            __builtin_amdgcn_fence(__ATOMIC_RELEASE, "agent");
            asm volatile("s_waitcnt vmcnt(0)" ::: "memory");
            const unsigned og = xb_add(&bar[XB_TOP], 1u);
            const unsigned tg = og / nx;
            if (og + 1u == (tg + 1u) * nx) xb_add(&bar[XB_TOPGEN], 1u);
            else XB_SPIN(xb_ld(&bar[XB_TOPGEN]) == tg, bar);
            __builtin_amdgcn_fence(__ATOMIC_ACQUIRE, "agent");
            xb_add(&bar[XB_XGEN(b.x)], 1u);
            asm volatile("s_waitcnt vmcnt(0)" ::: "memory");
        } else {
            XB_SPIN(xb_ld(&bar[XB_XGEN(b.x)]) == gen, bar);
            __builtin_amdgcn_fence(__ATOMIC_ACQUIRE, "agent");
            asm volatile("s_waitcnt vmcnt(0)" ::: "memory");
        }
    }
    __syncthreads();
}
__global__ void __launch_bounds__(NTHREADS, 2) mega_fwd(Args A) {
    extern __shared__ __attribute__((aligned(16))) unsigned char lds_raw[];
    LAS unsigned char* lds = (LAS unsigned char*)lds_raw;
    cg::grid_group grid = cg::this_grid();
#define TIDV int tid_ = threadIdx.x; asm volatile("" : "+v"(tid_)); const int tid = tid_, lane = tid & 63, wave = __builtin_amdgcn_readfirstlane(tid >> 6); \
    const int G = gridDim.x, gw = blockIdx.x * NWAVES + wave, ngw = G * NWAVES, gtid = blockIdx.x * NTHREADS + tid, gthreads = G * NTHREADS; \
    (void)lane; (void)gw; (void)ngw; (void)gtid; (void)gthreads;

    if (A.ph_hi < 0) grid.sync();
    { volatile LAS unsigned* misc = (volatile LAS unsigned*)(lds + LDS_MISC);
      if (threadIdx.x < 32) misc[threadIdx.x] = 0u;
      __syncthreads(); }
    XcdBarrier bar = xcd_barrier_post((unsigned*)(A.ws + WS_CTL) + 4096, (volatile LAS unsigned*)(lds + LDS_MISC) + 8);
    for (int ph = A.ph_lo; ph < A.ph_hi; ++ph) {
        if (ph > A.ph_lo) xcd_barrier(bar);
        int z = 0; asm volatile("" : "+s"(z));
        unsigned char* ws = A.ws + z;
        if (ph == 0) {
            TIDV
            LAS float* scr = (LAS float*)(lds + wave * 16384);
            constexpr int I_IN = 16 * (NIN / 32), I_SQ = 16 * 32, I_F1 = 16 * 128, I_F2 = 64 * 32, I_G = 2 * 32, I_U = 32;
            constexpr int NITEMS = I_IN + 3 * I_SQ + I_F1 + I_F2 + I_G + 4 * I_U;
            for (int it = gw; it < NITEMS; it += ngw) {
                int r = it;
                if (r < I_IN) { p0_transpose_item(INP(2), D, NIN, (bf16_t*)(ws + WS_WIN), scr, r, lane); continue; } r -= I_IN;
                if (r < I_SQ) { p0_transpose_item(INP(17), D, D, (bf16_t*)(ws + WS_WPR), scr, r, lane); continue; } r -= I_SQ;
                if (r < I_SQ) { p0_transpose_item(INP(18), D, D, (bf16_t*)(ws + WS_WPA), scr, r, lane); continue; } r -= I_SQ;
                if (r < I_SQ) { p0_transpose_item(INP(19), D, D, (bf16_t*)(ws + WS_WOUT), scr, r, lane); continue; } r -= I_SQ;
                if (r < I_F1) { p0_transpose_item(INP(22), D, FF, (bf16_t*)(ws + WS_WF1), scr, r, lane); continue; } r -= I_F1;
                if (r < I_F2) { p0_transpose_item(INP(23), FF, D, (bf16_t*)(ws + WS_WF2), scr, r, lane); continue; } r -= I_F2;
                if (r < I_G) { p0_transpose_item(INP(9), 128, D, (bf16_t*)(ws + WS_GUP), scr, r, lane); continue; } r -= I_G;
                { const int which = r / I_U, it2 = r % I_U, dd = which & 1;
                  p0_transpose_item((which < 2 ? INP(6) : INP(8)) + (size_t)dd * 64 * 1024, 64, D, (bf16_t*)(ws + (which < 2 ? WS_WUP : WS_AUP)) + (size_t)dd * 1024 * 64, scr, it2, lane); }
            }
            cvt_x_chunk(INP(0), (bf16_t*)(ws + WS_XB), gtid, gthreads);
            continue;
        }
        if (ph == 1 + 9 * NCHUNK) {
            TIDV
            ln_rows(A.out + (size_t)(NCHUNK - 1) * MC * D, INP(24), INP(25), nullptr, gw, ngw, lane);
            continue;
        }
        const int c = (ph - 1) / 9, sub = (ph - 1) % 9;
        const int T = (c < 4) ? 2048 : 8192;
        const float* xin = (c < 4) ? INP(0) + (size_t)c * MC * D : INP(1);
        float* outc = A.out + (size_t)c * MC * D;
        if (sub == 0) {
            { Epi8<FZ> e{{(bf16_t*)(ws + WS_Z)}};
              run_gemm(lds, (const bf16_t*)(ws + WS_XB), (const bf16_t*)(ws + WS_WIN), MC, NINP, D, e); }
            if (c > 0) { TIDV ln_rows(A.out + (size_t)(c - 1) * MC * D, INP(24), INP(25), nullptr, gw, ngw, lane); }
        } else if (sub == 1) {
            TIDV
            const int G_ = gridDim.x, b_ = blockIdx.x, tile_lo = (int)(((long)(MC / 32) * b_) / G_), tile_hi = (int)(((long)(MC / 32) * (b_ + 1)) / G_);
            prep_rows(INP(3), INP(4), INP(10), INP(15), INP(16), ws, T, tile_lo * 32 + wave, NWAVES, tile_hi * 32, lane, true);
            __syncthreads();
            const int nit = (tile_hi - tile_lo) * 40;
            for (int it = wave; it < nit; it += NWAVES) {
                const int mt = it / 40, r = it % 40, which = r >> 3, m0 = (tile_lo + mt) * 32, n0 = (r & 7) * 128;
                if (which < 2) { FW f{INP(5) + which * 1024, (float*)(ws + WS_OPW) + (size_t)which * MC * D};
                    wave_gemm_tile<64>((const bf16_t*)(ws + WS_TW), which * 64, (const bf16_t*)(ws + WS_WUP) + (size_t)which * 1024 * 64, m0, n0, lane, f); }
                else if (which < 4) { const int dd = which - 2;
                    FA f{INP(7) + dd * 1024, INP(11), (const bf16_t*)(ws + WS_KS), (const float*)(ws + WS_OPKH), (float*)(ws + WS_OPAK) + (size_t)dd * MC * D, (float*)(ws + WS_OPKT) + (size_t)dd * MC * D};
                    wave_gemm_tile<64>((const bf16_t*)(ws + WS_AD), dd * 64, (const bf16_t*)(ws + WS_AUP) + (size_t)dd * 1024 * 64, m0, n0, lane, f); }
                else { FG f{(bf16_t*)(ws + WS_G)};
                    wave_gemm_tile<128>((const bf16_t*)(ws + WS_SG), 0, (const bf16_t*)(ws + WS_GUP), m0, n0, lane, f); }
            }
        } else if (sub == 2) {
            const int nseq = MC / T, nchain = (c < 4) ? nseq * 32 : 192, nqb = T / 256, natt = nseq * 8 * nqb;
            LAS unsigned* qslot = (LAS unsigned*)(lds + LDS_MISC); const int tid = threadIdx.x;
            for (;;) {
                __syncthreads();
                if (tid == 0) qslot[0] = atomicAdd((unsigned*)(ws + WS_CTL) + 64 * c, 1u);
                __syncthreads();
                const int item = __builtin_amdgcn_readfirstlane((int)qslot[0]);
                if (item >= nchain + natt) break;
                if (item < nchain) {
                    if (c < 4) scan_chain(ws, lds, item >> 5, (item >> 1) & 15, item & 1, T, 0, T, 0, (bf16_t*)(ws + ((item & 1) ? WS_OB : WS_OF)), nullptr);
                    else {
                        const int ch = item / 3, job = item % 3, d_ = ch & 1;
                        bf16_t* ob = (job == 2) ? (bf16_t*)(A.out + (size_t)(NCHUNK - 1) * MC * D) + (size_t)d_ * MC * D : (bf16_t*)(ws + (d_ ? WS_OB : WS_OF));
                        scan_chain(ws, lds, ch >> 5, (ch >> 1) & 15, d_, T, job ? 4096 : 0, 4096, job == 2, ob, job == 0 ? (float*)(ws + WS_END) + (size_t)ch * 4096 : nullptr);
                    }
                }
                else {
                    const int u = item - nchain, qb = u % nqb, hq = (u / nqb) & 7, s = u / (nqb * 8);
                    const att::bf16* qkv = (const att::bf16*)(ws + WS_Z) + (size_t)s * T * ZLD;
                    att::attn_dense_body(qkv + (size_t)qb * 256 * ZLD + ZQ + hq * 128, qkv + ZK + (hq >> 2) * 128, qkv + ZV + (hq >> 2) * 128,
                                         (att::bf16*)(ws + WS_OATT) + ((size_t)s * T + (size_t)qb * 256) * D + hq * 128, T, (char*)lds_raw);
                }
            }
        } else if (sub == 3) {
            TIDV
            if (c == 4) {
                for (int it = gw; it < 64 * 128; it += ngw) {
                    const int ch = it >> 7, tile = it & 127, s_ = ch >> 5, h_ = (ch >> 1) & 15, d_ = ch & 1;
                    const size_t row0 = (size_t)s_ * T + (d_ ? 0 : 4096) + (size_t)tile * 32;
                    scan_fixup_tile((const bf16_t*)(A.out + (size_t)(NCHUNK - 1) * MC * D) + (size_t)d_ * MC * D + row0 * D + h_ * 64, (const float*)(ws + WS_END) + (size_t)ch * 4096,
                                    (bf16_t*)(ws + (d_ ? WS_OB : WS_OF)) + row0 * D + h_ * 64, lane);
                }
                xcd_barrier(bar);
            }
            post_rows(INP(12), INP(13), INP(14), ws, gw, ngw, lane);
        } else if (sub == 4) {
            { Epi4<FP1> e{{(const bf16_t*)(ws + WS_Z), (float*)(ws + WS_M32)}};
              run_gemm(lds, (const bf16_t*)(ws + WS_ORW), (const bf16_t*)(ws + WS_WPR), MC, D, D, e); }
            { Epi4<FP2> e{{(const bf16_t*)(ws + WS_Z), (const float*)(ws + WS_M32), (bf16_t*)(ws + WS_MB)}};
              run_gemm(lds, (const bf16_t*)(ws + WS_OATT), (const bf16_t*)(ws + WS_WPA), MC, D, D, e); }
        } else if (sub == 5) {
            Epi4<FOut> e{{xin, outc}};
            run_gemm(lds, (const bf16_t*)(ws + WS_MB), (const bf16_t*)(ws + WS_WOUT), MC, D, D, e);
        } else if (sub == 6) {
            TIDV
            ln_rows(outc, INP(20), INP(21), (bf16_t*)(ws + WS_HB), gw, ngw, lane);
            if (c + 1 < NCHUNK) cvt_x_chunk((c + 1 < 4) ? INP(0) + (size_t)(c + 1) * MC * D : INP(1), (bf16_t*)(ws + WS_XB), gtid, gthreads);
        } else if (sub == 7) {
            Epi8<FF1> e{{(bf16_t*)(ws + WS_FFH)}};
            run_gemm(lds, (const bf16_t*)(ws + WS_HB), (const bf16_t*)(ws + WS_WF1), MC, FF, D, e);
        } else {
            Epi4<FF2> e{{outc}};
            run_gemm(lds, (const bf16_t*)(ws + WS_FFH), (const bf16_t*)(ws + WS_WF2), MC, D, FF, e);
        }
    }
}

constexpr int NPHASE = 2 + 9 * NCHUNK;

extern "C" void kernel_launch(void* const* d_in, const int* in_sizes, int n_in, void* d_out, int out_size, void* d_ws, size_t ws_size, hipStream_t stream) {
    static int grid = 0;
    if (grid == 0) {
        if (n_in != 26 || out_size != MTOT * D || ws_size < WS_END + 2 * MiB) { fprintf(stderr, "kernel_launch: unexpected shapes n_in %d out %d ws %zu\n", n_in, out_size, ws_size); grid = -1; return; }
        int dev = 0, cus = 0, per_cu = 0;
        hipGetDevice(&dev); hipDeviceGetAttribute(&cus, hipDeviceAttributeMultiprocessorCount, dev);
        if (hipFuncSetAttribute((const void*)mega_fwd, hipFuncAttributeMaxDynamicSharedMemorySize, LDS_BYTES) != hipSuccess) { fprintf(stderr, "kernel_launch: LDS attribute failed\n"); grid = -1; return; }
        if (hipOccupancyMaxActiveBlocksPerMultiprocessor(&per_cu, (const void*)mega_fwd, NTHREADS, LDS_BYTES) != hipSuccess || per_cu < 1) per_cu = 1;
        (void)hipGetLastError();
        grid = cus * (per_cu > 1 ? 1 : per_cu);
    }
    if (grid < 0) return;
    hipMemsetAsync((char*)d_ws + WS_CTL, 0, 64 * 1024, stream);
    Args a{};
    for (int i = 0; i < 26; ++i) a.in[i] = (const float*)d_in[i];
    a.out = (float*)d_out; a.ws = (unsigned char*)d_ws; a.ph_lo = 0; a.ph_hi = NPHASE;
    void* args[] = {&a};
    hipError_t e = hipLaunchCooperativeKernel((const void*)mega_fwd, dim3(grid), dim3(NTHREADS), args, LDS_BYTES, stream);
    if (e != hipSuccess) fprintf(stderr, "cooperative launch failed: %s (grid %d)\n", hipGetErrorString(e), grid);
}
```

```cpp
#include <hip/hip_runtime.h>
#include <hip/hip_bf16.h>
#include <hip/hip_cooperative_groups.h>
#include <cstdio>
#include <cstdint>
namespace cg = cooperative_groups;
namespace pg8 {
#define PG8_LAS __attribute__((address_space(3)))
typedef unsigned short bf16_t;
typedef short bf16x8 __attribute__((ext_vector_type(8)));
typedef float f32x4 __attribute__((ext_vector_type(4)));
typedef unsigned u32x4 __attribute__((ext_vector_type(4)));
constexpr int BM = 256, BK = 64, HALF = 128, HTB = HALF * BK * 2  , STAGE_BYTES = 8 * HTB, NXCD = 8, WGM = 8;

__host__ __device__ __forceinline__ int lds_byte(int r, int c) { const int st = (r >> 4) * 2 + (c >> 5), rr = r & 15, cc = c & 31, ob = rr * 64 + cc * 2; return st * 1024 + (ob ^ (((ob >> 9) & 1) << 5)); }
__host__ __device__ __forceinline__ void stage_rc(int b, int& R, int& C) { const int st = b / 1024, sb = b % 1024, swz = sb ^ (((sb >> 9) & 1) << 5); R = (st >> 1) * 16 + swz / 64; C = (st & 1) * 32 + (swz % 64) / 2; }
__host__ __device__ __forceinline__ int perm32(int rho) { const int n = rho >> 4, i = rho & 15; return 8 * (i >> 2) + 4 * n + (i & 3); }

struct Unit { int pm, pn; };
struct Gemm { const bf16_t* A; const bf16_t* Bt; int M, N, K; };

struct StaticOrder {
    int nM, nN, nwg, G, c;
    __host__ __device__ void init(int M, int N, int G_, int c_) { nM = M / BM; nN = N / BM; nwg = nM * nN; G = G_; c = c_; }
    __host__ __device__ bool next(int i, Unit& u) const {
        const long L = (long)i * G + c; if (L >= nwg) return false;
        int wgid = (int)L; { const int q = nwg / NXCD, r = nwg % NXCD, xcd = wgid % NXCD, off = wgid / NXCD; wgid = (xcd < r ? xcd * (q + 1) : r * (q + 1) + (xcd - r) * q) + off; }
        const int nig = WGM * nN, gid = wgid / nig, fm = gid * WGM, gsz = (nM - fm) < WGM ? (nM - fm) : WGM;
        u.pm = fm + ((wgid % nig) % gsz); u.pn = (wgid % nig) / gsz; return true;
    }
    __device__ __forceinline__ void a_ready(const Unit&) const {}
    __device__ __forceinline__ void done(const Unit&) const {}
};
__device__ __forceinline__ unsigned cvt_pk_bf16(float lo, float hi) { unsigned r; asm volatile("v_cvt_pk_bf16_f32 %0, %1, %2" : "=v"(r) : "v"(lo), "v"(hi)); return r; }
typedef float f32x2 __attribute__((ext_vector_type(2)));
template <class Epi, class Sched, bool ALIGN_EPI = false, bool SP2 = false>
__device__ __forceinline__ void gemm_phase(PG8_LAS unsigned char* lds, const Gemm g, const Sched& S, const Epi& E) {
    int tid_ = threadIdx.x; asm volatile("" : "+v"(tid_));
    const int tid = tid_, wid = __builtin_amdgcn_readfirstlane(tid >> 6), lane = tid & 63, wr = wid >> 2, wc = wid & 3, fr = lane & 15, fq = lane >> 4;
    const int K = g.K, nt = K / BK;
    unsigned voffA[2], voffB[2];
#pragma unroll
    for (int i = 0; i < 2; ++i) { int R, C; stage_rc(tid * 16 + i * 8192, R, C); const int Rb = Epi::PERM ? ((R & ~31) + perm32(R & 31)) : R;
        voffA[i] = (unsigned)(R * K + C) * 2u; voffB[i] = (unsigned)(Rb * K + C) * 2u; }
    const size_t kstep = (size_t)(BK * 2);
    const size_t hstep = (size_t)HALF * K * 2;
    const size_t tstep = 2 * hstep;
    const unsigned ldsw = (unsigned)wid * 1024u;
    const int aoff = lds_byte(wr * 64 + fr, fq * 8), boff = lds_byte(wc * 32 + fr, fq * 8);
#define PG8_SA(b, h) (((b) * 2 + (h)) * HTB)
#define PG8_SB(b, h) ((4 + (b) * 2 + (h)) * HTB)
#define PG8_STAGE(bufoff, gbase, voff) do { _Pragma("unroll") for (int _i = 0; _i < 2; ++_i) \
        __builtin_amdgcn_global_load_lds((const unsigned*)((const char*)(gbase) + (voff)[_i]), (PG8_LAS unsigned*)(lds + (bufoff) + ldsw + _i * 8192), 16, 0, 0); } while (0)
#define PG8_LDA(dst, b, h) do { _Pragma("unroll") for (int m = 0; m < 4; ++m) _Pragma("unroll") for (int k = 0; k < 2; ++k) dst[m][k] = *(const PG8_LAS bf16x8*)(lds + PG8_SA(b, h) + aoff + m * 2048 + k * 1024); } while (0)
#define PG8_LDB(dst, b, h) do { _Pragma("unroll") for (int n = 0; n < 2; ++n) _Pragma("unroll") for (int k = 0; k < 2; ++k) dst[n][k] = *(const PG8_LAS bf16x8*)(lds + PG8_SB(b, h) + boff + n * 2048 + k * 1024); } while (0)
#define PG8_MMA(ai, bj, At, Bt) do { __builtin_amdgcn_s_setprio(1); _Pragma("unroll") for (int m = 0; m < 4; ++m) _Pragma("unroll") for (int n = 0; n < 2; ++n) _Pragma("unroll") for (int k = 0; k < 2; ++k) \
        acc[ai][bj][m][n] = __builtin_amdgcn_mfma_f32_16x16x32_bf16(Bt[n][k], At[m][k], acc[ai][bj][m][n], 0, 0, 0); __builtin_amdgcn_s_setprio(0); } while (0)
#define PG8_WAIT_V(n) asm volatile("s_waitcnt vmcnt(" #n ")" ::: "memory")
#define PG8_WAIT_L(n) asm volatile("s_waitcnt lgkmcnt(" #n ")" ::: "memory")
#define PG8_BAR __builtin_amdgcn_s_barrier()
#define PG8_SCHED __builtin_amdgcn_sched_barrier(0)
    Unit cur, nxt; int ui = 0;
    if (!S.next(0, cur)) return;
    f32x4 acc[2][2][4][2];
#pragma unroll
    for (int a = 0; a < 2; ++a)
#pragma unroll
        for (int b = 0; b < 2; ++b)
#pragma unroll
            for (int m = 0; m < 4; ++m)
#pragma unroll
                for (int n = 0; n < 2; ++n) acc[a][b][m][n] = (f32x4){0.f, 0.f, 0.f, 0.f};
    bf16x8 At[4][2], B0[2][2], B1[2][2];
    const char* cA = (const char*)g.A + (size_t)cur.pm * tstep; const char* cB = (const char*)g.Bt + (size_t)cur.pn * tstep;
    S.a_ready(cur);
    if constexpr (SP2) {
        PG8_STAGE(PG8_SB(0, 0), cB, voffB); PG8_STAGE(PG8_SB(0, 1), cB + hstep, voffB); PG8_STAGE(PG8_SA(0, 0), cA, voffA); PG8_STAGE(PG8_SA(0, 1), cA + hstep, voffA);
        if (wr == 1) PG8_BAR;
        PG8_WAIT_V(2); PG8_BAR;
        PG8_STAGE(PG8_SB(1, 0), cB + kstep, voffB); PG8_STAGE(PG8_SA(1, 0), cA + kstep, voffA); PG8_STAGE(PG8_SB(1, 1), cB + hstep + kstep, voffB);
        PG8_WAIT_V(6); PG8_BAR;
    } else {
        PG8_STAGE(PG8_SB(0, 0), cB, voffB); PG8_STAGE(PG8_SA(0, 0), cA, voffA); PG8_STAGE(PG8_SB(0, 1), cB + hstep, voffB); PG8_STAGE(PG8_SA(0, 1), cA + hstep, voffA);
        if (wr == 1) PG8_BAR;
        PG8_WAIT_V(4); PG8_BAR;
        PG8_STAGE(PG8_SB(1, 0), cB + kstep, voffB); PG8_STAGE(PG8_SA(1, 0), cA + kstep, voffA); PG8_STAGE(PG8_SB(1, 1), cB + hstep + kstep, voffB);
        PG8_WAIT_V(6); PG8_BAR;
    }
    for (;;) {
        const bool has_next = S.next(ui + 1, nxt);
        const char* nA = has_next ? (const char*)g.A + (size_t)nxt.pm * tstep : cA; const char* nB = has_next ? (const char*)g.Bt + (size_t)nxt.pn * tstep : cB;
        for (int t = 0; t < nt; t += 2) {
            const bool last = (t == nt - 2);
            const char* a1 = cA + (size_t)(t + 1) * kstep;
            const char* a2 = last ? nA : cA + (size_t)(t + 2) * kstep; const char* b2 = last ? nB : cB + (size_t)(t + 2) * kstep;
            const char* a3 = a2 + kstep; const char* b3 = b2 + kstep;
            if (last && has_next) S.a_ready(nxt);
            if constexpr (SP2) {
            PG8_LDB(B0, 0, 0); PG8_LDB(B1, 0, 1); PG8_SCHED; PG8_LDA(At, 0, 0); PG8_STAGE(PG8_SA(1, 1), a1 + hstep, voffA);
            PG8_WAIT_V(8); PG8_WAIT_L(0); PG8_BAR; PG8_MMA(0, 0, At, B0); PG8_MMA(0, 1, At, B1); PG8_BAR; PG8_SCHED;
            PG8_LDA(At, 0, 1); PG8_STAGE(PG8_SB(0, 0), b2, voffB); PG8_STAGE(PG8_SB(0, 1), b2 + hstep, voffB); PG8_STAGE(PG8_SA(0, 0), a2, voffA);
            PG8_WAIT_V(8); PG8_WAIT_L(0); PG8_BAR; PG8_MMA(1, 0, At, B0); PG8_MMA(1, 1, At, B1); PG8_BAR; PG8_SCHED;
            PG8_LDB(B0, 1, 0); PG8_LDB(B1, 1, 1); PG8_SCHED; PG8_LDA(At, 1, 0); PG8_STAGE(PG8_SA(0, 1), a2 + hstep, voffA);
            PG8_WAIT_V(8); PG8_WAIT_L(0); PG8_BAR; PG8_MMA(0, 0, At, B0); PG8_MMA(0, 1, At, B1); PG8_BAR; PG8_SCHED;
            PG8_LDA(At, 1, 1); PG8_STAGE(PG8_SB(1, 0), b3, voffB); PG8_STAGE(PG8_SB(1, 1), b3 + hstep, voffB); PG8_STAGE(PG8_SA(1, 0), a3, voffA);
            PG8_WAIT_V(8); PG8_WAIT_L(0); PG8_BAR; PG8_MMA(1, 0, At, B0); PG8_MMA(1, 1, At, B1); PG8_BAR; PG8_SCHED;
            } else {
            PG8_LDB(B0, 0, 0); PG8_SCHED; PG8_LDA(At, 0, 0); PG8_STAGE(PG8_SA(1, 1), a1 + hstep, voffA);
            PG8_WAIT_L(8); PG8_BAR; PG8_WAIT_L(0); PG8_MMA(0, 0, At, B0); PG8_BAR; PG8_SCHED;
            PG8_LDB(B1, 0, 1); PG8_STAGE(PG8_SB(0, 0), b2, voffB);
            PG8_BAR; PG8_WAIT_L(0); PG8_MMA(0, 1, At, B1); PG8_BAR;
            PG8_LDA(At, 0, 1); PG8_STAGE(PG8_SA(0, 0), a2, voffA);
            PG8_BAR; PG8_WAIT_L(0); PG8_MMA(1, 0, At, B0); PG8_BAR; PG8_SCHED;
            PG8_STAGE(PG8_SB(0, 1), b2 + hstep, voffB);
            PG8_WAIT_V(6); PG8_BAR; PG8_MMA(1, 1, At, B1); PG8_BAR;
            PG8_LDB(B0, 1, 0); PG8_SCHED; PG8_LDA(At, 1, 0); PG8_STAGE(PG8_SA(0, 1), a2 + hstep, voffA);
            PG8_WAIT_L(8); PG8_BAR; PG8_WAIT_L(0); PG8_MMA(0, 0, At, B0); PG8_BAR; PG8_SCHED;
            PG8_LDB(B1, 1, 1); PG8_STAGE(PG8_SB(1, 0), b3, voffB);
            PG8_BAR; PG8_WAIT_L(0); PG8_MMA(0, 1, At, B1); PG8_BAR;
            PG8_LDA(At, 1, 1); PG8_STAGE(PG8_SA(1, 0), a3, voffA);
            PG8_BAR; PG8_WAIT_L(0); PG8_MMA(1, 0, At, B0); PG8_BAR; PG8_SCHED;
            PG8_STAGE(PG8_SB(1, 1), b3 + hstep, voffB);
            PG8_WAIT_V(6); PG8_BAR; PG8_MMA(1, 1, At, B1); PG8_BAR;
            }
        }
        if constexpr (ALIGN_EPI) { if (wr == 0) PG8_BAR; }
        if constexpr (!Epi::AFTER_DRAIN) { E(acc, cur, wr, wc, fr, fq); S.done(cur); }
        if (!has_next) break;
#pragma unroll
        for (int a = 0; a < 2; ++a)
#pragma unroll
            for (int b = 0; b < 2; ++b)
#pragma unroll
                for (int m = 0; m < 4; ++m)
#pragma unroll
                    for (int n = 0; n < 2; ++n) acc[a][b][m][n] = (f32x4){0.f, 0.f, 0.f, 0.f};
        cur = nxt; cA = nA; cB = nB; ++ui;
        if constexpr (ALIGN_EPI) { if (wr == 1) PG8_BAR; }
    }
    PG8_WAIT_V(0);
    if constexpr (!ALIGN_EPI) { if (wr == 0) PG8_BAR; }
    PG8_BAR;
    if constexpr (Epi::AFTER_DRAIN) { E.fused(acc, cur, wr, wc, fr, fq, lds, wid, lane); S.done(cur); }
#undef PG8_SA
#undef PG8_SB
#undef PG8_STAGE
#undef PG8_LDA
#undef PG8_LDB
#undef PG8_MMA
#undef PG8_WAIT_V
#undef PG8_WAIT_L
#undef PG8_BAR
#undef PG8_SCHED
}
}
namespace att {
using bf16 = __hip_bfloat16;
constexpr int   D = 128, NW = 8, QBLK = 32, KVBLK = 64;
constexpr float SCALE = 0.088388347648318440f;
constexpr float THR = 8.f;
constexpr int LDQ = 7168, LDK = 7168, LDO = 1024;
constexpr size_t SHM_V = KVBLK * D * 2, SHM_K = KVBLK * D * 2, SHM_ATTN = 2 * SHM_V + 2 * SHM_K + NW * 64 * 4;
using bf16x8 = __attribute__((ext_vector_type(8))) short;
using s16x4  = __attribute__((ext_vector_type(4))) short;
using f32x16 = __attribute__((ext_vector_type(16))) float;
using u32x4  = __attribute__((ext_vector_type(4))) unsigned;
#define KSWZ(row, colB) ((row) * 256 + ((colB) ^ (((row) & 7) << 4)))
#define SBAR() __builtin_amdgcn_sched_barrier(0)
__device__ __forceinline__ int crow(int r, int hi) { return (r & 3) + 8 * (r >> 2) + 4 * hi; }
__device__ __forceinline__ unsigned cvtpk(float lo, float hi) {
  unsigned r; asm volatile("v_cvt_pk_bf16_f32 %0, %1, %2" : "=v"(r) : "v"(lo), "v"(hi)); return r;
}
__device__ __forceinline__ bf16x8 ld8(const bf16* p) { return *reinterpret_cast<const bf16x8*>(p); }
__device__ __forceinline__ void partialSM(f32x16& p0, f32x16& p1, float& m_reg, float& mn, float& alpha) {
  constexpr float C = SCALE * 1.4426950408889634f;
  float pmax = p0[0]; for (int r = 1; r < 16; ++r) pmax = fmaxf(pmax, p0[r]); for (int r = 0; r < 16; ++r) pmax = fmaxf(pmax, p1[r]);
  { auto rr = __builtin_amdgcn_permlane32_swap(__float_as_uint(pmax), __float_as_uint(pmax), false, false);
    pmax = fmaxf(__uint_as_float(rr[0]), __uint_as_float(rr[1])); }
  if (__builtin_expect(__all(pmax - m_reg <= THR / SCALE), 1)) { mn = m_reg; alpha = 1.f; }
  else { mn = fmaxf(m_reg, pmax); alpha = __builtin_amdgcn_exp2f((m_reg - mn) * C); m_reg = mn; }
  float mnC = -mn * C;
  for (int r = 0; r < 16; ++r) p0[r] = fmaf(p0[r], C, mnC); for (int r = 0; r < 16; ++r) p1[r] = fmaf(p1[r], C, mnC);
  for (int r = 0; r < 16; ++r) p0[r] = __builtin_amdgcn_exp2f(p0[r]);
}
__device__ __forceinline__ void finishSM(f32x16& p0, f32x16& p1, float alpha, float& l_reg, bf16x8& pa0, bf16x8& pa1, bf16x8& pa2, bf16x8& pa3) {
  for (int r = 0; r < 16; ++r) p1[r] = __builtin_amdgcn_exp2f(p1[r]);
  float ps = 0; for (int r = 0; r < 16; ++r) ps += p0[r]; for (int r = 0; r < 16; ++r) ps += p1[r];
  { auto rr = __builtin_amdgcn_permlane32_swap(__float_as_uint(ps), __float_as_uint(ps), false, false);
    ps = __uint_as_float(rr[0]) + __uint_as_float(rr[1]); }
  l_reg = l_reg * alpha + ps;
#define PK4(P, BASE, OUT) do { unsigned a0 = cvtpk(P[BASE + 0], P[BASE + 1]), a1 = cvtpk(P[BASE + 2], P[BASE + 3]);   \
    unsigned b0 = cvtpk(P[BASE + 4], P[BASE + 5]), b1 = cvtpk(P[BASE + 6], P[BASE + 7]);                              \
    auto r0 = __builtin_amdgcn_permlane32_swap(a0, b0, false, false); auto r1 = __builtin_amdgcn_permlane32_swap(a1, b1, false, false); \
    u32x4 w = {r0[0], r1[0], r0[1], r1[1]}; OUT = *reinterpret_cast<bf16x8*>(&w); } while (0)
  PK4(p0, 0, pa0); PK4(p0, 8, pa1); PK4(p1, 0, pa2); PK4(p1, 8, pa3);
#undef PK4
}
__device__ __forceinline__ void qkt(f32x16& p0, f32x16& p1, const bf16* Ks, const bf16x8* qr, int r32, int hi) {
  p0 = f32x16{}; p1 = f32x16{};
  for (int d0 = 0; d0 < 8; ++d0) { int cb = (d0 * 16 + hi * 8) * 2;
    bf16x8 b0 = *reinterpret_cast<const bf16x8*>((const char*)Ks + KSWZ(r32, cb));
    bf16x8 b1 = *reinterpret_cast<const bf16x8*>((const char*)Ks + KSWZ(32 + r32, cb));
    p0 = __builtin_amdgcn_mfma_f32_32x32x16_bf16(b0, qr[d0], p0, 0, 0, 0);
    p1 = __builtin_amdgcn_mfma_f32_32x32x16_bf16(b1, qr[d0], p1, 0, 0, 0); }
}
__device__ __forceinline__ int v_st(int k, int c) { const int kk = (k & ~0xC) | ((k & 4) << 1) | ((k & 8) >> 1); return ((kk >> 3) * 4 + (c >> 5)) * 512 + ((kk & 7) * 32 + (c & 31)) * 2; }
__device__ __forceinline__ int v_rd_base(int lane) { return ((lane & 3) << 3) | (((lane >> 2) & 3) << 6) | (((lane >> 4) & 1) << 5) | (((lane >> 5) & 1) << 8); }
constexpr int v_rd_off(int d0, int ks, int half) { return d0 * 512 + ks * 4096 + half * 2048; }
template <int OFF> __device__ __forceinline__ s16x4 tr_read(int vb) {
  s16x4 r; asm volatile("ds_read_b64_tr_b16 %0, %1 offset:%2" : "=&v"(r) : "v"(vb), "i"(OFF) : "memory"); return r;
}
template <int D0> __device__ __forceinline__ void pv_one(f32x16& od, int vb, bf16x8 pa0, bf16x8 pa1, bf16x8 pa2, bf16x8 pa3) {
  const s16x4 l0 = tr_read<v_rd_off(D0, 0, 0)>(vb), h0 = tr_read<v_rd_off(D0, 0, 1)>(vb), l1 = tr_read<v_rd_off(D0, 1, 0)>(vb), h1 = tr_read<v_rd_off(D0, 1, 1)>(vb);
  const s16x4 l2 = tr_read<v_rd_off(D0, 2, 0)>(vb), h2 = tr_read<v_rd_off(D0, 2, 1)>(vb), l3 = tr_read<v_rd_off(D0, 3, 0)>(vb), h3 = tr_read<v_rd_off(D0, 3, 1)>(vb);
  asm volatile("s_waitcnt lgkmcnt(0)" ::: "memory"); SBAR();
#define PK(L, H) (bf16x8){L[0], L[1], L[2], L[3], H[0], H[1], H[2], H[3]}
  od = __builtin_amdgcn_mfma_f32_32x32x16_bf16(pa0, PK(l0, h0), od, 0, 0, 0);
  od = __builtin_amdgcn_mfma_f32_32x32x16_bf16(pa1, PK(l1, h1), od, 0, 0, 0);
  od = __builtin_amdgcn_mfma_f32_32x32x16_bf16(pa2, PK(l2, h2), od, 0, 0, 0);
  od = __builtin_amdgcn_mfma_f32_32x32x16_bf16(pa3, PK(l3, h3), od, 0, 0, 0);
#undef PK
}
__device__ __forceinline__ void pv_d0(f32x16* o, int vb, bf16x8 pa0, bf16x8 pa1, bf16x8 pa2, bf16x8 pa3) {
  pv_one<0>(o[0], vb, pa0, pa1, pa2, pa3); pv_one<1>(o[1], vb, pa0, pa1, pa2, pa3); pv_one<2>(o[2], vb, pa0, pa1, pa2, pa3); pv_one<3>(o[3], vb, pa0, pa1, pa2, pa3);
}
__device__ __forceinline__ void attn_dense_body(const bf16* __restrict__ Qb, const bf16* __restrict__ Kh, const bf16* __restrict__ Vh,
                                                bf16* __restrict__ Ob, int seq, char* lds) {
  int tid_ = threadIdx.x; asm volatile("" : "+v"(tid_));
  const int tid = tid_, wid = tid >> 6, lane = tid & 63, r32 = lane & 31, hi = lane >> 5;
  bf16* V_lds = (bf16*)lds; bf16* K_lds = (bf16*)(lds + 2 * SHM_V);
  float* ws = (float*)(lds + 2 * SHM_V + 2 * SHM_K) + wid * 64; float* li_l = ws; float* al_l = ws + 32;
  float m_reg = -1e30f, l_reg = 0; f32x16 o[4] = {}; bf16x8 qr[8];
  const bf16* Qw = Qb + (long)(wid * QBLK + r32) * LDQ + hi * 8;
#pragma unroll
  for (int d0 = 0; d0 < 8; ++d0) qr[d0] = ld8(Qw + d0 * 16);
  const int sr = tid >> 4, sc = (tid & 15) * 8, vst0 = v_st(sr, sc), vst1 = v_st(32 + sr, sc);
  const int vb0 = (int)(uintptr_t)V_lds + v_rd_base(lane);
  struct { bf16x8 vs0, vs1, ks0, ks1; } sr_[2];
#define SLOAD(i, k0) do { sr_[i].vs0 = ld8(&Vh[(long)((k0) + sr) * LDK + sc]); sr_[i].vs1 = ld8(&Vh[(long)((k0) + 32 + sr) * LDK + sc]); \
    sr_[i].ks0 = ld8(&Kh[(long)((k0) + sr) * LDK + sc]); sr_[i].ks1 = ld8(&Kh[(long)((k0) + 32 + sr) * LDK + sc]); } while (0)
#define SWRITE(b, i) do { *(bf16x8*)((char*)V_lds + (b) * SHM_V + vst0) = sr_[i].vs0;          \
    *(bf16x8*)((char*)V_lds + (b) * SHM_V + vst1) = sr_[i].vs1; int kc = sc * 2;               \
    *(bf16x8*)((char*)K_lds + (b) * SHM_K + KSWZ(sr, kc)) = sr_[i].ks0;                       \
    *(bf16x8*)((char*)K_lds + (b) * SHM_K + KSWZ(32 + sr, kc)) = sr_[i].ks1; } while (0)
#define SWAIT() do { asm volatile("s_waitcnt vmcnt(4)" ::: "memory"); } while (0)
#define RESC(a) do { if (__any((a) < 1.f)) { if (hi == 0) al_l[r32] = (a); asm volatile("s_waitcnt lgkmcnt(0)" ::: "memory"); \
    for (int d = 0; d < 4; ++d) for (int r = 0; r < 16; ++r) o[d][r] *= al_l[crow(r, hi)]; } } while (0)
  f32x16 pA0, pA1, pB0, pB1; float mnA, mnB, alA, alB; bf16x8 pa0, pa1, pa2, pa3; const int NT = seq / KVBLK;
  constexpr int SE = 0, SO = 1;
  SLOAD(SE, 0); asm volatile("s_waitcnt vmcnt(0)" ::: "memory"); SWRITE(0, SE); __syncthreads();
  qkt(pA0, pA1, K_lds, qr, r32, hi); partialSM(pA0, pA1, m_reg, mnA, alA);
  SLOAD(SO, KVBLK); if (2 < NT) SLOAD(SE, 2 * KVBLK);
  SWAIT(); SWRITE(1, SO); __syncthreads();
  for (int j = 1; j + 1 < NT; j += 2) {
    SBAR(); qkt(pB0, pB1, (bf16*)((char*)K_lds + SHM_K), qr, r32, hi);
    finishSM(pA0, pA1, alA, l_reg, pa0, pa1, pa2, pa3); SBAR();
    SLOAD(SO, (j + 2) * KVBLK); SBAR();
    pv_d0(o, vb0, pa0, pa1, pa2, pa3); partialSM(pB0, pB1, m_reg, mnB, alB);
    __syncthreads(); SWAIT(); SWRITE(0, SE);
    RESC(alB); __syncthreads();
    SBAR(); qkt(pA0, pA1, K_lds, qr, r32, hi);
    finishSM(pB0, pB1, alB, l_reg, pa0, pa1, pa2, pa3); SBAR();
    if (j + 3 < NT) SLOAD(SE, (j + 3) * KVBLK); SBAR();
    pv_d0(o, vb0 + (int)SHM_V, pa0, pa1, pa2, pa3); partialSM(pA0, pA1, m_reg, mnA, alA);
    __syncthreads(); SWAIT(); SWRITE(1, SO);
    RESC(alA); __syncthreads();
  }
  SBAR(); qkt(pB0, pB1, (bf16*)((char*)K_lds + SHM_K), qr, r32, hi);
  finishSM(pA0, pA1, alA, l_reg, pa0, pa1, pa2, pa3); SBAR();
  pv_d0(o, vb0, pa0, pa1, pa2, pa3); partialSM(pB0, pB1, m_reg, mnB, alB);
  __syncthreads(); RESC(alB);
  finishSM(pB0, pB1, alB, l_reg, pa0, pa1, pa2, pa3); SBAR();
  pv_d0(o, vb0 + (int)SHM_V, pa0, pa1, pa2, pa3);
  if (hi == 0) li_l[r32] = l_reg; asm volatile("s_waitcnt lgkmcnt(0)" ::: "memory");
  float rli[16];
#pragma unroll
  for (int r = 0; r < 16; ++r) rli[r] = __builtin_amdgcn_rcpf(li_l[crow(r, hi)]);
  bf16* Ow = Ob + (long)(wid * QBLK) * LDO;
#pragma unroll
  for (int r = 0; r < 16; ++r) { int orow = crow(r, hi);
    for (int d0 = 0; d0 < 4; ++d0) Ow[(long)orow * LDO + d0 * 32 + r32] = __float2bfloat16(o[d0][r] * rli[r]); }
  __syncthreads();
#undef SLOAD
#undef SWRITE
#undef SWAIT
#undef RESC
}
#undef KSWZ
#undef SBAR
}
#define LAS __attribute__((address_space(3)))
typedef unsigned short bf16_t;
typedef float f32x4 __attribute__((ext_vector_type(4)));
typedef unsigned u32x4 __attribute__((ext_vector_type(4)));
typedef unsigned u32x2 __attribute__((ext_vector_type(2)));

constexpr int NWAVES = 8, NTHREADS = 512;
constexpr int D = 1024, FF = 4096, NIN = 7040, NINP = 7168, RWC = 3456;
constexpr int MC = 16384, NCHUNK = 5, MTOT = 81920;
constexpr float ALPHA = 1.189207115002721f;
constexpr float LN_EPS = 1e-5f, GN_EPS = 64e-5f, RMS_EPS = 1e-6f;
constexpr float DECAY_SCALE = 0.6065306597126334f;

constexpr size_t MiB = 1u << 20;
constexpr size_t WS_CTL = 0;
constexpr size_t WS_WIN = 1 * MiB, WS_WPR = 15 * MiB, WS_WPA = 17 * MiB, WS_WOUT = 19 * MiB, WS_WF1 = 21 * MiB, WS_WF2 = 29 * MiB;
constexpr size_t WS_WUP = 37 * MiB, WS_AUP = 37 * MiB + 512 * 1024, WS_GUP = 38 * MiB;
constexpr size_t WS_XB = 40 * MiB, WS_OF = 40 * MiB;
constexpr size_t WS_Z = 72 * MiB;
constexpr size_t WS_OPR = 296 * MiB, WS_OPKH = 360 * MiB, WS_VS = 424 * MiB;
constexpr size_t WS_KS = 488 * MiB, WS_OB = 488 * MiB, WS_HB = 488 * MiB;
constexpr size_t WS_TW = 520 * MiB, WS_AD = 524 * MiB, WS_SG = 528 * MiB;
constexpr size_t WS_OPW = 532 * MiB, WS_OPAK = 660 * MiB, WS_OPKT = 788 * MiB;
constexpr size_t WS_G = 916 * MiB, WS_OATT = 948 * MiB, WS_END = 980 * MiB;
constexpr size_t WS_ORW = 532 * MiB, WS_M32 = 564 * MiB, WS_MB = 628 * MiB, WS_FFH = 660 * MiB;
constexpr int ZLD = 7168, ZQ = 3456, ZK = 4480, ZV = 4736, ZG = 4992;

constexpr int LDS_BYTES = 131072 + 1024;
constexpr int LDS_MISC = 131072;

#define INP(k) (A.in[(k) + z])
struct Args {
    const float* in[26];
    float* out; unsigned char* ws;
    int ph_lo, ph_hi;
};

__device__ __forceinline__ float bf2f(unsigned v) { return __uint_as_float(v << 16); }
__device__ __forceinline__ float bflo(unsigned w) { return __uint_as_float(w << 16); }
__device__ __forceinline__ float bfhi(unsigned w) { return __uint_as_float(w & 0xffff0000u); }
typedef float f32x2c_t __attribute__((ext_vector_type(2))); typedef __bf16 bf16x2c_t __attribute__((ext_vector_type(2)));
__device__ __forceinline__ unsigned pk2(float lo, float hi) { f32x2c_t v = {lo, hi}; bf16x2c_t b = __builtin_convertvector(v, bf16x2c_t); return __builtin_bit_cast(unsigned, b); }
__device__ __forceinline__ float sigmoidf_(float x) { return 1.0f / (1.0f + __expf(-x)); }
__device__ __forceinline__ float wave_sum(float v) {
#pragma unroll
    for (int o = 1; o < 64; o <<= 1) v += __shfl_xor(v, o);
    return v;
}

__device__ __forceinline__ void p0_transpose_item(const float* W, int K, int N, bf16_t* WT, LAS float* scr, int item, int lane) {
    const int nblk = N / 32, kb = item / nblk, nb = item % nblk, k0 = 64 * kb, n0 = 32 * nb;
#pragma unroll 8
    for (int i = 0; i < 32; ++i) { const int kk = 2 * i + (lane >> 5); scr[kk * 33 + (lane & 31)] = W[(size_t)(k0 + kk) * N + n0 + (lane & 31)]; }
    asm volatile("s_waitcnt lgkmcnt(0)" ::: "memory");
    const int c = lane & 7;
#pragma unroll
    for (int j = 0; j < 4; ++j) { const int n = (lane >> 3) + 8 * j; const LAS float* s = scr + (8 * c) * 33 + n;
        u32x4 o; o.x = pk2(s[0 * 33], s[1 * 33]); o.y = pk2(s[2 * 33], s[3 * 33]); o.z = pk2(s[4 * 33], s[5 * 33]); o.w = pk2(s[6 * 33], s[7 * 33]);
        *(u32x4*)(WT + (size_t)(n0 + n) * K + k0 + 8 * c) = o; }
    asm volatile("s_waitcnt lgkmcnt(0)" ::: "memory");
}

__device__ __forceinline__ void cvt_x_chunk(const float* x, bf16_t* xb, int gtid, int gthreads) {
    const size_t n8 = (size_t)MC * D / 8;
    for (size_t i = gtid; i < n8; i += gthreads) {
        const f32x4 a = *(const f32x4*)(x + i * 8), b = *(const f32x4*)(x + i * 8 + 4);
        u32x4 o; o.x = pk2(a.x, a.y); o.y = pk2(a.z, a.w); o.z = pk2(b.x, b.y); o.w = pk2(b.z, b.w);
        *(u32x4*)(xb + i * 8) = o;
    }
}

__device__ __forceinline__ void ln_rows(float* base, const float* g, const float* b, bf16_t* hb, int gw, int ngw, int lane) {
    f32x4 gg[4], bb[4];
#pragma unroll
    for (int j = 0; j < 4; ++j) { gg[j] = *((const f32x4*)g + 64 * j + lane); bb[j] = *((const f32x4*)b + 64 * j + lane); }
    for (int m0 = gw; m0 < MC; m0 += 2 * ngw) {
        const int m1 = m0 + ngw; const bool has1 = m1 < MC;
        f32x4* xr0 = (f32x4*)(base + (size_t)m0 * D) + lane; f32x4* xr1 = (f32x4*)(base + (size_t)(has1 ? m1 : m0) * D) + lane;
        f32x4 v0[4], v1[4]; float s0 = 0.f, s1 = 0.f;
#pragma unroll
        for (int j = 0; j < 4; ++j) { v0[j] = xr0[64 * j]; v1[j] = xr1[64 * j]; }
#pragma unroll
        for (int j = 0; j < 4; ++j) { s0 += (v0[j].x + v0[j].y) + (v0[j].z + v0[j].w); s1 += (v1[j].x + v1[j].y) + (v1[j].z + v1[j].w); }
        const float mean0 = wave_sum(s0) * (1.f / D), mean1 = wave_sum(s1) * (1.f / D); float q0 = 0.f, q1 = 0.f;
#pragma unroll
        for (int j = 0; j < 4; ++j) { v0[j] = v0[j] - mean0; v1[j] = v1[j] - mean1;
            q0 += (v0[j].x * v0[j].x + v0[j].y * v0[j].y) + (v0[j].z * v0[j].z + v0[j].w * v0[j].w); q1 += (v1[j].x * v1[j].x + v1[j].y * v1[j].y) + (v1[j].z * v1[j].z + v1[j].w * v1[j].w); }
        const float rstd0 = 1.f / sqrtf(wave_sum(q0) * (1.f / D) + LN_EPS), rstd1 = 1.f / sqrtf(wave_sum(q1) * (1.f / D) + LN_EPS);
#pragma unroll
        for (int j = 0; j < 4; ++j) {
            const f32x4 y0 = v0[j] * rstd0 * gg[j] + bb[j]; xr0[64 * j] = y0;
            if (hb) { u32x2 w; w.x = pk2(y0.x, y0.y); w.y = pk2(y0.z, y0.w); *(u32x2*)(hb + (size_t)m0 * D + 256 * j + 4 * lane) = w; }
            if (has1) { const f32x4 y1 = v1[j] * rstd1 * gg[j] + bb[j]; xr1[64 * j] = y1;
                if (hb) { u32x2 w; w.x = pk2(y1.x, y1.y); w.y = pk2(y1.z, y1.w); *(u32x2*)(hb + (size_t)m1 * D + 256 * j + 4 * lane) = w; } }
        }
    }
}

template <class F> struct Epi4 {
    static constexpr bool PERM = false, AFTER_DRAIN = false; F f;
    __device__ __forceinline__ void operator()(const pg8::f32x4 (&acc)[2][2][4][2], const pg8::Unit& u, int wr, int wc, int fr, int fq) const {
        const int row0 = u.pm * 256 + wr * 64 + fr, col0 = u.pn * 256 + wc * 32 + 4 * fq;
#pragma unroll
        for (int ai = 0; ai < 2; ++ai)
#pragma unroll
            for (int m = 0; m < 4; ++m)
#pragma unroll
                for (int bj = 0; bj < 2; ++bj)
#pragma unroll
                    for (int n = 0; n < 2; ++n) { f(row0 + ai * 128 + m * 16, col0 + bj * 128 + n * 16, acc[ai][bj][m][n]); asm volatile("" ::: "memory"); }
    }
};
template <class F> struct Epi8 {
    static constexpr bool PERM = true, AFTER_DRAIN = false; F f;
    __device__ __forceinline__ void operator()(const pg8::f32x4 (&acc)[2][2][4][2], const pg8::Unit& u, int wr, int wc, int fr, int fq) const {
        const int row0 = u.pm * 256 + wr * 64 + fr, col0 = u.pn * 256 + wc * 32 + 8 * fq;
#pragma unroll
        for (int ai = 0; ai < 2; ++ai)
#pragma unroll
            for (int m = 0; m < 4; ++m)
#pragma unroll
                for (int bj = 0; bj < 2; ++bj) { f(row0 + ai * 128 + m * 16, col0 + bj * 128, acc[ai][bj][m][0], acc[ai][bj][m][1]); asm volatile("" ::: "memory"); }
    }
};
__device__ __forceinline__ u32x4 pack8(f32x4 a, f32x4 b) { u32x4 w; w.x = pk2(a.x, a.y); w.y = pk2(a.z, a.w); w.z = pk2(b.x, b.y); w.w = pk2(b.z, b.w); return w; }

struct FZ { bf16_t* z;
    __device__ __forceinline__ void operator()(int row, int col, f32x4 a, f32x4 b) const { *(u32x4*)(z + (size_t)row * ZLD + col) = pack8(a, b); } };
struct FW { const float* w0; float* opw;
    __device__ __forceinline__ void operator()(int row, int col, f32x4 a) const {
        const f32x4 x = a + *(const f32x4*)(w0 + col); f32x4 y;
#pragma unroll
        for (int i = 0; i < 4; ++i) y[i] = __expf(-DECAY_SCALE * sigmoidf_(x[i]));
        *(f32x4*)(opw + (size_t)row * D + col) = y; } };
struct FA { const float *a0, *k_a; const bf16_t* ks; const float* kh; float *opak, *opkt;
    __device__ __forceinline__ void operator()(int row, int col, f32x4 acc) const {
        const size_t o = (size_t)row * D + col;
        const f32x4 x = acc + *(const f32x4*)(a0 + col), ka = *(const f32x4*)(k_a + col), khv = *(const f32x4*)(kh + o);
        const u32x2 kw = *(const u32x2*)(ks + o);
        f32x4 k; k.x = bflo(kw.x); k.y = bfhi(kw.x); k.z = bflo(kw.y); k.w = bfhi(kw.y);
        f32x4 ak, kt;
#pragma unroll
        for (int i = 0; i < 4; ++i) { const float a = sigmoidf_(x[i]); ak[i] = a * khv[i]; kt[i] = k[i] * (1.0f + (a - 1.0f) * ka[i]); }
        *(f32x4*)(opak + o) = ak; *(f32x4*)(opkt + o) = kt; } };
struct FG { bf16_t* g;
    __device__ __forceinline__ void operator()(int row, int col, f32x4 a) const {
        u32x2 w; w.x = pk2(a.x, a.y); w.y = pk2(a.z, a.w); *(u32x2*)(g + (size_t)row * D + col) = w; } };
typedef short bf16x8v __attribute__((ext_vector_type(8)));
template <int K, class F> __device__ __forceinline__ void wave_gemm_tile(const bf16_t* A, int aoff, const bf16_t* Bt, int m0, int n0, int lane, const F& f) {
    const int fr = lane & 15, fq = lane >> 4; constexpr int KS = K / 32;
    bf16x8v a[2][KS];
#pragma unroll
    for (int mt = 0; mt < 2; ++mt)
#pragma unroll
        for (int ks = 0; ks < KS; ++ks) a[mt][ks] = *(const bf16x8v*)(A + (size_t)(m0 + mt * 16 + fr) * 128 + aoff + ks * 32 + 8 * fq);
#pragma unroll 2
    for (int nt = 0; nt < 8; ++nt) {
        const bf16_t* bp = Bt + (size_t)(n0 + nt * 16 + fr) * K + 8 * fq;
        f32x4 acc0 = {0.f, 0.f, 0.f, 0.f}, acc1 = {0.f, 0.f, 0.f, 0.f};
#pragma unroll
        for (int ks = 0; ks < KS; ++ks) { const bf16x8v b = *(const bf16x8v*)(bp + ks * 32);
            acc0 = __builtin_amdgcn_mfma_f32_16x16x32_bf16(b, a[0][ks], acc0, 0, 0, 0); acc1 = __builtin_amdgcn_mfma_f32_16x16x32_bf16(b, a[1][ks], acc1, 0, 0, 0); }
        f(m0 + fr, n0 + nt * 16 + 4 * fq, acc0); f(m0 + 16 + fr, n0 + nt * 16 + 4 * fq, acc1);
    }
}
struct FP1 { const bf16_t* gates; float* m32;
    __device__ __forceinline__ void operator()(int row, int col, f32x4 a) const {
        const u32x2 gw = *(const u32x2*)(gates + (size_t)row * ZLD + ZG + col); f32x4 y;
        y.x = sigmoidf_(bflo(gw.x)) * a.x; y.y = sigmoidf_(bfhi(gw.x)) * a.y; y.z = sigmoidf_(bflo(gw.y)) * a.z; y.w = sigmoidf_(bfhi(gw.y)) * a.w;
        *(f32x4*)(m32 + (size_t)row * D + col) = y;
    } };
struct FP2 { const bf16_t* gates; const float* m32; bf16_t* mb;
    __device__ __forceinline__ void operator()(int row, int col, f32x4 a) const {
        const u32x2 gw = *(const u32x2*)(gates + (size_t)row * ZLD + ZG + 1024 + col); const f32x4 p = *(const f32x4*)(m32 + (size_t)row * D + col); f32x4 y;
        y.x = p.x + sigmoidf_(bflo(gw.x)) * a.x; y.y = p.y + sigmoidf_(bfhi(gw.x)) * a.y; y.z = p.z + sigmoidf_(bflo(gw.y)) * a.z; y.w = p.w + sigmoidf_(bfhi(gw.y)) * a.w;
        u32x2 w; w.x = pk2(y.x, y.y); w.y = pk2(y.z, y.w); *(u32x2*)(mb + (size_t)row * D + col) = w;
    } };
struct FOut { const float* x; float* out;
    __device__ __forceinline__ void operator()(int row, int col, f32x4 a) const {
        const size_t o = (size_t)row * D + col; *(f32x4*)(out + o) = *(const f32x4*)(x + o) * ALPHA + a; } };
struct FF1 { bf16_t* ffh;
    __device__ __forceinline__ void operator()(int row, int col, f32x4 a, f32x4 b) const {
#pragma unroll
        for (int i = 0; i < 4; ++i) { const float u = fmaxf(a[i], 0.f), v = fmaxf(b[i], 0.f); a[i] = u * u; b[i] = v * v; }
        *(u32x4*)(ffh + (size_t)row * FF + col) = pack8(a, b); } };
struct FF2 { float* out;
    __device__ __forceinline__ void operator()(int row, int col, f32x4 a) const {
        const size_t o = (size_t)row * D + col; *(f32x4*)(out + o) = *(const f32x4*)(out + o) * ALPHA + a; } };

template <class E> __device__ __forceinline__ void run_gemm(LAS unsigned char* lds, const bf16_t* A, const bf16_t* Bt, int M, int N, int K, const E& e) {

    int G_ = (int)gridDim.x, c_ = (int)blockIdx.x; asm volatile("" : "+s"(G_), "+s"(c_));
    pg8::Gemm g{A, Bt, M, N, K}; pg8::StaticOrder S; S.init(M, N, G_, c_);
    pg8::gemm_phase<E, pg8::StaticOrder, true, true>(lds, g, S, e);
}

__device__ __forceinline__ void prep_rows(const float* mu_p, const float* mu_n, const float* k_k, const float* qn, const float* kn, unsigned char* ws, int T, int rbeg, int rstep, int rend, int lane, bool do_att) {
    bf16_t* Z = (bf16_t*)(ws + WS_Z);
    float* OPR = (float*)(ws + WS_OPR); float* OPKH = (float*)(ws + WS_OPKH); float* VS = (float*)(ws + WS_VS);
    bf16_t* KS = (bf16_t*)(ws + WS_KS); bf16_t* TW = (bf16_t*)(ws + WS_TW); bf16_t* AD = (bf16_t*)(ws + WS_AD); bf16_t* SG = (bf16_t*)(ws + WS_SG);
    for (int row = rbeg; row < rend; row += rstep) {
        const int t = row & (T - 1); const bool hp = t > 0, hn = t < T - 1;
        const bf16_t* zc = Z + (size_t)row * ZLD;
#pragma unroll
        for (int pass = 0; pass < 7; ++pass) {
            const int c = pass * 512 + lane * 8;
            if (c < RWC) {
                const u32x4 wc_ = *(const u32x4*)(zc + c);
                u32x4 wp = {0u, 0u, 0u, 0u}, wn = {0u, 0u, 0u, 0u};
                if (hp) wp = *(const u32x4*)(zc - ZLD + c);
                if (hn) wn = *(const u32x4*)(zc + ZLD + c);
                const f32x4 mp0 = *(const f32x4*)(mu_p + c), mp1 = *(const f32x4*)(mu_p + c + 4), mn0 = *(const f32x4*)(mu_n + c), mn1 = *(const f32x4*)(mu_n + c + 4);
                float z[8];
#pragma unroll
                for (int i = 0; i < 4; ++i) {
                    const float c0 = bflo(wc_[i]), c1 = bfhi(wc_[i]), p0 = bflo(wp[i]), p1 = bfhi(wp[i]), n0 = bflo(wn[i]), n1 = bfhi(wn[i]);
                    const float mpa = (2 * i < 4) ? mp0[2 * i] : mp1[2 * i - 4], mpb = (2 * i + 1 < 4) ? mp0[2 * i + 1] : mp1[2 * i - 3];
                    const float mna = (2 * i < 4) ? mn0[2 * i] : mn1[2 * i - 4], mnb = (2 * i + 1 < 4) ? mn0[2 * i + 1] : mn1[2 * i - 3];
                    z[2 * i] = c0 + mpa * (p0 - c0) + mna * (n0 - c0);
                    z[2 * i + 1] = c1 + mpb * (p1 - c1) + mnb * (n1 - c1);
                }
                if (pass < 2) {
                    float* o = OPR + (size_t)row * D + c;
                    *(f32x4*)o = (f32x4){z[0], z[1], z[2], z[3]}; *(f32x4*)(o + 4) = (f32x4){z[4], z[5], z[6], z[7]};
                } else if (pass < 4) {
                    const int cc = c - 1024;
                    u32x4 w; w.x = pk2(z[0], z[1]); w.y = pk2(z[2], z[3]); w.z = pk2(z[4], z[5]); w.w = pk2(z[6], z[7]);
                    *(u32x4*)(KS + (size_t)row * D + cc) = w;
                    const f32x4 kk0 = *(const f32x4*)(k_k + cc), kk1 = *(const f32x4*)(k_k + cc + 4);
                    float kp[8]; float ss = 0.f;
#pragma unroll
                    for (int i = 0; i < 8; ++i) { kp[i] = z[i] * (i < 4 ? kk0[i] : kk1[i - 4]); ss += kp[i] * kp[i]; }
                    ss += __shfl_xor(ss, 1); ss += __shfl_xor(ss, 2); ss += __shfl_xor(ss, 4);
                    const float inv = 1.0f / fmaxf(sqrtf(ss), 1e-12f);
                    float* o = OPKH + (size_t)row * D + cc;
                    *(f32x4*)o = (f32x4){kp[0] * inv, kp[1] * inv, kp[2] * inv, kp[3] * inv}; *(f32x4*)(o + 4) = (f32x4){kp[4] * inv, kp[5] * inv, kp[6] * inv, kp[7] * inv};
                } else if (pass < 6) {
                    float* o = VS + (size_t)row * D + (c - 2048);
                    *(f32x4*)o = (f32x4){z[0], z[1], z[2], z[3]}; *(f32x4*)(o + 4) = (f32x4){z[4], z[5], z[6], z[7]};
                } else {
                    const int sect = lane >> 4, cc = (lane & 15) * 8;
                    float y[8];
#pragma unroll
                    for (int i = 0; i < 8; ++i) {
                        if (sect == 0) { const float e = __expf(2.0f * z[i]); y[i] = 1.0f - 2.0f / (e + 1.0f); }
                        else if (sect == 1) y[i] = z[i];
                        else y[i] = sigmoidf_(z[i]);
                    }
                    u32x4 w; w.x = pk2(y[0], y[1]); w.y = pk2(y[2], y[3]); w.z = pk2(y[4], y[5]); w.w = pk2(y[6], y[7]);
                    bf16_t* dst = (sect == 0 ? TW : (sect == 1 ? AD : SG)) + (size_t)row * 128 + cc;
                    *(u32x4*)dst = w;
                }
            }
        }
        bf16_t* qrow = Z + (size_t)row * ZLD + ZQ;
#pragma unroll 1
        for (int p = do_att ? 0 : 3; p < 3; ++p) {
            const int head = p * 4 + (lane >> 4), sub = lane & 15, d0 = sub * 8;
            const bool act = head < 10;
            bf16_t* px = qrow + head * 128 + d0;
            u32x4 w = {0u, 0u, 0u, 0u}; if (act) w = *(const u32x4*)px;
            float x[8]; float ss = 0.f;
#pragma unroll
            for (int i = 0; i < 4; ++i) { x[2 * i] = bflo(w[i]); x[2 * i + 1] = bfhi(w[i]); ss += x[2 * i] * x[2 * i] + x[2 * i + 1] * x[2 * i + 1]; }
            ss += __shfl_xor(ss, 1); ss += __shfl_xor(ss, 2); ss += __shfl_xor(ss, 4); ss += __shfl_xor(ss, 8);
            const float rinv = rsqrtf(ss * (1.0f / 128.0f) + RMS_EPS);
            const float* gn = (head < 8) ? qn : kn;
            const f32x4 g0 = *(const f32x4*)(gn + d0), g1 = *(const f32x4*)(gn + d0 + 4);
            const int axis = sub >> 3, hf = (sub >> 2) & 1;
            const float pos = (float)(axis ? (t & 63) : (t >> 6));
            float y[8];
#pragma unroll
            for (int i = 0; i < 8; ++i) {
                const float xn = x[i] * rinv * (i < 4 ? g0[i] : g1[i - 4]);
                const float xp = __shfl_xor(xn, 4);
                const int fi = (sub & 3) * 8 + i;
                const float ang = pos * exp2f(-0.41524101186092f * (float)fi);
                y[i] = xn * __cosf(ang) + (hf ? xp : -xp) * __sinf(ang);
            }
            if (act) { u32x4 o; o.x = pk2(y[0], y[1]); o.y = pk2(y[2], y[3]); o.z = pk2(y[4], y[5]); o.w = pk2(y[6], y[7]); *(u32x4*)px = o; }
        }
    }
}

__device__ __forceinline__ float rowsum16(float x) {
    x += __int_as_float(__builtin_amdgcn_update_dpp(0, __float_as_int(x), 0x128, 0xf, 0xf, true));
    x += __int_as_float(__builtin_amdgcn_update_dpp(0, __float_as_int(x), 0x124, 0xf, 0xf, true));
    x += __int_as_float(__builtin_amdgcn_update_dpp(0, __float_as_int(x), 0x122, 0xf, 0xf, true));
    x += __int_as_float(__builtin_amdgcn_update_dpp(0, __float_as_int(x), 0x121, 0xf, 0xf, true));
    return x;
}
__device__ __forceinline__ void post_rows(const float* r_k, const float* gn_g, const float* gn_b, unsigned char* ws, int gw, int ngw, int lane) {
    const bf16_t* OF = (const bf16_t*)(ws + WS_OF); const bf16_t* OB = (const bf16_t*)(ws + WS_OB);
    const float* OPR = (const float*)(ws + WS_OPR); const float* VS = (const float*)(ws + WS_VS);
    const float* KTF = (const float*)(ws + WS_OPKT); const float* KTB = KTF + (size_t)MC * D;
    const bf16_t* G = (const bf16_t*)(ws + WS_G); bf16_t* ORW = (bf16_t*)(ws + WS_ORW);
    const int hg = lane >> 4, sub = lane & 15;
    for (int row = gw; row < MC; row += ngw) {
        const size_t ro = (size_t)row * D;
#pragma unroll 2
        for (int pass = 0; pass < 4; ++pass) {
            const int c = (4 * pass + hg) * 64 + sub * 4; const size_t o = ro + c;
            const u32x2 wf = *(const u32x2*)(OF + o), wb = *(const u32x2*)(OB + o), wg = *(const u32x2*)(G + o);
            const f32x4 r4 = *(const f32x4*)(OPR + o), ktf = *(const f32x4*)(KTF + o), ktb = *(const f32x4*)(KTB + o), v4 = *(const f32x4*)(VS + o);
            const f32x4 rk = *(const f32x4*)(r_k + c), gg = *(const f32x4*)(gn_g + c), gb = *(const f32x4*)(gn_b + c);
            f32x4 ov; ov.x = bflo(wf.x) + bflo(wb.x); ov.y = bfhi(wf.x) + bfhi(wb.x); ov.z = bflo(wf.y) + bflo(wb.y); ov.w = bfhi(wf.y) + bfhi(wb.y);
            const float mean = rowsum16((ov.x + ov.y) + (ov.z + ov.w)) * (1.0f / 64.0f);
            const f32x4 dv = ov - mean;
            const float var = rowsum16((dv.x * dv.x + dv.y * dv.y) + (dv.z * dv.z + dv.w * dv.w)) * (1.0f / 64.0f);
            const f32x4 bt = r4 * (ktf + ktb) * rk;
            const float bs = rowsum16((bt.x + bt.y) + (bt.z + bt.w));
            const float rstd = rsqrtf(var + GN_EPS);
            f32x4 g4; g4.x = bflo(wg.x); g4.y = bfhi(wg.x); g4.z = bflo(wg.y); g4.w = bfhi(wg.y);
            const f32x4 y = (dv * rstd * gg + gb + v4 * bs) * g4;
            u32x2 w; w.x = pk2(y.x, y.y); w.y = pk2(y.z, y.w); *(u32x2*)(ORW + o) = w;
        }
    }
}

#define DPPQ(q) "quad_perm:[" #q "," #q "," #q "," #q "] row_mask:0xf bank_mask:0xf"
#define FMAC_DPP(acc, x, s, q) asm("v_fmac_f32_dpp %0, %1, %2 " DPPQ(q) : "+v"(acc) : "v"(x), "v"(s))
#define MUL_DPP(dst, x, s, q) asm("v_mul_f32_dpp %0, %1, %2 " DPPQ(q) : "=v"(dst) : "v"(x), "v"(s))
#define LBAR() asm volatile("s_waitcnt lgkmcnt(0)\n\ts_barrier" ::: "memory")

typedef float f32x2s __attribute__((ext_vector_type(2)));
struct ScanCtx {
    const float* ga[6]; bf16_t* po; long r0, dstep; int T;
    LAS float* part; LAS float* opart; LAS float* ring; int wid, lane;
};
constexpr int SCAN_RING = 16, SCAN_SLOTF = 6 * 64;
__device__ __forceinline__ void scan_hload(const ScanCtx& C, int u, float (&R)[6]) {
    const int uu = u < C.T ? u : C.T - 1; const long ro = (C.r0 + C.dstep * (long)uu) * D;
#pragma unroll
    for (int a = 0; a < 6; ++a) R[a] = C.ga[a][ro];
}
__device__ __forceinline__ void scan_hwrite(const ScanCtx& C, int u, const float (&R)[6]) {
    LAS float* sl = C.ring + (u & (SCAN_RING - 1)) * SCAN_SLOTF + C.lane;
#pragma unroll
    for (int a = 0; a < 6; ++a) sl[a * 64] = R[a];
}
__device__ __forceinline__ void scan_ld4(const LAS float* p, f32x4 (&v)[4]) {
#pragma unroll
    for (int q = 0; q < 4; ++q) v[q] = *(const LAS f32x4*)(p + 4 * q);
}
__device__ __forceinline__ void scan_hreduce(const ScanCtx& C, int hsl, int parity, int tblock) {
#pragma unroll
    for (int k = 0; k < 2; ++k) { const int slot = hsl + 4 * k; const LAS float* op = C.opart + (parity * 8 + slot) * 256 + C.lane;
        const float o = (op[0] + op[64]) + (op[128] + op[192]);
        C.po[(C.r0 + C.dstep * (long)(tblock + slot)) * D] = (bf16_t)(pk2(o, o) & 0xffffu); }
}
__device__ __forceinline__ void scan_chain(unsigned char* ws, LAS unsigned char* lds, int s, int h, int d, int T, int tbeg, int nsteps, int mode, bf16_t* obase, float* sd) {
    int tid_ = threadIdx.x; asm volatile("" : "+v"(tid_));
    const int tid = tid_, lane = tid & 63, wid = __builtin_amdgcn_readfirstlane(tid >> 6);
    ScanCtx C; C.T = nsteps; C.wid = wid; C.lane = lane;
    const int col = h * 64; const size_t dofs = (size_t)d * MC * D;
    C.ga[0] = (const float*)(ws + WS_OPKH) + col + lane; C.ga[1] = (const float*)(ws + WS_OPW) + dofs + col + lane; C.ga[2] = (const float*)(ws + WS_OPAK) + dofs + col + lane;
    C.ga[3] = (const float*)(ws + WS_OPKT) + dofs + col + lane; C.ga[4] = (const float*)(ws + WS_OPR) + col + lane; C.ga[5] = (const float*)(ws + WS_VS) + col + lane;
    C.po = obase + col + lane;
    C.dstep = d ? -1 : 1; C.r0 = (d ? (long)s * T + T - 1 : (long)s * T) + C.dstep * (long)tbeg;
    C.part = (LAS float*)lds; C.opart = (LAS float*)(lds + 2048); C.ring = (LAS float*)(lds + 18432);
    if (wid < 4) {
        f32x2s S2[8];
#pragma unroll
        for (int j = 0; j < 8; ++j) { S2[j].x = (mode && lane == 16 * wid + 2 * j) ? 1.f : 0.f; S2[j].y = (mode && lane == 16 * wid + 2 * j + 1) ? 1.f : 0.f; }
        LBAR();
        f32x4 kh[4]; scan_ld4(C.ring + wid * 16, kh);
        int par = 0;
        for (int t0 = 0; t0 < nsteps; t0 += 8) {
#pragma unroll
            for (int i = 0; i < 8; ++i) {
                const LAS float* sl = C.ring + (((t0 & 8) + i) & (SCAN_RING - 1)) * SCAN_SLOTF;
                f32x4 w4[4], ak[4], kt[4], r4[4];
                scan_ld4(sl + 64 + wid * 16, w4); scan_ld4(sl + 128 + wid * 16, ak); scan_ld4(sl + 192 + wid * 16, kt); scan_ld4(sl + 256 + wid * 16, r4);
                const float vraw = sl[320 + lane];
                f32x4 khn[4]; scan_ld4(C.ring + (((t0 & 8) + i + 1) & (SCAN_RING - 1)) * SCAN_SLOTF + wid * 16, khn);
                f32x2s pa = {0.f, 0.f}, pb = {0.f, 0.f};
#pragma unroll
                for (int q = 0; q < 4; ++q) { pa = kh[q].xy * S2[2 * q] + pa; pb = kh[q].zw * S2[2 * q + 1] + pb; }
                LAS float* pp = C.part + (i & 1) * 256;
                pp[wid * 64 + lane] = (pa.x + pa.y) + (pb.x + pb.y);
                LBAR();
                const unsigned paddr = (unsigned)(unsigned long)(pp + lane);
                f32x2s r0, r1;
                asm volatile("ds_read2st64_b32 %0, %2 offset1:1\n\tds_read2st64_b32 %1, %2 offset0:2 offset1:3" : "=&v"(r0), "=&v"(r1) : "v"(paddr) : "memory");
                asm volatile("s_waitcnt lgkmcnt(0)" : "+v"(r0), "+v"(r1) :: "memory");
                const float nsk = -((r0.x + r0.y) + (r1.x + r1.y)), vv = mode ? 0.f : vraw;
                const f32x2s nsk2 = {nsk, nsk}, vv2 = {vv, vv};
                f32x2s oa = {0.f, 0.f}, ob = {0.f, 0.f};
#pragma unroll
                for (int q = 0; q < 4; ++q) {
                    S2[2 * q]     = S2[2 * q]     * w4[q].xy + (nsk2 * ak[q].xy + vv2 * kt[q].xy); oa = r4[q].xy * S2[2 * q]     + oa;
                    S2[2 * q + 1] = S2[2 * q + 1] * w4[q].zw + (nsk2 * ak[q].zw + vv2 * kt[q].zw); ob = r4[q].zw * S2[2 * q + 1] + ob;
                }
                C.opart[(par * 8 + i) * 256 + wid * 64 + lane] = (oa.x + oa.y) + (ob.x + ob.y);
#pragma unroll
                for (int q = 0; q < 4; ++q) kh[q] = khn[q];
            }
            par ^= 1;
        }
        if (sd) {
#pragma unroll
            for (int i = 0; i < 4; ++i) *(f32x4*)(sd + (size_t)lane * 64 + 16 * wid + 4 * i) = (f32x4){S2[2 * i].x, S2[2 * i].y, S2[2 * i + 1].x, S2[2 * i + 1].y};
        }
    } else {
        const int hsl = wid - 4; int par = 0;
        float R[6];
#pragma unroll
        for (int k = 0; k < 2; ++k) { scan_hload(C, hsl + 4 * k, R); scan_hwrite(C, hsl + 4 * k, R); }
        scan_hload(C, hsl + 8, R);
        LBAR();
        for (int t0 = 0; t0 < nsteps; t0 += 8) {
#pragma unroll
            for (int i = 0; i < 8; ++i) {
                if ((i & 3) == hsl) { scan_hwrite(C, t0 + i + 8, R); scan_hload(C, t0 + i + 12, R); }
                LBAR();
                if (i == 0 && t0 > 0) scan_hreduce(C, hsl, par ^ 1, t0 - 8);
            }
            par ^= 1;
        }
    }
    LBAR();
    if (wid >= 4) scan_hreduce(C, wid - 4, ((nsteps >> 3) & 1) ^ 1, nsteps - 8);
}

__device__ __forceinline__ void scan_fixup_tile(const bf16_t* Q, const float* sd, bf16_t* O, int lane) {
    const int fr = lane & 15, fq = lane >> 4;
    bf16x8v a[2][2];
#pragma unroll
    for (int mt = 0; mt < 2; ++mt)
#pragma unroll
        for (int ks = 0; ks < 2; ++ks) a[mt][ks] = *(const bf16x8v*)(Q + (size_t)(mt * 16 + fr) * D + ks * 32 + 8 * fq);
#pragma unroll 2
    for (int nt = 0; nt < 4; ++nt) {
        f32x4 acc0 = {0.f, 0.f, 0.f, 0.f}, acc1 = {0.f, 0.f, 0.f, 0.f};
#pragma unroll
        for (int ks = 0; ks < 2; ++ks) {
            const float* bp = sd + (size_t)(nt * 16 + fr) * 64 + ks * 32 + 8 * fq;
            const f32x4 b0 = *(const f32x4*)bp, b1 = *(const f32x4*)(bp + 4);
            const u32x4 bw = pack8(b0, b1); const bf16x8v b = __builtin_bit_cast(bf16x8v, bw);
            acc0 = __builtin_amdgcn_mfma_f32_16x16x32_bf16(b, a[0][ks], acc0, 0, 0, 0); acc1 = __builtin_amdgcn_mfma_f32_16x16x32_bf16(b, a[1][ks], acc1, 0, 0, 0);
        }
#pragma unroll
        for (int mt = 0; mt < 2; ++mt) {
            bf16_t* op = O + (size_t)(mt * 16 + fr) * D + nt * 16 + 4 * fq; const f32x4 acc = mt ? acc1 : acc0;
            const u32x2 w = *(const u32x2*)op; u32x2 o;
            o.x = pk2(bflo(w.x) + acc.x, bfhi(w.x) + acc.y); o.y = pk2(bflo(w.y) + acc.z, bfhi(w.y) + acc.w);
            *(u32x2*)op = o;
        }
    }
}

#define RLX_AGENT __ATOMIC_RELAXED, __HIP_MEMORY_SCOPE_AGENT
#define XB_TMO      128
#define XB_XCNT(j)  (256  + 64 * (j))
#define XB_XSUB(j)  (1280 + 64 * (j))
#define XB_XGEN(j)  (2304 + 64 * (j))
#define XB_TOP      3328
#define XB_TOPGEN   3392
#define XCD_BAR_WORDS 3456
#define XB_SPIN_CAP (1u << 28)

__device__ __forceinline__ unsigned xb_ld(unsigned* p)              { return __hip_atomic_load(p, __ATOMIC_RELAXED, __HIP_MEMORY_SCOPE_AGENT); }
__device__ __forceinline__ unsigned xb_add(unsigned* p, unsigned v) { return __hip_atomic_fetch_add(p, v, __ATOMIC_RELAXED, __HIP_MEMORY_SCOPE_AGENT); }
__device__ __forceinline__ unsigned xb_xcc_id() { return (unsigned)__builtin_amdgcn_s_getreg((3 << 11) | 20) & 0xFu; }
#define XB_SPIN(cond, bar) do { unsigned _sp = 0; while (cond) { __builtin_amdgcn_s_sleep(1); \
    if ((++_sp & 255u) == 0u) { if (xb_ld(&(bar)[XB_TMO])) break; if (_sp > XB_SPIN_CAP) { atomicAdd(&(bar)[XB_TMO], 1u); break; } } } } while (0)

struct XcdBarrier {
    unsigned* bar; unsigned x;
    volatile LAS unsigned* st;
};

__device__ __forceinline__ XcdBarrier xcd_barrier_post(unsigned* bar, volatile LAS unsigned* st) {
    XcdBarrier b; b.bar = bar; b.x = xb_xcc_id(); b.st = st;
    if (threadIdx.x == 0) (void)xb_add(&bar[XB_XCNT(b.x)], 1u);
    return b;
}
__device__ __forceinline__ void xcd_barrier_complete(unsigned* bar, unsigned x, unsigned& nloc, unsigned& nx) {
    const unsigned G = gridDim.x * gridDim.y * gridDim.z;
    unsigned sum, cnt, mine, sp = 0u;
    for (;;) {
        sum = 0u; cnt = 0u; mine = 0u;
#pragma unroll
        for (unsigned j = 0; j < 16; ++j) { const unsigned c = xb_ld(&bar[XB_XCNT(j)]); sum += c; cnt += (c > 0u) ? 1u : 0u; mine = (j == x) ? c : mine; }
        if (sum == G) break;
        __builtin_amdgcn_s_sleep(1);
        if ((++sp & 255u) == 0u) { if (xb_ld(&bar[XB_TMO])) break; if (sp > XB_SPIN_CAP) { atomicAdd(&bar[XB_TMO], 1u); break; } }
    }
    nloc = mine > 0u ? mine : 1u; nx = cnt > 0u ? cnt : 1u;
}

__device__ __forceinline__ void xcd_barrier(const XcdBarrier& b) {
    asm volatile("s_waitcnt vmcnt(0)" ::: "memory");
    __syncthreads();
    if (threadIdx.x == 0) {
        unsigned* bar = b.bar;
        __builtin_amdgcn_s_waitcnt(0);
        unsigned nloc = b.st[0], nx = b.st[1];
        if (nloc == 0u) { xcd_barrier_complete(bar, b.x, nloc, nx); b.st[0] = nloc; b.st[1] = nx; }
        const unsigned old = xb_add(&bar[XB_XSUB(b.x)], 1u);
        const unsigned gen = old / nloc;
        if (old + 1u == (gen + 1u) * nloc) {
            __builtin_amdgcn_fence(__ATOMIC_RELEASE, "agent");
            asm volatile("s_waitcnt vmcnt(0)" ::: "memory");
            const unsigned og = xb_add(&bar[XB_TOP], 1u);
            const unsigned tg = og / nx;
            if (og + 1u == (tg + 1u) * nx) xb_add(&bar[XB_TOPGEN], 1u);
            else XB_SPIN(xb_ld(&bar[XB_TOPGEN]) == tg, bar);
            __builtin_amdgcn_fence(__ATOMIC_ACQUIRE, "agent");
            xb_add(&bar[XB_XGEN(b.x)], 1u);
            asm volatile("s_waitcnt vmcnt(0)" ::: "memory");
        } else {
            XB_SPIN(xb_ld(&bar[XB_XGEN(b.x)]) == gen, bar);
            __builtin_amdgcn_fence(__ATOMIC_ACQUIRE, "agent");
            asm volatile("s_waitcnt vmcnt(0)" ::: "memory");
        }
    }
    __syncthreads();
}
__global__ void __launch_bounds__(NTHREADS, 2) mega_fwd(Args A) {
    extern __shared__ __attribute__((aligned(16))) unsigned char lds_raw[];
    LAS unsigned char* lds = (LAS unsigned char*)lds_raw;
    cg::grid_group grid = cg::this_grid();
#define TIDV int tid_ = threadIdx.x; asm volatile("" : "+v"(tid_)); const int tid = tid_, lane = tid & 63, wave = __builtin_amdgcn_readfirstlane(tid >> 6); \
    const int G = gridDim.x, gw = blockIdx.x * NWAVES + wave, ngw = G * NWAVES, gtid = blockIdx.x * NTHREADS + tid, gthreads = G * NTHREADS; \
    (void)lane; (void)gw; (void)ngw; (void)gtid; (void)gthreads;

    if (A.ph_hi < 0) grid.sync();
    { volatile LAS unsigned* misc = (volatile LAS unsigned*)(lds + LDS_MISC);
      if (threadIdx.x < 32) misc[threadIdx.x] = 0u;
      __syncthreads(); }
    XcdBarrier bar = xcd_barrier_post((unsigned*)(A.ws + WS_CTL) + 4096, (volatile LAS unsigned*)(lds + LDS_MISC) + 8);
    for (int ph = A.ph_lo; ph < A.ph_hi; ++ph) {
        if (ph > A.ph_lo) xcd_barrier(bar);
        int z = 0; asm volatile("" : "+s"(z));
        unsigned char* ws = A.ws + z;
        if (ph == 0) {
            TIDV
            LAS float* scr = (LAS float*)(lds + wave * 16384);
            constexpr int I_IN = 16 * (NIN / 32), I_SQ = 16 * 32, I_F1 = 16 * 128, I_F2 = 64 * 32, I_G = 2 * 32, I_U = 32;
            constexpr int NITEMS = I_IN + 3 * I_SQ + I_F1 + I_F2 + I_G + 4 * I_U;
            for (int it = gw; it < NITEMS; it += ngw) {
                int r = it;
                if (r < I_IN) { p0_transpose_item(INP(2), D, NIN, (bf16_t*)(ws + WS_WIN), scr, r, lane); continue; } r -= I_IN;
                if (r < I_SQ) { p0_transpose_item(INP(17), D, D, (bf16_t*)(ws + WS_WPR), scr, r, lane); continue; } r -= I_SQ;
                if (r < I_SQ) { p0_transpose_item(INP(18), D, D, (bf16_t*)(ws + WS_WPA), scr, r, lane); continue; } r -= I_SQ;
                if (r < I_SQ) { p0_transpose_item(INP(19), D, D, (bf16_t*)(ws + WS_WOUT), scr, r, lane); continue; } r -= I_SQ;
                if (r < I_F1) { p0_transpose_item(INP(22), D, FF, (bf16_t*)(ws + WS_WF1), scr, r, lane); continue; } r -= I_F1;
                if (r < I_F2) { p0_transpose_item(INP(23), FF, D, (bf16_t*)(ws + WS_WF2), scr, r, lane); continue; } r -= I_F2;
                if (r < I_G) { p0_transpose_item(INP(9), 128, D, (bf16_t*)(ws + WS_GUP), scr, r, lane); continue; } r -= I_G;
                { const int which = r / I_U, it2 = r % I_U, dd = which & 1;
                  p0_transpose_item((which < 2 ? INP(6) : INP(8)) + (size_t)dd * 64 * 1024, 64, D, (bf16_t*)(ws + (which < 2 ? WS_WUP : WS_AUP)) + (size_t)dd * 1024 * 64, scr, it2, lane); }
            }
            cvt_x_chunk(INP(0), (bf16_t*)(ws + WS_XB), gtid, gthreads);
            continue;
        }
        if (ph == 1 + 9 * NCHUNK) {
            TIDV
            ln_rows(A.out + (size_t)(NCHUNK - 1) * MC * D, INP(24), INP(25), nullptr, gw, ngw, lane);
            continue;
        }
        const int c = (ph - 1) / 9, sub = (ph - 1) % 9;
        const int T = (c < 4) ? 2048 : 8192;
        const float* xin = (c < 4) ? INP(0) + (size_t)c * MC * D : INP(1);
        float* outc = A.out + (size_t)c * MC * D;
        if (sub == 0) {
            { Epi8<FZ> e{{(bf16_t*)(ws + WS_Z)}};
              run_gemm(lds, (const bf16_t*)(ws + WS_XB), (const bf16_t*)(ws + WS_WIN), MC, NINP, D, e); }
            if (c > 0) { TIDV ln_rows(A.out + (size_t)(c - 1) * MC * D, INP(24), INP(25), nullptr, gw, ngw, lane); }
        } else if (sub == 1) {
            TIDV
            const int G_ = gridDim.x, b_ = blockIdx.x, tile_lo = (int)(((long)(MC / 32) * b_) / G_), tile_hi = (int)(((long)(MC / 32) * (b_ + 1)) / G_);
            prep_rows(INP(3), INP(4), INP(10), INP(15), INP(16), ws, T, tile_lo * 32 + wave, NWAVES, tile_hi * 32, lane, true);
            __syncthreads();
            const int nit = (tile_hi - tile_lo) * 40;
            for (int it = wave; it < nit; it += NWAVES) {
                const int mt = it / 40, r = it % 40, which = r >> 3, m0 = (tile_lo + mt) * 32, n0 = (r & 7) * 128;
                if (which < 2) { FW f{INP(5) + which * 1024, (float*)(ws + WS_OPW) + (size_t)which * MC * D};
                    wave_gemm_tile<64>((const bf16_t*)(ws + WS_TW), which * 64, (const bf16_t*)(ws + WS_WUP) + (size_t)which * 1024 * 64, m0, n0, lane, f); }
                else if (which < 4) { const int dd = which - 2;
                    FA f{INP(7) + dd * 1024, INP(11), (const bf16_t*)(ws + WS_KS), (const float*)(ws + WS_OPKH), (float*)(ws + WS_OPAK) + (size_t)dd * MC * D, (float*)(ws + WS_OPKT) + (size_t)dd * MC * D};
                    wave_gemm_tile<64>((const bf16_t*)(ws + WS_AD), dd * 64, (const bf16_t*)(ws + WS_AUP) + (size_t)dd * 1024 * 64, m0, n0, lane, f); }
                else { FG f{(bf16_t*)(ws + WS_G)};
                    wave_gemm_tile<128>((const bf16_t*)(ws + WS_SG), 0, (const bf16_t*)(ws + WS_GUP), m0, n0, lane, f); }
            }
        } else if (sub == 2) {
            const int nseq = MC / T, nchain = (c < 4) ? nseq * 32 : 192, nqb = T / 256, natt = nseq * 8 * nqb;
            LAS unsigned* qslot = (LAS unsigned*)(lds + LDS_MISC); const int tid = threadIdx.x;
            for (;;) {
                __syncthreads();
                if (tid == 0) qslot[0] = atomicAdd((unsigned*)(ws + WS_CTL) + 64 * c, 1u);
                __syncthreads();
                const int item = __builtin_amdgcn_readfirstlane((int)qslot[0]);
                if (item >= nchain + natt) break;
                if (item < nchain) {
                    if (c < 4) scan_chain(ws, lds, item >> 5, (item >> 1) & 15, item & 1, T, 0, T, 0, (bf16_t*)(ws + ((item & 1) ? WS_OB : WS_OF)), nullptr);
                    else {
                        const int ch = item / 3, job = item % 3, d_ = ch & 1;
                        bf16_t* ob = (job == 2) ? (bf16_t*)(A.out + (size_t)(NCHUNK - 1) * MC * D) + (size_t)d_ * MC * D : (bf16_t*)(ws + (d_ ? WS_OB : WS_OF));
                        scan_chain(ws, lds, ch >> 5, (ch >> 1) & 15, d_, T, job ? 4096 : 0, 4096, job == 2, ob, job == 0 ? (float*)(ws + WS_END) + (size_t)ch * 4096 : nullptr);
                    }
                }
                else {
                    const int u = item - nchain, qb = u % nqb, hq = (u / nqb) & 7, s = u / (nqb * 8);
                    const att::bf16* qkv = (const att::bf16*)(ws + WS_Z) + (size_t)s * T * ZLD;
                    att::attn_dense_body(qkv + (size_t)qb * 256 * ZLD + ZQ + hq * 128, qkv + ZK + (hq >> 2) * 128, qkv + ZV + (hq >> 2) * 128,
                                         (att::bf16*)(ws + WS_OATT) + ((size_t)s * T + (size_t)qb * 256) * D + hq * 128, T, (char*)lds_raw);
                }
            }
        } else if (sub == 3) {
            TIDV
            if (c == 4) {
                for (int it = gw; it < 64 * 128; it += ngw) {
                    const int ch = it >> 7, tile = it & 127, s_ = ch >> 5, h_ = (ch >> 1) & 15, d_ = ch & 1;
                    const size_t row0 = (size_t)s_ * T + (d_ ? 0 : 4096) + (size_t)tile * 32;
                    scan_fixup_tile((const bf16_t*)(A.out + (size_t)(NCHUNK - 1) * MC * D) + (size_t)d_ * MC * D + row0 * D + h_ * 64, (const float*)(ws + WS_END) + (size_t)ch * 4096,
                                    (bf16_t*)(ws + (d_ ? WS_OB : WS_OF)) + row0 * D + h_ * 64, lane);
                }
                xcd_barrier(bar);
            }
            post_rows(INP(12), INP(13), INP(14), ws, gw, ngw, lane);
        } else if (sub == 4) {
            { Epi4<FP1> e{{(const bf16_t*)(ws + WS_Z), (float*)(ws + WS_M32)}};
              run_gemm(lds, (const bf16_t*)(ws + WS_ORW), (const bf16_t*)(ws + WS_WPR), MC, D, D, e); }
            { Epi4<FP2> e{{(const bf16_t*)(ws + WS_Z), (const float*)(ws + WS_M32), (bf16_t*)(ws + WS_MB)}};
              run_gemm(lds, (const bf16_t*)(ws + WS_OATT), (const bf16_t*)(ws + WS_WPA), MC, D, D, e); }
        } else if (sub == 5) {
            Epi4<FOut> e{{xin, outc}};
            run_gemm(lds, (const bf16_t*)(ws + WS_MB), (const bf16_t*)(ws + WS_WOUT), MC, D, D, e);
        } else if (sub == 6) {
            TIDV
            ln_rows(outc, INP(20), INP(21), (bf16_t*)(ws + WS_HB), gw, ngw, lane);
            if (c + 1 < NCHUNK) cvt_x_chunk((c + 1 < 4) ? INP(0) + (size_t)(c + 1) * MC * D : INP(1), (bf16_t*)(ws + WS_XB), gtid, gthreads);
        } else if (sub == 7) {
            Epi8<FF1> e{{(bf16_t*)(ws + WS_FFH)}};
            run_gemm(lds, (const bf16_t*)(ws + WS_HB), (const bf16_t*)(ws + WS_WF1), MC, FF, D, e);
        } else {
            Epi4<FF2> e{{outc}};
            run_gemm(lds, (const bf16_t*)(ws + WS_FFH), (const bf16_t*)(ws + WS_WF2), MC, D, FF, e);
        }
    }
}

constexpr int NPHASE = 2 + 9 * NCHUNK;

extern "C" void kernel_launch(void* const* d_in, const int* in_sizes, int n_in, void* d_out, int out_size, void* d_ws, size_t ws_size, hipStream_t stream) {
    static int grid = 0;
    if (grid == 0) {
        if (n_in != 26 || out_size != MTOT * D || ws_size < WS_END + 2 * MiB) { fprintf(stderr, "kernel_launch: unexpected shapes n_in %d out %d ws %zu\n", n_in, out_size, ws_size); grid = -1; return; }
        int dev = 0, cus = 0, per_cu = 0;
        hipGetDevice(&dev); hipDeviceGetAttribute(&cus, hipDeviceAttributeMultiprocessorCount, dev);
        if (hipFuncSetAttribute((const void*)mega_fwd, hipFuncAttributeMaxDynamicSharedMemorySize, LDS_BYTES) != hipSuccess) { fprintf(stderr, "kernel_launch: LDS attribute failed\n"); grid = -1; return; }
        if (hipOccupancyMaxActiveBlocksPerMultiprocessor(&per_cu, (const void*)mega_fwd, NTHREADS, LDS_BYTES) != hipSuccess || per_cu < 1) per_cu = 1;
        (void)hipGetLastError();
        grid = cus * (per_cu > 1 ? 1 : per_cu);
    }
    if (grid < 0) return;
    hipMemsetAsync((char*)d_ws + WS_CTL, 0, 64 * 1024, stream);
    Args a{};
    for (int i = 0; i < 26; ++i) a.in[i] = (const float*)d_in[i];
    a.out = (float*)d_out; a.ws = (unsigned char*)d_ws; a.ph_lo = 0; a.ph_hi = NPHASE;
    void* args[] = {&a};
    hipError_t e = hipLaunchCooperativeKernel((const void*)mega_fwd, dim3(grid), dim3(NTHREADS), args, LDS_BYTES, stream);
    if (e != hipSuccess) fprintf(stderr, "cooperative launch failed: %s (grid %d)\n", hipGetErrorString(e), grid);
}
```

```cpp
#include <hip/hip_runtime.h>
#include <hip/hip_bf16.h>
#include <hip/hip_cooperative_groups.h>
#include <cstdio>
#include <cstdint>
namespace cg = cooperative_groups;
namespace pg8 {
#define PG8_LAS __attribute__((address_space(3)))
typedef unsigned short bf16_t;
typedef short bf16x8 __attribute__((ext_vector_type(8)));
typedef float f32x4 __attribute__((ext_vector_type(4)));
typedef unsigned u32x4 __attribute__((ext_vector_type(4)));
constexpr int BM = 256, BK = 64, HALF = 128, HTB = HALF * BK * 2  , STAGE_BYTES = 8 * HTB, NXCD = 8, WGM = 8;

__host__ __device__ __forceinline__ int lds_byte(int r, int c) { const int st = (r >> 4) * 2 + (c >> 5), rr = r & 15, cc = c & 31, ob = rr * 64 + cc * 2; return st * 1024 + (ob ^ (((ob >> 9) & 1) << 5)); }
__host__ __device__ __forceinline__ void stage_rc(int b, int& R, int& C) { const int st = b / 1024, sb = b % 1024, swz = sb ^ (((sb >> 9) & 1) << 5); R = (st >> 1) * 16 + swz / 64; C = (st & 1) * 32 + (swz % 64) / 2; }
__host__ __device__ __forceinline__ int perm32(int rho) { const int n = rho >> 4, i = rho & 15; return 8 * (i >> 2) + 4 * n + (i & 3); }

struct Unit { int pm, pn; };
struct Gemm { const bf16_t* A; const bf16_t* Bt; int M, N, K; };

struct StaticOrder {
    int nM, nN, nwg, G, c;
    __host__ __device__ void init(int M, int N, int G_, int c_) { nM = M / BM; nN = N / BM; nwg = nM * nN; G = G_; c = c_; }
    __host__ __device__ bool next(int i, Unit& u) const {
        const long L = (long)i * G + c; if (L >= nwg) return false;
        int wgid = (int)L; { const int q = nwg / NXCD, r = nwg % NXCD, xcd = wgid % NXCD, off = wgid / NXCD; wgid = (xcd < r ? xcd * (q + 1) : r * (q + 1) + (xcd - r) * q) + off; }
        const int nig = WGM * nN, gid = wgid / nig, fm = gid * WGM, gsz = (nM - fm) < WGM ? (nM - fm) : WGM;
        u.pm = fm + ((wgid % nig) % gsz); u.pn = (wgid % nig) / gsz; return true;
    }
    __device__ __forceinline__ void a_ready(const Unit&) const {}
    __device__ __forceinline__ void done(const Unit&) const {}
};
__device__ __forceinline__ unsigned cvt_pk_bf16(float lo, float hi) { unsigned r; asm volatile("v_cvt_pk_bf16_f32 %0, %1, %2" : "=v"(r) : "v"(lo), "v"(hi)); return r; }
typedef float f32x2 __attribute__((ext_vector_type(2)));
template <class Epi, class Sched, bool ALIGN_EPI = false, bool SP2 = false>
__device__ __forceinline__ void gemm_phase(PG8_LAS unsigned char* lds, const Gemm g, const Sched& S, const Epi& E) {
    int tid_ = threadIdx.x; asm volatile("" : "+v"(tid_));
    const int tid = tid_, wid = __builtin_amdgcn_readfirstlane(tid >> 6), lane = tid & 63, wr = wid >> 2, wc = wid & 3, fr = lane & 15, fq = lane >> 4;
    const int K = g.K, nt = K / BK;
    unsigned voffA[2], voffB[2];
#pragma unroll
    for (int i = 0; i < 2; ++i) { int R, C; stage_rc(tid * 16 + i * 8192, R, C); const int Rb = Epi::PERM ? ((R & ~31) + perm32(R & 31)) : R;
        voffA[i] = (unsigned)(R * K + C) * 2u; voffB[i] = (unsigned)(Rb * K + C) * 2u; }
    const size_t kstep = (size_t)(BK * 2);
    const size_t hstep = (size_t)HALF * K * 2;
    const size_t tstep = 2 * hstep;
    const unsigned ldsw = (unsigned)wid * 1024u;
    const int aoff = lds_byte(wr * 64 + fr, fq * 8), boff = lds_byte(wc * 32 + fr, fq * 8);
#define PG8_SA(b, h) (((b) * 2 + (h)) * HTB)
#define PG8_SB(b, h) ((4 + (b) * 2 + (h)) * HTB)
#define PG8_STAGE(bufoff, gbase, voff) do { _Pragma("unroll") for (int _i = 0; _i < 2; ++_i) \
        __builtin_amdgcn_global_load_lds((const unsigned*)((const char*)(gbase) + (voff)[_i]), (PG8_LAS unsigned*)(lds + (bufoff) + ldsw + _i * 8192), 16, 0, 0); } while (0)
#define PG8_LDA(dst, b, h) do { _Pragma("unroll") for (int m = 0; m < 4; ++m) _Pragma("unroll") for (int k = 0; k < 2; ++k) dst[m][k] = *(const PG8_LAS bf16x8*)(lds + PG8_SA(b, h) + aoff + m * 2048 + k * 1024); } while (0)
#define PG8_LDB(dst, b, h) do { _Pragma("unroll") for (int n = 0; n < 2; ++n) _Pragma("unroll") for (int k = 0; k < 2; ++k) dst[n][k] = *(const PG8_LAS bf16x8*)(lds + PG8_SB(b, h) + boff + n * 2048 + k * 1024); } while (0)
#define PG8_MMA(ai, bj, At, Bt) do { __builtin_amdgcn_s_setprio(1); _Pragma("unroll") for (int m = 0; m < 4; ++m) _Pragma("unroll") for (int n = 0; n < 2; ++n) _Pragma("unroll") for (int k = 0; k < 2; ++k) \
        acc[ai][bj][m][n] = __builtin_amdgcn_mfma_f32_16x16x32_bf16(Bt[n][k], At[m][k], acc[ai][bj][m][n], 0, 0, 0); __builtin_amdgcn_s_setprio(0); } while (0)
#define PG8_WAIT_V(n) asm volatile("s_waitcnt vmcnt(" #n ")" ::: "memory")
#define PG8_WAIT_L(n) asm volatile("s_waitcnt lgkmcnt(" #n ")" ::: "memory")
#define PG8_BAR __builtin_amdgcn_s_barrier()
#define PG8_SCHED __builtin_amdgcn_sched_barrier(0)
    Unit cur, nxt; int ui = 0;
    if (!S.next(0, cur)) return;
    f32x4 acc[2][2][4][2];
#pragma unroll
    for (int a = 0; a < 2; ++a)
#pragma unroll
        for (int b = 0; b < 2; ++b)
#pragma unroll
            for (int m = 0; m < 4; ++m)
#pragma unroll
                for (int n = 0; n < 2; ++n) acc[a][b][m][n] = (f32x4){0.f, 0.f, 0.f, 0.f};
    bf16x8 At[4][2], B0[2][2], B1[2][2];
    const char* cA = (const char*)g.A + (size_t)cur.pm * tstep; const char* cB = (const char*)g.Bt + (size_t)cur.pn * tstep;
    S.a_ready(cur);
    if constexpr (SP2) {
        PG8_STAGE(PG8_SB(0, 0), cB, voffB); PG8_STAGE(PG8_SB(0, 1), cB + hstep, voffB); PG8_STAGE(PG8_SA(0, 0), cA, voffA); PG8_STAGE(PG8_SA(0, 1), cA + hstep, voffA);
        if (wr == 1) PG8_BAR;
        PG8_WAIT_V(2); PG8_BAR;
        PG8_STAGE(PG8_SB(1, 0), cB + kstep, voffB); PG8_STAGE(PG8_SA(1, 0), cA + kstep, voffA); PG8_STAGE(PG8_SB(1, 1), cB + hstep + kstep, voffB);
        PG8_WAIT_V(6); PG8_BAR;
    } else {
        PG8_STAGE(PG8_SB(0, 0), cB, voffB); PG8_STAGE(PG8_SA(0, 0), cA, voffA); PG8_STAGE(PG8_SB(0, 1), cB + hstep, voffB); PG8_STAGE(PG8_SA(0, 1), cA + hstep, voffA);
        if (wr == 1) PG8_BAR;
        PG8_WAIT_V(4); PG8_BAR;
        PG8_STAGE(PG8_SB(1, 0), cB + kstep, voffB); PG8_STAGE(PG8_SA(1, 0), cA + kstep, voffA); PG8_STAGE(PG8_SB(1, 1), cB + hstep + kstep, voffB);
        PG8_WAIT_V(6); PG8_BAR;
    }
    for (;;) {
        const bool has_next = S.next(ui + 1, nxt);
        const char* nA = has_next ? (const char*)g.A + (size_t)nxt.pm * tstep : cA; const char* nB = has_next ? (const char*)g.Bt + (size_t)nxt.pn * tstep : cB;
        for (int t = 0; t < nt; t += 2) {
            const bool last = (t == nt - 2);
            const char* a1 = cA + (size_t)(t + 1) * kstep;
            const char* a2 = last ? nA : cA + (size_t)(t + 2) * kstep; const char* b2 = last ? nB : cB + (size_t)(t + 2) * kstep;
            const char* a3 = a2 + kstep; const char* b3 = b2 + kstep;
            if (last && has_next) S.a_ready(nxt);
            if constexpr (SP2) {
            PG8_LDB(B0, 0, 0); PG8_LDB(B1, 0, 1); PG8_SCHED; PG8_LDA(At, 0, 0); PG8_STAGE(PG8_SA(1, 1), a1 + hstep, voffA);
            PG8_WAIT_V(8); PG8_WAIT_L(0); PG8_BAR; PG8_MMA(0, 0, At, B0); PG8_MMA(0, 1, At, B1); PG8_BAR; PG8_SCHED;
            PG8_LDA(At, 0, 1); PG8_STAGE(PG8_SB(0, 0), b2, voffB); PG8_STAGE(PG8_SB(0, 1), b2 + hstep, voffB); PG8_STAGE(PG8_SA(0, 0), a2, voffA);
            PG8_WAIT_V(8); PG8_WAIT_L(0); PG8_BAR; PG8_MMA(1, 0, At, B0); PG8_MMA(1, 1, At, B1); PG8_BAR; PG8_SCHED;
            PG8_LDB(B0, 1, 0); PG8_LDB(B1, 1, 1); PG8_SCHED; PG8_LDA(At, 1, 0); PG8_STAGE(PG8_SA(0, 1), a2 + hstep, voffA);
            PG8_WAIT_V(8); PG8_WAIT_L(0); PG8_BAR; PG8_MMA(0, 0, At, B0); PG8_MMA(0, 1, At, B1); PG8_BAR; PG8_SCHED;
            PG8_LDA(At, 1, 1); PG8_STAGE(PG8_SB(1, 0), b3, voffB); PG8_STAGE(PG8_SB(1, 1), b3 + hstep, voffB); PG8_STAGE(PG8_SA(1, 0), a3, voffA);
            PG8_WAIT_V(8); PG8_WAIT_L(0); PG8_BAR; PG8_MMA(1, 0, At, B0); PG8_MMA(1, 1, At, B1); PG8_BAR; PG8_SCHED;
            } else {
            PG8_LDB(B0, 0, 0); PG8_SCHED; PG8_LDA(At, 0, 0); PG8_STAGE(PG8_SA(1, 1), a1 + hstep, voffA);
            PG8_WAIT_L(8); PG8_BAR; PG8_WAIT_L(0); PG8_MMA(0, 0, At, B0); PG8_BAR; PG8_SCHED;
            PG8_LDB(B1, 0, 1); PG8_STAGE(PG8_SB(0, 0), b2, voffB);
            PG8_BAR; PG8_WAIT_L(0); PG8_MMA(0, 1, At, B1); PG8_BAR;
            PG8_LDA(At, 0, 1); PG8_STAGE(PG8_SA(0, 0), a2, voffA);
            PG8_BAR; PG8_WAIT_L(0); PG8_MMA(1, 0, At, B0); PG8_BAR; PG8_SCHED;
            PG8_STAGE(PG8_SB(0, 1), b2 + hstep, voffB);
            PG8_WAIT_V(6); PG8_BAR; PG8_MMA(1, 1, At, B1); PG8_BAR;
            PG8_LDB(B0, 1, 0); PG8_SCHED; PG8_LDA(At, 1, 0); PG8_STAGE(PG8_SA(0, 1), a2 + hstep, voffA);
            PG8_WAIT_L(8); PG8_BAR; PG8_WAIT_L(0); PG8_MMA(0, 0, At, B0); PG8_BAR; PG8_SCHED;
            PG8_LDB(B1, 1, 1); PG8_STAGE(PG8_SB(1, 0), b3, voffB);
            PG8_BAR; PG8_WAIT_L(0); PG8_MMA(0, 1, At, B1); PG8_BAR;
            PG8_LDA(At, 1, 1); PG8_STAGE(PG8_SA(1, 0), a3, voffA);
            PG8_BAR; PG8_WAIT_L(0); PG8_MMA(1, 0, At, B0); PG8_BAR; PG8_SCHED;
            PG8_STAGE(PG8_SB(1, 1), b3 + hstep, voffB);
            PG8_WAIT_V(6); PG8_BAR; PG8_MMA(1, 1, At, B1); PG8_BAR;
            }
        }
        if constexpr (ALIGN_EPI) { if (wr == 0) PG8_BAR; }
        if constexpr (!Epi::AFTER_DRAIN) { E(acc, cur, wr, wc, fr, fq); S.done(cur); }
        if (!has_next) break;
#pragma unroll
        for (int a = 0; a < 2; ++a)
#pragma unroll
            for (int b = 0; b < 2; ++b)
#pragma unroll
                for (int m = 0; m < 4; ++m)
#pragma unroll
                    for (int n = 0; n < 2; ++n) acc[a][b][m][n] = (f32x4){0.f, 0.f, 0.f, 0.f};
        cur = nxt; cA = nA; cB = nB; ++ui;
        if constexpr (ALIGN_EPI) { if (wr == 1) PG8_BAR; }
    }
    PG8_WAIT_V(0);
    if constexpr (!ALIGN_EPI) { if (wr == 0) PG8_BAR; }
    PG8_BAR;
    if constexpr (Epi::AFTER_DRAIN) { E.fused(acc, cur, wr, wc, fr, fq, lds, wid, lane); S.done(cur); }
#undef PG8_SA
#undef PG8_SB
#undef PG8_STAGE
#undef PG8_LDA
#undef PG8_LDB
#undef PG8_MMA
#undef PG8_WAIT_V
#undef PG8_WAIT_L
#undef PG8_BAR
#undef PG8_SCHED
}
}
namespace att {
using bf16 = __hip_bfloat16;
constexpr int   D = 128, NW = 8, QBLK = 32, KVBLK = 64;
constexpr float SCALE = 0.088388347648318440f;
constexpr float THR = 8.f;
constexpr int LDQ = 7168, LDK = 7168, LDO = 1024;
constexpr size_t SHM_V = KVBLK * D * 2, SHM_K = KVBLK * D * 2, SHM_ATTN = 2 * SHM_V + 2 * SHM_K + NW * 64 * 4;
using bf16x8 = __attribute__((ext_vector_type(8))) short;
using s16x4  = __attribute__((ext_vector_type(4))) short;
using f32x16 = __attribute__((ext_vector_type(16))) float;
using u32x4  = __attribute__((ext_vector_type(4))) unsigned;
#define KSWZ(row, colB) ((row) * 256 + ((colB) ^ (((row) & 7) << 4)))
#define SBAR() __builtin_amdgcn_sched_barrier(0)
__device__ __forceinline__ int crow(int r, int hi) { return (r & 3) + 8 * (r >> 2) + 4 * hi; }
__device__ __forceinline__ unsigned cvtpk(float lo, float hi) {
  unsigned r; asm volatile("v_cvt_pk_bf16_f32 %0, %1, %2" : "=v"(r) : "v"(lo), "v"(hi)); return r;
}
__device__ __forceinline__ bf16x8 ld8(const bf16* p) { return *reinterpret_cast<const bf16x8*>(p); }
__device__ __forceinline__ void partialSM(f32x16& p0, f32x16& p1, float& m_reg, float& mn, float& alpha) {
  constexpr float C = SCALE * 1.4426950408889634f;
  float pmax = p0[0]; for (int r = 1; r < 16; ++r) pmax = fmaxf(pmax, p0[r]); for (int r = 0; r < 16; ++r) pmax = fmaxf(pmax, p1[r]);
  { auto rr = __builtin_amdgcn_permlane32_swap(__float_as_uint(pmax), __float_as_uint(pmax), false, false);
    pmax = fmaxf(__uint_as_float(rr[0]), __uint_as_float(rr[1])); }
  if (__builtin_expect(__all(pmax - m_reg <= THR / SCALE), 1)) { mn = m_reg; alpha = 1.f; }
  else { mn = fmaxf(m_reg, pmax); alpha = __builtin_amdgcn_exp2f((m_reg - mn) * C); m_reg = mn; }
  float mnC = -mn * C;
  for (int r = 0; r < 16; ++r) p0[r] = fmaf(p0[r], C, mnC); for (int r = 0; r < 16; ++r) p1[r] = fmaf(p1[r], C, mnC);
  for (int r = 0; r < 16; ++r) p0[r] = __builtin_amdgcn_exp2f(p0[r]);
}
__device__ __forceinline__ void finishSM(f32x16& p0, f32x16& p1, float alpha, float& l_reg, bf16x8& pa0, bf16x8& pa1, bf16x8& pa2, bf16x8& pa3) {
  for (int r = 0; r < 16; ++r) p1[r] = __builtin_amdgcn_exp2f(p1[r]);
  float ps = 0; for (int r = 0; r < 16; ++r) ps += p0[r]; for (int r = 0; r < 16; ++r) ps += p1[r];
  { auto rr = __builtin_amdgcn_permlane32_swap(__float_as_uint(ps), __float_as_uint(ps), false, false);
    ps = __uint_as_float(rr[0]) + __uint_as_float(rr[1]); }
  l_reg = l_reg * alpha + ps;
#define PK4(P, BASE, OUT) do { unsigned a0 = cvtpk(P[BASE + 0], P[BASE + 1]), a1 = cvtpk(P[BASE + 2], P[BASE + 3]);   \
    unsigned b0 = cvtpk(P[BASE + 4], P[BASE + 5]), b1 = cvtpk(P[BASE + 6], P[BASE + 7]);                              \
    auto r0 = __builtin_amdgcn_permlane32_swap(a0, b0, false, false); auto r1 = __builtin_amdgcn_permlane32_swap(a1, b1, false, false); \
    u32x4 w = {r0[0], r1[0], r0[1], r1[1]}; OUT = *reinterpret_cast<bf16x8*>(&w); } while (0)
  PK4(p0, 0, pa0); PK4(p0, 8, pa1); PK4(p1, 0, pa2); PK4(p1, 8, pa3);
#undef PK4
}
__device__ __forceinline__ void qkt(f32x16& p0, f32x16& p1, const bf16* Ks, const bf16x8* qr, int r32, int hi) {
  p0 = f32x16{}; p1 = f32x16{};
  for (int d0 = 0; d0 < 8; ++d0) { int cb = (d0 * 16 + hi * 8) * 2;
    bf16x8 b0 = *reinterpret_cast<const bf16x8*>((const char*)Ks + KSWZ(r32, cb));
    bf16x8 b1 = *reinterpret_cast<const bf16x8*>((const char*)Ks + KSWZ(32 + r32, cb));
    p0 = __builtin_amdgcn_mfma_f32_32x32x16_bf16(b0, qr[d0], p0, 0, 0, 0);
    p1 = __builtin_amdgcn_mfma_f32_32x32x16_bf16(b1, qr[d0], p1, 0, 0, 0); }
}
__device__ __forceinline__ int v_st(int k, int c) { const int kk = (k & ~0xC) | ((k & 4) << 1) | ((k & 8) >> 1); return ((kk >> 3) * 4 + (c >> 5)) * 512 + ((kk & 7) * 32 + (c & 31)) * 2; }
__device__ __forceinline__ int v_rd_base(int lane) { return ((lane & 3) << 3) | (((lane >> 2) & 3) << 6) | (((lane >> 4) & 1) << 5) | (((lane >> 5) & 1) << 8); }
constexpr int v_rd_off(int d0, int ks, int half) { return d0 * 512 + ks * 4096 + half * 2048; }
template <int OFF> __device__ __forceinline__ s16x4 tr_read(int vb) {
  s16x4 r; asm volatile("ds_read_b64_tr_b16 %0, %1 offset:%2" : "=&v"(r) : "v"(vb), "i"(OFF) : "memory"); return r;
}
template <int D0> __device__ __forceinline__ void pv_one(f32x16& od, int vb, bf16x8 pa0, bf16x8 pa1, bf16x8 pa2, bf16x8 pa3) {
  const s16x4 l0 = tr_read<v_rd_off(D0, 0, 0)>(vb), h0 = tr_read<v_rd_off(D0, 0, 1)>(vb), l1 = tr_read<v_rd_off(D0, 1, 0)>(vb), h1 = tr_read<v_rd_off(D0, 1, 1)>(vb);
  const s16x4 l2 = tr_read<v_rd_off(D0, 2, 0)>(vb), h2 = tr_read<v_rd_off(D0, 2, 1)>(vb), l3 = tr_read<v_rd_off(D0, 3, 0)>(vb), h3 = tr_read<v_rd_off(D0, 3, 1)>(vb);
  asm volatile("s_waitcnt lgkmcnt(0)" ::: "memory"); SBAR();
#define PK(L, H) (bf16x8){L[0], L[1], L[2], L[3], H[0], H[1], H[2], H[3]}
  od = __builtin_amdgcn_mfma_f32_32x32x16_bf16(pa0, PK(l0, h0), od, 0, 0, 0);
  od = __builtin_amdgcn_mfma_f32_32x32x16_bf16(pa1, PK(l1, h1), od, 0, 0, 0);
  od = __builtin_amdgcn_mfma_f32_32x32x16_bf16(pa2, PK(l2, h2), od, 0, 0, 0);
  od = __builtin_amdgcn_mfma_f32_32x32x16_bf16(pa3, PK(l3, h3), od, 0, 0, 0);
#undef PK
}
__device__ __forceinline__ void pv_d0(f32x16* o, int vb, bf16x8 pa0, bf16x8 pa1, bf16x8 pa2, bf16x8 pa3) {
  pv_one<0>(o[0], vb, pa0, pa1, pa2, pa3); pv_one<1>(o[1], vb, pa0, pa1, pa2, pa3); pv_one<2>(o[2], vb, pa0, pa1, pa2, pa3); pv_one<3>(o[3], vb, pa0, pa1, pa2, pa3);
}
__device__ __forceinline__ void attn_dense_body(const bf16* __restrict__ Qb, const bf16* __restrict__ Kh, const bf16* __restrict__ Vh,
                                                bf16* __restrict__ Ob, int seq, char* lds) {
  int tid_ = threadIdx.x; asm volatile("" : "+v"(tid_));
  const int tid = tid_, wid = tid >> 6, lane = tid & 63, r32 = lane & 31, hi = lane >> 5;
  bf16* V_lds = (bf16*)lds; bf16* K_lds = (bf16*)(lds + 2 * SHM_V);
  float* ws = (float*)(lds + 2 * SHM_V + 2 * SHM_K) + wid * 64; float* li_l = ws; float* al_l = ws + 32;
  float m_reg = -1e30f, l_reg = 0; f32x16 o[4] = {}; bf16x8 qr[8];
  const bf16* Qw = Qb + (long)(wid * QBLK + r32) * LDQ + hi * 8;
#pragma unroll
  for (int d0 = 0; d0 < 8; ++d0) qr[d0] = ld8(Qw + d0 * 16);
  const int sr = tid >> 4, sc = (tid & 15) * 8, vst0 = v_st(sr, sc), vst1 = v_st(32 + sr, sc);
  const int vb0 = (int)(uintptr_t)V_lds + v_rd_base(lane);
  struct { bf16x8 vs0, vs1, ks0, ks1; } sr_[2];
#define SLOAD(i, k0) do { sr_[i].vs0 = ld8(&Vh[(long)((k0) + sr) * LDK + sc]); sr_[i].vs1 = ld8(&Vh[(long)((k0) + 32 + sr) * LDK + sc]); \
    sr_[i].ks0 = ld8(&Kh[(long)((k0) + sr) * LDK + sc]); sr_[i].ks1 = ld8(&Kh[(long)((k0) + 32 + sr) * LDK + sc]); } while (0)
#define SWRITE(b, i) do { *(bf16x8*)((char*)V_lds + (b) * SHM_V + vst0) = sr_[i].vs0;          \
    *(bf16x8*)((char*)V_lds + (b) * SHM_V + vst1) = sr_[i].vs1; int kc = sc * 2;               \
    *(bf16x8*)((char*)K_lds + (b) * SHM_K + KSWZ(sr, kc)) = sr_[i].ks0;                       \
    *(bf16x8*)((char*)K_lds + (b) * SHM_K + KSWZ(32 + sr, kc)) = sr_[i].ks1; } while (0)
#define SWAIT() do { asm volatile("s_waitcnt vmcnt(4)" ::: "memory"); } while (0)
#define RESC(a) do { if (__any((a) < 1.f)) { if (hi == 0) al_l[r32] = (a); asm volatile("s_waitcnt lgkmcnt(0)" ::: "memory"); \
    for (int d = 0; d < 4; ++d) for (int r = 0; r < 16; ++r) o[d][r] *= al_l[crow(r, hi)]; } } while (0)
  f32x16 pA0, pA1, pB0, pB1; float mnA, mnB, alA, alB; bf16x8 pa0, pa1, pa2, pa3; const int NT = seq / KVBLK;
  constexpr int SE = 0, SO = 1;
  SLOAD(SE, 0); asm volatile("s_waitcnt vmcnt(0)" ::: "memory"); SWRITE(0, SE); __syncthreads();
  qkt(pA0, pA1, K_lds, qr, r32, hi); partialSM(pA0, pA1, m_reg, mnA, alA);
  SLOAD(SO, KVBLK); if (2 < NT) SLOAD(SE, 2 * KVBLK);
  SWAIT(); SWRITE(1, SO); __syncthreads();
  for (int j = 1; j + 1 < NT; j += 2) {
    SBAR(); qkt(pB0, pB1, (bf16*)((char*)K_lds + SHM_K), qr, r32, hi);
    finishSM(pA0, pA1, alA, l_reg, pa0, pa1, pa2, pa3); SBAR();
    SLOAD(SO, (j + 2) * KVBLK); SBAR();
    pv_d0(o, vb0, pa0, pa1, pa2, pa3); partialSM(pB0, pB1, m_reg, mnB, alB);
    __syncthreads(); SWAIT(); SWRITE(0, SE);
    RESC(alB); __syncthreads();
    SBAR(); qkt(pA0, pA1, K_lds, qr, r32, hi);
    finishSM(pB0, pB1, alB, l_reg, pa0, pa1, pa2, pa3); SBAR();
    if (j + 3 < NT) SLOAD(SE, (j + 3) * KVBLK); SBAR();
    pv_d0(o, vb0 + (int)SHM_V, pa0, pa1, pa2, pa3); partialSM(pA0, pA1, m_reg, mnA, alA);
    __syncthreads(); SWAIT(); SWRITE(1, SO);
    RESC(alA); __syncthreads();
  }
  SBAR(); qkt(pB0, pB1, (bf16*)((char*)K_lds + SHM_K), qr, r32, hi);
  finishSM(pA0, pA1, alA, l_reg, pa0, pa1, pa2, pa3); SBAR();
  pv_d0(o, vb0, pa0, pa1, pa2, pa3); partialSM(pB0, pB1, m_reg, mnB, alB);
  __syncthreads(); RESC(alB);
  finishSM(pB0, pB1, alB, l_reg, pa0, pa1, pa2, pa3); SBAR();
  pv_d0(o, vb0 + (int)SHM_V, pa0, pa1, pa2, pa3);
  if (hi == 0) li_l[r32] = l_reg; asm volatile("s_waitcnt lgkmcnt(0)" ::: "memory");
  float rli[16];
#pragma unroll
  for (int r = 0; r < 16; ++r) rli[r] = __builtin_amdgcn_rcpf(li_l[crow(r, hi)]);
  bf16* Ow = Ob + (long)(wid * QBLK) * LDO;
#pragma unroll
  for (int r = 0; r < 16; ++r) { int orow = crow(r, hi);
    for (int d0 = 0; d0 < 4; ++d0) Ow[(long)orow * LDO + d0 * 32 + r32] = __float2bfloat16(o[d0][r] * rli[r]); }
  __syncthreads();
#undef SLOAD
#undef SWRITE
#undef SWAIT
#undef RESC
}
#undef KSWZ
#undef SBAR
}
#define LAS __attribute__((address_space(3)))
typedef unsigned short bf16_t;
typedef float f32x4 __attribute__((ext_vector_type(4)));
typedef unsigned u32x4 __attribute__((ext_vector_type(4)));
typedef unsigned u32x2 __attribute__((ext_vector_type(2)));

constexpr int NWAVES = 8, NTHREADS = 512;
constexpr int D = 1024, FF = 4096, NIN = 7040, NINP = 7168, RWC = 3456;
constexpr int MC = 16384, NCHUNK = 5, MTOT = 81920;
constexpr float ALPHA = 1.189207115002721f;
constexpr float LN_EPS = 1e-5f, GN_EPS = 64e-5f, RMS_EPS = 1e-6f;
constexpr float DECAY_SCALE = 0.6065306597126334f;

constexpr size_t MiB = 1u << 20;
constexpr size_t WS_CTL = 0;
constexpr size_t WS_WIN = 1 * MiB, WS_WPR = 15 * MiB, WS_WPA = 17 * MiB, WS_WOUT = 19 * MiB, WS_WF1 = 21 * MiB, WS_WF2 = 29 * MiB;
constexpr size_t WS_WUP = 37 * MiB, WS_AUP = 37 * MiB + 512 * 1024, WS_GUP = 38 * MiB;
constexpr size_t WS_XB = 40 * MiB, WS_OF = 40 * MiB;
constexpr size_t WS_Z = 72 * MiB;
constexpr size_t WS_OPR = 296 * MiB, WS_OPKH = 360 * MiB, WS_VS = 424 * MiB;
constexpr size_t WS_KS = 488 * MiB, WS_OB = 488 * MiB, WS_HB = 488 * MiB;
constexpr size_t WS_TW = 520 * MiB, WS_AD = 524 * MiB, WS_SG = 528 * MiB;
constexpr size_t WS_OPW = 532 * MiB, WS_OPAK = 660 * MiB, WS_OPKT = 788 * MiB;
constexpr size_t WS_G = 916 * MiB, WS_OATT = 948 * MiB, WS_END = 980 * MiB;
constexpr size_t WS_ORW = 532 * MiB, WS_M32 = 564 * MiB, WS_MB = 628 * MiB, WS_FFH = 660 * MiB;
constexpr int ZLD = 7168, ZQ = 3456, ZK = 4480, ZV = 4736, ZG = 4992;

constexpr int LDS_BYTES = 131072 + 1024;
constexpr int LDS_MISC = 131072;

#define INP(k) (A.in[(k) + z])
struct Args {
    const float* in[26];
    float* out; unsigned char* ws;
    int ph_lo, ph_hi;
};

__device__ __forceinline__ float bf2f(unsigned v) { return __uint_as_float(v << 16); }
__device__ __forceinline__ float bflo(unsigned w) { return __uint_as_float(w << 16); }
__device__ __forceinline__ float bfhi(unsigned w) { return __uint_as_float(w & 0xffff0000u); }
typedef float f32x2c_t __attribute__((ext_vector_type(2))); typedef __bf16 bf16x2c_t __attribute__((ext_vector_type(2)));
__device__ __forceinline__ unsigned pk2(float lo, float hi) { f32x2c_t v = {lo, hi}; bf16x2c_t b = __builtin_convertvector(v, bf16x2c_t); return __builtin_bit_cast(unsigned, b); }
__device__ __forceinline__ float sigmoidf_(float x) { return 1.0f / (1.0f + __expf(-x)); }
__device__ __forceinline__ float wave_sum(float v) {
#pragma unroll
    for (int o = 1; o < 64; o <<= 1) v += __shfl_xor(v, o);
    return v;
}

__device__ __forceinline__ void p0_transpose_item(const float* W, int K, int N, bf16_t* WT, LAS float* scr, int item, int lane) {
    const int nblk = N / 32, kb = item / nblk, nb = item % nblk, k0 = 64 * kb, n0 = 32 * nb;
#pragma unroll 8
    for (int i = 0; i < 32; ++i) { const int kk = 2 * i + (lane >> 5); scr[kk * 33 + (lane & 31)] = W[(size_t)(k0 + kk) * N + n0 + (lane & 31)]; }
    asm volatile("s_waitcnt lgkmcnt(0)" ::: "memory");
    const int c = lane & 7;
#pragma unroll
    for (int j = 0; j < 4; ++j) { const int n = (lane >> 3) + 8 * j; const LAS float* s = scr + (8 * c) * 33 + n;
        u32x4 o; o.x = pk2(s[0 * 33], s[1 * 33]); o.y = pk2(s[2 * 33], s[3 * 33]); o.z = pk2(s[4 * 33], s[5 * 33]); o.w = pk2(s[6 * 33], s[7 * 33]);
        *(u32x4*)(WT + (size_t)(n0 + n) * K + k0 + 8 * c) = o; }
    asm volatile("s_waitcnt lgkmcnt(0)" ::: "memory");
}

__device__ __forceinline__ void cvt_x_chunk(const float* x, bf16_t* xb, int gtid, int gthreads) {
    const size_t n8 = (size_t)MC * D / 8;
    for (size_t i = gtid; i < n8; i += gthreads) {
        const f32x4 a = *(const f32x4*)(x + i * 8), b = *(const f32x4*)(x + i * 8 + 4);
        u32x4 o; o.x = pk2(a.x, a.y); o.y = pk2(a.z, a.w); o.z = pk2(b.x, b.y); o.w = pk2(b.z, b.w);
        *(u32x4*)(xb + i * 8) = o;
    }
}

__device__ __forceinline__ void ln_rows(float* base, const float* g, const float* b, bf16_t* hb, int gw, int ngw, int lane) {
    f32x4 gg[4], bb[4];
#pragma unroll
    for (int j = 0; j < 4; ++j) { gg[j] = *((const f32x4*)g + 64 * j + lane); bb[j] = *((const f32x4*)b + 64 * j + lane); }
    for (int m0 = gw; m0 < MC; m0 += 2 * ngw) {
        const int m1 = m0 + ngw; const bool has1 = m1 < MC;
        f32x4* xr0 = (f32x4*)(base + (size_t)m0 * D) + lane; f32x4* xr1 = (f32x4*)(base + (size_t)(has1 ? m1 : m0) * D) + lane;
        f32x4 v0[4], v1[4]; float s0 = 0.f, s1 = 0.f;
#pragma unroll
        for (int j = 0; j < 4; ++j) { v0[j] = xr0[64 * j]; v1[j] = xr1[64 * j]; }
#pragma unroll
        for (int j = 0; j < 4; ++j) { s0 += (v0[j].x + v0[j].y) + (v0[j].z + v0[j].w); s1 += (v1[j].x + v1[j].y) + (v1[j].z + v1[j].w); }
        const float mean0 = wave_sum(s0) * (1.f / D), mean1 = wave_sum(s1) * (1.f / D); float q0 = 0.f, q1 = 0.f;
#pragma unroll
        for (int j = 0; j < 4; ++j) { v0[j] = v0[j] - mean0; v1[j] = v1[j] - mean1;
            q0 += (v0[j].x * v0[j].x + v0[j].y * v0[j].y) + (v0[j].z * v0[j].z + v0[j].w * v0[j].w); q1 += (v1[j].x * v1[j].x + v1[j].y * v1[j].y) + (v1[j].z * v1[j].z + v1[j].w * v1[j].w); }
        const float rstd0 = 1.f / sqrtf(wave_sum(q0) * (1.f / D) + LN_EPS), rstd1 = 1.f / sqrtf(wave_sum(q1) * (1.f / D) + LN_EPS);
#pragma unroll
        for (int j = 0; j < 4; ++j) {
            const f32x4 y0 = v0[j] * rstd0 * gg[j] + bb[j]; xr0[64 * j] = y0;
            if (hb) { u32x2 w; w.x = pk2(y0.x, y0.y); w.y = pk2(y0.z, y0.w); *(u32x2*)(hb + (size_t)m0 * D + 256 * j + 4 * lane) = w; }
            if (has1) { const f32x4 y1 = v1[j] * rstd1 * gg[j] + bb[j]; xr1[64 * j] = y1;
                if (hb) { u32x2 w; w.x = pk2(y1.x, y1.y); w.y = pk2(y1.z, y1.w); *(u32x2*)(hb + (size_t)m1 * D + 256 * j + 4 * lane) = w; } }
        }
    }
}

template <class F> struct Epi4 {
    static constexpr bool PERM = false, AFTER_DRAIN = false; F f;
    __device__ __forceinline__ void operator()(const pg8::f32x4 (&acc)[2][2][4][2], const pg8::Unit& u, int wr, int wc, int fr, int fq) const {
        const int row0 = u.pm * 256 + wr * 64 + fr, col0 = u.pn * 256 + wc * 32 + 4 * fq;
#pragma unroll
        for (int ai = 0; ai < 2; ++ai)
#pragma unroll
            for (int m = 0; m < 4; ++m)
#pragma unroll
                for (int bj = 0; bj < 2; ++bj)
#pragma unroll
                    for (int n = 0; n < 2; ++n) { f(row0 + ai * 128 + m * 16, col0 + bj * 128 + n * 16, acc[ai][bj][m][n]); asm volatile("" ::: "memory"); }
    }
};
template <class F> struct Epi8 {
    static constexpr bool PERM = true, AFTER_DRAIN = false; F f;
    __device__ __forceinline__ void operator()(const pg8::f32x4 (&acc)[2][2][4][2], const pg8::Unit& u, int wr, int wc, int fr, int fq) const {
        const int row0 = u.pm * 256 + wr * 64 + fr, col0 = u.pn * 256 + wc * 32 + 8 * fq;
#pragma unroll
        for (int ai = 0; ai < 2; ++ai)
#pragma unroll
            for (int m = 0; m < 4; ++m)
#pragma unroll
                for (int bj = 0; bj < 2; ++bj) { f(row0 + ai * 128 + m * 16, col0 + bj * 128, acc[ai][bj][m][0], acc[ai][bj][m][1]); asm volatile("" ::: "memory"); }
    }
};
__device__ __forceinline__ u32x4 pack8(f32x4 a, f32x4 b) { u32x4 w; w.x = pk2(a.x, a.y); w.y = pk2(a.z, a.w); w.z = pk2(b.x, b.y); w.w = pk2(b.z, b.w); return w; }

struct FZ { bf16_t* z;
    __device__ __forceinline__ void operator()(int row, int col, f32x4 a, f32x4 b) const { *(u32x4*)(z + (size_t)row * ZLD + col) = pack8(a, b); } };
struct FW { const float* w0; bf16_t* opw;
    __device__ __forceinline__ void operator()(int row, int col, f32x4 a) const {
        const f32x4 x = a + *(const f32x4*)(w0 + col); f32x4 y;
#pragma unroll
        for (int i = 0; i < 4; ++i) y[i] = __expf(-DECAY_SCALE * sigmoidf_(x[i]));
        u32x2 w; w.x = pk2(y.x, y.y); w.y = pk2(y.z, y.w); *(u32x2*)(opw + (size_t)row * D + col) = w; } };
struct FA { const float *a0, *k_a; const bf16_t* ks; const bf16_t* kh; bf16_t *opak, *opkt;
    __device__ __forceinline__ void operator()(int row, int col, f32x4 acc) const {
        const size_t o = (size_t)row * D + col;
        const f32x4 x = acc + *(const f32x4*)(a0 + col), ka = *(const f32x4*)(k_a + col); const u32x2 hw = *(const u32x2*)(kh + o);
        f32x4 khv; khv.x = bflo(hw.x); khv.y = bfhi(hw.x); khv.z = bflo(hw.y); khv.w = bfhi(hw.y);
        const u32x2 kw = *(const u32x2*)(ks + o);
        f32x4 k; k.x = bflo(kw.x); k.y = bfhi(kw.x); k.z = bflo(kw.y); k.w = bfhi(kw.y);
        f32x4 ak, kt;
#pragma unroll
        for (int i = 0; i < 4; ++i) { const float a = sigmoidf_(x[i]); ak[i] = a * khv[i]; kt[i] = k[i] * (1.0f + (a - 1.0f) * ka[i]); }
        u32x2 wa, wt; wa.x = pk2(ak.x, ak.y); wa.y = pk2(ak.z, ak.w); wt.x = pk2(kt.x, kt.y); wt.y = pk2(kt.z, kt.w);
        *(u32x2*)(opak + o) = wa; *(u32x2*)(opkt + o) = wt; } };
struct FG { bf16_t* g;
    __device__ __forceinline__ void operator()(int row, int col, f32x4 a) const {
        u32x2 w; w.x = pk2(a.x, a.y); w.y = pk2(a.z, a.w); *(u32x2*)(g + (size_t)row * D + col) = w; } };
typedef short bf16x8v __attribute__((ext_vector_type(8)));
template <int K, class F> __device__ __forceinline__ void wave_gemm_tile(const bf16_t* A, int aoff, const bf16_t* Bt, int m0, int n0, int lane, const F& f) {
    const int fr = lane & 15, fq = lane >> 4; constexpr int KS = K / 32;
    bf16x8v a[2][KS];
#pragma unroll
    for (int mt = 0; mt < 2; ++mt)
#pragma unroll
        for (int ks = 0; ks < KS; ++ks) a[mt][ks] = *(const bf16x8v*)(A + (size_t)(m0 + mt * 16 + fr) * 128 + aoff + ks * 32 + 8 * fq);
#pragma unroll 2
    for (int nt = 0; nt < 8; ++nt) {
        const bf16_t* bp = Bt + (size_t)(n0 + nt * 16 + fr) * K + 8 * fq;
        f32x4 acc0 = {0.f, 0.f, 0.f, 0.f}, acc1 = {0.f, 0.f, 0.f, 0.f};
#pragma unroll
        for (int ks = 0; ks < KS; ++ks) { const bf16x8v b = *(const bf16x8v*)(bp + ks * 32);
            acc0 = __builtin_amdgcn_mfma_f32_16x16x32_bf16(b, a[0][ks], acc0, 0, 0, 0); acc1 = __builtin_amdgcn_mfma_f32_16x16x32_bf16(b, a[1][ks], acc1, 0, 0, 0); }
        f(m0 + fr, n0 + nt * 16 + 4 * fq, acc0); f(m0 + 16 + fr, n0 + nt * 16 + 4 * fq, acc1);
    }
}
struct FP1 { const bf16_t* gates; float* m32;
    __device__ __forceinline__ void operator()(int row, int col, f32x4 a) const {
        const u32x2 gw = *(const u32x2*)(gates + (size_t)row * ZLD + ZG + col); f32x4 y;
        y.x = sigmoidf_(bflo(gw.x)) * a.x; y.y = sigmoidf_(bfhi(gw.x)) * a.y; y.z = sigmoidf_(bflo(gw.y)) * a.z; y.w = sigmoidf_(bfhi(gw.y)) * a.w;
        *(f32x4*)(m32 + (size_t)row * D + col) = y;
    } };
struct FP2 { const bf16_t* gates; const float* m32; bf16_t* mb;
    __device__ __forceinline__ void operator()(int row, int col, f32x4 a) const {
        const u32x2 gw = *(const u32x2*)(gates + (size_t)row * ZLD + ZG + 1024 + col); const f32x4 p = *(const f32x4*)(m32 + (size_t)row * D + col); f32x4 y;
        y.x = p.x + sigmoidf_(bflo(gw.x)) * a.x; y.y = p.y + sigmoidf_(bfhi(gw.x)) * a.y; y.z = p.z + sigmoidf_(bflo(gw.y)) * a.z; y.w = p.w + sigmoidf_(bfhi(gw.y)) * a.w;
        u32x2 w; w.x = pk2(y.x, y.y); w.y = pk2(y.z, y.w); *(u32x2*)(mb + (size_t)row * D + col) = w;
    } };
struct FOut { const float* x; float* out;
    __device__ __forceinline__ void operator()(int row, int col, f32x4 a) const {
        const size_t o = (size_t)row * D + col; *(f32x4*)(out + o) = *(const f32x4*)(x + o) * ALPHA + a; } };
struct FF1 { bf16_t* ffh;
    __device__ __forceinline__ void operator()(int row, int col, f32x4 a, f32x4 b) const {
#pragma unroll
        for (int i = 0; i < 4; ++i) { const float u = fmaxf(a[i], 0.f), v = fmaxf(b[i], 0.f); a[i] = u * u; b[i] = v * v; }
        *(u32x4*)(ffh + (size_t)row * FF + col) = pack8(a, b); } };
struct FF2 { float* out;
    __device__ __forceinline__ void operator()(int row, int col, f32x4 a) const {
        const size_t o = (size_t)row * D + col; *(f32x4*)(out + o) = *(const f32x4*)(out + o) * ALPHA + a; } };

template <class E> __device__ __forceinline__ void run_gemm(LAS unsigned char* lds, const bf16_t* A, const bf16_t* Bt, int M, int N, int K, const E& e) {

    int G_ = (int)gridDim.x, c_ = (int)blockIdx.x; asm volatile("" : "+s"(G_), "+s"(c_));
    pg8::Gemm g{A, Bt, M, N, K}; pg8::StaticOrder S; S.init(M, N, G_, c_);
    pg8::gemm_phase<E, pg8::StaticOrder, true, true>(lds, g, S, e);
}

__device__ __forceinline__ void prep_rows(const float* mu_p, const float* mu_n, const float* k_k, const float* qn, const float* kn, unsigned char* ws, int T, int rbeg, int rstep, int rend, int lane, bool do_att) {
    bf16_t* Z = (bf16_t*)(ws + WS_Z);
    bf16_t* OPR = (bf16_t*)(ws + WS_OPR); bf16_t* OPKH = (bf16_t*)(ws + WS_OPKH); bf16_t* VS = (bf16_t*)(ws + WS_VS);
    bf16_t* KS = (bf16_t*)(ws + WS_KS); bf16_t* TW = (bf16_t*)(ws + WS_TW); bf16_t* AD = (bf16_t*)(ws + WS_AD); bf16_t* SG = (bf16_t*)(ws + WS_SG);
    for (int row = rbeg; row < rend; row += rstep) {
        const int t = row & (T - 1); const bool hp = t > 0, hn = t < T - 1;
        const bf16_t* zc = Z + (size_t)row * ZLD;
#pragma unroll
        for (int pass = 0; pass < 7; ++pass) {
            const int c = pass * 512 + lane * 8;
            if (c < RWC) {
                const u32x4 wc_ = *(const u32x4*)(zc + c);
                u32x4 wp = {0u, 0u, 0u, 0u}, wn = {0u, 0u, 0u, 0u};
                if (hp) wp = *(const u32x4*)(zc - ZLD + c);
                if (hn) wn = *(const u32x4*)(zc + ZLD + c);
                const f32x4 mp0 = *(const f32x4*)(mu_p + c), mp1 = *(const f32x4*)(mu_p + c + 4), mn0 = *(const f32x4*)(mu_n + c), mn1 = *(const f32x4*)(mu_n + c + 4);
                float z[8];
#pragma unroll
                for (int i = 0; i < 4; ++i) {
                    const float c0 = bflo(wc_[i]), c1 = bfhi(wc_[i]), p0 = bflo(wp[i]), p1 = bfhi(wp[i]), n0 = bflo(wn[i]), n1 = bfhi(wn[i]);
                    const float mpa = (2 * i < 4) ? mp0[2 * i] : mp1[2 * i - 4], mpb = (2 * i + 1 < 4) ? mp0[2 * i + 1] : mp1[2 * i - 3];
                    const float mna = (2 * i < 4) ? mn0[2 * i] : mn1[2 * i - 4], mnb = (2 * i + 1 < 4) ? mn0[2 * i + 1] : mn1[2 * i - 3];
                    z[2 * i] = c0 + mpa * (p0 - c0) + mna * (n0 - c0);
                    z[2 * i + 1] = c1 + mpb * (p1 - c1) + mnb * (n1 - c1);
                }
                if (pass < 2) {
                    u32x4 w; w.x = pk2(z[0], z[1]); w.y = pk2(z[2], z[3]); w.z = pk2(z[4], z[5]); w.w = pk2(z[6], z[7]);
                    *(u32x4*)(OPR + (size_t)row * D + c) = w;
                } else if (pass < 4) {
                    const int cc = c - 1024;
                    u32x4 w; w.x = pk2(z[0], z[1]); w.y = pk2(z[2], z[3]); w.z = pk2(z[4], z[5]); w.w = pk2(z[6], z[7]);
                    *(u32x4*)(KS + (size_t)row * D + cc) = w;
                    const f32x4 kk0 = *(const f32x4*)(k_k + cc), kk1 = *(const f32x4*)(k_k + cc + 4);
                    float kp[8]; float ss = 0.f;
#pragma unroll
                    for (int i = 0; i < 8; ++i) { kp[i] = z[i] * (i < 4 ? kk0[i] : kk1[i - 4]); ss += kp[i] * kp[i]; }
                    ss += __shfl_xor(ss, 1); ss += __shfl_xor(ss, 2); ss += __shfl_xor(ss, 4);
                    const float inv = 1.0f / fmaxf(sqrtf(ss), 1e-12f);
                    u32x4 wk; wk.x = pk2(kp[0] * inv, kp[1] * inv); wk.y = pk2(kp[2] * inv, kp[3] * inv); wk.z = pk2(kp[4] * inv, kp[5] * inv); wk.w = pk2(kp[6] * inv, kp[7] * inv);
                    *(u32x4*)(OPKH + (size_t)row * D + cc) = wk;
                } else if (pass < 6) {
                    u32x4 w; w.x = pk2(z[0], z[1]); w.y = pk2(z[2], z[3]); w.z = pk2(z[4], z[5]); w.w = pk2(z[6], z[7]);
                    *(u32x4*)(VS + (size_t)row * D + (c - 2048)) = w;
                } else {
                    const int sect = lane >> 4, cc = (lane & 15) * 8;
                    float y[8];
#pragma unroll
                    for (int i = 0; i < 8; ++i) {
                        if (sect == 0) { const float e = __expf(2.0f * z[i]); y[i] = 1.0f - 2.0f / (e + 1.0f); }
                        else if (sect == 1) y[i] = z[i];
                        else y[i] = sigmoidf_(z[i]);
                    }
                    u32x4 w; w.x = pk2(y[0], y[1]); w.y = pk2(y[2], y[3]); w.z = pk2(y[4], y[5]); w.w = pk2(y[6], y[7]);
                    bf16_t* dst = (sect == 0 ? TW : (sect == 1 ? AD : SG)) + (size_t)row * 128 + cc;
                    *(u32x4*)dst = w;
                }
            }
        }
        bf16_t* qrow = Z + (size_t)row * ZLD + ZQ;
#pragma unroll 1
        for (int p = do_att ? 0 : 3; p < 3; ++p) {
            const int head = p * 4 + (lane >> 4), sub = lane & 15, d0 = sub * 8;
            const bool act = head < 10;
            bf16_t* px = qrow + head * 128 + d0;
            u32x4 w = {0u, 0u, 0u, 0u}; if (act) w = *(const u32x4*)px;
            float x[8]; float ss = 0.f;
#pragma unroll
            for (int i = 0; i < 4; ++i) { x[2 * i] = bflo(w[i]); x[2 * i + 1] = bfhi(w[i]); ss += x[2 * i] * x[2 * i] + x[2 * i + 1] * x[2 * i + 1]; }
            ss += __shfl_xor(ss, 1); ss += __shfl_xor(ss, 2); ss += __shfl_xor(ss, 4); ss += __shfl_xor(ss, 8);
            const float rinv = rsqrtf(ss * (1.0f / 128.0f) + RMS_EPS);
            const float* gn = (head < 8) ? qn : kn;
            const f32x4 g0 = *(const f32x4*)(gn + d0), g1 = *(const f32x4*)(gn + d0 + 4);
            const int axis = sub >> 3, hf = (sub >> 2) & 1;
            const float pos = (float)(axis ? (t & 63) : (t >> 6));
            float y[8];
#pragma unroll
            for (int i = 0; i < 8; ++i) {
                const float xn = x[i] * rinv * (i < 4 ? g0[i] : g1[i - 4]);
                const float xp = __shfl_xor(xn, 4);
                const int fi = (sub & 3) * 8 + i;
                const float ang = pos * exp2f(-0.41524101186092f * (float)fi);
                y[i] = xn * __cosf(ang) + (hf ? xp : -xp) * __sinf(ang);
            }
            if (act) { u32x4 o; o.x = pk2(y[0], y[1]); o.y = pk2(y[2], y[3]); o.z = pk2(y[4], y[5]); o.w = pk2(y[6], y[7]); *(u32x4*)px = o; }
        }
    }
}

__device__ __forceinline__ float rowsum16(float x) {
    x += __int_as_float(__builtin_amdgcn_update_dpp(0, __float_as_int(x), 0x128, 0xf, 0xf, true));
    x += __int_as_float(__builtin_amdgcn_update_dpp(0, __float_as_int(x), 0x124, 0xf, 0xf, true));
    x += __int_as_float(__builtin_amdgcn_update_dpp(0, __float_as_int(x), 0x122, 0xf, 0xf, true));
    x += __int_as_float(__builtin_amdgcn_update_dpp(0, __float_as_int(x), 0x121, 0xf, 0xf, true));
    return x;
}
__device__ __forceinline__ void post_rows(const float* r_k, const float* gn_g, const float* gn_b, unsigned char* ws, int gw, int ngw, int lane) {
    const bf16_t* OF = (const bf16_t*)(ws + WS_OF); const bf16_t* OB = (const bf16_t*)(ws + WS_OB);
    const bf16_t* OPR = (const bf16_t*)(ws + WS_OPR); const bf16_t* VS = (const bf16_t*)(ws + WS_VS);
    const bf16_t* KTF = (const bf16_t*)(ws + WS_OPKT); const bf16_t* KTB = KTF + (size_t)MC * D;
    const bf16_t* G = (const bf16_t*)(ws + WS_G); bf16_t* ORW = (bf16_t*)(ws + WS_ORW);
    const int hg = lane >> 4, sub = lane & 15;
    for (int row = gw; row < MC; row += ngw) {
        const size_t ro = (size_t)row * D;
#pragma unroll 2
        for (int pass = 0; pass < 4; ++pass) {
            const int c = (4 * pass + hg) * 64 + sub * 4; const size_t o = ro + c;
            const u32x2 wf = *(const u32x2*)(OF + o), wb = *(const u32x2*)(OB + o), wg = *(const u32x2*)(G + o);
            const u32x2 wr = *(const u32x2*)(OPR + o), wtf = *(const u32x2*)(KTF + o), wtb = *(const u32x2*)(KTB + o), wv = *(const u32x2*)(VS + o);
            f32x4 r4, ktf, ktb, v4;
            r4.x = bflo(wr.x); r4.y = bfhi(wr.x); r4.z = bflo(wr.y); r4.w = bfhi(wr.y); ktf.x = bflo(wtf.x); ktf.y = bfhi(wtf.x); ktf.z = bflo(wtf.y); ktf.w = bfhi(wtf.y);
            ktb.x = bflo(wtb.x); ktb.y = bfhi(wtb.x); ktb.z = bflo(wtb.y); ktb.w = bfhi(wtb.y); v4.x = bflo(wv.x); v4.y = bfhi(wv.x); v4.z = bflo(wv.y); v4.w = bfhi(wv.y);
            const f32x4 rk = *(const f32x4*)(r_k + c), gg = *(const f32x4*)(gn_g + c), gb = *(const f32x4*)(gn_b + c);
            f32x4 ov; ov.x = bflo(wf.x) + bflo(wb.x); ov.y = bfhi(wf.x) + bfhi(wb.x); ov.z = bflo(wf.y) + bflo(wb.y); ov.w = bfhi(wf.y) + bfhi(wb.y);
            const float mean = rowsum16((ov.x + ov.y) + (ov.z + ov.w)) * (1.0f / 64.0f);
            const f32x4 dv = ov - mean;
            const float var = rowsum16((dv.x * dv.x + dv.y * dv.y) + (dv.z * dv.z + dv.w * dv.w)) * (1.0f / 64.0f);
            const f32x4 bt = r4 * (ktf + ktb) * rk;
            const float bs = rowsum16((bt.x + bt.y) + (bt.z + bt.w));
            const float rstd = rsqrtf(var + GN_EPS);
            f32x4 g4; g4.x = bflo(wg.x); g4.y = bfhi(wg.x); g4.z = bflo(wg.y); g4.w = bfhi(wg.y);
            const f32x4 y = (dv * rstd * gg + gb + v4 * bs) * g4;
            u32x2 w; w.x = pk2(y.x, y.y); w.y = pk2(y.z, y.w); *(u32x2*)(ORW + o) = w;
        }
    }
}

#define DPPQ(q) "quad_perm:[" #q "," #q "," #q "," #q "] row_mask:0xf bank_mask:0xf"
#define FMAC_DPP(acc, x, s, q) asm("v_fmac_f32_dpp %0, %1, %2 " DPPQ(q) : "+v"(acc) : "v"(x), "v"(s))
#define MUL_DPP(dst, x, s, q) asm("v_mul_f32_dpp %0, %1, %2 " DPPQ(q) : "=v"(dst) : "v"(x), "v"(s))
#define LBAR() asm volatile("s_waitcnt lgkmcnt(0)\n\ts_barrier" ::: "memory")

typedef float f32x2s __attribute__((ext_vector_type(2)));
struct ScanCtx {
    const unsigned* gp[3]; bf16_t* po; long r0, dstep; int T;
    LAS float* part; LAS float* opart; LAS float* ring; int wid, lane;
};
constexpr int SCAN_RING = 16, SCAN_SLOTF = 6 * 64;
__device__ __forceinline__ void scan_hload(const ScanCtx& C, int u, unsigned (&R)[3]) {
    const int uu = u < C.T ? u : C.T - 1; const long ro = (C.r0 + C.dstep * (long)uu) * (D / 2);
#pragma unroll
    for (int p = 0; p < 3; ++p) R[p] = C.gp[p][ro];
}
__device__ __forceinline__ void scan_hwrite(const ScanCtx& C, int u, const unsigned (&R)[3]) {
    LAS float* sl = C.ring + (u & (SCAN_RING - 1)) * SCAN_SLOTF + (C.lane >> 5) * 64 + 2 * (C.lane & 31);
#pragma unroll
    for (int p = 0; p < 3; ++p) *(LAS f32x2s*)(sl + p * 128) = (f32x2s){bflo(R[p]), bfhi(R[p])};
}
__device__ __forceinline__ void scan_ld4(const LAS float* p, f32x4 (&v)[4]) {
#pragma unroll
    for (int q = 0; q < 4; ++q) v[q] = *(const LAS f32x4*)(p + 4 * q);
}
__device__ __forceinline__ void scan_hreduce(const ScanCtx& C, int hsl, int parity, int tblock) {
#pragma unroll
    for (int k = 0; k < 2; ++k) { const int slot = hsl + 4 * k; const LAS float* op = C.opart + (parity * 8 + slot) * 256 + C.lane;
        const float o = (op[0] + op[64]) + (op[128] + op[192]);
        C.po[(C.r0 + C.dstep * (long)(tblock + slot)) * D] = (bf16_t)(pk2(o, o) & 0xffffu); }
}
__device__ __forceinline__ void scan_chain(unsigned char* ws, LAS unsigned char* lds, int s, int h, int d, int T, int tbeg, int nsteps, int mode, bf16_t* obase, float* sd) {
    int tid_ = threadIdx.x; asm volatile("" : "+v"(tid_));
    const int tid = tid_, lane = tid & 63, wid = __builtin_amdgcn_readfirstlane(tid >> 6);
    ScanCtx C; C.T = nsteps; C.wid = wid; C.lane = lane;
    const int col = h * 64; const size_t dofs = (size_t)d * MC * D;
    { const bool hi_ = lane >= 32; const int li_ = lane & 31;
      const bf16_t* b0 = hi_ ? (const bf16_t*)(ws + WS_OPW) + dofs : (const bf16_t*)(ws + WS_OPKH);
      const bf16_t* b1 = hi_ ? (const bf16_t*)(ws + WS_OPKT) + dofs : (const bf16_t*)(ws + WS_OPAK) + dofs;
      const bf16_t* b2 = hi_ ? (const bf16_t*)(ws + WS_VS) : (const bf16_t*)(ws + WS_OPR);
      C.gp[0] = (const unsigned*)(b0 + col) + li_; C.gp[1] = (const unsigned*)(b1 + col) + li_; C.gp[2] = (const unsigned*)(b2 + col) + li_; }
    C.po = obase + col + lane;
    C.dstep = d ? -1 : 1; C.r0 = (d ? (long)s * T + T - 1 : (long)s * T) + C.dstep * (long)tbeg;
    C.part = (LAS float*)lds; C.opart = (LAS float*)(lds + 2048); C.ring = (LAS float*)(lds + 18432);
    if (wid < 4) {
        f32x2s S2[8];
#pragma unroll
        for (int j = 0; j < 8; ++j) { S2[j].x = (mode && lane == 16 * wid + 2 * j) ? 1.f : 0.f; S2[j].y = (mode && lane == 16 * wid + 2 * j + 1) ? 1.f : 0.f; }
        LBAR();
        f32x4 kh[4]; scan_ld4(C.ring + wid * 16, kh);
        int par = 0;
        for (int t0 = 0; t0 < nsteps; t0 += 8) {
#pragma unroll
            for (int i = 0; i < 8; ++i) {
                const LAS float* sl = C.ring + (((t0 & 8) + i) & (SCAN_RING - 1)) * SCAN_SLOTF;
                f32x4 w4[4], ak[4], kt[4], r4[4];
                scan_ld4(sl + 64 + wid * 16, w4); scan_ld4(sl + 128 + wid * 16, ak); scan_ld4(sl + 192 + wid * 16, kt); scan_ld4(sl + 256 + wid * 16, r4);
                const float vraw = sl[320 + lane];
                f32x4 khn[4]; scan_ld4(C.ring + (((t0 & 8) + i + 1) & (SCAN_RING - 1)) * SCAN_SLOTF + wid * 16, khn);
                f32x2s pa = {0.f, 0.f}, pb = {0.f, 0.f};
#pragma unroll
                for (int q = 0; q < 4; ++q) { pa = kh[q].xy * S2[2 * q] + pa; pb = kh[q].zw * S2[2 * q + 1] + pb; }
                LAS float* pp = C.part + (i & 1) * 256;
                pp[wid * 64 + lane] = (pa.x + pa.y) + (pb.x + pb.y);
                LBAR();
                const unsigned paddr = (unsigned)(unsigned long)(pp + lane);
                f32x2s r0, r1;
                asm volatile("ds_read2st64_b32 %0, %2 offset1:1\n\tds_read2st64_b32 %1, %2 offset0:2 offset1:3" : "=&v"(r0), "=&v"(r1) : "v"(paddr) : "memory");
                asm volatile("s_waitcnt lgkmcnt(0)" : "+v"(r0), "+v"(r1) :: "memory");
                const float nsk = -((r0.x + r0.y) + (r1.x + r1.y)), vv = mode ? 0.f : vraw;
                const f32x2s nsk2 = {nsk, nsk}, vv2 = {vv, vv};
                f32x2s oa = {0.f, 0.f}, ob = {0.f, 0.f};
#pragma unroll
                for (int q = 0; q < 4; ++q) {
                    S2[2 * q]     = S2[2 * q]     * w4[q].xy + (nsk2 * ak[q].xy + vv2 * kt[q].xy); oa = r4[q].xy * S2[2 * q]     + oa;
                    S2[2 * q + 1] = S2[2 * q + 1] * w4[q].zw + (nsk2 * ak[q].zw + vv2 * kt[q].zw); ob = r4[q].zw * S2[2 * q + 1] + ob;
                }
                C.opart[(par * 8 + i) * 256 + wid * 64 + lane] = (oa.x + oa.y) + (ob.x + ob.y);
#pragma unroll
                for (int q = 0; q < 4; ++q) kh[q] = khn[q];
            }
            par ^= 1;
        }
        if (sd) {
#pragma unroll
            for (int i = 0; i < 4; ++i) *(f32x4*)(sd + (size_t)lane * 64 + 16 * wid + 4 * i) = (f32x4){S2[2 * i].x, S2[2 * i].y, S2[2 * i + 1].x, S2[2 * i + 1].y};
        }
    } else {
        const int hsl = wid - 4; int par = 0;
        unsigned R[3];
#pragma unroll
        for (int k = 0; k < 2; ++k) { scan_hload(C, hsl + 4 * k, R); scan_hwrite(C, hsl + 4 * k, R); }
        scan_hload(C, hsl + 8, R);
        LBAR();
        for (int t0 = 0; t0 < nsteps; t0 += 8) {
#pragma unroll
            for (int i = 0; i < 8; ++i) {
                if ((i & 3) == hsl) { scan_hwrite(C, t0 + i + 8, R); scan_hload(C, t0 + i + 12, R); }
                LBAR();
                if (i == 0 && t0 > 0) scan_hreduce(C, hsl, par ^ 1, t0 - 8);
            }
            par ^= 1;
        }
    }
    LBAR();
    if (wid >= 4) scan_hreduce(C, wid - 4, ((nsteps >> 3) & 1) ^ 1, nsteps - 8);
}

__device__ __forceinline__ void scan_fixup_tile(const bf16_t* Q, const float* sd, bf16_t* O, int lane) {
    const int fr = lane & 15, fq = lane >> 4;
    bf16x8v a[2][2];
#pragma unroll
    for (int mt = 0; mt < 2; ++mt)
#pragma unroll
        for (int ks = 0; ks < 2; ++ks) a[mt][ks] = *(const bf16x8v*)(Q + (size_t)(mt * 16 + fr) * D + ks * 32 + 8 * fq);
#pragma unroll 2
    for (int nt = 0; nt < 4; ++nt) {
        f32x4 acc0 = {0.f, 0.f, 0.f, 0.f}, acc1 = {0.f, 0.f, 0.f, 0.f};
#pragma unroll
        for (int ks = 0; ks < 2; ++ks) {
            const float* bp = sd + (size_t)(nt * 16 + fr) * 64 + ks * 32 + 8 * fq;
            const f32x4 b0 = *(const f32x4*)bp, b1 = *(const f32x4*)(bp + 4);
            const u32x4 bw = pack8(b0, b1); const bf16x8v b = __builtin_bit_cast(bf16x8v, bw);
            acc0 = __builtin_amdgcn_mfma_f32_16x16x32_bf16(b, a[0][ks], acc0, 0, 0, 0); acc1 = __builtin_amdgcn_mfma_f32_16x16x32_bf16(b, a[1][ks], acc1, 0, 0, 0);
        }
#pragma unroll
        for (int mt = 0; mt < 2; ++mt) {
            bf16_t* op = O + (size_t)(mt * 16 + fr) * D + nt * 16 + 4 * fq; const f32x4 acc = mt ? acc1 : acc0;
            const u32x2 w = *(const u32x2*)op; u32x2 o;
            o.x = pk2(bflo(w.x) + acc.x, bfhi(w.x) + acc.y); o.y = pk2(bflo(w.y) + acc.z, bfhi(w.y) + acc.w);
            *(u32x2*)op = o;
        }
    }
}

#define RLX_AGENT __ATOMIC_RELAXED, __HIP_MEMORY_SCOPE_AGENT
#define XB_TMO      128
#define XB_XCNT(j)  (256  + 64 * (j))
#define XB_XSUB(j)  (1280 + 64 * (j))
#define XB_XGEN(j)  (2304 + 64 * (j))
#define XB_TOP      3328
#define XB_TOPGEN   3392
#define XCD_BAR_WORDS 3456
#define XB_SPIN_CAP (1u << 28)

__device__ __forceinline__ unsigned xb_ld(unsigned* p)              { return __hip_atomic_load(p, __ATOMIC_RELAXED, __HIP_MEMORY_SCOPE_AGENT); }
__device__ __forceinline__ unsigned xb_add(unsigned* p, unsigned v) { return __hip_atomic_fetch_add(p, v, __ATOMIC_RELAXED, __HIP_MEMORY_SCOPE_AGENT); }
__device__ __forceinline__ unsigned xb_xcc_id() { return (unsigned)__builtin_amdgcn_s_getreg((3 << 11) | 20) & 0xFu; }
#define XB_SPIN(cond, bar) do { unsigned _sp = 0; while (cond) { __builtin_amdgcn_s_sleep(1); \
    if ((++_sp & 255u) == 0u) { if (xb_ld(&(bar)[XB_TMO])) break; if (_sp > XB_SPIN_CAP) { atomicAdd(&(bar)[XB_TMO], 1u); break; } } } } while (0)

struct XcdBarrier {
    unsigned* bar; unsigned x;
    volatile LAS unsigned* st;
};

__device__ __forceinline__ XcdBarrier xcd_barrier_post(unsigned* bar, volatile LAS unsigned* st) {
    XcdBarrier b; b.bar = bar; b.x = xb_xcc_id(); b.st = st;
    if (threadIdx.x == 0) (void)xb_add(&bar[XB_XCNT(b.x)], 1u);
    return b;
}
__device__ __forceinline__ void xcd_barrier_complete(unsigned* bar, unsigned x, unsigned& nloc, unsigned& nx) {
    const unsigned G = gridDim.x * gridDim.y * gridDim.z;
    unsigned sum, cnt, mine, sp = 0u;
    for (;;) {
        sum = 0u; cnt = 0u; mine = 0u;
#pragma unroll
        for (unsigned j = 0; j < 16; ++j) { const unsigned c = xb_ld(&bar[XB_XCNT(j)]); sum += c; cnt += (c > 0u) ? 1u : 0u; mine = (j == x) ? c : mine; }
        if (sum == G) break;
        __builtin_amdgcn_s_sleep(1);
        if ((++sp & 255u) == 0u) { if (xb_ld(&bar[XB_TMO])) break; if (sp > XB_SPIN_CAP) { atomicAdd(&bar[XB_TMO], 1u); break; } }
    }
    nloc = mine > 0u ? mine : 1u; nx = cnt > 0u ? cnt : 1u;
}

__device__ __forceinline__ void xcd_barrier(const XcdBarrier& b) {
    asm volatile("s_waitcnt vmcnt(0)" ::: "memory");
    __syncthreads();
    if (threadIdx.x == 0) {
        unsigned* bar = b.bar;
        __builtin_amdgcn_s_waitcnt(0);
        unsigned nloc = b.st[0], nx = b.st[1];
        if (nloc == 0u) { xcd_barrier_complete(bar, b.x, nloc, nx); b.st[0] = nloc; b.st[1] = nx; }
        const unsigned old = xb_add(&bar[XB_XSUB(b.x)], 1u);
        const unsigned gen = old / nloc;
        if (old + 1u == (gen + 1u) * nloc) {
            __builtin_amdgcn_fence(__ATOMIC_RELEASE, "agent");
            asm volatile("s_waitcnt vmcnt(0)" ::: "memory");
            const unsigned og = xb_add(&bar[XB_TOP], 1u);
            const unsigned tg = og / nx;
            if (og + 1u == (tg + 1u) * nx) xb_add(&bar[XB_TOPGEN], 1u);
            else XB_SPIN(xb_ld(&bar[XB_TOPGEN]) == tg, bar);
            __builtin_amdgcn_fence(__ATOMIC_ACQUIRE, "agent");
            xb_add(&bar[XB_XGEN(b.x)], 1u);
            asm volatile("s_waitcnt vmcnt(0)" ::: "memory");
        } else {
            XB_SPIN(xb_ld(&bar[XB_XGEN(b.x)]) == gen, bar);
            __builtin_amdgcn_fence(__ATOMIC_ACQUIRE, "agent");
            asm volatile("s_waitcnt vmcnt(0)" ::: "memory");
        }
    }
    __syncthreads();
}
__global__ void __launch_bounds__(NTHREADS, 2) mega_fwd(Args A) {
    extern __shared__ __attribute__((aligned(16))) unsigned char lds_raw[];
    LAS unsigned char* lds = (LAS unsigned char*)lds_raw;
    cg::grid_group grid = cg::this_grid();
#define TIDV int tid_ = threadIdx.x; asm volatile("" : "+v"(tid_)); const int tid = tid_, lane = tid & 63, wave = __builtin_amdgcn_readfirstlane(tid >> 6); \
    const int G = gridDim.x, gw = blockIdx.x * NWAVES + wave, ngw = G * NWAVES, gtid = blockIdx.x * NTHREADS + tid, gthreads = G * NTHREADS; \
    (void)lane; (void)gw; (void)ngw; (void)gtid; (void)gthreads;

    if (A.ph_hi < 0) grid.sync();
    { volatile LAS unsigned* misc = (volatile LAS unsigned*)(lds + LDS_MISC);
      if (threadIdx.x < 32) misc[threadIdx.x] = 0u;
      __syncthreads(); }
    XcdBarrier bar = xcd_barrier_post((unsigned*)(A.ws + WS_CTL) + 4096, (volatile LAS unsigned*)(lds + LDS_MISC) + 8);
    for (int ph = A.ph_lo; ph < A.ph_hi; ++ph) {
        if (ph > A.ph_lo) xcd_barrier(bar);
        int z = 0; asm volatile("" : "+s"(z));
        unsigned char* ws = A.ws + z;
        if (ph == 0) {
            TIDV
            LAS float* scr = (LAS float*)(lds + wave * 16384);
            constexpr int I_IN = 16 * (NIN / 32), I_SQ = 16 * 32, I_F1 = 16 * 128, I_F2 = 64 * 32, I_G = 2 * 32, I_U = 32;
            constexpr int NITEMS = I_IN + 3 * I_SQ + I_F1 + I_F2 + I_G + 4 * I_U;
            for (int it = gw; it < NITEMS; it += ngw) {
                int r = it;
                if (r < I_IN) { p0_transpose_item(INP(2), D, NIN, (bf16_t*)(ws + WS_WIN), scr, r, lane); continue; } r -= I_IN;
                if (r < I_SQ) { p0_transpose_item(INP(17), D, D, (bf16_t*)(ws + WS_WPR), scr, r, lane); continue; } r -= I_SQ;
                if (r < I_SQ) { p0_transpose_item(INP(18), D, D, (bf16_t*)(ws + WS_WPA), scr, r, lane); continue; } r -= I_SQ;
                if (r < I_SQ) { p0_transpose_item(INP(19), D, D, (bf16_t*)(ws + WS_WOUT), scr, r, lane); continue; } r -= I_SQ;
                if (r < I_F1) { p0_transpose_item(INP(22), D, FF, (bf16_t*)(ws + WS_WF1), scr, r, lane); continue; } r -= I_F1;
                if (r < I_F2) { p0_transpose_item(INP(23), FF, D, (bf16_t*)(ws + WS_WF2), scr, r, lane); continue; } r -= I_F2;
                if (r < I_G) { p0_transpose_item(INP(9), 128, D, (bf16_t*)(ws + WS_GUP), scr, r, lane); continue; } r -= I_G;
                { const int which = r / I_U, it2 = r % I_U, dd = which & 1;
                  p0_transpose_item((which < 2 ? INP(6) : INP(8)) + (size_t)dd * 64 * 1024, 64, D, (bf16_t*)(ws + (which < 2 ? WS_WUP : WS_AUP)) + (size_t)dd * 1024 * 64, scr, it2, lane); }
            }
            cvt_x_chunk(INP(0), (bf16_t*)(ws + WS_XB), gtid, gthreads);
            continue;
        }
        if (ph == 1 + 9 * NCHUNK) {
            TIDV
            ln_rows(A.out + (size_t)(NCHUNK - 1) * MC * D, INP(24), INP(25), nullptr, gw, ngw, lane);
            continue;
        }
        const int c = (ph - 1) / 9, sub = (ph - 1) % 9;
        const int T = (c < 4) ? 2048 : 8192;
        const float* xin = (c < 4) ? INP(0) + (size_t)c * MC * D : INP(1);
        float* outc = A.out + (size_t)c * MC * D;
        if (sub == 0) {
            { Epi8<FZ> e{{(bf16_t*)(ws + WS_Z)}};
              run_gemm(lds, (const bf16_t*)(ws + WS_XB), (const bf16_t*)(ws + WS_WIN), MC, NINP, D, e); }
            if (c > 0) { TIDV ln_rows(A.out + (size_t)(c - 1) * MC * D, INP(24), INP(25), nullptr, gw, ngw, lane); }
        } else if (sub == 1) {
            TIDV
            const int G_ = gridDim.x, b_ = blockIdx.x, tile_lo = (int)(((long)(MC / 32) * b_) / G_), tile_hi = (int)(((long)(MC / 32) * (b_ + 1)) / G_);
            prep_rows(INP(3), INP(4), INP(10), INP(15), INP(16), ws, T, tile_lo * 32 + wave, NWAVES, tile_hi * 32, lane, true);
            __syncthreads();
            const int nit = (tile_hi - tile_lo) * 40;
            for (int it = wave; it < nit; it += NWAVES) {
                const int mt = it / 40, r = it % 40, which = r >> 3, m0 = (tile_lo + mt) * 32, n0 = (r & 7) * 128;
                if (which < 2) { FW f{INP(5) + which * 1024, (bf16_t*)(ws + WS_OPW) + (size_t)which * MC * D};
                    wave_gemm_tile<64>((const bf16_t*)(ws + WS_TW), which * 64, (const bf16_t*)(ws + WS_WUP) + (size_t)which * 1024 * 64, m0, n0, lane, f); }
                else if (which < 4) { const int dd = which - 2;
                    FA f{INP(7) + dd * 1024, INP(11), (const bf16_t*)(ws + WS_KS), (const bf16_t*)(ws + WS_OPKH), (bf16_t*)(ws + WS_OPAK) + (size_t)dd * MC * D, (bf16_t*)(ws + WS_OPKT) + (size_t)dd * MC * D};
                    wave_gemm_tile<64>((const bf16_t*)(ws + WS_AD), dd * 64, (const bf16_t*)(ws + WS_AUP) + (size_t)dd * 1024 * 64, m0, n0, lane, f); }
                else { FG f{(bf16_t*)(ws + WS_G)};
                    wave_gemm_tile<128>((const bf16_t*)(ws + WS_SG), 0, (const bf16_t*)(ws + WS_GUP), m0, n0, lane, f); }
            }
        } else if (sub == 2) {
            const int nseq = MC / T, nchain = (c < 4) ? nseq * 32 : 192, nqb = T / 256, natt = nseq * 8 * nqb;
            LAS unsigned* qslot = (LAS unsigned*)(lds + LDS_MISC); const int tid = threadIdx.x;
            for (;;) {
                __syncthreads();
                if (tid == 0) qslot[0] = atomicAdd((unsigned*)(ws + WS_CTL) + 64 * c, 1u);
                __syncthreads();
                const int item = __builtin_amdgcn_readfirstlane((int)qslot[0]);
                if (item >= nchain + natt) break;
                if (item < nchain) {
                    if (c < 4) scan_chain(ws, lds, item >> 5, (item >> 1) & 15, item & 1, T, 0, T, 0, (bf16_t*)(ws + ((item & 1) ? WS_OB : WS_OF)), nullptr);
                    else {
                        const int ch = item / 3, job = item % 3, d_ = ch & 1;
                        bf16_t* ob = (job == 2) ? (bf16_t*)(A.out + (size_t)(NCHUNK - 1) * MC * D) + (size_t)d_ * MC * D : (bf16_t*)(ws + (d_ ? WS_OB : WS_OF));
                        scan_chain(ws, lds, ch >> 5, (ch >> 1) & 15, d_, T, job ? 4096 : 0, 4096, job == 2, ob, job == 0 ? (float*)(ws + WS_END) + (size_t)ch * 4096 : nullptr);
                    }
                }
                else {
                    const int u = item - nchain, qb = u % nqb, hq = (u / nqb) & 7, s = u / (nqb * 8);
                    const att::bf16* qkv = (const att::bf16*)(ws + WS_Z) + (size_t)s * T * ZLD;
                    att::attn_dense_body(qkv + (size_t)qb * 256 * ZLD + ZQ + hq * 128, qkv + ZK + (hq >> 2) * 128, qkv + ZV + (hq >> 2) * 128,
                                         (att::bf16*)(ws + WS_OATT) + ((size_t)s * T + (size_t)qb * 256) * D + hq * 128, T, (char*)lds_raw);
                }
            }
        } else if (sub == 3) {
            TIDV
            if (c == 4) {
                for (int it = gw; it < 64 * 128; it += ngw) {
                    const int ch = it >> 7, tile = it & 127, s_ = ch >> 5, h_ = (ch >> 1) & 15, d_ = ch & 1;
                    const size_t row0 = (size_t)s_ * T + (d_ ? 0 : 4096) + (size_t)tile * 32;
                    scan_fixup_tile((const bf16_t*)(A.out + (size_t)(NCHUNK - 1) * MC * D) + (size_t)d_ * MC * D + row0 * D + h_ * 64, (const float*)(ws + WS_END) + (size_t)ch * 4096,
                                    (bf16_t*)(ws + (d_ ? WS_OB : WS_OF)) + row0 * D + h_ * 64, lane);
                }
                xcd_barrier(bar);
            }
            post_rows(INP(12), INP(13), INP(14), ws, gw, ngw, lane);
        } else if (sub == 4) {
            { Epi4<FP1> e{{(const bf16_t*)(ws + WS_Z), (float*)(ws + WS_M32)}};
              run_gemm(lds, (const bf16_t*)(ws + WS_ORW), (const bf16_t*)(ws + WS_WPR), MC, D, D, e); }
            { Epi4<FP2> e{{(const bf16_t*)(ws + WS_Z), (const float*)(ws + WS_M32), (bf16_t*)(ws + WS_MB)}};
              run_gemm(lds, (const bf16_t*)(ws + WS_OATT), (const bf16_t*)(ws + WS_WPA), MC, D, D, e); }
        } else if (sub == 5) {
            Epi4<FOut> e{{xin, outc}};
            run_gemm(lds, (const bf16_t*)(ws + WS_MB), (const bf16_t*)(ws + WS_WOUT), MC, D, D, e);
        } else if (sub == 6) {
            TIDV
            ln_rows(outc, INP(20), INP(21), (bf16_t*)(ws + WS_HB), gw, ngw, lane);
            if (c + 1 < NCHUNK) cvt_x_chunk((c + 1 < 4) ? INP(0) + (size_t)(c + 1) * MC * D : INP(1), (bf16_t*)(ws + WS_XB), gtid, gthreads);
        } else if (sub == 7) {
            Epi8<FF1> e{{(bf16_t*)(ws + WS_FFH)}};
            run_gemm(lds, (const bf16_t*)(ws + WS_HB), (const bf16_t*)(ws + WS_WF1), MC, FF, D, e);
        } else {
            Epi4<FF2> e{{outc}};
            run_gemm(lds, (const bf16_t*)(ws + WS_FFH), (const bf16_t*)(ws + WS_WF2), MC, D, FF, e);
        }
    }
}

constexpr int NPHASE = 2 + 9 * NCHUNK;

extern "C" void kernel_launch(void* const* d_in, const int* in_sizes, int n_in, void* d_out, int out_size, void* d_ws, size_t ws_size, hipStream_t stream) {
    static int grid = 0;
    if (grid == 0) {
        if (n_in != 26 || out_size != MTOT * D || ws_size < WS_END + 2 * MiB) { fprintf(stderr, "kernel_launch: unexpected shapes n_in %d out %d ws %zu\n", n_in, out_size, ws_size); grid = -1; return; }
        int dev = 0, cus = 0, per_cu = 0;
        hipGetDevice(&dev); hipDeviceGetAttribute(&cus, hipDeviceAttributeMultiprocessorCount, dev);
        if (hipFuncSetAttribute((const void*)mega_fwd, hipFuncAttributeMaxDynamicSharedMemorySize, LDS_BYTES) != hipSuccess) { fprintf(stderr, "kernel_launch: LDS attribute failed\n"); grid = -1; return; }
        if (hipOccupancyMaxActiveBlocksPerMultiprocessor(&per_cu, (const void*)mega_fwd, NTHREADS, LDS_BYTES) != hipSuccess || per_cu < 1) per_cu = 1;
        (void)hipGetLastError();
        grid = cus * (per_cu > 1 ? 1 : per_cu);
    }
    if (grid < 0) return;
    hipMemsetAsync((char*)d_ws + WS_CTL, 0, 64 * 1024, stream);
    Args a{};
    for (int i = 0; i < 26; ++i) a.in[i] = (const float*)d_in[i];
    a.out = (float*)d_out; a.ws = (unsigned char*)d_ws; a.ph_lo = 0; a.ph_hi = NPHASE;
    void* args[] = {&a};
    hipError_t e = hipLaunchCooperativeKernel((const void*)mega_fwd, dim3(grid), dim3(NTHREADS), args, LDS_BYTES, stream);
    if (e != hipSuccess) fprintf(stderr, "cooperative launch failed: %s (grid %d)\n", hipGetErrorString(e), grid);
}
```

```cpp
#include <hip/hip_runtime.h>
#include <hip/hip_bf16.h>
#include <hip/hip_cooperative_groups.h>
#include <cstdio>
#include <cstdint>
namespace cg = cooperative_groups;
namespace pg8 {
#define PG8_LAS __attribute__((address_space(3)))
typedef unsigned short bf16_t;
typedef short bf16x8 __attribute__((ext_vector_type(8)));
typedef float f32x4 __attribute__((ext_vector_type(4)));
typedef unsigned u32x4 __attribute__((ext_vector_type(4)));
constexpr int BM = 256, BK = 64, HALF = 128, HTB = HALF * BK * 2  , STAGE_BYTES = 8 * HTB, NXCD = 8, WGM = 8;

__host__ __device__ __forceinline__ int lds_byte(int r, int c) { const int st = (r >> 4) * 2 + (c >> 5), rr = r & 15, cc = c & 31, ob = rr * 64 + cc * 2; return st * 1024 + (ob ^ (((ob >> 9) & 1) << 5)); }
__host__ __device__ __forceinline__ void stage_rc(int b, int& R, int& C) { const int st = b / 1024, sb = b % 1024, swz = sb ^ (((sb >> 9) & 1) << 5); R = (st >> 1) * 16 + swz / 64; C = (st & 1) * 32 + (swz % 64) / 2; }
__host__ __device__ __forceinline__ int perm32(int rho) { const int n = rho >> 4, i = rho & 15; return 8 * (i >> 2) + 4 * n + (i & 3); }

struct Unit { int pm, pn; };
struct Gemm { const bf16_t* A; const bf16_t* Bt; int M, N, K; };

struct StaticOrder {
    int nM, nN, nwg, G, c;
    __host__ __device__ void init(int M, int N, int G_, int c_) { nM = M / BM; nN = N / BM; nwg = nM * nN; G = G_; c = c_; }
    __host__ __device__ bool next(int i, Unit& u) const {
        const long L = (long)i * G + c; if (L >= nwg) return false;
        int wgid = (int)L; { const int q = nwg / NXCD, r = nwg % NXCD, xcd = wgid % NXCD, off = wgid / NXCD; wgid = (xcd < r ? xcd * (q + 1) : r * (q + 1) + (xcd - r) * q) + off; }
        const int nig = WGM * nN, gid = wgid / nig, fm = gid * WGM, gsz = (nM - fm) < WGM ? (nM - fm) : WGM;
        u.pm = fm + ((wgid % nig) % gsz); u.pn = (wgid % nig) / gsz; return true;
    }
    __device__ __forceinline__ void a_ready(const Unit&) const {}
    __device__ __forceinline__ void done(const Unit&) const {}
};
__device__ __forceinline__ unsigned cvt_pk_bf16(float lo, float hi) { unsigned r; asm volatile("v_cvt_pk_bf16_f32 %0, %1, %2" : "=v"(r) : "v"(lo), "v"(hi)); return r; }
typedef float f32x2 __attribute__((ext_vector_type(2)));
template <class Epi, class Sched, bool ALIGN_EPI = false, bool SP2 = false>
__device__ __forceinline__ void gemm_phase(PG8_LAS unsigned char* lds, const Gemm g, const Sched& S, const Epi& E) {
    int tid_ = threadIdx.x; asm volatile("" : "+v"(tid_));
    const int tid = tid_, wid = __builtin_amdgcn_readfirstlane(tid >> 6), lane = tid & 63, wr = wid >> 2, wc = wid & 3, fr = lane & 15, fq = lane >> 4;
    const int K = g.K, nt = K / BK;
    unsigned voffA[2], voffB[2];
#pragma unroll
    for (int i = 0; i < 2; ++i) { int R, C; stage_rc(tid * 16 + i * 8192, R, C); const int Rb = Epi::PERM ? ((R & ~31) + perm32(R & 31)) : R;
        voffA[i] = (unsigned)(R * K + C) * 2u; voffB[i] = (unsigned)(Rb * K + C) * 2u; }
    const size_t kstep = (size_t)(BK * 2);
    const size_t hstep = (size_t)HALF * K * 2;
    const size_t tstep = 2 * hstep;
    const unsigned ldsw = (unsigned)wid * 1024u;
    const int aoff = lds_byte(wr * 64 + fr, fq * 8), boff = lds_byte(wc * 32 + fr, fq * 8);
#define PG8_SA(b, h) (((b) * 2 + (h)) * HTB)
#define PG8_SB(b, h) ((4 + (b) * 2 + (h)) * HTB)
#define PG8_STAGE(bufoff, gbase, voff) do { _Pragma("unroll") for (int _i = 0; _i < 2; ++_i) \
        __builtin_amdgcn_global_load_lds((const unsigned*)((const char*)(gbase) + (voff)[_i]), (PG8_LAS unsigned*)(lds + (bufoff) + ldsw + _i * 8192), 16, 0, 0); } while (0)
#define PG8_LDA(dst, b, h) do { _Pragma("unroll") for (int m = 0; m < 4; ++m) _Pragma("unroll") for (int k = 0; k < 2; ++k) dst[m][k] = *(const PG8_LAS bf16x8*)(lds + PG8_SA(b, h) + aoff + m * 2048 + k * 1024); } while (0)
#define PG8_LDB(dst, b, h) do { _Pragma("unroll") for (int n = 0; n < 2; ++n) _Pragma("unroll") for (int k = 0; k < 2; ++k) dst[n][k] = *(const PG8_LAS bf16x8*)(lds + PG8_SB(b, h) + boff + n * 2048 + k * 1024); } while (0)
#define PG8_MMA(ai, bj, At, Bt) do { __builtin_amdgcn_s_setprio(1); _Pragma("unroll") for (int m = 0; m < 4; ++m) _Pragma("unroll") for (int n = 0; n < 2; ++n) _Pragma("unroll") for (int k = 0; k < 2; ++k) \
        acc[ai][bj][m][n] = __builtin_amdgcn_mfma_f32_16x16x32_bf16(Bt[n][k], At[m][k], acc[ai][bj][m][n], 0, 0, 0); __builtin_amdgcn_s_setprio(0); } while (0)
#define PG8_WAIT_V(n) asm volatile("s_waitcnt vmcnt(" #n ")" ::: "memory")
#define PG8_WAIT_L(n) asm volatile("s_waitcnt lgkmcnt(" #n ")" ::: "memory")
#define PG8_BAR __builtin_amdgcn_s_barrier()
#define PG8_SCHED __builtin_amdgcn_sched_barrier(0)
    Unit cur, nxt; int ui = 0;
    if (!S.next(0, cur)) return;
    f32x4 acc[2][2][4][2];
#pragma unroll
    for (int a = 0; a < 2; ++a)
#pragma unroll
        for (int b = 0; b < 2; ++b)
#pragma unroll
            for (int m = 0; m < 4; ++m)
#pragma unroll
                for (int n = 0; n < 2; ++n) acc[a][b][m][n] = (f32x4){0.f, 0.f, 0.f, 0.f};
    bf16x8 At[4][2], B0[2][2], B1[2][2];
    const char* cA = (const char*)g.A + (size_t)cur.pm * tstep; const char* cB = (const char*)g.Bt + (size_t)cur.pn * tstep;
    S.a_ready(cur);
    if constexpr (SP2) {
        PG8_STAGE(PG8_SB(0, 0), cB, voffB); PG8_STAGE(PG8_SB(0, 1), cB + hstep, voffB); PG8_STAGE(PG8_SA(0, 0), cA, voffA); PG8_STAGE(PG8_SA(0, 1), cA + hstep, voffA);
        if (wr == 1) PG8_BAR;
        PG8_WAIT_V(2); PG8_BAR;
        PG8_STAGE(PG8_SB(1, 0), cB + kstep, voffB); PG8_STAGE(PG8_SA(1, 0), cA + kstep, voffA); PG8_STAGE(PG8_SB(1, 1), cB + hstep + kstep, voffB);
        PG8_WAIT_V(6); PG8_BAR;
    } else {
        PG8_STAGE(PG8_SB(0, 0), cB, voffB); PG8_STAGE(PG8_SA(0, 0), cA, voffA); PG8_STAGE(PG8_SB(0, 1), cB + hstep, voffB); PG8_STAGE(PG8_SA(0, 1), cA + hstep, voffA);
        if (wr == 1) PG8_BAR;
        PG8_WAIT_V(4); PG8_BAR;
        PG8_STAGE(PG8_SB(1, 0), cB + kstep, voffB); PG8_STAGE(PG8_SA(1, 0), cA + kstep, voffA); PG8_STAGE(PG8_SB(1, 1), cB + hstep + kstep, voffB);
        PG8_WAIT_V(6); PG8_BAR;
    }
    for (;;) {
        const bool has_next = S.next(ui + 1, nxt);
        const char* nA = has_next ? (const char*)g.A + (size_t)nxt.pm * tstep : cA; const char* nB = has_next ? (const char*)g.Bt + (size_t)nxt.pn * tstep : cB;
        for (int t = 0; t < nt; t += 2) {
            const bool last = (t == nt - 2);
            const char* a1 = cA + (size_t)(t + 1) * kstep;
            const char* a2 = last ? nA : cA + (size_t)(t + 2) * kstep; const char* b2 = last ? nB : cB + (size_t)(t + 2) * kstep;
            const char* a3 = a2 + kstep; const char* b3 = b2 + kstep;
            if (last && has_next) S.a_ready(nxt);
            if constexpr (SP2) {
            PG8_LDB(B0, 0, 0); PG8_LDB(B1, 0, 1); PG8_SCHED; PG8_LDA(At, 0, 0); PG8_STAGE(PG8_SA(1, 1), a1 + hstep, voffA);
            PG8_WAIT_V(8); PG8_WAIT_L(0); PG8_BAR; PG8_MMA(0, 0, At, B0); PG8_MMA(0, 1, At, B1); PG8_BAR; PG8_SCHED;
            PG8_LDA(At, 0, 1); PG8_STAGE(PG8_SB(0, 0), b2, voffB); PG8_STAGE(PG8_SB(0, 1), b2 + hstep, voffB); PG8_STAGE(PG8_SA(0, 0), a2, voffA);
            PG8_WAIT_V(8); PG8_WAIT_L(0); PG8_BAR; PG8_MMA(1, 0, At, B0); PG8_MMA(1, 1, At, B1); PG8_BAR; PG8_SCHED;
            PG8_LDB(B0, 1, 0); PG8_LDB(B1, 1, 1); PG8_SCHED; PG8_LDA(At, 1, 0); PG8_STAGE(PG8_SA(0, 1), a2 + hstep, voffA);
            PG8_WAIT_V(8); PG8_WAIT_L(0); PG8_BAR; PG8_MMA(0, 0, At, B0); PG8_MMA(0, 1, At, B1); PG8_BAR; PG8_SCHED;
            PG8_LDA(At, 1, 1); PG8_STAGE(PG8_SB(1, 0), b3, voffB); PG8_STAGE(PG8_SB(1, 1), b3 + hstep, voffB); PG8_STAGE(PG8_SA(1, 0), a3, voffA);
            PG8_WAIT_V(8); PG8_WAIT_L(0); PG8_BAR; PG8_MMA(1, 0, At, B0); PG8_MMA(1, 1, At, B1); PG8_BAR; PG8_SCHED;
            } else {
            PG8_LDB(B0, 0, 0); PG8_SCHED; PG8_LDA(At, 0, 0); PG8_STAGE(PG8_SA(1, 1), a1 + hstep, voffA);
            PG8_WAIT_L(8); PG8_BAR; PG8_WAIT_L(0); PG8_MMA(0, 0, At, B0); PG8_BAR; PG8_SCHED;
            PG8_LDB(B1, 0, 1); PG8_STAGE(PG8_SB(0, 0), b2, voffB);
            PG8_BAR; PG8_WAIT_L(0); PG8_MMA(0, 1, At, B1); PG8_BAR;
            PG8_LDA(At, 0, 1); PG8_STAGE(PG8_SA(0, 0), a2, voffA);
            PG8_BAR; PG8_WAIT_L(0); PG8_MMA(1, 0, At, B0); PG8_BAR; PG8_SCHED;
            PG8_STAGE(PG8_SB(0, 1), b2 + hstep, voffB);
            PG8_WAIT_V(6); PG8_BAR; PG8_MMA(1, 1, At, B1); PG8_BAR;
            PG8_LDB(B0, 1, 0); PG8_SCHED; PG8_LDA(At, 1, 0); PG8_STAGE(PG8_SA(0, 1), a2 + hstep, voffA);
            PG8_WAIT_L(8); PG8_BAR; PG8_WAIT_L(0); PG8_MMA(0, 0, At, B0); PG8_BAR; PG8_SCHED;
            PG8_LDB(B1, 1, 1); PG8_STAGE(PG8_SB(1, 0), b3, voffB);
            PG8_BAR; PG8_WAIT_L(0); PG8_MMA(0, 1, At, B1); PG8_BAR;
            PG8_LDA(At, 1, 1); PG8_STAGE(PG8_SA(1, 0), a3, voffA);
            PG8_BAR; PG8_WAIT_L(0); PG8_MMA(1, 0, At, B0); PG8_BAR; PG8_SCHED;
            PG8_STAGE(PG8_SB(1, 1), b3 + hstep, voffB);
            PG8_WAIT_V(6); PG8_BAR; PG8_MMA(1, 1, At, B1); PG8_BAR;
            }
        }
        if constexpr (ALIGN_EPI) { if (wr == 0) PG8_BAR; }
        if constexpr (!Epi::AFTER_DRAIN) { E(acc, cur, wr, wc, fr, fq); S.done(cur); }
        if (!has_next) break;
#pragma unroll
        for (int a = 0; a < 2; ++a)
#pragma unroll
            for (int b = 0; b < 2; ++b)
#pragma unroll
                for (int m = 0; m < 4; ++m)
#pragma unroll
                    for (int n = 0; n < 2; ++n) acc[a][b][m][n] = (f32x4){0.f, 0.f, 0.f, 0.f};
        cur = nxt; cA = nA; cB = nB; ++ui;
        if constexpr (ALIGN_EPI) { if (wr == 1) PG8_BAR; }
    }
    PG8_WAIT_V(0);
    if constexpr (!ALIGN_EPI) { if (wr == 0) PG8_BAR; }
    PG8_BAR;
    if constexpr (Epi::AFTER_DRAIN) { E.fused(acc, cur, wr, wc, fr, fq, lds, wid, lane); S.done(cur); }
#undef PG8_SA
#undef PG8_SB
#undef PG8_STAGE
#undef PG8_LDA
#undef PG8_LDB
#undef PG8_MMA
#undef PG8_WAIT_V
#undef PG8_WAIT_L
#undef PG8_BAR
#undef PG8_SCHED
}
}
namespace att {
using bf16 = __hip_bfloat16;
constexpr int   D = 128, NW = 8, QBLK = 32, KVBLK = 64;
constexpr float SCALE = 0.088388347648318440f;
constexpr float THR = 8.f;
constexpr int LDQ = 7168, LDK = 7168, LDO = 1024;
constexpr size_t SHM_V = KVBLK * D * 2, SHM_K = KVBLK * D * 2, SHM_ATTN = 2 * SHM_V + 2 * SHM_K + NW * 64 * 4;
using bf16x8 = __attribute__((ext_vector_type(8))) short;
using s16x4  = __attribute__((ext_vector_type(4))) short;
using f32x16 = __attribute__((ext_vector_type(16))) float;
using u32x4  = __attribute__((ext_vector_type(4))) unsigned;
#define KSWZ(row, colB) ((row) * 256 + ((colB) ^ (((row) & 7) << 4)))
#define SBAR() __builtin_amdgcn_sched_barrier(0)
__device__ __forceinline__ int crow(int r, int hi) { return (r & 3) + 8 * (r >> 2) + 4 * hi; }
__device__ __forceinline__ unsigned cvtpk(float lo, float hi) {
  unsigned r; asm volatile("v_cvt_pk_bf16_f32 %0, %1, %2" : "=v"(r) : "v"(lo), "v"(hi)); return r;
}
__device__ __forceinline__ bf16x8 ld8(const bf16* p) { return *reinterpret_cast<const bf16x8*>(p); }
__device__ __forceinline__ void partialSM(f32x16& p0, f32x16& p1, float& m_reg, float& mn, float& alpha) {
  constexpr float C = SCALE * 1.4426950408889634f;
  float pmax = p0[0]; for (int r = 1; r < 16; ++r) pmax = fmaxf(pmax, p0[r]); for (int r = 0; r < 16; ++r) pmax = fmaxf(pmax, p1[r]);
  { auto rr = __builtin_amdgcn_permlane32_swap(__float_as_uint(pmax), __float_as_uint(pmax), false, false);
    pmax = fmaxf(__uint_as_float(rr[0]), __uint_as_float(rr[1])); }
  if (__builtin_expect(__all(pmax - m_reg <= THR / SCALE), 1)) { mn = m_reg; alpha = 1.f; }
  else { mn = fmaxf(m_reg, pmax); alpha = __builtin_amdgcn_exp2f((m_reg - mn) * C); m_reg = mn; }
  float mnC = -mn * C;
  for (int r = 0; r < 16; ++r) p0[r] = fmaf(p0[r], C, mnC); for (int r = 0; r < 16; ++r) p1[r] = fmaf(p1[r], C, mnC);
  for (int r = 0; r < 16; ++r) p0[r] = __builtin_amdgcn_exp2f(p0[r]);
}
__device__ __forceinline__ void finishSM(f32x16& p0, f32x16& p1, float alpha, float& l_reg, bf16x8& pa0, bf16x8& pa1, bf16x8& pa2, bf16x8& pa3) {
  for (int r = 0; r < 16; ++r) p1[r] = __builtin_amdgcn_exp2f(p1[r]);
  float ps = 0; for (int r = 0; r < 16; ++r) ps += p0[r]; for (int r = 0; r < 16; ++r) ps += p1[r];
  { auto rr = __builtin_amdgcn_permlane32_swap(__float_as_uint(ps), __float_as_uint(ps), false, false);
    ps = __uint_as_float(rr[0]) + __uint_as_float(rr[1]); }
  l_reg = l_reg * alpha + ps;
#define PK4(P, BASE, OUT) do { unsigned a0 = cvtpk(P[BASE + 0], P[BASE + 1]), a1 = cvtpk(P[BASE + 2], P[BASE + 3]);   \
    unsigned b0 = cvtpk(P[BASE + 4], P[BASE + 5]), b1 = cvtpk(P[BASE + 6], P[BASE + 7]);                              \
    auto r0 = __builtin_amdgcn_permlane32_swap(a0, b0, false, false); auto r1 = __builtin_amdgcn_permlane32_swap(a1, b1, false, false); \
    u32x4 w = {r0[0], r1[0], r0[1], r1[1]}; OUT = *reinterpret_cast<bf16x8*>(&w); } while (0)
  PK4(p0, 0, pa0); PK4(p0, 8, pa1); PK4(p1, 0, pa2); PK4(p1, 8, pa3);
#undef PK4
}
__device__ __forceinline__ void qkt(f32x16& p0, f32x16& p1, const bf16* Ks, const bf16x8* qr, int r32, int hi) {
  p0 = f32x16{}; p1 = f32x16{};
  for (int d0 = 0; d0 < 8; ++d0) { int cb = (d0 * 16 + hi * 8) * 2;
    bf16x8 b0 = *reinterpret_cast<const bf16x8*>((const char*)Ks + KSWZ(r32, cb));
    bf16x8 b1 = *reinterpret_cast<const bf16x8*>((const char*)Ks + KSWZ(32 + r32, cb));
    p0 = __builtin_amdgcn_mfma_f32_32x32x16_bf16(b0, qr[d0], p0, 0, 0, 0);
    p1 = __builtin_amdgcn_mfma_f32_32x32x16_bf16(b1, qr[d0], p1, 0, 0, 0); }
}
__device__ __forceinline__ int v_st(int k, int c) { const int kk = (k & ~0xC) | ((k & 4) << 1) | ((k & 8) >> 1); return ((kk >> 3) * 4 + (c >> 5)) * 512 + ((kk & 7) * 32 + (c & 31)) * 2; }
__device__ __forceinline__ int v_rd_base(int lane) { return ((lane & 3) << 3) | (((lane >> 2) & 3) << 6) | (((lane >> 4) & 1) << 5) | (((lane >> 5) & 1) << 8); }
constexpr int v_rd_off(int d0, int ks, int half) { return d0 * 512 + ks * 4096 + half * 2048; }
template <int OFF> __device__ __forceinline__ s16x4 tr_read(int vb) {
  s16x4 r; asm volatile("ds_read_b64_tr_b16 %0, %1 offset:%2" : "=&v"(r) : "v"(vb), "i"(OFF) : "memory"); return r;
}
template <int D0> __device__ __forceinline__ void pv_one(f32x16& od, int vb, bf16x8 pa0, bf16x8 pa1, bf16x8 pa2, bf16x8 pa3) {
  const s16x4 l0 = tr_read<v_rd_off(D0, 0, 0)>(vb), h0 = tr_read<v_rd_off(D0, 0, 1)>(vb), l1 = tr_read<v_rd_off(D0, 1, 0)>(vb), h1 = tr_read<v_rd_off(D0, 1, 1)>(vb);
  const s16x4 l2 = tr_read<v_rd_off(D0, 2, 0)>(vb), h2 = tr_read<v_rd_off(D0, 2, 1)>(vb), l3 = tr_read<v_rd_off(D0, 3, 0)>(vb), h3 = tr_read<v_rd_off(D0, 3, 1)>(vb);
  asm volatile("s_waitcnt lgkmcnt(0)" ::: "memory"); SBAR();
#define PK(L, H) (bf16x8){L[0], L[1], L[2], L[3], H[0], H[1], H[2], H[3]}
  od = __builtin_amdgcn_mfma_f32_32x32x16_bf16(pa0, PK(l0, h0), od, 0, 0, 0);
  od = __builtin_amdgcn_mfma_f32_32x32x16_bf16(pa1, PK(l1, h1), od, 0, 0, 0);
  od = __builtin_amdgcn_mfma_f32_32x32x16_bf16(pa2, PK(l2, h2), od, 0, 0, 0);
  od = __builtin_amdgcn_mfma_f32_32x32x16_bf16(pa3, PK(l3, h3), od, 0, 0, 0);
#undef PK
}
__device__ __forceinline__ void pv_d0(f32x16* o, int vb, bf16x8 pa0, bf16x8 pa1, bf16x8 pa2, bf16x8 pa3) {
  pv_one<0>(o[0], vb, pa0, pa1, pa2, pa3); pv_one<1>(o[1], vb, pa0, pa1, pa2, pa3); pv_one<2>(o[2], vb, pa0, pa1, pa2, pa3); pv_one<3>(o[3], vb, pa0, pa1, pa2, pa3);
}
__device__ __forceinline__ void attn_dense_body(const bf16* __restrict__ Qb, const bf16* __restrict__ Kh, const bf16* __restrict__ Vh,
                                                bf16* __restrict__ Ob, int seq, char* lds) {
  int tid_ = threadIdx.x; asm volatile("" : "+v"(tid_));
  const int tid = tid_, wid = tid >> 6, lane = tid & 63, r32 = lane & 31, hi = lane >> 5;
  bf16* V_lds = (bf16*)lds; bf16* K_lds = (bf16*)(lds + 2 * SHM_V);
  float* ws = (float*)(lds + 2 * SHM_V + 2 * SHM_K) + wid * 64; float* li_l = ws; float* al_l = ws + 32;
  float m_reg = -1e30f, l_reg = 0; f32x16 o[4] = {}; bf16x8 qr[8];
  const bf16* Qw = Qb + (long)(wid * QBLK + r32) * LDQ + hi * 8;
#pragma unroll
  for (int d0 = 0; d0 < 8; ++d0) qr[d0] = ld8(Qw + d0 * 16);
  const int sr = tid >> 4, sc = (tid & 15) * 8, vst0 = v_st(sr, sc), vst1 = v_st(32 + sr, sc);
  const int vb0 = (int)(uintptr_t)V_lds + v_rd_base(lane);
  struct { bf16x8 vs0, vs1, ks0, ks1; } sr_[2];
#define SLOAD(i, k0) do { sr_[i].vs0 = ld8(&Vh[(long)((k0) + sr) * LDK + sc]); sr_[i].vs1 = ld8(&Vh[(long)((k0) + 32 + sr) * LDK + sc]); \
    sr_[i].ks0 = ld8(&Kh[(long)((k0) + sr) * LDK + sc]); sr_[i].ks1 = ld8(&Kh[(long)((k0) + 32 + sr) * LDK + sc]); } while (0)
#define SWRITE(b, i) do { *(bf16x8*)((char*)V_lds + (b) * SHM_V + vst0) = sr_[i].vs0;          \
    *(bf16x8*)((char*)V_lds + (b) * SHM_V + vst1) = sr_[i].vs1; int kc = sc * 2;               \
    *(bf16x8*)((char*)K_lds + (b) * SHM_K + KSWZ(sr, kc)) = sr_[i].ks0;                       \
    *(bf16x8*)((char*)K_lds + (b) * SHM_K + KSWZ(32 + sr, kc)) = sr_[i].ks1; } while (0)
#define SWAIT() do { asm volatile("s_waitcnt vmcnt(4)" ::: "memory"); } while (0)
#define RESC(a) do { if (__any((a) < 1.f)) { if (hi == 0) al_l[r32] = (a); asm volatile("s_waitcnt lgkmcnt(0)" ::: "memory"); \
    for (int d = 0; d < 4; ++d) for (int r = 0; r < 16; ++r) o[d][r] *= al_l[crow(r, hi)]; } } while (0)
  f32x16 pA0, pA1, pB0, pB1; float mnA, mnB, alA, alB; bf16x8 pa0, pa1, pa2, pa3; const int NT = seq / KVBLK;
  constexpr int SE = 0, SO = 1;
  SLOAD(SE, 0); asm volatile("s_waitcnt vmcnt(0)" ::: "memory"); SWRITE(0, SE); __syncthreads();
  qkt(pA0, pA1, K_lds, qr, r32, hi); partialSM(pA0, pA1, m_reg, mnA, alA);
  SLOAD(SO, KVBLK); if (2 < NT) SLOAD(SE, 2 * KVBLK);
  SWAIT(); SWRITE(1, SO); __syncthreads();
  for (int j = 1; j + 1 < NT; j += 2) {
    SBAR(); qkt(pB0, pB1, (bf16*)((char*)K_lds + SHM_K), qr, r32, hi);
    finishSM(pA0, pA1, alA, l_reg, pa0, pa1, pa2, pa3); SBAR();
    SLOAD(SO, (j + 2) * KVBLK); SBAR();
    pv_d0(o, vb0, pa0, pa1, pa2, pa3); partialSM(pB0, pB1, m_reg, mnB, alB);
    __syncthreads(); SWAIT(); SWRITE(0, SE);
    RESC(alB); __syncthreads();
    SBAR(); qkt(pA0, pA1, K_lds, qr, r32, hi);
    finishSM(pB0, pB1, alB, l_reg, pa0, pa1, pa2, pa3); SBAR();
    if (j + 3 < NT) SLOAD(SE, (j + 3) * KVBLK); SBAR();
    pv_d0(o, vb0 + (int)SHM_V, pa0, pa1, pa2, pa3); partialSM(pA0, pA1, m_reg, mnA, alA);
    __syncthreads(); SWAIT(); SWRITE(1, SO);
    RESC(alA); __syncthreads();
  }
  SBAR(); qkt(pB0, pB1, (bf16*)((char*)K_lds + SHM_K), qr, r32, hi);
  finishSM(pA0, pA1, alA, l_reg, pa0, pa1, pa2, pa3); SBAR();
  pv_d0(o, vb0, pa0, pa1, pa2, pa3); partialSM(pB0, pB1, m_reg, mnB, alB);
  __syncthreads(); RESC(alB);
  finishSM(pB0, pB1, alB, l_reg, pa0, pa1, pa2, pa3); SBAR();
  pv_d0(o, vb0 + (int)SHM_V, pa0, pa1, pa2, pa3);
  if (hi == 0) li_l[r32] = l_reg; asm volatile("s_waitcnt lgkmcnt(0)" ::: "memory");
  float rli[16];
#pragma unroll
  for (int r = 0; r < 16; ++r) rli[r] = __builtin_amdgcn_rcpf(li_l[crow(r, hi)]);
  bf16* Ow = Ob + (long)(wid * QBLK) * LDO;
#pragma unroll
  for (int r = 0; r < 16; ++r) { int orow = crow(r, hi);
    for (int d0 = 0; d0 < 4; ++d0) Ow[(long)orow * LDO + d0 * 32 + r32] = __float2bfloat16(o[d0][r] * rli[r]); }
  __syncthreads();
#undef SLOAD
#undef SWRITE
#undef SWAIT
#undef RESC
}
#undef KSWZ
#undef SBAR
}
#define LAS __attribute__((address_space(3)))
typedef unsigned short bf16_t;
typedef float f32x4 __attribute__((ext_vector_type(4)));
typedef unsigned u32x4 __attribute__((ext_vector_type(4)));
typedef unsigned u32x2 __attribute__((ext_vector_type(2)));

constexpr int NWAVES = 8, NTHREADS = 512;
constexpr int D = 1024, FF = 4096, NIN = 7040, NINP = 7168, RWC = 3456;
constexpr int MC = 16384, NCHUNK = 5, MTOT = 81920;
constexpr float ALPHA = 1.189207115002721f;
constexpr float LN_EPS = 1e-5f, GN_EPS = 64e-5f, RMS_EPS = 1e-6f;
constexpr float DECAY_SCALE = 0.6065306597126334f;

constexpr size_t MiB = 1u << 20;
constexpr size_t WS_CTL = 0;
constexpr size_t WS_WIN = 1 * MiB, WS_WPR = 15 * MiB, WS_WPA = 17 * MiB, WS_WOUT = 19 * MiB, WS_WF1 = 21 * MiB, WS_WF2 = 29 * MiB;
constexpr size_t WS_WUP = 37 * MiB, WS_AUP = 37 * MiB + 512 * 1024, WS_GUP = 38 * MiB;
constexpr size_t WS_XB = 40 * MiB, WS_OF = 40 * MiB;
constexpr size_t WS_Z = 72 * MiB;
constexpr size_t WS_OPR = 296 * MiB, WS_OPKH = 360 * MiB, WS_VS = 424 * MiB;
constexpr size_t WS_KS = 488 * MiB, WS_OB = 488 * MiB, WS_HB = 488 * MiB;
constexpr size_t WS_TW = 520 * MiB, WS_AD = 524 * MiB, WS_SG = 528 * MiB;
constexpr size_t WS_OPW = 532 * MiB, WS_OPAK = 660 * MiB, WS_OPKT = 788 * MiB;
constexpr size_t WS_G = 916 * MiB, WS_OATT = 948 * MiB, WS_END = 980 * MiB;
constexpr size_t WS_ORW = 532 * MiB, WS_M32 = 564 * MiB, WS_MB = 628 * MiB, WS_FFH = 660 * MiB;
constexpr int ZLD = 7168, ZQ = 3456, ZK = 4480, ZV = 4736, ZG = 4992;

constexpr int LDS_BYTES = 131072 + 1024;
constexpr int LDS_MISC = 131072;

#define INP(k) (A.in[(k) + z])
struct Args {
    const float* in[26];
    float* out; unsigned char* ws;
    int ph_lo, ph_hi;
};

__device__ __forceinline__ float bf2f(unsigned v) { return __uint_as_float(v << 16); }
__device__ __forceinline__ float bflo(unsigned w) { return __uint_as_float(w << 16); }
__device__ __forceinline__ float bfhi(unsigned w) { return __uint_as_float(w & 0xffff0000u); }
typedef float f32x2c_t __attribute__((ext_vector_type(2))); typedef __bf16 bf16x2c_t __attribute__((ext_vector_type(2)));
__device__ __forceinline__ unsigned pk2(float lo, float hi) { f32x2c_t v = {lo, hi}; bf16x2c_t b = __builtin_convertvector(v, bf16x2c_t); return __builtin_bit_cast(unsigned, b); }
__device__ __forceinline__ float sigmoidf_(float x) { return 1.0f / (1.0f + __expf(-x)); }
__device__ __forceinline__ float wave_sum(float v) {
#pragma unroll
    for (int o = 1; o < 64; o <<= 1) v += __shfl_xor(v, o);
    return v;
}

__device__ __forceinline__ void p0_transpose_item(const float* W, int K, int N, bf16_t* WT, LAS float* scr, int item, int lane) {
    const int nblk = N / 32, kb = item / nblk, nb = item % nblk, k0 = 64 * kb, n0 = 32 * nb;
#pragma unroll 8
    for (int i = 0; i < 32; ++i) { const int kk = 2 * i + (lane >> 5); scr[kk * 33 + (lane & 31)] = W[(size_t)(k0 + kk) * N + n0 + (lane & 31)]; }
    asm volatile("s_waitcnt lgkmcnt(0)" ::: "memory");
    const int c = lane & 7;
#pragma unroll
    for (int j = 0; j < 4; ++j) { const int n = (lane >> 3) + 8 * j; const LAS float* s = scr + (8 * c) * 33 + n;
        u32x4 o; o.x = pk2(s[0 * 33], s[1 * 33]); o.y = pk2(s[2 * 33], s[3 * 33]); o.z = pk2(s[4 * 33], s[5 * 33]); o.w = pk2(s[6 * 33], s[7 * 33]);
        *(u32x4*)(WT + (size_t)(n0 + n) * K + k0 + 8 * c) = o; }
    asm volatile("s_waitcnt lgkmcnt(0)" ::: "memory");
}

__device__ __forceinline__ void cvt_x_chunk(const float* x, bf16_t* xb, int gtid, int gthreads) {
    const size_t n8 = (size_t)MC * D / 8;
    for (size_t i = gtid; i < n8; i += gthreads) {
        const f32x4 a = *(const f32x4*)(x + i * 8), b = *(const f32x4*)(x + i * 8 + 4);
        u32x4 o; o.x = pk2(a.x, a.y); o.y = pk2(a.z, a.w); o.z = pk2(b.x, b.y); o.w = pk2(b.z, b.w);
        *(u32x4*)(xb + i * 8) = o;
    }
}

__device__ __forceinline__ void ln_rows(float* base, const float* g, const float* b, bf16_t* hb, int gw, int ngw, int lane) {
    f32x4 gg[4], bb[4];
#pragma unroll
    for (int j = 0; j < 4; ++j) { gg[j] = *((const f32x4*)g + 64 * j + lane); bb[j] = *((const f32x4*)b + 64 * j + lane); }
    for (int m0 = gw; m0 < MC; m0 += 2 * ngw) {
        const int m1 = m0 + ngw; const bool has1 = m1 < MC;
        f32x4* xr0 = (f32x4*)(base + (size_t)m0 * D) + lane; f32x4* xr1 = (f32x4*)(base + (size_t)(has1 ? m1 : m0) * D) + lane;
        f32x4 v0[4], v1[4]; float s0 = 0.f, s1 = 0.f;
#pragma unroll
        for (int j = 0; j < 4; ++j) { v0[j] = xr0[64 * j]; v1[j] = xr1[64 * j]; }
#pragma unroll
        for (int j = 0; j < 4; ++j) { s0 += (v0[j].x + v0[j].y) + (v0[j].z + v0[j].w); s1 += (v1[j].x + v1[j].y) + (v1[j].z + v1[j].w); }
        const float mean0 = wave_sum(s0) * (1.f / D), mean1 = wave_sum(s1) * (1.f / D); float q0 = 0.f, q1 = 0.f;
#pragma unroll
        for (int j = 0; j < 4; ++j) { v0[j] = v0[j] - mean0; v1[j] = v1[j] - mean1;
            q0 += (v0[j].x * v0[j].x + v0[j].y * v0[j].y) + (v0[j].z * v0[j].z + v0[j].w * v0[j].w); q1 += (v1[j].x * v1[j].x + v1[j].y * v1[j].y) + (v1[j].z * v1[j].z + v1[j].w * v1[j].w); }
        const float rstd0 = 1.f / sqrtf(wave_sum(q0) * (1.f / D) + LN_EPS), rstd1 = 1.f / sqrtf(wave_sum(q1) * (1.f / D) + LN_EPS);
#pragma unroll
        for (int j = 0; j < 4; ++j) {
            const f32x4 y0 = v0[j] * rstd0 * gg[j] + bb[j]; xr0[64 * j] = y0;
            if (hb) { u32x2 w; w.x = pk2(y0.x, y0.y); w.y = pk2(y0.z, y0.w); *(u32x2*)(hb + (size_t)m0 * D + 256 * j + 4 * lane) = w; }
            if (has1) { const f32x4 y1 = v1[j] * rstd1 * gg[j] + bb[j]; xr1[64 * j] = y1;
                if (hb) { u32x2 w; w.x = pk2(y1.x, y1.y); w.y = pk2(y1.z, y1.w); *(u32x2*)(hb + (size_t)m1 * D + 256 * j + 4 * lane) = w; } }
        }
    }
}

template <class F> struct Epi4 {
    static constexpr bool PERM = false, AFTER_DRAIN = false; F f;
    __device__ __forceinline__ void operator()(const pg8::f32x4 (&acc)[2][2][4][2], const pg8::Unit& u, int wr, int wc, int fr, int fq) const {
        const int row0 = u.pm * 256 + wr * 64 + fr, col0 = u.pn * 256 + wc * 32 + 4 * fq;
#pragma unroll
        for (int ai = 0; ai < 2; ++ai)
#pragma unroll
            for (int m = 0; m < 4; ++m)
#pragma unroll
                for (int bj = 0; bj < 2; ++bj)
#pragma unroll
                    for (int n = 0; n < 2; ++n) { f(row0 + ai * 128 + m * 16, col0 + bj * 128 + n * 16, acc[ai][bj][m][n]); asm volatile("" ::: "memory"); }
    }
};
template <class F> struct Epi8 {
    static constexpr bool PERM = true, AFTER_DRAIN = false; F f;
    __device__ __forceinline__ void operator()(const pg8::f32x4 (&acc)[2][2][4][2], const pg8::Unit& u, int wr, int wc, int fr, int fq) const {
        const int row0 = u.pm * 256 + wr * 64 + fr, col0 = u.pn * 256 + wc * 32 + 8 * fq;
#pragma unroll
        for (int ai = 0; ai < 2; ++ai)
#pragma unroll
            for (int m = 0; m < 4; ++m)
#pragma unroll
                for (int bj = 0; bj < 2; ++bj) { f(row0 + ai * 128 + m * 16, col0 + bj * 128, acc[ai][bj][m][0], acc[ai][bj][m][1]); asm volatile("" ::: "memory"); }
    }
};
__device__ __forceinline__ u32x4 pack8(f32x4 a, f32x4 b) { u32x4 w; w.x = pk2(a.x, a.y); w.y = pk2(a.z, a.w); w.z = pk2(b.x, b.y); w.w = pk2(b.z, b.w); return w; }

struct FZ { bf16_t* z;
    __device__ __forceinline__ void operator()(int row, int col, f32x4 a, f32x4 b) const { *(u32x4*)(z + (size_t)row * ZLD + col) = pack8(a, b); } };
struct FW { const float* w0; bf16_t* opw;
    __device__ __forceinline__ void operator()(int row, int col, f32x4 a) const {
        const f32x4 x = a + *(const f32x4*)(w0 + col); f32x4 y;
#pragma unroll
        for (int i = 0; i < 4; ++i) y[i] = __expf(-DECAY_SCALE * sigmoidf_(x[i]));
        u32x2 w; w.x = pk2(y.x, y.y); w.y = pk2(y.z, y.w); *(u32x2*)(opw + (size_t)row * D + col) = w; } };
struct FA { const float *a0, *k_a; const bf16_t* ks; const bf16_t* kh; bf16_t *opak, *opkt;
    __device__ __forceinline__ void operator()(int row, int col, f32x4 acc) const {
        const size_t o = (size_t)row * D + col;
        const f32x4 x = acc + *(const f32x4*)(a0 + col), ka = *(const f32x4*)(k_a + col); const u32x2 hw = *(const u32x2*)(kh + o);
        f32x4 khv; khv.x = bflo(hw.x); khv.y = bfhi(hw.x); khv.z = bflo(hw.y); khv.w = bfhi(hw.y);
        const u32x2 kw = *(const u32x2*)(ks + o);
        f32x4 k; k.x = bflo(kw.x); k.y = bfhi(kw.x); k.z = bflo(kw.y); k.w = bfhi(kw.y);
        f32x4 ak, kt;
#pragma unroll
        for (int i = 0; i < 4; ++i) { const float a = sigmoidf_(x[i]); ak[i] = a * khv[i]; kt[i] = k[i] * (1.0f + (a - 1.0f) * ka[i]); }
        u32x2 wa, wt; wa.x = pk2(ak.x, ak.y); wa.y = pk2(ak.z, ak.w); wt.x = pk2(kt.x, kt.y); wt.y = pk2(kt.z, kt.w);
        *(u32x2*)(opak + o) = wa; *(u32x2*)(opkt + o) = wt; } };
struct FG { bf16_t* g;
    __device__ __forceinline__ void operator()(int row, int col, f32x4 a) const {
        u32x2 w; w.x = pk2(a.x, a.y); w.y = pk2(a.z, a.w); *(u32x2*)(g + (size_t)row * D + col) = w; } };
typedef short bf16x8v __attribute__((ext_vector_type(8)));
template <int K, class F> __device__ __forceinline__ void wave_gemm_tile(const bf16_t* A, int aoff, const bf16_t* Bt, int m0, int n0, int lane, const F& f) {
    const int fr = lane & 15, fq = lane >> 4; constexpr int KS = K / 32;
    bf16x8v a[2][KS];
#pragma unroll
    for (int mt = 0; mt < 2; ++mt)
#pragma unroll
        for (int ks = 0; ks < KS; ++ks) a[mt][ks] = *(const bf16x8v*)(A + (size_t)(m0 + mt * 16 + fr) * 128 + aoff + ks * 32 + 8 * fq);
#pragma unroll 2
    for (int nt = 0; nt < 8; ++nt) {
        const bf16_t* bp = Bt + (size_t)(n0 + nt * 16 + fr) * K + 8 * fq;
        f32x4 acc0 = {0.f, 0.f, 0.f, 0.f}, acc1 = {0.f, 0.f, 0.f, 0.f};
#pragma unroll
        for (int ks = 0; ks < KS; ++ks) { const bf16x8v b = *(const bf16x8v*)(bp + ks * 32);
            acc0 = __builtin_amdgcn_mfma_f32_16x16x32_bf16(b, a[0][ks], acc0, 0, 0, 0); acc1 = __builtin_amdgcn_mfma_f32_16x16x32_bf16(b, a[1][ks], acc1, 0, 0, 0); }
        f(m0 + fr, n0 + nt * 16 + 4 * fq, acc0); f(m0 + 16 + fr, n0 + nt * 16 + 4 * fq, acc1);
    }
}
struct FP1 { const bf16_t* gates; bf16_t* m32;
    __device__ __forceinline__ void operator()(int row, int col, f32x4 a) const {
        const u32x2 gw = *(const u32x2*)(gates + (size_t)row * ZLD + ZG + col); f32x4 y;
        y.x = sigmoidf_(bflo(gw.x)) * a.x; y.y = sigmoidf_(bfhi(gw.x)) * a.y; y.z = sigmoidf_(bflo(gw.y)) * a.z; y.w = sigmoidf_(bfhi(gw.y)) * a.w;
        u32x2 w; w.x = pk2(y.x, y.y); w.y = pk2(y.z, y.w); *(u32x2*)(m32 + (size_t)row * D + col) = w;
    } };
struct FP2 { const bf16_t* gates; const bf16_t* m32; bf16_t* mb;
    __device__ __forceinline__ void operator()(int row, int col, f32x4 a) const {
        const u32x2 gw = *(const u32x2*)(gates + (size_t)row * ZLD + ZG + 1024 + col); const u32x2 pw = *(const u32x2*)(m32 + (size_t)row * D + col); f32x4 p, y; p.x = bflo(pw.x); p.y = bfhi(pw.x); p.z = bflo(pw.y); p.w = bfhi(pw.y);
        y.x = p.x + sigmoidf_(bflo(gw.x)) * a.x; y.y = p.y + sigmoidf_(bfhi(gw.x)) * a.y; y.z = p.z + sigmoidf_(bflo(gw.y)) * a.z; y.w = p.w + sigmoidf_(bfhi(gw.y)) * a.w;
        u32x2 w; w.x = pk2(y.x, y.y); w.y = pk2(y.z, y.w); *(u32x2*)(mb + (size_t)row * D + col) = w;
    } };
struct FOut { const float* x; float* out;
    __device__ __forceinline__ void operator()(int row, int col, f32x4 a) const {
        const size_t o = (size_t)row * D + col; *(f32x4*)(out + o) = *(const f32x4*)(x + o) * ALPHA + a; } };
struct FF1 { bf16_t* ffh;
    __device__ __forceinline__ void operator()(int row, int col, f32x4 a, f32x4 b) const {
#pragma unroll
        for (int i = 0; i < 4; ++i) { const float u = fmaxf(a[i], 0.f), v = fmaxf(b[i], 0.f); a[i] = u * u; b[i] = v * v; }
        *(u32x4*)(ffh + (size_t)row * FF + col) = pack8(a, b); } };
struct FF2 { float* out;
    __device__ __forceinline__ void operator()(int row, int col, f32x4 a) const {
        const size_t o = (size_t)row * D + col; *(f32x4*)(out + o) = *(const f32x4*)(out + o) * ALPHA + a; } };

template <class E> __device__ __forceinline__ void run_gemm(LAS unsigned char* lds, const bf16_t* A, const bf16_t* Bt, int M, int N, int K, const E& e) {

    int G_ = (int)gridDim.x, c_ = (int)blockIdx.x; asm volatile("" : "+s"(G_), "+s"(c_));
    pg8::Gemm g{A, Bt, M, N, K}; pg8::StaticOrder S; S.init(M, N, G_, c_);
    pg8::gemm_phase<E, pg8::StaticOrder, true, true>(lds, g, S, e);
}

__device__ __forceinline__ void prep_rows(const float* mu_p, const float* mu_n, const float* k_k, const float* qn, const float* kn, unsigned char* ws, int T, int rbeg, int rstep, int rend, int lane, bool do_att) {
    bf16_t* Z = (bf16_t*)(ws + WS_Z);
    bf16_t* OPR = (bf16_t*)(ws + WS_OPR); bf16_t* OPKH = (bf16_t*)(ws + WS_OPKH); bf16_t* VS = (bf16_t*)(ws + WS_VS);
    bf16_t* KS = (bf16_t*)(ws + WS_KS); bf16_t* TW = (bf16_t*)(ws + WS_TW); bf16_t* AD = (bf16_t*)(ws + WS_AD); bf16_t* SG = (bf16_t*)(ws + WS_SG);
    for (int row = rbeg; row < rend; row += rstep) {
        const int t = row & (T - 1); const bool hp = t > 0, hn = t < T - 1;
        const bf16_t* zc = Z + (size_t)row * ZLD;
#pragma unroll
        for (int pass = 0; pass < 7; ++pass) {
            const int c = pass * 512 + lane * 8;
            if (c < RWC) {
                const u32x4 wc_ = *(const u32x4*)(zc + c);
                u32x4 wp = {0u, 0u, 0u, 0u}, wn = {0u, 0u, 0u, 0u};
                if (hp) wp = *(const u32x4*)(zc - ZLD + c);
                if (hn) wn = *(const u32x4*)(zc + ZLD + c);
                const f32x4 mp0 = *(const f32x4*)(mu_p + c), mp1 = *(const f32x4*)(mu_p + c + 4), mn0 = *(const f32x4*)(mu_n + c), mn1 = *(const f32x4*)(mu_n + c + 4);
                float z[8];
#pragma unroll
                for (int i = 0; i < 4; ++i) {
                    const float c0 = bflo(wc_[i]), c1 = bfhi(wc_[i]), p0 = bflo(wp[i]), p1 = bfhi(wp[i]), n0 = bflo(wn[i]), n1 = bfhi(wn[i]);
                    const float mpa = (2 * i < 4) ? mp0[2 * i] : mp1[2 * i - 4], mpb = (2 * i + 1 < 4) ? mp0[2 * i + 1] : mp1[2 * i - 3];
                    const float mna = (2 * i < 4) ? mn0[2 * i] : mn1[2 * i - 4], mnb = (2 * i + 1 < 4) ? mn0[2 * i + 1] : mn1[2 * i - 3];
                    z[2 * i] = c0 + mpa * (p0 - c0) + mna * (n0 - c0);
                    z[2 * i + 1] = c1 + mpb * (p1 - c1) + mnb * (n1 - c1);
                }
                if (pass < 2) {
                    u32x4 w; w.x = pk2(z[0], z[1]); w.y = pk2(z[2], z[3]); w.z = pk2(z[4], z[5]); w.w = pk2(z[6], z[7]);
                    *(u32x4*)(OPR + (size_t)row * D + c) = w;
                } else if (pass < 4) {
                    const int cc = c - 1024;
                    u32x4 w; w.x = pk2(z[0], z[1]); w.y = pk2(z[2], z[3]); w.z = pk2(z[4], z[5]); w.w = pk2(z[6], z[7]);
                    *(u32x4*)(KS + (size_t)row * D + cc) = w;
                    const f32x4 kk0 = *(const f32x4*)(k_k + cc), kk1 = *(const f32x4*)(k_k + cc + 4);
                    float kp[8]; float ss = 0.f;
#pragma unroll
                    for (int i = 0; i < 8; ++i) { kp[i] = z[i] * (i < 4 ? kk0[i] : kk1[i - 4]); ss += kp[i] * kp[i]; }
                    ss += __shfl_xor(ss, 1); ss += __shfl_xor(ss, 2); ss += __shfl_xor(ss, 4);
                    const float inv = 1.0f / fmaxf(sqrtf(ss), 1e-12f);
                    u32x4 wk; wk.x = pk2(kp[0] * inv, kp[1] * inv); wk.y = pk2(kp[2] * inv, kp[3] * inv); wk.z = pk2(kp[4] * inv, kp[5] * inv); wk.w = pk2(kp[6] * inv, kp[7] * inv);
                    *(u32x4*)(OPKH + (size_t)row * D + cc) = wk;
                } else if (pass < 6) {
                    u32x4 w; w.x = pk2(z[0], z[1]); w.y = pk2(z[2], z[3]); w.z = pk2(z[4], z[5]); w.w = pk2(z[6], z[7]);
                    *(u32x4*)(VS + (size_t)row * D + (c - 2048)) = w;
                } else {
                    const int sect = lane >> 4, cc = (lane & 15) * 8;
                    float y[8];
#pragma unroll
                    for (int i = 0; i < 8; ++i) {
                        if (sect == 0) { const float e = __expf(2.0f * z[i]); y[i] = 1.0f - 2.0f / (e + 1.0f); }
                        else if (sect == 1) y[i] = z[i];
                        else y[i] = sigmoidf_(z[i]);
                    }
                    u32x4 w; w.x = pk2(y[0], y[1]); w.y = pk2(y[2], y[3]); w.z = pk2(y[4], y[5]); w.w = pk2(y[6], y[7]);
                    bf16_t* dst = (sect == 0 ? TW : (sect == 1 ? AD : SG)) + (size_t)row * 128 + cc;
                    *(u32x4*)dst = w;
                }
            }
        }
        bf16_t* qrow = Z + (size_t)row * ZLD + ZQ;
#pragma unroll 1
        for (int p = do_att ? 0 : 3; p < 3; ++p) {
            const int head = p * 4 + (lane >> 4), sub = lane & 15, d0 = sub * 8;
            const bool act = head < 10;
            bf16_t* px = qrow + head * 128 + d0;
            u32x4 w = {0u, 0u, 0u, 0u}; if (act) w = *(const u32x4*)px;
            float x[8]; float ss = 0.f;
#pragma unroll
            for (int i = 0; i < 4; ++i) { x[2 * i] = bflo(w[i]); x[2 * i + 1] = bfhi(w[i]); ss += x[2 * i] * x[2 * i] + x[2 * i + 1] * x[2 * i + 1]; }
            ss += __shfl_xor(ss, 1); ss += __shfl_xor(ss, 2); ss += __shfl_xor(ss, 4); ss += __shfl_xor(ss, 8);
            const float rinv = rsqrtf(ss * (1.0f / 128.0f) + RMS_EPS);
            const float* gn = (head < 8) ? qn : kn;
            const f32x4 g0 = *(const f32x4*)(gn + d0), g1 = *(const f32x4*)(gn + d0 + 4);
            const int axis = sub >> 3, hf = (sub >> 2) & 1;
            const float pos = (float)(axis ? (t & 63) : (t >> 6));
            float y[8];
#pragma unroll
            for (int i = 0; i < 8; ++i) {
                const float xn = x[i] * rinv * (i < 4 ? g0[i] : g1[i - 4]);
                const float xp = __shfl_xor(xn, 4);
                const int fi = (sub & 3) * 8 + i;
                const float ang = pos * exp2f(-0.41524101186092f * (float)fi);
                y[i] = xn * __cosf(ang) + (hf ? xp : -xp) * __sinf(ang);
            }
            if (act) { u32x4 o; o.x = pk2(y[0], y[1]); o.y = pk2(y[2], y[3]); o.z = pk2(y[4], y[5]); o.w = pk2(y[6], y[7]); *(u32x4*)px = o; }
        }
    }
}

__device__ __forceinline__ float rowsum16(float x) {
    x += __int_as_float(__builtin_amdgcn_update_dpp(0, __float_as_int(x), 0x128, 0xf, 0xf, true));
    x += __int_as_float(__builtin_amdgcn_update_dpp(0, __float_as_int(x), 0x124, 0xf, 0xf, true));
    x += __int_as_float(__builtin_amdgcn_update_dpp(0, __float_as_int(x), 0x122, 0xf, 0xf, true));
    x += __int_as_float(__builtin_amdgcn_update_dpp(0, __float_as_int(x), 0x121, 0xf, 0xf, true));
    return x;
}
__device__ __forceinline__ void post_rows(const float* r_k, const float* gn_g, const float* gn_b, unsigned char* ws, int gw, int ngw, int lane) {
    const bf16_t* OF = (const bf16_t*)(ws + WS_OF); const bf16_t* OB = (const bf16_t*)(ws + WS_OB);
    const bf16_t* OPR = (const bf16_t*)(ws + WS_OPR); const bf16_t* VS = (const bf16_t*)(ws + WS_VS);
    const bf16_t* KTF = (const bf16_t*)(ws + WS_OPKT); const bf16_t* KTB = KTF + (size_t)MC * D;
    const bf16_t* G = (const bf16_t*)(ws + WS_G); bf16_t* ORW = (bf16_t*)(ws + WS_ORW);
    const int hg = lane >> 4, sub = lane & 15;
    for (int row = gw; row < MC; row += ngw) {
        const size_t ro = (size_t)row * D;
#pragma unroll 2
        for (int pass = 0; pass < 4; ++pass) {
            const int c = (4 * pass + hg) * 64 + sub * 4; const size_t o = ro + c;
            const u32x2 wf = *(const u32x2*)(OF + o), wb = *(const u32x2*)(OB + o), wg = *(const u32x2*)(G + o);
            const u32x2 wr = *(const u32x2*)(OPR + o), wtf = *(const u32x2*)(KTF + o), wtb = *(const u32x2*)(KTB + o), wv = *(const u32x2*)(VS + o);
            f32x4 r4, ktf, ktb, v4;
            r4.x = bflo(wr.x); r4.y = bfhi(wr.x); r4.z = bflo(wr.y); r4.w = bfhi(wr.y); ktf.x = bflo(wtf.x); ktf.y = bfhi(wtf.x); ktf.z = bflo(wtf.y); ktf.w = bfhi(wtf.y);
            ktb.x = bflo(wtb.x); ktb.y = bfhi(wtb.x); ktb.z = bflo(wtb.y); ktb.w = bfhi(wtb.y); v4.x = bflo(wv.x); v4.y = bfhi(wv.x); v4.z = bflo(wv.y); v4.w = bfhi(wv.y);
            const f32x4 rk = *(const f32x4*)(r_k + c), gg = *(const f32x4*)(gn_g + c), gb = *(const f32x4*)(gn_b + c);
            f32x4 ov; ov.x = bflo(wf.x) + bflo(wb.x); ov.y = bfhi(wf.x) + bfhi(wb.x); ov.z = bflo(wf.y) + bflo(wb.y); ov.w = bfhi(wf.y) + bfhi(wb.y);
            const float mean = rowsum16((ov.x + ov.y) + (ov.z + ov.w)) * (1.0f / 64.0f);
            const f32x4 dv = ov - mean;
            const float var = rowsum16((dv.x * dv.x + dv.y * dv.y) + (dv.z * dv.z + dv.w * dv.w)) * (1.0f / 64.0f);
            const f32x4 bt = r4 * (ktf + ktb) * rk;
            const float bs = rowsum16((bt.x + bt.y) + (bt.z + bt.w));
            const float rstd = rsqrtf(var + GN_EPS);
            f32x4 g4; g4.x = bflo(wg.x); g4.y = bfhi(wg.x); g4.z = bflo(wg.y); g4.w = bfhi(wg.y);
            const f32x4 y = (dv * rstd * gg + gb + v4 * bs) * g4;
            u32x2 w; w.x = pk2(y.x, y.y); w.y = pk2(y.z, y.w); *(u32x2*)(ORW + o) = w;
        }
    }
}

#define DPPQ(q) "quad_perm:[" #q "," #q "," #q "," #q "] row_mask:0xf bank_mask:0xf"
#define FMAC_DPP(acc, x, s, q) asm("v_fmac_f32_dpp %0, %1, %2 " DPPQ(q) : "+v"(acc) : "v"(x), "v"(s))
#define MUL_DPP(dst, x, s, q) asm("v_mul_f32_dpp %0, %1, %2 " DPPQ(q) : "=v"(dst) : "v"(x), "v"(s))
#define LBAR() asm volatile("s_waitcnt lgkmcnt(0)\n\ts_barrier" ::: "memory")

typedef float f32x2s __attribute__((ext_vector_type(2)));
struct ScanCtx {
    const unsigned* gp[3]; bf16_t* po; long r0, dstep; int T;
    LAS float* part; LAS float* opart; LAS float* ring; int wid, lane;
};
constexpr int SCAN_RING = 16, SCAN_SLOTF = 6 * 64;
__device__ __forceinline__ void scan_hload(const ScanCtx& C, int u, unsigned (&R)[3]) {
    const int uu = u < C.T ? u : C.T - 1; const long ro = (C.r0 + C.dstep * (long)uu) * (D / 2);
#pragma unroll
    for (int p = 0; p < 3; ++p) R[p] = C.gp[p][ro];
}
__device__ __forceinline__ void scan_hwrite(const ScanCtx& C, int u, const unsigned (&R)[3]) {
    LAS float* sl = C.ring + (u & (SCAN_RING - 1)) * SCAN_SLOTF + (C.lane >> 5) * 64 + 2 * (C.lane & 31);
#pragma unroll
    for (int p = 0; p < 3; ++p) *(LAS f32x2s*)(sl + p * 128) = (f32x2s){bflo(R[p]), bfhi(R[p])};
}
__device__ __forceinline__ void scan_ld4(const LAS float* p, f32x4 (&v)[4]) {
#pragma unroll
    for (int q = 0; q < 4; ++q) v[q] = *(const LAS f32x4*)(p + 4 * q);
}
__device__ __forceinline__ void scan_hreduce(const ScanCtx& C, int hsl, int parity, int tblock) {
#pragma unroll
    for (int k = 0; k < 2; ++k) { const int slot = hsl + 4 * k; const LAS float* op = C.opart + (parity * 8 + slot) * 256 + C.lane;
        const float o = (op[0] + op[64]) + (op[128] + op[192]);
        C.po[(C.r0 + C.dstep * (long)(tblock + slot)) * D] = (bf16_t)(pk2(o, o) & 0xffffu); }
}
__device__ __forceinline__ void scan_chain(unsigned char* ws, LAS unsigned char* lds, int s, int h, int d, int T, int tbeg, int nsteps, int mode, bf16_t* obase, float* sd) {
    int tid_ = threadIdx.x; asm volatile("" : "+v"(tid_));
    const int tid = tid_, lane = tid & 63, wid = __builtin_amdgcn_readfirstlane(tid >> 6);
    ScanCtx C; C.T = nsteps; C.wid = wid; C.lane = lane;
    const int col = h * 64; const size_t dofs = (size_t)d * MC * D;
    { const bool hi_ = lane >= 32; const int li_ = lane & 31;
      const bf16_t* b0 = hi_ ? (const bf16_t*)(ws + WS_OPW) + dofs : (const bf16_t*)(ws + WS_OPKH);
      const bf16_t* b1 = hi_ ? (const bf16_t*)(ws + WS_OPKT) + dofs : (const bf16_t*)(ws + WS_OPAK) + dofs;
      const bf16_t* b2 = hi_ ? (const bf16_t*)(ws + WS_VS) : (const bf16_t*)(ws + WS_OPR);
      C.gp[0] = (const unsigned*)(b0 + col) + li_; C.gp[1] = (const unsigned*)(b1 + col) + li_; C.gp[2] = (const unsigned*)(b2 + col) + li_; }
    C.po = obase + col + lane;
    C.dstep = d ? -1 : 1; C.r0 = (d ? (long)s * T + T - 1 : (long)s * T) + C.dstep * (long)tbeg;
    C.part = (LAS float*)lds; C.opart = (LAS float*)(lds + 2048); C.ring = (LAS float*)(lds + 18432);
    if (wid < 4) {
        f32x2s S2[8];
#pragma unroll
        for (int j = 0; j < 8; ++j) { S2[j].x = (mode && lane == 16 * wid + 2 * j) ? 1.f : 0.f; S2[j].y = (mode && lane == 16 * wid + 2 * j + 1) ? 1.f : 0.f; }
        LBAR();
        f32x4 kh[4]; scan_ld4(C.ring + wid * 16, kh);
        int par = 0;
        for (int t0 = 0; t0 < nsteps; t0 += 8) {
#pragma unroll
            for (int i = 0; i < 8; ++i) {
                const LAS float* sl = C.ring + (((t0 & 8) + i) & (SCAN_RING - 1)) * SCAN_SLOTF;
                f32x4 w4[4], ak[4], kt[4], r4[4];
                scan_ld4(sl + 64 + wid * 16, w4); scan_ld4(sl + 128 + wid * 16, ak); scan_ld4(sl + 192 + wid * 16, kt); scan_ld4(sl + 256 + wid * 16, r4);
                const float vraw = sl[320 + lane];
                f32x4 khn[4]; scan_ld4(C.ring + (((t0 & 8) + i + 1) & (SCAN_RING - 1)) * SCAN_SLOTF + wid * 16, khn);
                f32x2s pa = {0.f, 0.f}, pb = {0.f, 0.f};
#pragma unroll
                for (int q = 0; q < 4; ++q) { pa = kh[q].xy * S2[2 * q] + pa; pb = kh[q].zw * S2[2 * q + 1] + pb; }
                LAS float* pp = C.part + (i & 1) * 256;
                pp[wid * 64 + lane] = (pa.x + pa.y) + (pb.x + pb.y);
                LBAR();
                const unsigned paddr = (unsigned)(unsigned long)(pp + lane);
                f32x2s r0, r1;
                asm volatile("ds_read2st64_b32 %0, %2 offset1:1\n\tds_read2st64_b32 %1, %2 offset0:2 offset1:3" : "=&v"(r0), "=&v"(r1) : "v"(paddr) : "memory");
                asm volatile("s_waitcnt lgkmcnt(0)" : "+v"(r0), "+v"(r1) :: "memory");
                const float nsk = -((r0.x + r0.y) + (r1.x + r1.y)), vv = mode ? 0.f : vraw;
                const f32x2s nsk2 = {nsk, nsk}, vv2 = {vv, vv};
                f32x2s oa = {0.f, 0.f}, ob = {0.f, 0.f};
#pragma unroll
                for (int q = 0; q < 4; ++q) {
                    S2[2 * q]     = S2[2 * q]     * w4[q].xy + (nsk2 * ak[q].xy + vv2 * kt[q].xy); oa = r4[q].xy * S2[2 * q]     + oa;
                    S2[2 * q + 1] = S2[2 * q + 1] * w4[q].zw + (nsk2 * ak[q].zw + vv2 * kt[q].zw); ob = r4[q].zw * S2[2 * q + 1] + ob;
                }
                C.opart[(par * 8 + i) * 256 + wid * 64 + lane] = (oa.x + oa.y) + (ob.x + ob.y);
#pragma unroll
                for (int q = 0; q < 4; ++q) kh[q] = khn[q];
            }
            par ^= 1;
        }
        if (sd) {
#pragma unroll
            for (int i = 0; i < 4; ++i) *(f32x4*)(sd + (size_t)lane * 64 + 16 * wid + 4 * i) = (f32x4){S2[2 * i].x, S2[2 * i].y, S2[2 * i + 1].x, S2[2 * i + 1].y};
        }
    } else {
        const int hsl = wid - 4; int par = 0;
        unsigned R[3];
#pragma unroll
        for (int k = 0; k < 2; ++k) { scan_hload(C, hsl + 4 * k, R); scan_hwrite(C, hsl + 4 * k, R); }
        scan_hload(C, hsl + 8, R);
        LBAR();
        for (int t0 = 0; t0 < nsteps; t0 += 8) {
#pragma unroll
            for (int i = 0; i < 8; ++i) {
                if ((i & 3) == hsl) { scan_hwrite(C, t0 + i + 8, R); scan_hload(C, t0 + i + 12, R); }
                LBAR();
                if (i == 0 && t0 > 0) scan_hreduce(C, hsl, par ^ 1, t0 - 8);
            }
            par ^= 1;
        }
    }
    LBAR();
    if (wid >= 4) scan_hreduce(C, wid - 4, ((nsteps >> 3) & 1) ^ 1, nsteps - 8);
}

__device__ __forceinline__ void scan_fixup_tile(const bf16_t* Q, const float* sd, bf16_t* O, int lane) {
    const int fr = lane & 15, fq = lane >> 4;
    bf16x8v a[2][2];
#pragma unroll
    for (int mt = 0; mt < 2; ++mt)
#pragma unroll
        for (int ks = 0; ks < 2; ++ks) a[mt][ks] = *(const bf16x8v*)(Q + (size_t)(mt * 16 + fr) * D + ks * 32 + 8 * fq);
#pragma unroll 2
    for (int nt = 0; nt < 4; ++nt) {
        f32x4 acc0 = {0.f, 0.f, 0.f, 0.f}, acc1 = {0.f, 0.f, 0.f, 0.f};
#pragma unroll
        for (int ks = 0; ks < 2; ++ks) {
            const float* bp = sd + (size_t)(nt * 16 + fr) * 64 + ks * 32 + 8 * fq;
            const f32x4 b0 = *(const f32x4*)bp, b1 = *(const f32x4*)(bp + 4);
            const u32x4 bw = pack8(b0, b1); const bf16x8v b = __builtin_bit_cast(bf16x8v, bw);
            acc0 = __builtin_amdgcn_mfma_f32_16x16x32_bf16(b, a[0][ks], acc0, 0, 0, 0); acc1 = __builtin_amdgcn_mfma_f32_16x16x32_bf16(b, a[1][ks], acc1, 0, 0, 0);
        }
#pragma unroll
        for (int mt = 0; mt < 2; ++mt) {
            bf16_t* op = O + (size_t)(mt * 16 + fr) * D + nt * 16 + 4 * fq; const f32x4 acc = mt ? acc1 : acc0;
            const u32x2 w = *(const u32x2*)op; u32x2 o;
            o.x = pk2(bflo(w.x) + acc.x, bfhi(w.x) + acc.y); o.y = pk2(bflo(w.y) + acc.z, bfhi(w.y) + acc.w);
            *(u32x2*)op = o;
        }
    }
}

#define RLX_AGENT __ATOMIC_RELAXED, __HIP_MEMORY_SCOPE_AGENT
#define XB_TMO      128
#define XB_XCNT(j)  (256  + 64 * (j))
#define XB_XSUB(j)  (1280 + 64 * (j))
#define XB_XGEN(j)  (2304 + 64 * (j))
#define XB_TOP      3328
#define XB_TOPGEN   3392
#define XCD_BAR_WORDS 3456
#define XB_SPIN_CAP (1u << 28)

__device__ __forceinline__ unsigned xb_ld(unsigned* p)              { return __hip_atomic_load(p, __ATOMIC_RELAXED, __HIP_MEMORY_SCOPE_AGENT); }
__device__ __forceinline__ unsigned xb_add(unsigned* p, unsigned v) { return __hip_atomic_fetch_add(p, v, __ATOMIC_RELAXED, __HIP_MEMORY_SCOPE_AGENT); }
__device__ __forceinline__ unsigned xb_xcc_id() { return (unsigned)__builtin_amdgcn_s_getreg((3 << 11) | 20) & 0xFu; }
#define XB_SPIN(cond, bar) do { unsigned _sp = 0; while (cond) { __builtin_amdgcn_s_sleep(1); \
    if ((++_sp & 255u) == 0u) { if (xb_ld(&(bar)[XB_TMO])) break; if (_sp > XB_SPIN_CAP) { atomicAdd(&(bar)[XB_TMO], 1u); break; } } } } while (0)

struct XcdBarrier {
    unsigned* bar; unsigned x;
    volatile LAS unsigned* st;
};

__device__ __forceinline__ XcdBarrier xcd_barrier_post(unsigned* bar, volatile LAS unsigned* st) {
    XcdBarrier b; b.bar = bar; b.x = xb_xcc_id(); b.st = st;
    if (threadIdx.x == 0) (void)xb_add(&bar[XB_XCNT(b.x)], 1u);
    return b;
}
__device__ __forceinline__ void xcd_barrier_complete(unsigned* bar, unsigned x, unsigned& nloc, unsigned& nx) {
    const unsigned G = gridDim.x * gridDim.y * gridDim.z;
    unsigned sum, cnt, mine, sp = 0u;
    for (;;) {
        sum = 0u; cnt = 0u; mine = 0u;
#pragma unroll
        for (unsigned j = 0; j < 16; ++j) { const unsigned c = xb_ld(&bar[XB_XCNT(j)]); sum += c; cnt += (c > 0u) ? 1u : 0u; mine = (j == x) ? c : mine; }
        if (sum == G) break;
        __builtin_amdgcn_s_sleep(1);
        if ((++sp & 255u) == 0u) { if (xb_ld(&bar[XB_TMO])) break; if (sp > XB_SPIN_CAP) { atomicAdd(&bar[XB_TMO], 1u); break; } }
    }
    nloc = mine > 0u ? mine : 1u; nx = cnt > 0u ? cnt : 1u;
}

__device__ __forceinline__ void xcd_barrier(const XcdBarrier& b) {
    asm volatile("s_waitcnt vmcnt(0)" ::: "memory");
    __syncthreads();
    if (threadIdx.x == 0) {
        unsigned* bar = b.bar;
        __builtin_amdgcn_s_waitcnt(0);
        unsigned nloc = b.st[0], nx = b.st[1];
        if (nloc == 0u) { xcd_barrier_complete(bar, b.x, nloc, nx); b.st[0] = nloc; b.st[1] = nx; }
        const unsigned old = xb_add(&bar[XB_XSUB(b.x)], 1u);
        const unsigned gen = old / nloc;
        if (old + 1u == (gen + 1u) * nloc) {
            __builtin_amdgcn_fence(__ATOMIC_RELEASE, "agent");
            asm volatile("s_waitcnt vmcnt(0)" ::: "memory");
            const unsigned og = xb_add(&bar[XB_TOP], 1u);
            const unsigned tg = og / nx;
            if (og + 1u == (tg + 1u) * nx) xb_add(&bar[XB_TOPGEN], 1u);
            else XB_SPIN(xb_ld(&bar[XB_TOPGEN]) == tg, bar);
            __builtin_amdgcn_fence(__ATOMIC_ACQUIRE, "agent");
            xb_add(&bar[XB_XGEN(b.x)], 1u);
            asm volatile("s_waitcnt vmcnt(0)" ::: "memory");
        } else {
            XB_SPIN(xb_ld(&bar[XB_XGEN(b.x)]) == gen, bar);
            __builtin_amdgcn_fence(__ATOMIC_ACQUIRE, "agent");
            asm volatile("s_waitcnt vmcnt(0)" ::: "memory");
        }
    }
    __syncthreads();
}
__global__ void __launch_bounds__(NTHREADS, 2) mega_fwd(Args A) {
    extern __shared__ __attribute__((aligned(16))) unsigned char lds_raw[];
    LAS unsigned char* lds = (LAS unsigned char*)lds_raw;
    cg::grid_group grid = cg::this_grid();
#define TIDV int tid_ = threadIdx.x; asm volatile("" : "+v"(tid_)); const int tid = tid_, lane = tid & 63, wave = __builtin_amdgcn_readfirstlane(tid >> 6); \
    const int G = gridDim.x, gw = blockIdx.x * NWAVES + wave, ngw = G * NWAVES, gtid = blockIdx.x * NTHREADS + tid, gthreads = G * NTHREADS; \
    (void)lane; (void)gw; (void)ngw; (void)gtid; (void)gthreads;

    if (A.ph_hi < 0) grid.sync();
    { volatile LAS unsigned* misc = (volatile LAS unsigned*)(lds + LDS_MISC);
      if (threadIdx.x < 32) misc[threadIdx.x] = 0u;
      __syncthreads(); }
    XcdBarrier bar = xcd_barrier_post((unsigned*)(A.ws + WS_CTL) + 4096, (volatile LAS unsigned*)(lds + LDS_MISC) + 8);
    for (int ph = A.ph_lo; ph < A.ph_hi; ++ph) {
        if (ph > A.ph_lo) xcd_barrier(bar);
        int z = 0; asm volatile("" : "+s"(z));
        unsigned char* ws = A.ws + z;
        if (ph == 0) {
            TIDV
            LAS float* scr = (LAS float*)(lds + wave * 16384);
            constexpr int I_IN = 16 * (NIN / 32), I_SQ = 16 * 32, I_F1 = 16 * 128, I_F2 = 64 * 32, I_G = 2 * 32, I_U = 32;
            constexpr int NITEMS = I_IN + 3 * I_SQ + I_F1 + I_F2 + I_G + 4 * I_U;
            for (int it = gw; it < NITEMS; it += ngw) {
                int r = it;
                if (r < I_IN) { p0_transpose_item(INP(2), D, NIN, (bf16_t*)(ws + WS_WIN), scr, r, lane); continue; } r -= I_IN;
                if (r < I_SQ) { p0_transpose_item(INP(17), D, D, (bf16_t*)(ws + WS_WPR), scr, r, lane); continue; } r -= I_SQ;
                if (r < I_SQ) { p0_transpose_item(INP(18), D, D, (bf16_t*)(ws + WS_WPA), scr, r, lane); continue; } r -= I_SQ;
                if (r < I_SQ) { p0_transpose_item(INP(19), D, D, (bf16_t*)(ws + WS_WOUT), scr, r, lane); continue; } r -= I_SQ;
                if (r < I_F1) { p0_transpose_item(INP(22), D, FF, (bf16_t*)(ws + WS_WF1), scr, r, lane); continue; } r -= I_F1;
                if (r < I_F2) { p0_transpose_item(INP(23), FF, D, (bf16_t*)(ws + WS_WF2), scr, r, lane); continue; } r -= I_F2;
                if (r < I_G) { p0_transpose_item(INP(9), 128, D, (bf16_t*)(ws + WS_GUP), scr, r, lane); continue; } r -= I_G;
                { const int which = r / I_U, it2 = r % I_U, dd = which & 1;
                  p0_transpose_item((which < 2 ? INP(6) : INP(8)) + (size_t)dd * 64 * 1024, 64, D, (bf16_t*)(ws + (which < 2 ? WS_WUP : WS_AUP)) + (size_t)dd * 1024 * 64, scr, it2, lane); }
            }
            cvt_x_chunk(INP(0), (bf16_t*)(ws + WS_XB), gtid, gthreads);
            continue;
        }
        if (ph == 1 + 9 * NCHUNK) {
            TIDV
            ln_rows(A.out + (size_t)(NCHUNK - 1) * MC * D, INP(24), INP(25), nullptr, gw, ngw, lane);
            continue;
        }
        const int c = (ph - 1) / 9, sub = (ph - 1) % 9;
        const int T = (c < 4) ? 2048 : 8192;
        const float* xin = (c < 4) ? INP(0) + (size_t)c * MC * D : INP(1);
        float* outc = A.out + (size_t)c * MC * D;
        if (sub == 0) {
            { Epi8<FZ> e{{(bf16_t*)(ws + WS_Z)}};
              run_gemm(lds, (const bf16_t*)(ws + WS_XB), (const bf16_t*)(ws + WS_WIN), MC, NINP, D, e); }
            if (c > 0) { TIDV ln_rows(A.out + (size_t)(c - 1) * MC * D, INP(24), INP(25), nullptr, gw, ngw, lane); }
        } else if (sub == 1) {
            TIDV
            const int G_ = gridDim.x, b_ = blockIdx.x, tile_lo = (int)(((long)(MC / 32) * b_) / G_), tile_hi = (int)(((long)(MC / 32) * (b_ + 1)) / G_);
            prep_rows(INP(3), INP(4), INP(10), INP(15), INP(16), ws, T, tile_lo * 32 + wave, NWAVES, tile_hi * 32, lane, true);
            __syncthreads();
            const int nit = (tile_hi - tile_lo) * 40;
            for (int it = wave; it < nit; it += NWAVES) {
                const int mt = it / 40, r = it % 40, which = r >> 3, m0 = (tile_lo + mt) * 32, n0 = (r & 7) * 128;
                if (which < 2) { FW f{INP(5) + which * 1024, (bf16_t*)(ws + WS_OPW) + (size_t)which * MC * D};
                    wave_gemm_tile<64>((const bf16_t*)(ws + WS_TW), which * 64, (const bf16_t*)(ws + WS_WUP) + (size_t)which * 1024 * 64, m0, n0, lane, f); }
                else if (which < 4) { const int dd = which - 2;
                    FA f{INP(7) + dd * 1024, INP(11), (const bf16_t*)(ws + WS_KS), (const bf16_t*)(ws + WS_OPKH), (bf16_t*)(ws + WS_OPAK) + (size_t)dd * MC * D, (bf16_t*)(ws + WS_OPKT) + (size_t)dd * MC * D};
                    wave_gemm_tile<64>((const bf16_t*)(ws + WS_AD), dd * 64, (const bf16_t*)(ws + WS_AUP) + (size_t)dd * 1024 * 64, m0, n0, lane, f); }
                else { FG f{(bf16_t*)(ws + WS_G)};
                    wave_gemm_tile<128>((const bf16_t*)(ws + WS_SG), 0, (const bf16_t*)(ws + WS_GUP), m0, n0, lane, f); }
            }
        } else if (sub == 2) {
            const int nseq = MC / T, nchain = (c < 4) ? nseq * 32 : 192, nqb = T / 256, natt = nseq * 8 * nqb;
            LAS unsigned* qslot = (LAS unsigned*)(lds + LDS_MISC); const int tid = threadIdx.x;
            for (;;) {
                __syncthreads();
                if (tid == 0) qslot[0] = atomicAdd((unsigned*)(ws + WS_CTL) + 64 * c, 1u);
                __syncthreads();
                const int item = __builtin_amdgcn_readfirstlane((int)qslot[0]);
                if (item >= nchain + natt) break;
                if (item < nchain) {
                    if (c < 4) scan_chain(ws, lds, item >> 5, (item >> 1) & 15, item & 1, T, 0, T, 0, (bf16_t*)(ws + ((item & 1) ? WS_OB : WS_OF)), nullptr);
                    else {
                        const int ch = item / 3, job = item % 3, d_ = ch & 1;
                        bf16_t* ob = (job == 2) ? (bf16_t*)(A.out + (size_t)(NCHUNK - 1) * MC * D) + (size_t)d_ * MC * D : (bf16_t*)(ws + (d_ ? WS_OB : WS_OF));
                        scan_chain(ws, lds, ch >> 5, (ch >> 1) & 15, d_, T, job ? 4096 : 0, 4096, job == 2, ob, job == 0 ? (float*)(ws + WS_END) + (size_t)ch * 4096 : nullptr);
                    }
                }
                else {
                    const int u = item - nchain, qb = u % nqb, hq = (u / nqb) & 7, s = u / (nqb * 8);
                    const att::bf16* qkv = (const att::bf16*)(ws + WS_Z) + (size_t)s * T * ZLD;
                    att::attn_dense_body(qkv + (size_t)qb * 256 * ZLD + ZQ + hq * 128, qkv + ZK + (hq >> 2) * 128, qkv + ZV + (hq >> 2) * 128,
                                         (att::bf16*)(ws + WS_OATT) + ((size_t)s * T + (size_t)qb * 256) * D + hq * 128, T, (char*)lds_raw);
                }
            }
        } else if (sub == 3) {
            TIDV
            if (c == 4) {
                for (int it = gw; it < 64 * 128; it += ngw) {
                    const int ch = it >> 7, tile = it & 127, s_ = ch >> 5, h_ = (ch >> 1) & 15, d_ = ch & 1;
                    const size_t row0 = (size_t)s_ * T + (d_ ? 0 : 4096) + (size_t)tile * 32;
                    scan_fixup_tile((const bf16_t*)(A.out + (size_t)(NCHUNK - 1) * MC * D) + (size_t)d_ * MC * D + row0 * D + h_ * 64, (const float*)(ws + WS_END) + (size_t)ch * 4096,
                                    (bf16_t*)(ws + (d_ ? WS_OB : WS_OF)) + row0 * D + h_ * 64, lane);
                }
                xcd_barrier(bar);
            }
            post_rows(INP(12), INP(13), INP(14), ws, gw, ngw, lane);
        } else if (sub == 4) {
            { Epi4<FP1> e{{(const bf16_t*)(ws + WS_Z), (bf16_t*)(ws + WS_M32)}};
              run_gemm(lds, (const bf16_t*)(ws + WS_ORW), (const bf16_t*)(ws + WS_WPR), MC, D, D, e); }
            { Epi4<FP2> e{{(const bf16_t*)(ws + WS_Z), (const bf16_t*)(ws + WS_M32), (bf16_t*)(ws + WS_MB)}};
              run_gemm(lds, (const bf16_t*)(ws + WS_OATT), (const bf16_t*)(ws + WS_WPA), MC, D, D, e); }
        } else if (sub == 5) {
            Epi4<FOut> e{{xin, outc}};
            run_gemm(lds, (const bf16_t*)(ws + WS_MB), (const bf16_t*)(ws + WS_WOUT), MC, D, D, e);
        } else if (sub == 6) {
            TIDV
            ln_rows(outc, INP(20), INP(21), (bf16_t*)(ws + WS_HB), gw, ngw, lane);
            if (c + 1 < NCHUNK) cvt_x_chunk((c + 1 < 4) ? INP(0) + (size_t)(c + 1) * MC * D : INP(1), (bf16_t*)(ws + WS_XB), gtid, gthreads);
        } else if (sub == 7) {
            Epi8<FF1> e{{(bf16_t*)(ws + WS_FFH)}};
            run_gemm(lds, (const bf16_t*)(ws + WS_HB), (const bf16_t*)(ws + WS_WF1), MC, FF, D, e);
        } else {
            Epi4<FF2> e{{outc}};
            run_gemm(lds, (const bf16_t*)(ws + WS_FFH), (const bf16_t*)(ws + WS_WF2), MC, D, FF, e);
        }
    }
}

constexpr int NPHASE = 2 + 9 * NCHUNK;

extern "C" void kernel_launch(void* const* d_in, const int* in_sizes, int n_in, void* d_out, int out_size, void* d_ws, size_t ws_size, hipStream_t stream) {
    static int grid = 0;
    if (grid == 0) {
        if (n_in != 26 || out_size != MTOT * D || ws_size < WS_END + 2 * MiB) { fprintf(stderr, "kernel_launch: unexpected shapes n_in %d out %d ws %zu\n", n_in, out_size, ws_size); grid = -1; return; }
        int dev = 0, cus = 0, per_cu = 0;
        hipGetDevice(&dev); hipDeviceGetAttribute(&cus, hipDeviceAttributeMultiprocessorCount, dev);
        if (hipFuncSetAttribute((const void*)mega_fwd, hipFuncAttributeMaxDynamicSharedMemorySize, LDS_BYTES) != hipSuccess) { fprintf(stderr, "kernel_launch: LDS attribute failed\n"); grid = -1; return; }
        if (hipOccupancyMaxActiveBlocksPerMultiprocessor(&per_cu, (const void*)mega_fwd, NTHREADS, LDS_BYTES) != hipSuccess || per_cu < 1) per_cu = 1;
        (void)hipGetLastError();
        grid = cus * (per_cu > 1 ? 1 : per_cu);
    }
    if (grid < 0) return;
    hipMemsetAsync((char*)d_ws + WS_CTL, 0, 64 * 1024, stream);
    Args a{};
    for (int i = 0; i < 26; ++i) a.in[i] = (const float*)d_in[i];
    a.out = (float*)d_out; a.ws = (unsigned char*)d_ws; a.ph_lo = 0; a.ph_hi = NPHASE;
    void* args[] = {&a};
    hipError_t e = hipLaunchCooperativeKernel((const void*)mega_fwd, dim3(grid), dim3(NTHREADS), args, LDS_BYTES, stream);
    if (e != hipSuccess) fprintf(stderr, "cooperative launch failed: %s (grid %d)\n", hipGetErrorString(e), grid);
}
```
